# Optimizing an MI355X kernel written in HIP

```python
import jax, jax.numpy as jnp
from jax import lax
import numpy as np

D_MODEL = 2048
BATCH = 8
SEQ = 2048
DEPTH = 1

NORM_EPS = 1e-5
SWA_HEADS = 32
SWA_KV_HEADS = 4
SWA_HEAD_DIM = 64
SWA_WINDOW = 128
SWA_BLOCK = 128
GLA_HEADS = 4
GLA_DK = D_MODEL // (2 * GLA_HEADS)
GLA_DV = D_MODEL // GLA_HEADS
GLA_GATE_RANK = 16
GLA_TAU = 16.0
GLA_CHUNK = 64
N_EXPERTS = 32
TOP_K = 4
D_FF = D_MODEL
SWIGLU_LIMIT = 7.0
SWIGLU_ALPHA = 1.702
MOE_BLOCK = 128

SWA_Q = SWA_HEADS * SWA_HEAD_DIM
SWA_KV = SWA_KV_HEADS * SWA_HEAD_DIM
GLA_K = GLA_HEADS * GLA_DK
GLA_V = GLA_HEADS * GLA_DV
IN_SPLITS = (SWA_Q, SWA_KV, SWA_KV, GLA_K, GLA_K, GLA_V, GLA_V, GLA_GATE_RANK, D_MODEL, D_MODEL)
D_IN = SWA_Q + 2 * SWA_KV + 2 * GLA_K + 2 * GLA_V + GLA_GATE_RANK + 2 * D_MODEL

kernel_name = "hybrid_swa_gla_moe_block"


def rms_norm(x, g):
    xf = x.astype(jnp.float32)
    y = xf * lax.rsqrt(jnp.mean(xf * xf, axis=-1, keepdims=True) + NORM_EPS)
    return (y * g.astype(jnp.float32)).astype(x.dtype)


def alibi_slopes(n):
    return jnp.exp2(-8.0 * jnp.arange(1, n + 1, dtype=jnp.float32) / n)


def swa_attention(q, k, v, sinks):
    B, S = q.shape[0], q.shape[1]
    nb = S // SWA_BLOCK
    G = SWA_HEADS // SWA_KV_HEADS
    qb = q.reshape(B, nb, SWA_BLOCK, SWA_KV_HEADS, G, SWA_HEAD_DIM)

    def band(t):
        tb = t.reshape(B, nb, SWA_BLOCK, SWA_KV_HEADS, SWA_HEAD_DIM)
        prev = jnp.concatenate([jnp.zeros_like(tb[:, :1]), tb[:, :-1]], axis=1)
        return jnp.concatenate([prev, tb], axis=2)

    kb, vb = band(k), band(v)
    scores = jnp.einsum("bnqkgd,bnskd->bnkgqs", qb, kb).astype(jnp.float32) * (SWA_HEAD_DIM ** -0.5)
    r = jnp.arange(SWA_BLOCK)[:, None]
    j = jnp.arange(2 * SWA_BLOCK)[None, :]
    dist = r - j + SWA_BLOCK
    blk = jnp.arange(nb)[:, None, None]
    valid = (dist >= 0) & (dist < SWA_WINDOW) & (blk * SWA_BLOCK + j - SWA_BLOCK >= 0)
    slopes = alibi_slopes(SWA_HEADS).reshape(SWA_KV_HEADS, G)
    scores = scores - slopes[:, :, None, None] * dist.astype(jnp.float32)
    scores = jnp.where(valid[None, :, None, None], scores, -jnp.inf)
    sink = sinks.astype(jnp.float32).reshape(SWA_KV_HEADS, G)[:, :, None, None]
    m = jnp.maximum(jnp.max(scores, axis=-1, keepdims=True), sink)
    p = jnp.exp(scores - m)
    p = p / (jnp.sum(p, axis=-1, keepdims=True) + jnp.exp(sink - m))
    o = jnp.einsum("bnkgqs,bnskd->bnqkgd", p.astype(v.dtype), vb)
    return o.reshape(B, S, SWA_Q)


def gla_attention(q, k, v, log_a):
    B, S = q.shape[0], q.shape[1]
    nc = S // GLA_CHUNK
    f32 = jnp.float32

    def chunks(t):
        return t.astype(f32).reshape(B, nc, GLA_CHUNK, GLA_HEADS, t.shape[-1]).transpose(1, 0, 3, 2, 4)

    qc = chunks(q) * (GLA_DK ** -0.5)
    kc, vc = chunks(k), chunks(v)
    bc = jnp.cumsum(chunks(log_a), axis=3)
    causal = jnp.tril(jnp.ones((GLA_CHUNK, GLA_CHUNK), dtype=bool))

    def step(state, inp):
        q_, k_, v_, b_ = inp
        inter = jnp.einsum("bhtd,bhde->bhte", q_ * jnp.exp(b_), state)
        diff = jnp.where(causal[:, :, None], b_[:, :, :, None, :] - b_[:, :, None, :, :], -jnp.inf)
        att = jnp.einsum("bhtd,bhsd,bhtsd->bhts", q_, k_, jnp.exp(diff))
        intra = jnp.einsum("bhts,bhse->bhte", att, v_)
        b_last = b_[:, :, -1:, :]
        new_state = jnp.exp(b_last[:, :, 0, :, None]) * state + jnp.einsum(
            "bhsd,bhse->bhde", k_ * jnp.exp(b_last - b_), v_)
        return new_state, inter + intra

    state0 = jnp.zeros((B, GLA_HEADS, GLA_DK, GLA_DV), f32)
    _, o = lax.scan(step, state0, (qc, kc, vc, bc))
    return o.transpose(1, 0, 3, 2, 4).reshape(B, S, GLA_HEADS, GLA_DV).astype(v.dtype)


def moe_ffn(h, w_router, b_router, w_gate_up, b_gate_up, w_down, b_down):
    B, S, D = h.shape
    N = B * S
    A = N * TOP_K
    xf = h.reshape(N, D)
    logits = (xf @ w_router + b_router).astype(jnp.float32)
    top_val, top_idx = lax.top_k(logits, TOP_K)
    gates = jax.nn.softmax(top_val, axis=-1)
    eid = top_idx.reshape(A)
    order = jnp.argsort(eid)
    sorted_e = eid[order]
    token_of = order // TOP_K
    counts = jnp.bincount(eid, length=N_EXPERTS)
    padded = (counts + MOE_BLOCK - 1) // MOE_BLOCK * MOE_BLOCK
    offsets = jnp.cumsum(counts) - counts
    padded_ends = jnp.cumsum(padded)
    padded_offsets = padded_ends - padded
    pos = padded_offsets[sorted_e] + jnp.arange(A) - offsets[sorted_e]
    n_blocks = (A + N_EXPERTS * (MOE_BLOCK - 1) + MOE_BLOCK - 1) // MOE_BLOCK
    P = n_blocks * MOE_BLOCK
    x_pad = jnp.zeros((P, D), h.dtype).at[pos].set(xf[token_of])
    block_start = jnp.arange(n_blocks) * MOE_BLOCK
    block_e = jnp.minimum(jnp.sum(padded_ends[None, :] <= block_start[:, None], axis=1), N_EXPERTS - 1)

    def expert_block(args):
        xb, e = args
        gu = xb @ w_gate_up[e] + b_gate_up[e]
        glu, lin = gu[:, :D_FF], gu[:, D_FF:]
        glu = jnp.minimum(glu, SWIGLU_LIMIT)
        lin = jnp.clip(lin, -SWIGLU_LIMIT, SWIGLU_LIMIT)
        act = glu * jax.nn.sigmoid(SWIGLU_ALPHA * glu) * (lin + 1.0)
        return act @ w_down[e] + b_down[e]

    y_pad = lax.map(expert_block, (x_pad.reshape(n_blocks, MOE_BLOCK, D), block_e))
    y_sorted = y_pad.reshape(P, D)[pos] * gates.reshape(A)[order][:, None].astype(h.dtype)
    return jax.ops.segment_sum(y_sorted, token_of, num_segments=N).reshape(B, S, D)


def setup_inputs(seed: int = 0) -> dict:
    key = jax.random.key(seed)
    ks = jax.random.split(key, 17)
    L = DEPTH

    def nrm(k, shape, scale):
        return jax.random.normal(k, shape, jnp.float32) * scale

    return {
        "x": nrm(ks[0], (BATCH, SEQ, D_MODEL), 1.0),
        "attn_norm_g": 1.0 + nrm(ks[1], (L, D_MODEL), 0.02),
        "w_in": nrm(ks[2], (L, D_MODEL, D_IN), D_MODEL ** -0.5),
        "swa_sinks": nrm(ks[3], (L, SWA_HEADS), 0.5),
        "w_alpha2": nrm(ks[4], (L, GLA_GATE_RANK, GLA_K), GLA_GATE_RANK ** -0.5),
        "b_alpha": nrm(ks[5], (L, GLA_K), 0.5),
        "gla_norm_g": 1.0 + nrm(ks[6], (L, GLA_DV), 0.02),
        "w_out": nrm(ks[7], (L, D_MODEL, D_MODEL), D_MODEL ** -0.5),
        "ffn_norm_g": 1.0 + nrm(ks[8], (L, D_MODEL), 0.02),
        "w_router": nrm(ks[9], (L, D_MODEL, N_EXPERTS), D_MODEL ** -0.5),
        "b_router": nrm(ks[10], (L, N_EXPERTS), 0.01),
        "w_gate_up": nrm(ks[11], (L, N_EXPERTS, D_MODEL, 2 * D_FF), D_MODEL ** -0.5),
        "b_gate_up": nrm(ks[12], (L, N_EXPERTS, 2 * D_FF), 0.01),
        "w_down": nrm(ks[13], (L, N_EXPERTS, D_FF, D_MODEL), D_FF ** -0.5),
        "b_down": nrm(ks[14], (L, N_EXPERTS, D_MODEL), 0.01),
        "final_norm_g": 1.0 + nrm(ks[15], (D_MODEL,), 0.02),
    }


def reference(x, attn_norm_g, w_in, swa_sinks, w_alpha2, b_alpha, gla_norm_g, w_out,
              ffn_norm_g, w_router, b_router, w_gate_up, b_gate_up, w_down, b_down, final_norm_g):
    B, S = x.shape[0], x.shape[1]
    split_points = [int(p) for p in np.cumsum(IN_SPLITS)[:-1]]
    for l in range(DEPTH):
        h = rms_norm(x, attn_norm_g[l])
        q_a, k_a, v_a, q_b, k_b, v_b, r_b, a_lr, g_a, g_b = jnp.split(h @ w_in[l], split_points, axis=-1)
        o_a = swa_attention(q_a.reshape(B, S, SWA_HEADS, SWA_HEAD_DIM),
                            k_a.reshape(B, S, SWA_KV_HEADS, SWA_HEAD_DIM),
                            v_a.reshape(B, S, SWA_KV_HEADS, SWA_HEAD_DIM), swa_sinks[l])
        log_a = jax.nn.log_sigmoid((a_lr @ w_alpha2[l] + b_alpha[l]).astype(jnp.float32)) / GLA_TAU
        o_b = gla_attention(q_b.reshape(B, S, GLA_HEADS, GLA_DK),
                            k_b.reshape(B, S, GLA_HEADS, GLA_DK),
                            v_b.reshape(B, S, GLA_HEADS, GLA_DV),
                            log_a.reshape(B, S, GLA_HEADS, GLA_DK))
        o_b = rms_norm(o_b, gla_norm_g[l]).reshape(B, S, GLA_V) * jax.nn.silu(r_b)
        mix = (jax.nn.sigmoid(g_a) * o_a + jax.nn.sigmoid(g_b) * o_b) @ w_out[l]
        x = x + mix
        x = x + moe_ffn(rms_norm(x, ffn_norm_g[l]), w_router[l], b_router[l],
                        w_gate_up[l], b_gate_up[l], w_down[l], b_down[l])
    return rms_norm(x, final_norm_g)
```

```cpp
#define MK_N_LAUNCHES 1
#include <hip/hip_runtime.h>
#include <cstdio>
#include <cstdint>

#define DI __device__ __forceinline__
#define LAS __attribute__((address_space(3)))
#define GAS __attribute__((address_space(1)))
typedef unsigned short bf16_t;
typedef short bf16x8 __attribute__((ext_vector_type(8)));
typedef short s16x4 __attribute__((ext_vector_type(4)));
typedef float f32x4 __attribute__((ext_vector_type(4)));
typedef float f32x16 __attribute__((ext_vector_type(16)));
typedef unsigned u32x4 __attribute__((ext_vector_type(4)));
typedef unsigned u32x2 __attribute__((ext_vector_type(2)));
typedef float f32x2_t __attribute__((ext_vector_type(2)));
typedef __bf16 bf16x2_t __attribute__((ext_vector_type(2)));

DI unsigned pk_bf16(float lo, float hi) { f32x2_t v = {lo, hi}; bf16x2_t b = __builtin_convertvector(v, bf16x2_t); return __builtin_bit_cast(unsigned, b); }
DI float bf_lo(unsigned w) { return __uint_as_float(w << 16); }
DI float bf_hi(unsigned w) { return __uint_as_float(w & 0xffff0000u); }
DI float bf2f(bf16_t v) { return __uint_as_float(((unsigned)v) << 16); }
DI bf16_t f2bf(float f) { return (bf16_t)(pk_bf16(f, 0.f) & 0xffffu); }
DI float fast_exp(float x) { return __builtin_amdgcn_exp2f(x * 1.4426950408889634f); }
DI float fast_rcp(float x) { return __builtin_amdgcn_rcpf(x); }
DI float fast_sigmoid(float x) { return fast_rcp(1.0f + fast_exp(-x)); }
DI float wave_sum(float v) {
#pragma unroll
    for (int o = 1; o < 64; o <<= 1) v += __shfl_xor(v, o);
    return v;
}
DI int crow(int reg, int h) { return (reg & 3) + 8 * (reg >> 2) + 4 * h; }
#define MFMA32(a, b, c) __builtin_amdgcn_mfma_f32_32x32x16_bf16((a), (b), (c), 0, 0, 0)

namespace pg8 {
constexpr int BM = 256, BK = 64, HALF = 128, HTB = HALF * BK * 2  , STAGE_BYTES = 8 * HTB, NXCD = 8, WGM = 8;

DI int lds_byte(int r, int c) { const int st = (r >> 4) * 2 + (c >> 5), rr = r & 15, cc = c & 31, ob = rr * 64 + cc * 2; return st * 1024 + (ob ^ (((ob >> 9) & 1) << 5)); }
DI void stage_rc(int b, int& R, int& C) { const int st = b / 1024, sb = b % 1024, swz = sb ^ (((sb >> 9) & 1) << 5); R = (st >> 1) * 16 + swz / 64; C = (st & 1) * 32 + (swz % 64) / 2; }
DI int perm32(int rho) { const int n = rho >> 4, i = rho & 15; return 8 * (i >> 2) + 4 * n + (i & 3); }

struct Unit { int pm, pn, e, rb, nrow; };

struct StaticOrder {
    int nM, nN, nwg, G, c;
    DI void init(int M, int N, int G_, int c_) { nM = M / BM; nN = N / BM; nwg = nM * nN; G = G_; c = c_; }
    DI bool next(int i, int& pm, int& pn) const {
        const long L = (long)i * G + c; if (L >= nwg) return false;
        int wgid = (int)L; { const int q = nwg / NXCD, r = nwg % NXCD, xcd = wgid % NXCD, off = wgid / NXCD; wgid = (xcd < r ? xcd * (q + 1) : r * (q + 1) + (xcd - r) * q) + off; }
        const int nig = WGM * nN, gid = wgid / nig, fm = gid * WGM, gsz = (nM - fm) < WGM ? (nM - fm) : WGM;
        pm = fm + ((wgid % nig) % gsz); pn = (wgid % nig) / gsz; return true;
    }
};

struct DenseProb {
    const bf16_t* A; const bf16_t* Bt; int K; StaticOrder S;
    DI bool next(int i, Unit& u) const { int pm, pn; if (!S.next(i, pm, pn)) return false; u.pm = pm; u.pn = pn; u.e = 0; u.rb = 0; u.nrow = 256; return true; }
    DI const char* a_base(const Unit& u) const { return (const char*)A + (size_t)u.pm * 256 * K * 2; }
    DI const char* b_base(const Unit& u) const { return (const char*)Bt + (size_t)u.pn * 256 * K * 2; }
    DI void a_voff(const Unit&, const int (&R)[2], const int (&C)[2], unsigned (&v)[2][2]) const {
#pragma unroll
        for (int h = 0; h < 2; ++h)
#pragma unroll
            for (int i = 0; i < 2; ++i) v[h][i] = (unsigned)((h * HALF + R[i]) * K + C[i]) * 2u;
    }
};

template <class Prob, class Epi>
DI void gemm_phase(LAS unsigned char* lds, const Prob& P, const Epi& E) {
    const int tid = threadIdx.x, wid = __builtin_amdgcn_readfirstlane(tid >> 6), lane = tid & 63, wr = wid >> 2, wc = wid & 3, fr = lane & 15, fq = lane >> 4;
    const int K = P.K, nt = K / BK;
    int sR[2], sC[2]; unsigned voffB[2];
#pragma unroll
    for (int i = 0; i < 2; ++i) { int R, C; stage_rc(tid * 16 + i * 8192, R, C); const int Rb = Epi::PERM ? ((R & ~31) + perm32(R & 31)) : R; sR[i] = R; sC[i] = C; voffB[i] = (unsigned)(Rb * K + C) * 2u; }
    const size_t kstep = (size_t)(BK * 2);
    const size_t hstep = (size_t)HALF * K * 2;
    const unsigned ldsw = (unsigned)wid * 1024u;
    const int aoff = lds_byte(wr * 64 + fr, fq * 8), boff = lds_byte(wc * 32 + fr, fq * 8);
#define PG8_SA(b, h) (((b) * 2 + (h)) * HTB)
#define PG8_SB(b, h) ((4 + (b) * 2 + (h)) * HTB)
#define PG8_STAGE2(bufoff, gbase, v0, v1) do { \
        __builtin_amdgcn_global_load_lds((const unsigned*)((const char*)(gbase) + (v0)), (LAS unsigned*)(lds + (bufoff) + ldsw), 16, 0, 0); \
        __builtin_amdgcn_global_load_lds((const unsigned*)((const char*)(gbase) + (v1)), (LAS unsigned*)(lds + (bufoff) + ldsw + 8192), 16, 0, 0); } while (0)
#define PG8_STAGEB(bufoff, gbase) PG8_STAGE2(bufoff, gbase, voffB[0], voffB[1])
#define PG8_LDA(dst, b, h) do { _Pragma("unroll") for (int m = 0; m < 4; ++m) _Pragma("unroll") for (int k = 0; k < 2; ++k) dst[m][k] = *(const LAS bf16x8*)(lds + PG8_SA(b, h) + aoff + m * 2048 + k * 1024); } while (0)
#define PG8_LDB(dst, b, h) do { _Pragma("unroll") for (int n = 0; n < 2; ++n) _Pragma("unroll") for (int k = 0; k < 2; ++k) dst[n][k] = *(const LAS bf16x8*)(lds + PG8_SB(b, h) + boff + n * 2048 + k * 1024); } while (0)
#define PG8_MMA(ai, bj, At, Bt) do { __builtin_amdgcn_s_setprio(1); _Pragma("unroll") for (int m = 0; m < 4; ++m) _Pragma("unroll") for (int n = 0; n < 2; ++n) _Pragma("unroll") for (int k = 0; k < 2; ++k) \
        acc[ai][bj][m][n] = __builtin_amdgcn_mfma_f32_16x16x32_bf16(Bt[n][k], At[m][k], acc[ai][bj][m][n], 0, 0, 0); __builtin_amdgcn_s_setprio(0); } while (0)
#define PG8_WAIT_V(n) asm volatile("s_waitcnt vmcnt(" #n ")" ::: "memory")
#define PG8_WAIT_L(n) asm volatile("s_waitcnt lgkmcnt(" #n ")" ::: "memory")
#define PG8_BAR __builtin_amdgcn_s_barrier()
#define PG8_SCHED __builtin_amdgcn_sched_barrier(0)
    Unit cur, nxt; int ui = 0;
    if (!P.next(0, cur)) return;
    f32x4 acc[2][2][4][2];
#pragma unroll
    for (int a = 0; a < 2; ++a)
#pragma unroll
        for (int b = 0; b < 2; ++b)
#pragma unroll
            for (int m = 0; m < 4; ++m)
#pragma unroll
                for (int n = 0; n < 2; ++n) acc[a][b][m][n] = (f32x4){0.f, 0.f, 0.f, 0.f};
    bf16x8 At[4][2], B0[2][2], B1[2][2];
    const char* cA = P.a_base(cur); const char* cB = P.b_base(cur);
    unsigned vAc[2][2], vAn[2][2];
    P.a_voff(cur, sR, sC, vAc);
    PG8_STAGEB(PG8_SB(0, 0), cB); PG8_STAGEB(PG8_SB(0, 1), cB + hstep); PG8_STAGE2(PG8_SA(0, 0), cA, vAc[0][0], vAc[0][1]); PG8_STAGE2(PG8_SA(0, 1), cA, vAc[1][0], vAc[1][1]);
    if (wr == 1) PG8_BAR;
    PG8_WAIT_V(2); PG8_BAR;
    PG8_STAGEB(PG8_SB(1, 0), cB + kstep); PG8_STAGE2(PG8_SA(1, 0), cA + kstep, vAc[0][0], vAc[0][1]); PG8_STAGEB(PG8_SB(1, 1), cB + hstep + kstep);
    PG8_WAIT_V(6); PG8_BAR;
    for (;;) {
        const bool has_next = P.next(ui + 1, nxt);
        const char* nA = cA; const char* nB = cB;
        if (has_next) { nA = P.a_base(nxt); nB = P.b_base(nxt); P.a_voff(nxt, sR, sC, vAn); }
        else {
#pragma unroll
            for (int h = 0; h < 2; ++h)
#pragma unroll
                for (int i = 0; i < 2; ++i) vAn[h][i] = vAc[h][i];
        }
        for (int t = 0; t < nt; t += 2) {
            const bool last = (t == nt - 2);
            const char* a1 = cA + (size_t)(t + 1) * kstep;
            const char* a2 = last ? nA : cA + (size_t)(t + 2) * kstep; const char* b2 = last ? nB : cB + (size_t)(t + 2) * kstep;
            const char* a3 = a2 + kstep; const char* b3 = b2 + kstep;
            const unsigned w00 = last ? vAn[0][0] : vAc[0][0], w01 = last ? vAn[0][1] : vAc[0][1], w10 = last ? vAn[1][0] : vAc[1][0], w11 = last ? vAn[1][1] : vAc[1][1];
            PG8_LDB(B0, 0, 0); PG8_LDB(B1, 0, 1); PG8_SCHED; PG8_LDA(At, 0, 0); PG8_STAGE2(PG8_SA(1, 1), a1, vAc[1][0], vAc[1][1]);
            PG8_WAIT_V(8); PG8_WAIT_L(0); PG8_BAR; PG8_MMA(0, 0, At, B0); PG8_MMA(0, 1, At, B1); PG8_BAR; PG8_SCHED;
            PG8_LDA(At, 0, 1); PG8_STAGEB(PG8_SB(0, 0), b2); PG8_STAGEB(PG8_SB(0, 1), b2 + hstep); PG8_STAGE2(PG8_SA(0, 0), a2, w00, w01);
            PG8_WAIT_V(8); PG8_WAIT_L(0); PG8_BAR; PG8_MMA(1, 0, At, B0); PG8_MMA(1, 1, At, B1); PG8_BAR; PG8_SCHED;
            PG8_LDB(B0, 1, 0); PG8_LDB(B1, 1, 1); PG8_SCHED; PG8_LDA(At, 1, 0); PG8_STAGE2(PG8_SA(0, 1), a2, w10, w11);
            PG8_WAIT_V(8); PG8_WAIT_L(0); PG8_BAR; PG8_MMA(0, 0, At, B0); PG8_MMA(0, 1, At, B1); PG8_BAR; PG8_SCHED;
            PG8_LDA(At, 1, 1); PG8_STAGEB(PG8_SB(1, 0), b3); PG8_STAGEB(PG8_SB(1, 1), b3 + hstep); PG8_STAGE2(PG8_SA(1, 0), a3, w00, w01);
            PG8_WAIT_V(8); PG8_WAIT_L(0); PG8_BAR; PG8_MMA(1, 0, At, B0); PG8_MMA(1, 1, At, B1); PG8_BAR; PG8_SCHED;
        }
        if (wr == 0) PG8_BAR;
        E(acc, cur, wr, wc, fr, fq);
        if (!has_next) break;
#pragma unroll
        for (int a = 0; a < 2; ++a)
#pragma unroll
            for (int b = 0; b < 2; ++b)
#pragma unroll
                for (int m = 0; m < 4; ++m)
#pragma unroll
                    for (int n = 0; n < 2; ++n) acc[a][b][m][n] = (f32x4){0.f, 0.f, 0.f, 0.f};
        cur = nxt; cA = nA; cB = nB; ++ui;
#pragma unroll
        for (int h = 0; h < 2; ++h)
#pragma unroll
            for (int i = 0; i < 2; ++i) vAc[h][i] = vAn[h][i];
        if (wr == 1) PG8_BAR;
    }
    PG8_WAIT_V(0);
    PG8_BAR;
#undef PG8_SA
#undef PG8_SB
#undef PG8_STAGE2
#undef PG8_STAGEB
#undef PG8_LDA
#undef PG8_LDB
#undef PG8_MMA
#undef PG8_WAIT_V
#undef PG8_WAIT_L
#undef PG8_BAR
#undef PG8_SCHED
}
}
namespace pg8 {
struct EpiBf16Plain {
    static constexpr bool PERM = true;
    bf16_t* O; int ldc;
    DI void operator()(const f32x4 (&acc)[2][2][4][2], const Unit& u, int wr, int wc, int fr, int fq) const {
        const int row0 = u.pm * BM + wr * 64 + fr, col0 = u.pn * BM + wc * 32 + 8 * fq;
#pragma unroll
        for (int ai = 0; ai < 2; ++ai)
#pragma unroll
            for (int m = 0; m < 4; ++m) { bf16_t* rowp = O + (size_t)(row0 + ai * HALF + m * 16) * ldc + col0;
#pragma unroll
                for (int bj = 0; bj < 2; ++bj) { const f32x4 v0 = acc[ai][bj][m][0], v1 = acc[ai][bj][m][1];
                    u32x4 w; w.x = pk_bf16(v0[0], v0[1]); w.y = pk_bf16(v0[2], v0[3]); w.z = pk_bf16(v1[0], v1[1]); w.w = pk_bf16(v1[2], v1[3]);
                    *(u32x4*)(rowp + bj * HALF) = w; } }
    }
};
struct EpiResF32 {
    static constexpr bool PERM = false;
    const float* base; float* C; int ldc;
    DI void operator()(const f32x4 (&acc)[2][2][4][2], const Unit& u, int wr, int wc, int fr, int fq) const {
        const int row0 = u.pm * BM + wr * 64 + fr, col0 = u.pn * BM + wc * 32 + 4 * fq;
#pragma unroll
        for (int ai = 0; ai < 2; ++ai)
#pragma unroll
            for (int m = 0; m < 4; ++m) { const size_t off = (size_t)(row0 + ai * HALF + m * 16) * ldc + col0;
#pragma unroll
                for (int bj = 0; bj < 2; ++bj)
#pragma unroll
                    for (int n = 0; n < 2; ++n) { const f32x4 bs = *(const f32x4*)(base + off + bj * HALF + n * 16); *(f32x4*)(C + off + bj * HALF + n * 16) = bs + acc[ai][bj][m][n]; } }
    }
};
struct EpiGlu {
    static constexpr bool PERM = true;
    bf16_t* O; int ldc; const float* bias;
    DI void operator()(const f32x4 (&acc)[2][2][4][2], const Unit& u, int wr, int wc, int fr, int fq) const {
        const int row0 = u.pm * BM + wr * 64 + fr, colg = u.pn * HALF + wc * 32 + 8 * fq;
        const float* bg = bias + (size_t)u.e * 4096 + colg;
        f32x4 bgl[2], bln[2];
#pragma unroll
        for (int n = 0; n < 2; ++n) { bgl[n] = *(const f32x4*)(bg + 4 * n); bln[n] = *(const f32x4*)(bg + 2048 + 4 * n); }
#pragma unroll
        for (int ai = 0; ai < 2; ++ai)
#pragma unroll
            for (int m = 0; m < 4; ++m) { bf16_t* rowp = O + (size_t)(row0 + ai * HALF + m * 16) * ldc + colg;
                float r[8];
#pragma unroll
                for (int n = 0; n < 2; ++n)
#pragma unroll
                    for (int j = 0; j < 4; ++j) { float g = acc[ai][0][m][n][j] + bgl[n][j], l = acc[ai][1][m][n][j] + bln[n][j];
                        g = fminf(g, 7.0f); l = fminf(fmaxf(l, -7.0f), 7.0f);
                        r[4 * n + j] = g * fast_sigmoid(1.702f * g) * (l + 1.0f); }
                u32x4 w; w.x = pk_bf16(r[0], r[1]); w.y = pk_bf16(r[2], r[3]); w.z = pk_bf16(r[4], r[5]); w.w = pk_bf16(r[6], r[7]);
                *(u32x4*)rowp = w; }
    }
};
struct EpiBf16BiasE {
    static constexpr bool PERM = true;
    bf16_t* O; int ldc; const float* bias;
    DI void operator()(const f32x4 (&acc)[2][2][4][2], const Unit& u, int wr, int wc, int fr, int fq) const {
        const int row0 = u.pm * BM + wr * 64 + fr, col0 = u.pn * BM + wc * 32 + 8 * fq;
        const float* bp = bias + (size_t)u.e * 2048 + col0;
        f32x4 bv[2][2];
#pragma unroll
        for (int bj = 0; bj < 2; ++bj)
#pragma unroll
            for (int n = 0; n < 2; ++n) bv[bj][n] = *(const f32x4*)(bp + bj * HALF + 4 * n);
#pragma unroll
        for (int ai = 0; ai < 2; ++ai)
#pragma unroll
            for (int m = 0; m < 4; ++m) { bf16_t* rowp = O + (size_t)(row0 + ai * HALF + m * 16) * ldc + col0;
#pragma unroll
                for (int bj = 0; bj < 2; ++bj) { const f32x4 v0 = acc[ai][bj][m][0] + bv[bj][0], v1 = acc[ai][bj][m][1] + bv[bj][1];
                    u32x4 w; w.x = pk_bf16(v0[0], v0[1]); w.y = pk_bf16(v0[2], v0[3]); w.z = pk_bf16(v1[0], v1[1]); w.w = pk_bf16(v1[2], v1[3]);
                    *(u32x4*)(rowp + bj * HALF) = w; } }
    }
};
}
constexpr int NWAVES = 8;
constexpr int NTOK = 16384, DM = 2048, SEQ = 2048, NBATCH = 8;
constexpr int DIN = 12816, LDP = 13056;
constexpr int C_QA = 0, C_KA = 2048, C_VA = 2304, C_QB = 2560, C_KB = 3584, C_VB = 4608, C_RB = 6656, C_GA = 8704, C_GB = 10752, C_ALR = 12800;
constexpr int NEXP = 32, TOPK = 4, DFF = 2048;
constexpr int PMAX = 73728;
constexpr float EPS = 1e-5f;
constexpr float LOG2E = 1.4426950408889634f;

constexpr size_t MiB = 1u << 20;
constexpr size_t WS_CTL = 0, CTL_ZERO_BYTES = 1 * MiB;
constexpr size_t WS_TOPE = 1 * MiB;
constexpr size_t WS_TOPS = WS_TOPE + (size_t)NTOK * 4 * 4;
constexpr size_t WS_GATE = WS_TOPS + (size_t)NTOK * 4 * 4;
constexpr size_t WS_TOKL = WS_GATE + (size_t)NTOK * 4 * 4;
constexpr size_t WS_WIN  = 4 * MiB;
constexpr size_t WS_WOUT = WS_WIN + (size_t)LDP * DM * 2;
constexpr size_t WS_WGU  = WS_WOUT + (size_t)DM * DM * 2;
constexpr size_t WS_WDN  = WS_WGU + (size_t)NEXP * 4096 * DM * 2;
constexpr size_t WS_H    = WS_WDN + (size_t)NEXP * DM * DM * 2;
constexpr size_t WS_PROJ = WS_H + (size_t)NTOK * DM * 2;
constexpr size_t WS_OA   = WS_PROJ + (size_t)NTOK * LDP * 2;
constexpr size_t WS_OB   = WS_OA + (size_t)NTOK * DM * 2;
constexpr size_t WS_MIX  = WS_OB + (size_t)NTOK * DM * 2;
constexpr size_t WS_X1   = WS_MIX + (size_t)NTOK * DM * 2;
constexpr size_t WS_GQT  = WS_X1 + (size_t)NTOK * DM * 4;
constexpr size_t WS_GKT  = WS_GQT + (size_t)1024 * 16384 * 2;
constexpr size_t WS_GATT = WS_GKT + (size_t)1024 * 16384 * 2;
constexpr size_t WS_GDEC = WS_GATT + (size_t)1024 * 4096 * 2;
constexpr size_t WS_GVT  = WS_GDEC + (size_t)1024 * 256 * 4;
constexpr size_t WS_ACT  = WS_GVT + (size_t)1024 * 32768 * 2;
constexpr size_t WS_Y    = WS_ACT + (size_t)PMAX * DFF * 2;
constexpr size_t WS_END  = WS_Y + (size_t)PMAX * DM * 2;
static_assert(WS_TOKL + (size_t)NEXP * NTOK * 4 <= WS_WIN, "routing tables below the weight copies");
static_assert(WS_WIN % 256 == 0 && WS_WOUT % 256 == 0 && WS_WGU % 256 == 0 && WS_WDN % 256 == 0 && WS_H % 256 == 0 && WS_PROJ % 256 == 0 && WS_OA % 256 == 0 && WS_X1 % 256 == 0 &&
              WS_GQT % 256 == 0 && WS_GKT % 256 == 0 && WS_GATT % 256 == 0 && WS_GDEC % 256 == 0 && WS_GVT % 256 == 0 && WS_ACT % 256 == 0 && WS_Y % 256 == 0, "alignment");
constexpr int CW_TMO = 0, CW_CODE = 1;
constexpr int CW_BAR = 4096;
constexpr int CW_CNT = 8192;
constexpr int RING_OFF = 0, RING_BYTES = 131072;
constexpr int LDSCTL_OFF = RING_BYTES, MISC_OFF = LDSCTL_OFF + 320;
constexpr int TBL_OFF = LDSCTL_OFF + 1024;
constexpr int LDS_BYTES = 147456;
static_assert(MISC_OFF + 128 <= TBL_OFF && TBL_OFF + 4096 <= LDS_BYTES, "LDS map");

typedef GAS unsigned gu32;
#define RLX_AGENT __ATOMIC_RELAXED, __HIP_MEMORY_SCOPE_AGENT
#define LDS_WAIT() asm volatile("s_waitcnt lgkmcnt(0)" ::: "memory")
#define VM_WAIT() asm volatile("s_waitcnt vmcnt(0)" ::: "memory")

#define XB_TMO      128
#define XB_XCNT(j)  (256  + 64 * (j))
#define XB_XSUB(j)  (1280 + 64 * (j))
#define XB_XGEN(j)  (2304 + 64 * (j))
#define XB_TOP      3328
#define XB_TOPGEN   3392
#define XCD_BAR_WORDS 3456
#define XB_SPIN_CAP (1u << 18)

__device__ __forceinline__ unsigned xb_ld(unsigned* p)              { return __hip_atomic_load(p, __ATOMIC_RELAXED, __HIP_MEMORY_SCOPE_AGENT); }
__device__ __forceinline__ unsigned xb_add(unsigned* p, unsigned v) { return __hip_atomic_fetch_add(p, v, __ATOMIC_RELAXED, __HIP_MEMORY_SCOPE_AGENT); }
__device__ __forceinline__ unsigned xb_xcc_id() { return (unsigned)__builtin_amdgcn_s_getreg((3 << 11) | 20) & 0xFu; }
#define XB_SPIN(cond, bar) do { unsigned _sp = 0; while (cond) { __builtin_amdgcn_s_sleep(1); \
    if ((++_sp & 255u) == 0u) { if (xb_ld(&(bar)[XB_TMO])) break; if (_sp > XB_SPIN_CAP) { atomicAdd(&(bar)[XB_TMO], 1u); break; } } } } while (0)

struct XcdBarrier {
    unsigned* bar; unsigned x;
    volatile LAS unsigned* st;
};

__device__ __forceinline__ XcdBarrier xcd_barrier_post(unsigned* bar, volatile LAS unsigned* st) {
    XcdBarrier b; b.bar = bar; b.x = xb_xcc_id(); b.st = st;
    if (threadIdx.x == 0) (void)xb_add(&bar[XB_XCNT(b.x)], 1u);
    return b;
}
__device__ __forceinline__ void xcd_barrier_complete(unsigned* bar, unsigned x, unsigned& nloc, unsigned& nx) {
    const unsigned G = gridDim.x * gridDim.y * gridDim.z;
    unsigned sum, cnt, mine, sp = 0u;
    for (;;) {
        sum = 0u; cnt = 0u; mine = 0u;
#pragma unroll
        for (unsigned j = 0; j < 16; ++j) { const unsigned c = xb_ld(&bar[XB_XCNT(j)]); sum += c; cnt += (c > 0u) ? 1u : 0u; mine = (j == x) ? c : mine; }
        if (sum == G) break;
        __builtin_amdgcn_s_sleep(1);
        if ((++sp & 255u) == 0u) { if (xb_ld(&bar[XB_TMO])) break; if (sp > XB_SPIN_CAP) { atomicAdd(&bar[XB_TMO], 1u); break; } }
    }
    nloc = mine > 0u ? mine : 1u; nx = cnt > 0u ? cnt : 1u;
}

__device__ __forceinline__ void xcd_barrier(const XcdBarrier& b) {
    asm volatile("s_waitcnt vmcnt(0)" ::: "memory");
    __syncthreads();
    if (threadIdx.x == 0) {
        unsigned* bar = b.bar;
        __builtin_amdgcn_s_waitcnt(0);
        unsigned nloc = b.st[0], nx = b.st[1];
        if (nloc == 0u) { xcd_barrier_complete(bar, b.x, nloc, nx); b.st[0] = nloc; b.st[1] = nx; }
        const unsigned old = xb_add(&bar[XB_XSUB(b.x)], 1u);
        const unsigned gen = old / nloc;
        if (old + 1u == (gen + 1u) * nloc) {
            __builtin_amdgcn_fence(__ATOMIC_RELEASE, "agent");
            asm volatile("s_waitcnt vmcnt(0)" ::: "memory");
            const unsigned og = xb_add(&bar[XB_TOP], 1u);
            const unsigned tg = og / nx;
            if (og + 1u == (tg + 1u) * nx) xb_add(&bar[XB_TOPGEN], 1u);
            else XB_SPIN(xb_ld(&bar[XB_TOPGEN]) == tg, bar);
            __builtin_amdgcn_fence(__ATOMIC_ACQUIRE, "agent");
            xb_add(&bar[XB_XGEN(b.x)], 1u);
            asm volatile("s_waitcnt vmcnt(0)" ::: "memory");
        } else {
            XB_SPIN(xb_ld(&bar[XB_XGEN(b.x)]) == gen, bar);
            __builtin_amdgcn_fence(__ATOMIC_ACQUIRE, "agent");
            asm volatile("s_waitcnt vmcnt(0)" ::: "memory");
        }
    }
    __syncthreads();
}

struct Frame {
    LAS unsigned char* lds;
    gu32* ctl;
    int tid, lane, wave, vcu, G;
    const float *x, *attn_g, *w_in, *sinks, *w_alpha2, *b_alpha, *gla_g, *w_out, *ffn_g, *w_router, *b_router, *w_gu, *b_gu, *w_dn, *b_dn, *final_g;
    float* out;
    int *tope, *tops, *tokl; float* gate;
    bf16_t *Win, *Wout, *Wgu, *Wdn, *H, *PROJ, *OA, *OB, *MIX, *GQT, *GKT, *GATT, *GVT, *ACT, *Y;
    float *X1, *GDEC;
};
DI void p0_transpose_item(const float* Wsrc, int ldw, int srccol0, int nvalid, int k0, bf16_t* dst, int K, LAS float* scr, int lane) {
    const int krow = lane >> 3, n4 = lane & 7;
    const bool ok = 4 * n4 < nvalid;
#pragma unroll
    for (int i = 0; i < 8; ++i) { const int kk = 8 * i + krow; f32x4 v = (f32x4){0.f, 0.f, 0.f, 0.f};
        if (ok) v = *(const f32x4*)(Wsrc + (size_t)(k0 + kk) * ldw + srccol0 + 4 * n4);
        LAS float* d = scr + kk * 33 + 4 * n4; d[0] = v[0]; d[1] = v[1]; d[2] = v[2]; d[3] = v[3]; }
    LDS_WAIT(); asm volatile("" ::: "memory");
    const int c = lane & 7;
#pragma unroll
    for (int j = 0; j < 4; ++j) { const int n = (lane >> 3) + 8 * j; const LAS float* s = scr + (8 * c) * 33 + n;
        u32x4 o; o.x = pk_bf16(s[0 * 33], s[1 * 33]); o.y = pk_bf16(s[2 * 33], s[3 * 33]); o.z = pk_bf16(s[4 * 33], s[5 * 33]); o.w = pk_bf16(s[6 * 33], s[7 * 33]);
        *(u32x4*)(dst + (size_t)n * K + k0 + 8 * c) = o; }
    LDS_WAIT(); asm volatile("" ::: "memory");
}
DI void rms_row_to_bf16(const float* xrow, const float* g, bf16_t* orow, int lane) {
    const f32x4* xr = (const f32x4*)xrow + lane; const f32x4* gr = (const f32x4*)g + lane;
    f32x4 v[8]; float s = 0.f;
#pragma unroll
    for (int j = 0; j < 8; ++j) { v[j] = xr[64 * j]; s += (v[j].x * v[j].x + v[j].y * v[j].y) + (v[j].z * v[j].z + v[j].w * v[j].w); }
    const float r = 1.0f / sqrtf(wave_sum(s) * (1.f / DM) + EPS);
    u32x2* o8 = (u32x2*)orow + lane;
#pragma unroll
    for (int j = 0; j < 8; ++j) { const f32x4 gg = gr[64 * j]; u32x2 w; w.x = pk_bf16(v[j].x * r * gg.x, v[j].y * r * gg.y); w.y = pk_bf16(v[j].z * r * gg.z, v[j].w * r * gg.w); o8[64 * j] = w; }
}
DI void p0_prologue(Frame& F) {
    LAS float* scr = (LAS float*)(F.lds + RING_OFF + F.wave * 16384);
    const int gw = F.vcu * NWAVES + F.wave, NGW = F.G * NWAVES;
    constexpr int I_IN = 32 * 408, I_OUT = 32 * 64, I_GU = 32 * 32 * 128, I_DN = 32 * 32 * 64;
    constexpr int NITEMS = I_IN + I_OUT + I_GU + I_DN;
    for (int it = gw; it < NITEMS; it += NGW) {
        int r = it;
        if (r < I_IN) { const int kb = r / 408, nb = r % 408, n0 = 32 * nb; int sc = n0, nv = 32;
            if (n0 >= 8704 && n0 < 12800) sc = n0 + 16; else if (n0 == 12800) { sc = 8704; nv = 16; } else if (n0 > 12800) { sc = 0; nv = 0; }
            p0_transpose_item(F.w_in, DIN, sc, nv, 64 * kb, F.Win + (size_t)n0 * DM, DM, scr, F.lane); continue; }
        r -= I_IN;
        if (r < I_OUT) { const int kb = r / 64, nb = r % 64; p0_transpose_item(F.w_out, DM, 32 * nb, 32, 64 * kb, F.Wout + (size_t)(32 * nb) * DM, DM, scr, F.lane); continue; }
        r -= I_OUT;
        if (r < I_GU) { const int e = r / 4096, rr = r % 4096, kb = rr / 128, nb = rr % 128, n0 = 32 * nb, pn = n0 >> 8, i0 = n0 & 255;
            const int sc = (i0 < 128) ? (128 * pn + i0) : (2048 + 128 * pn + i0 - 128);
            p0_transpose_item(F.w_gu + (size_t)e * DM * 4096, 4096, sc, 32, 64 * kb, F.Wgu + ((size_t)e * 4096 + n0) * DM, DM, scr, F.lane); continue; }
        r -= I_GU;
        { const int e = r / 2048, rr = r % 2048, kb = rr / 64, nb = rr % 64;
            p0_transpose_item(F.w_dn + (size_t)e * DFF * DM, DM, 32 * nb, 32, 64 * kb, F.Wdn + ((size_t)e * DM + 32 * nb) * DFF, DFF, scr, F.lane); }
    }
    for (int m = gw; m < NTOK; m += NGW) rms_row_to_bf16(F.x + (size_t)m * DM, F.attn_g, F.H + (size_t)m * DM, F.lane);
}

DI s16x4 tr_read(const LAS unsigned char* p) { return __builtin_bit_cast(s16x4, __builtin_amdgcn_ds_read_tr16_b64_v4i16((LAS s16x4*)p)); }
DI bf16x8 pack8(const f32x16& x, int s) {
    u32x4 p; p.x = pk_bf16(x[8 * s + 0], x[8 * s + 1]); p.y = pk_bf16(x[8 * s + 2], x[8 * s + 3]); p.z = pk_bf16(x[8 * s + 4], x[8 * s + 5]); p.w = pk_bf16(x[8 * s + 6], x[8 * s + 7]);
    return __builtin_bit_cast(bf16x8, p);
}
DI void swa_phase(Frame& F) {
    LAS unsigned char* Ks = F.lds;
    LAS unsigned char* Vs = F.lds + 36864;
    const int lane = F.lane, w = F.wave, c31 = lane & 31, h = lane >> 5;
    const int i16 = lane & 15, q4 = i16 >> 2, p4 = i16 & 3, blk = (lane >> 4) & 1;
    for (int u = F.vcu; u < 512; u += F.G) {
        const int kh = u & 3, qb = (u >> 2) & 15, b = u >> 6;
        const size_t tokbase = (size_t)b * SEQ;
        const int pos0 = qb * 128 - 128;
#pragma unroll
        for (int i = 0; i < 4; ++i) { const int id = F.tid + 512 * i, row = id >> 3, ch = id & 7, pos = pos0 + row;
            u32x4 kv = (u32x4){0u, 0u, 0u, 0u}, vv = (u32x4){0u, 0u, 0u, 0u};
            if (pos >= 0) { const bf16_t* src = F.PROJ + (tokbase + pos) * LDP + C_KA + kh * 64 + ch * 8; kv = *(const u32x4*)src; vv = *(const u32x4*)(src + (C_VA - C_KA)); }
            *(LAS u32x4*)(Ks + row * 144 + ch * 16) = kv; *(LAS u32x4*)(Vs + row * 144 + ch * 16) = vv; }
        __syncthreads();
        const int head = kh * 8 + w;
        const float slope2 = __builtin_amdgcn_exp2f(-0.25f * (float)(head + 1)) * LOG2E;
        const float sink2 = F.sinks[head] * LOG2E;
        for (int qt = 0; qt < 4; ++qt) {
            const size_t qrow = tokbase + qb * 128 + qt * 32 + c31;
            bf16x8 bq[4];
#pragma unroll
            for (int ks = 0; ks < 4; ++ks) bq[ks] = *(const bf16x8*)(F.PROJ + qrow * LDP + C_QA + head * 64 + ks * 16 + h * 8);
            f32x16 S[5];
#pragma unroll
            for (int kt = 0; kt < 5; ++kt) { f32x16 acc;
#pragma unroll
                for (int i = 0; i < 16; ++i) acc[i] = 0.f;
#pragma unroll
                for (int ks = 0; ks < 4; ++ks) { const bf16x8 a = *(const LAS bf16x8*)(Ks + (32 * (qt + kt) + c31) * 144 + (ks * 16 + h * 8) * 2); acc = MFMA32(a, bq[ks], acc); }
                S[kt] = acc; }
            float mx = sink2;
#pragma unroll
            for (int kt = 0; kt < 5; ++kt)
#pragma unroll
                for (int i = 0; i < 16; ++i) { const int key = 32 * (qt + kt) + crow(i, h); const int dist = 32 * qt + c31 + 128 - key;
                    const bool valid = (dist >= 0) && (dist < 128) && (pos0 + key >= 0);
                    const float s = valid ? (S[kt][i] * (0.125f * LOG2E) - slope2 * (float)dist) : -INFINITY;
                    S[kt][i] = s; mx = fmaxf(mx, s); }
            mx = fmaxf(mx, __shfl_xor(mx, 32));
            float sum = 0.f;
#pragma unroll
            for (int kt = 0; kt < 5; ++kt)
#pragma unroll
                for (int i = 0; i < 16; ++i) { const float p = __builtin_amdgcn_exp2f(S[kt][i] - mx); S[kt][i] = p; sum += p; }
            sum += __shfl_xor(sum, 32); sum += __builtin_amdgcn_exp2f(sink2 - mx);
            const float inv = 1.0f / sum;
            f32x16 O[2];
#pragma unroll
            for (int dt = 0; dt < 2; ++dt)
#pragma unroll
                for (int i = 0; i < 16; ++i) O[dt][i] = 0.f;
#pragma unroll
            for (int kt = 0; kt < 5; ++kt)
#pragma unroll
                for (int s = 0; s < 2; ++s) { const bf16x8 bp = pack8(S[kt], s);
                    const int kb = 32 * (qt + kt) + 16 * s + 4 * h + q4;
#pragma unroll
                    for (int dt = 0; dt < 2; ++dt) { const LAS unsigned char* vp = Vs + kb * 144 + (32 * dt + 16 * blk + 4 * p4) * 2;
                        const s16x4 lo = tr_read(vp), hi = tr_read(vp + 8 * 144);
                        const bf16x8 a = __builtin_shufflevector(lo, hi, 0, 1, 2, 3, 4, 5, 6, 7);
                        O[dt] = MFMA32(a, bp, O[dt]); } }
            bf16_t* orow = F.OA + qrow * DM + head * 64 + 4 * h;
#pragma unroll
            for (int dt = 0; dt < 2; ++dt)
#pragma unroll
                for (int g4 = 0; g4 < 4; ++g4) { u32x2 wv; wv.x = pk_bf16(O[dt][4 * g4] * inv, O[dt][4 * g4 + 1] * inv); wv.y = pk_bf16(O[dt][4 * g4 + 2] * inv, O[dt][4 * g4 + 3] * inv);
                    *(u32x2*)(orow + 32 * dt + 8 * g4) = wv; }
        }
        __syncthreads();
    }
}

DI void gla_prep_phase(Frame& F) {
    LAS unsigned char* Qs = F.lds;
    LAS unsigned char* Kss = F.lds + 33792;
    LAS float* alr = (LAS float*)(F.lds + 67584);
    LAS float* tot = (LAS float*)(F.lds + 71680);
    const int tid = F.tid, lane = F.lane, w = F.wave, c31 = lane & 31, h = lane >> 5;
    for (int u = F.vcu; u < 1024; u += F.G) {
        const int hh = (u >> 5) & 3, b = u >> 7, c = u & 31;
        const size_t T0 = (size_t)b * SEQ + c * 64;
        if (tid < 128) { const int t = tid >> 1, hf = tid & 1; const u32x4 raw = *(const u32x4*)(F.PROJ + (T0 + t) * LDP + C_ALR + 8 * hf);
            LAS float* d = alr + t * 16 + 8 * hf;
            d[0] = bf_lo(raw.x); d[1] = bf_hi(raw.x); d[2] = bf_lo(raw.y); d[3] = bf_hi(raw.y); d[4] = bf_lo(raw.z); d[5] = bf_hi(raw.z); d[6] = bf_lo(raw.w); d[7] = bf_hi(raw.w); }
        __syncthreads();
        const int d = tid & 255, hf = tid >> 8;
        float w2[16];
#pragma unroll
        for (int r = 0; r < 16; ++r) w2[r] = F.w_alpha2[r * 1024 + hh * 256 + d];
        const float ba = F.b_alpha[hh * 256 + d];
        float bc[32]; float run = 0.f;
#pragma unroll
        for (int i = 0; i < 32; ++i) { const LAS f32x4* ar = (const LAS f32x4*)(alr + (32 * hf + i) * 16); float z = ba;
#pragma unroll
            for (int r4 = 0; r4 < 4; ++r4) { const f32x4 a = ar[r4]; z += a.x * w2[4 * r4] + a.y * w2[4 * r4 + 1] + a.z * w2[4 * r4 + 2] + a.w * w2[4 * r4 + 3]; }
            const float la = (fminf(z, 0.f) - __logf(1.0f + fast_exp(-fabsf(z)))) * (1.0f / 16.0f);
            run += la; bc[i] = run; }
        tot[hf * 256 + d] = run;
        __syncthreads();
        const float t0 = tot[d], t1 = tot[256 + d], blast = t0 + t1;
        if (hf) {
#pragma unroll
            for (int i = 0; i < 32; ++i) bc[i] += t0;
        } else F.GDEC[(size_t)u * 256 + d] = fast_exp(blast);
        const bf16_t* qsrc = F.PROJ + (T0 + 32 * hf) * LDP + C_QB + hh * 256 + d;
        unsigned kpk[16];
#pragma unroll
        for (int i2 = 0; i2 < 16; ++i2) { float kh2[2];
#pragma unroll
            for (int j = 0; j < 2; ++j) { const int i = 2 * i2 + j; const float q = bf2f(qsrc[(size_t)i * LDP]), k = bf2f(qsrc[(size_t)i * LDP + (C_KB - C_QB)]);
                const float e = fast_exp(bc[i]);
                *(LAS bf16_t*)(Qs + (32 * hf + i) * 528 + d * 2) = f2bf(q * e * 0.0625f);
                *(LAS bf16_t*)(Kss + (32 * hf + i) * 528 + d * 2) = f2bf(k * fast_exp(-bc[i]));
                kh2[j] = k * fast_exp(blast - bc[i]); }
            kpk[i2] = pk_bf16(kh2[0], kh2[1]); }
        { u32x4* dst = (u32x4*)(F.GKT + (size_t)u * 16384 + d * 64 + 32 * hf);
#pragma unroll
            for (int j = 0; j < 4; ++j) dst[j] = (u32x4){kpk[4 * j], kpk[4 * j + 1], kpk[4 * j + 2], kpk[4 * j + 3]}; }
        __syncthreads();
        if (w < 4) { const int m = w >> 1, n = w & 1; f32x16 acc;
#pragma unroll
            for (int i = 0; i < 16; ++i) acc[i] = 0.f;
#pragma unroll
            for (int ks = 0; ks < 16; ++ks) { const bf16x8 a = *(const LAS bf16x8*)(Qs + (32 * m + c31) * 528 + (16 * ks + 8 * h) * 2), bb = *(const LAS bf16x8*)(Kss + (32 * n + c31) * 528 + (16 * ks + 8 * h) * 2);
                acc = MFMA32(a, bb, acc); }
            bf16_t* ao = F.GATT + (size_t)u * 4096;
#pragma unroll
            for (int i = 0; i < 16; ++i) { const int t = 32 * m + crow(i, h), s = 32 * n + c31; ao[t * 64 + s] = f2bf(s <= t ? acc[i] : 0.f); }
        } else { const int t2 = tid - 256;
#pragma unroll
            for (int j = 0; j < 8; ++j) { const int id = t2 + 256 * j, row = id >> 5, ch = id & 31; *(u32x4*)(F.GQT + (size_t)u * 16384 + row * 256 + ch * 8) = *(const LAS u32x4*)(Qs + row * 528 + ch * 16); } }
        { const bf16_t* vsrc = F.PROJ + T0 * LDP + C_VB + hh * 512 + tid; u32x4* dst = (u32x4*)(F.GVT + (size_t)u * 32768 + tid * 64);
#pragma unroll
            for (int t8 = 0; t8 < 8; ++t8) { float v[8];
#pragma unroll
                for (int j = 0; j < 8; ++j) v[j] = bf2f(vsrc[(size_t)(8 * t8 + j) * LDP]);
                dst[t8] = (u32x4){pk_bf16(v[0], v[1]), pk_bf16(v[2], v[3]), pk_bf16(v[4], v[5]), pk_bf16(v[6], v[7])}; } }
        __syncthreads();
    }
}

DI void gla_scan_phase(Frame& F) {
    if (F.vcu >= 64) return;
    LAS unsigned char* Qs = F.lds;
    LAS unsigned char* KTs = F.lds + 33792;
    LAS unsigned char* ATs = F.lds + 70656;
    LAS float* DECs = (LAS float*)(F.lds + 79872);
    const int tid = F.tid, lane = F.lane, w = F.wave, c31 = lane & 31, h = lane >> 5;
    const int u = F.vcu, hf = u & 1, hh = (u >> 1) & 3, b = u >> 3;
    f32x16 S[8];
#pragma unroll
    for (int i = 0; i < 8; ++i)
#pragma unroll
        for (int j = 0; j < 16; ++j) S[i][j] = 0.f;
    const int vrow = hf * 256 + 32 * w + c31;
    for (int c = 0; c < 32; ++c) {
        const size_t item = (size_t)(b * 4 + hh) * 32 + c;
        const size_t T0 = (size_t)b * SEQ + c * 64;
#pragma unroll
        for (int j = 0; j < 4; ++j) { const int id = tid + 512 * j, row = id >> 5, ch = id & 31; *(LAS u32x4*)(Qs + row * 528 + ch * 16) = *(const u32x4*)(F.GQT + item * 16384 + row * 256 + ch * 8); }
#pragma unroll
        for (int j = 0; j < 4; ++j) { const int id = tid + 512 * j, row = id >> 3, ch = id & 7; *(LAS u32x4*)(KTs + row * 144 + ch * 16) = *(const u32x4*)(F.GKT + item * 16384 + row * 64 + ch * 8); }
        { const int row = tid >> 3, ch = tid & 7; *(LAS u32x4*)(ATs + row * 144 + ch * 16) = *(const u32x4*)(F.GATT + item * 4096 + row * 64 + ch * 8); }
        if (tid < 64) *(LAS f32x4*)(DECs + 4 * tid) = *(const f32x4*)(F.GDEC + item * 256 + 4 * tid);
        bf16x8 bv[4];
#pragma unroll
        for (int ks = 0; ks < 4; ++ks) bv[ks] = *(const bf16x8*)(F.GVT + item * 32768 + (size_t)vrow * 64 + 16 * ks + 8 * h);
        __syncthreads();
        f32x16 o[2];
#pragma unroll
        for (int m = 0; m < 2; ++m)
#pragma unroll
            for (int j = 0; j < 16; ++j) o[m][j] = 0.f;
#pragma unroll
        for (int i = 0; i < 8; ++i)
#pragma unroll
            for (int s = 0; s < 2; ++s) { const bf16x8 bs = pack8(S[i], s);
#pragma unroll
                for (int m = 0; m < 2; ++m) { const LAS unsigned char* ap = Qs + (32 * m + c31) * 528 + (32 * i + 16 * s + 4 * h) * 2;
                    const s16x4 lo = *(const LAS s16x4*)ap, hi = *(const LAS s16x4*)(ap + 16);
                    const bf16x8 a = __builtin_shufflevector(lo, hi, 0, 1, 2, 3, 4, 5, 6, 7);
                    o[m] = MFMA32(a, bs, o[m]); } }
#pragma unroll
        for (int ks = 0; ks < 4; ++ks)
#pragma unroll
            for (int m = 0; m < 2; ++m) { const bf16x8 a = *(const LAS bf16x8*)(ATs + (32 * m + c31) * 144 + (16 * ks + 8 * h) * 2); o[m] = MFMA32(a, bv[ks], o[m]); }
        { bf16_t* ob = F.OB + T0 * DM + hh * 512 + vrow;
#pragma unroll
            for (int m = 0; m < 2; ++m)
#pragma unroll
                for (int j = 0; j < 16; ++j) ob[(size_t)(32 * m + crow(j, h)) * DM] = f2bf(o[m][j]); }
#pragma unroll
        for (int i = 0; i < 8; ++i) {
#pragma unroll
            for (int g4 = 0; g4 < 4; ++g4) { const f32x4 dc = *(const LAS f32x4*)(DECs + 32 * i + 8 * g4 + 4 * h);
                S[i][4 * g4] *= dc.x; S[i][4 * g4 + 1] *= dc.y; S[i][4 * g4 + 2] *= dc.z; S[i][4 * g4 + 3] *= dc.w; }
#pragma unroll
            for (int ks = 0; ks < 4; ++ks) { const bf16x8 a = *(const LAS bf16x8*)(KTs + (32 * i + c31) * 144 + (16 * ks + 8 * h) * 2); S[i] = MFMA32(a, bv[ks], S[i]); } }
        __syncthreads();
    }
}

DI void merge_phase(Frame& F) {
    const int gw = F.vcu * NWAVES + F.wave, NGW = F.G * NWAVES, lane = F.lane;
    for (int m = gw; m < NTOK; m += NGW) {
        const bf16_t* pr = F.PROJ + (size_t)m * LDP;
#pragma unroll
        for (int j = 0; j < 4; ++j) { const int c0 = j * 512 + lane * 8;
            const u32x4 ob = *(const u32x4*)(F.OB + (size_t)m * DM + c0), oa = *(const u32x4*)(F.OA + (size_t)m * DM + c0);
            const u32x4 rb = *(const u32x4*)(pr + C_RB + c0), ga = *(const u32x4*)(pr + C_GA + c0), gb = *(const u32x4*)(pr + C_GB + c0);
            const f32x4 g0 = *(const f32x4*)(F.gla_g + lane * 8), g1 = *(const f32x4*)(F.gla_g + lane * 8 + 4);
            float vb[8] = {bf_lo(ob.x), bf_hi(ob.x), bf_lo(ob.y), bf_hi(ob.y), bf_lo(ob.z), bf_hi(ob.z), bf_lo(ob.w), bf_hi(ob.w)};
            const float va[8] = {bf_lo(oa.x), bf_hi(oa.x), bf_lo(oa.y), bf_hi(oa.y), bf_lo(oa.z), bf_hi(oa.z), bf_lo(oa.w), bf_hi(oa.w)};
            const float vr[8] = {bf_lo(rb.x), bf_hi(rb.x), bf_lo(rb.y), bf_hi(rb.y), bf_lo(rb.z), bf_hi(rb.z), bf_lo(rb.w), bf_hi(rb.w)};
            const float vga[8] = {bf_lo(ga.x), bf_hi(ga.x), bf_lo(ga.y), bf_hi(ga.y), bf_lo(ga.z), bf_hi(ga.z), bf_lo(ga.w), bf_hi(ga.w)};
            const float vgb[8] = {bf_lo(gb.x), bf_hi(gb.x), bf_lo(gb.y), bf_hi(gb.y), bf_lo(gb.z), bf_hi(gb.z), bf_lo(gb.w), bf_hi(gb.w)};
            const float gn[8] = {g0.x, g0.y, g0.z, g0.w, g1.x, g1.y, g1.z, g1.w};
            float ss = 0.f;
#pragma unroll
            for (int k = 0; k < 8; ++k) ss += vb[k] * vb[k];
            const float rn = 1.0f / sqrtf(wave_sum(ss) * (1.f / 512.f) + EPS);
            float r[8];
#pragma unroll
            for (int k = 0; k < 8; ++k) { const float obn = vb[k] * rn * gn[k]; const float sl = vr[k] * fast_sigmoid(vr[k]);
                r[k] = fast_sigmoid(vga[k]) * va[k] + fast_sigmoid(vgb[k]) * obn * sl; }
            *(u32x4*)(F.MIX + (size_t)m * DM + c0) = (u32x4){pk_bf16(r[0], r[1]), pk_bf16(r[2], r[3]), pk_bf16(r[4], r[5]), pk_bf16(r[6], r[7])}; }
    }
}

DI void router_phase(Frame& F) {
    LAS float* hs = (LAS float*)F.lds;
    LAS float* lg = (LAS float*)(F.lds + TBL_OFF);
    const int tid = F.tid, lane = F.lane, w = F.wave;
    for (int tile = F.vcu; tile < NTOK / 16; tile += F.G) {
        const int t0 = tile * 16;
#pragma unroll
        for (int q = 0; q < 2; ++q) { const int tl = 2 * w + q; const size_t m = (size_t)(t0 + tl);
            const f32x4* xr = (const f32x4*)(F.X1 + m * DM) + lane; const f32x4* gr = (const f32x4*)F.ffn_g + lane;
            f32x4 v[8]; float s = 0.f;
#pragma unroll
            for (int j = 0; j < 8; ++j) { v[j] = xr[64 * j]; s += (v[j].x * v[j].x + v[j].y * v[j].y) + (v[j].z * v[j].z + v[j].w * v[j].w); }
            const float r = 1.0f / sqrtf(wave_sum(s) * (1.f / DM) + EPS);
            u32x2* o8 = (u32x2*)(F.H + m * DM) + lane; LAS f32x4* hrow = (LAS f32x4*)(hs + tl * DM) + lane;
#pragma unroll
            for (int j = 0; j < 8; ++j) { const f32x4 gg = gr[64 * j]; f32x4 y; y.x = v[j].x * r * gg.x; y.y = v[j].y * r * gg.y; y.z = v[j].z * r * gg.z; y.w = v[j].w * r * gg.w;
                hrow[64 * j] = y; u32x2 wv; wv.x = pk_bf16(y.x, y.y); wv.y = pk_bf16(y.z, y.w); o8[64 * j] = wv; } }
        __syncthreads();
        { const int tl = tid >> 5, e = tid & 31; const LAS float* hr = hs + tl * DM; const float* wr_ = F.w_router + e;
            float a0 = 0.f, a1 = 0.f, a2 = 0.f, a3 = 0.f;
#pragma unroll 4
            for (int c = 0; c < DM; c += 4) { const f32x4 hv = *(const LAS f32x4*)(hr + c);
                a0 += hv.x * wr_[(size_t)(c + 0) * 32]; a1 += hv.y * wr_[(size_t)(c + 1) * 32]; a2 += hv.z * wr_[(size_t)(c + 2) * 32]; a3 += hv.w * wr_[(size_t)(c + 3) * 32]; }
            lg[tl * 32 + e] = ((a0 + a1) + (a2 + a3)) + F.b_router[e]; }
        __syncthreads();
        if (tid < 16) { const int m = t0 + tid; float v[32];
#pragma unroll
            for (int e = 0; e < 32; ++e) v[e] = lg[tid * 32 + e];
            float tv[4]; int ti[4];
#pragma unroll
            for (int k = 0; k < 4; ++k) { float best = -INFINITY; int bi = 0;
#pragma unroll
                for (int e = 0; e < 32; ++e) if (v[e] > best) { best = v[e]; bi = e; }
                tv[k] = best; ti[k] = bi;
#pragma unroll
                for (int e = 0; e < 32; ++e) v[e] = (e == bi) ? -INFINITY : v[e]; }
            const float e1 = fast_exp(tv[1] - tv[0]), e2 = fast_exp(tv[2] - tv[0]), e3 = fast_exp(tv[3] - tv[0]); const float inv = 1.0f / (1.0f + e1 + e2 + e3);
            const float gt[4] = {inv, e1 * inv, e2 * inv, e3 * inv};
#pragma unroll
            for (int k = 0; k < 4; ++k) { const unsigned slot = __hip_atomic_fetch_add((unsigned*)(F.ctl + CW_CNT + 64 * ti[k]), 1u, __ATOMIC_RELAXED, __HIP_MEMORY_SCOPE_AGENT);
                F.tokl[(size_t)ti[k] * NTOK + slot] = m; F.tope[m * 4 + k] = ti[k]; F.tops[m * 4 + k] = (int)slot; F.gate[m * 4 + k] = gt[k]; } }
        __syncthreads();
    }
}

DI void moe_tables(Frame& F) {
    LAS int* tb = (LAS int*)(F.lds + TBL_OFF);
    if (F.tid == 0) { int acc = 0;
        for (int e = 0; e < NEXP; ++e) { const int c = (int)__hip_atomic_load((unsigned*)(F.ctl + CW_CNT + 64 * e), __ATOMIC_RELAXED, __HIP_MEMORY_SCOPE_AGENT); tb[e] = acc; tb[40 + e] = c; acc += (c + 255) >> 8; }
        tb[32] = acc; }
    __syncthreads();
}
struct MoeProb {
    const bf16_t* A; const bf16_t* Bt; const int* tokl; const LAS int* tb; int K, NT  , brows  , G, c; bool gather;
    DI bool next(int i, pg8::Unit& u) const {
        const int L = i * G + c; const int nb = tb[32]; if (L >= nb * NT) return false;
        const int blk = L / NT, pn = L % NT; int e = 0;
        for (int j = 1; j < NEXP; ++j) e += (tb[j] <= blk) ? 1 : 0;
        const int rb = blk - tb[e]; int nr = tb[40 + e] - rb * 256; nr = nr > 256 ? 256 : nr;
        u.pm = blk; u.pn = pn; u.e = e; u.rb = rb; u.nrow = nr; return true;
    }
    DI const char* a_base(const pg8::Unit& u) const { return gather ? (const char*)A : (const char*)A + (size_t)u.pm * 256 * K * 2; }
    DI const char* b_base(const pg8::Unit& u) const { return (const char*)Bt + ((size_t)u.e * brows + (size_t)u.pn * 256) * K * 2; }
    DI void a_voff(const pg8::Unit& u, const int (&R)[2], const int (&C)[2], unsigned (&v)[2][2]) const {
#pragma unroll
        for (int h = 0; h < 2; ++h)
#pragma unroll
            for (int i = 0; i < 2; ++i) { const int r = h * 128 + R[i];
                if (gather) { int tok = 0; if (r < u.nrow) tok = tokl[(size_t)u.e * NTOK + u.rb * 256 + r]; v[h][i] = (unsigned)(tok * K + C[i]) * 2u; }
                else v[h][i] = (unsigned)(r * K + C[i]) * 2u; }
    }
};

DI void final_phase(Frame& F) {
    const LAS int* tb = (const LAS int*)(F.lds + TBL_OFF);
    const int gw = F.vcu * NWAVES + F.wave, NGW = F.G * NWAVES, lane = F.lane;
    for (int m = gw; m < NTOK; m += NGW) {
        const bf16_t* yr[4]; float gt[4];
#pragma unroll
        for (int k = 0; k < 4; ++k) { const int e = F.tope[m * 4 + k], sl = F.tops[m * 4 + k]; gt[k] = F.gate[m * 4 + k]; yr[k] = F.Y + ((size_t)tb[e] * 256 + sl) * DM; }
        float v[4][8]; float ss = 0.f;
#pragma unroll
        for (int j = 0; j < 4; ++j) { const int c0 = 8 * (lane + 64 * j);
            const f32x4 x0 = *(const f32x4*)(F.X1 + (size_t)m * DM + c0), x1 = *(const f32x4*)(F.X1 + (size_t)m * DM + c0 + 4);
            float a[8] = {x0.x, x0.y, x0.z, x0.w, x1.x, x1.y, x1.z, x1.w};
#pragma unroll
            for (int k = 0; k < 4; ++k) { const u32x4 y = *(const u32x4*)(yr[k] + c0);
                a[0] += gt[k] * bf_lo(y.x); a[1] += gt[k] * bf_hi(y.x); a[2] += gt[k] * bf_lo(y.y); a[3] += gt[k] * bf_hi(y.y);
                a[4] += gt[k] * bf_lo(y.z); a[5] += gt[k] * bf_hi(y.z); a[6] += gt[k] * bf_lo(y.w); a[7] += gt[k] * bf_hi(y.w); }
#pragma unroll
            for (int q = 0; q < 8; ++q) { v[j][q] = a[q]; ss += a[q] * a[q]; } }
        const float r = 1.0f / sqrtf(wave_sum(ss) * (1.f / DM) + EPS);
#pragma unroll
        for (int j = 0; j < 4; ++j) { const int c0 = 8 * (lane + 64 * j);
            const f32x4 g0 = *(const f32x4*)(F.final_g + c0), g1 = *(const f32x4*)(F.final_g + c0 + 4);
            *(f32x4*)(F.out + (size_t)m * DM + c0) = (f32x4){v[j][0] * r * g0.x, v[j][1] * r * g0.y, v[j][2] * r * g0.z, v[j][3] * r * g0.w};
            *(f32x4*)(F.out + (size_t)m * DM + c0 + 4) = (f32x4){v[j][4] * r * g1.x, v[j][5] * r * g1.y, v[j][6] * r * g1.z, v[j][7] * r * g1.w}; }
    }
}
#ifndef MK_N_LAUNCHES
#define MK_N_LAUNCHES 1
#endif
constexpr int N_PHASES = 10;
struct Args { const float* in[16]; float* out; unsigned char* ws; int ph_lo, ph_hi; };
static_assert(sizeof(Args) == 16 * 8 + 8 + 8 + 8, "Args has no padding");

__global__ void __launch_bounds__(NWAVES * 64, 2) fwd_kernel(Args args) {
    extern __shared__ __attribute__((aligned(16))) unsigned char lds_raw[];
    Frame F;
    F.lds = (LAS unsigned char*)lds_raw;
    F.tid = threadIdx.x; F.lane = F.tid & 63; F.wave = __builtin_amdgcn_readfirstlane(F.tid >> 6);
    F.G = gridDim.x; { const int bx = blockIdx.x; F.vcu = (F.G % 8 == 0) ? (bx % 8) * (F.G / 8) + bx / 8 : bx; }
    unsigned char* ws = args.ws;
    F.ctl = (gu32*)(ws + WS_CTL);
    F.x = args.in[0]; F.attn_g = args.in[1]; F.w_in = args.in[2]; F.sinks = args.in[3]; F.w_alpha2 = args.in[4]; F.b_alpha = args.in[5]; F.gla_g = args.in[6]; F.w_out = args.in[7];
    F.ffn_g = args.in[8]; F.w_router = args.in[9]; F.b_router = args.in[10]; F.w_gu = args.in[11]; F.b_gu = args.in[12]; F.w_dn = args.in[13]; F.b_dn = args.in[14]; F.final_g = args.in[15];
    F.out = args.out;
    F.tope = (int*)(ws + WS_TOPE); F.tops = (int*)(ws + WS_TOPS); F.gate = (float*)(ws + WS_GATE); F.tokl = (int*)(ws + WS_TOKL);
    F.Win = (bf16_t*)(ws + WS_WIN); F.Wout = (bf16_t*)(ws + WS_WOUT); F.Wgu = (bf16_t*)(ws + WS_WGU); F.Wdn = (bf16_t*)(ws + WS_WDN);
    F.H = (bf16_t*)(ws + WS_H); F.PROJ = (bf16_t*)(ws + WS_PROJ); F.OA = (bf16_t*)(ws + WS_OA); F.OB = (bf16_t*)(ws + WS_OB); F.MIX = (bf16_t*)(ws + WS_MIX);
    F.X1 = (float*)(ws + WS_X1); F.GQT = (bf16_t*)(ws + WS_GQT); F.GKT = (bf16_t*)(ws + WS_GKT); F.GATT = (bf16_t*)(ws + WS_GATT); F.GDEC = (float*)(ws + WS_GDEC); F.GVT = (bf16_t*)(ws + WS_GVT);
    F.ACT = (bf16_t*)(ws + WS_ACT); F.Y = (bf16_t*)(ws + WS_Y);
    for (int u = F.tid; u < (LDS_BYTES - LDSCTL_OFF) / 4; u += NWAVES * 64) ((LAS unsigned*)(F.lds + LDSCTL_OFF))[u] = 0u;
    __syncthreads();
    const int lo = args.ph_lo, hi = args.ph_hi;
    const bool use_bar = (hi - lo) > 1;
    XcdBarrier bar; bar.bar = (unsigned*)(F.ctl + CW_BAR); bar.x = 0; bar.st = nullptr;
    if (use_bar) bar = xcd_barrier_post((unsigned*)(F.ctl + CW_BAR), (volatile LAS unsigned*)(F.lds + MISC_OFF) + 8);
#define IN(k) (lo <= (k) && (k) < hi)
#define SEAM(k) do { if (IN(k) && IN((k) + 1)) xcd_barrier(bar); } while (0)

    if (IN(0)) { p0_prologue(F); }
    SEAM(0);
    if (IN(1)) {
        pg8::DenseProb P; P.A = F.H; P.Bt = F.Win; P.K = DM; P.S.init(NTOK, LDP, F.G, (int)blockIdx.x);
        pg8::EpiBf16Plain E{F.PROJ, LDP};
        pg8::gemm_phase(F.lds + RING_OFF, P, E);
    }
    SEAM(1);
    if (IN(2)) { swa_phase(F); gla_prep_phase(F); }
    SEAM(2);
    if (IN(3)) { gla_scan_phase(F); }
    SEAM(3);
    if (IN(4)) { merge_phase(F); }
    SEAM(4);
    if (IN(5)) {
        pg8::DenseProb P; P.A = F.MIX; P.Bt = F.Wout; P.K = DM; P.S.init(NTOK, DM, F.G, (int)blockIdx.x);
        pg8::EpiResF32 E{F.x, F.X1, DM};
        pg8::gemm_phase(F.lds + RING_OFF, P, E);
    }
    SEAM(5);
    if (IN(6)) { router_phase(F); }
    SEAM(6);
    if (IN(7)) {
        moe_tables(F);
        MoeProb P; P.A = F.H; P.Bt = F.Wgu; P.tokl = F.tokl; P.tb = (const LAS int*)(F.lds + TBL_OFF); P.K = DM; P.NT = 16; P.brows = 4096; P.G = F.G; P.c = (int)blockIdx.x; P.gather = true;
        pg8::EpiGlu E{F.ACT, DFF, F.b_gu};
        pg8::gemm_phase(F.lds + RING_OFF, P, E);
    }
    SEAM(7);
    if (IN(8)) {
        moe_tables(F);
        MoeProb P; P.A = F.ACT; P.Bt = F.Wdn; P.tokl = F.tokl; P.tb = (const LAS int*)(F.lds + TBL_OFF); P.K = DFF; P.NT = 8; P.brows = 2048; P.G = F.G; P.c = (int)blockIdx.x; P.gather = false;
        pg8::EpiBf16BiasE E{F.Y, DM, F.b_dn};
        pg8::gemm_phase(F.lds + RING_OFF, P, E);
    }
    SEAM(8);
    if (IN(9)) { moe_tables(F); final_phase(F); }
#undef IN
#undef SEAM
}

extern "C" void kernel_launch(void* const* d_in, const int* in_sizes, int n_in, void* d_out, int out_size, void* d_ws, size_t ws_size, hipStream_t stream) {
    static int grid = 0;
    if (grid == 0) {
        if (n_in != 16 || out_size != NTOK * DM || ws_size < WS_END) { fprintf(stderr, "kernel_launch: unexpected shapes (n_in %d, out %d, ws %zu, need %zu); nothing launched\n", n_in, out_size, ws_size, (size_t)WS_END); grid = -1; return; }
        int dev = 0, cus = 0, per_cu = 0;
        if (hipGetDevice(&dev) != hipSuccess || hipDeviceGetAttribute(&cus, hipDeviceAttributeMultiprocessorCount, dev) != hipSuccess) { fprintf(stderr, "kernel_launch: device query failed\n"); grid = -1; return; }
        if (hipFuncSetAttribute((const void*)fwd_kernel, hipFuncAttributeMaxDynamicSharedMemorySize, LDS_BYTES) != hipSuccess) { fprintf(stderr, "kernel_launch: hipFuncSetAttribute failed\n"); grid = -1; return; }
        if (hipOccupancyMaxActiveBlocksPerMultiprocessor(&per_cu, (const void*)fwd_kernel, NWAVES * 64, LDS_BYTES) != hipSuccess || per_cu < 1)
            fprintf(stderr, "kernel_launch: note: occupancy query reports %d workgroups per CU\n", per_cu);
        (void)hipGetLastError();
        grid = cus;
    }
    if (grid < 0) return;
    if (hipMemsetAsync((char*)d_ws + WS_CTL, 0, CTL_ZERO_BYTES, stream) != hipSuccess) { fprintf(stderr, "kernel_launch: hipMemsetAsync failed\n"); return; }
    Args a{};
    for (int i = 0; i < 16; ++i) a.in[i] = (const float*)d_in[i];
    a.out = (float*)d_out; a.ws = (unsigned char*)d_ws;
    if (MK_N_LAUNCHES == 1) { a.ph_lo = 0; a.ph_hi = N_PHASES; hipLaunchKernelGGL(fwd_kernel, dim3(grid), dim3(NWAVES * 64), LDS_BYTES, stream, a); }
    else for (int p = 0; p < N_PHASES; ++p) { a.ph_lo = p; a.ph_hi = p + 1; hipLaunchKernelGGL(fwd_kernel, dim3(grid), dim3(NWAVES * 64), LDS_BYTES, stream, a); }
    const hipError_t le = hipPeekAtLastError();
    if (le != hipSuccess) fprintf(stderr, "kernel_launch: launch failed: %s\n", hipGetErrorName(le));
}
```

```cpp
#define MK_N_LAUNCHES 1
#include <hip/hip_runtime.h>
#include <cstdio>
#include <cstdint>

#define DI __device__ __forceinline__
#define LAS __attribute__((address_space(3)))
#define GAS __attribute__((address_space(1)))
typedef unsigned short bf16_t;
typedef short bf16x8 __attribute__((ext_vector_type(8)));
typedef short s16x4 __attribute__((ext_vector_type(4)));
typedef float f32x4 __attribute__((ext_vector_type(4)));
typedef float f32x16 __attribute__((ext_vector_type(16)));
typedef unsigned u32x4 __attribute__((ext_vector_type(4)));
typedef unsigned u32x2 __attribute__((ext_vector_type(2)));
typedef float f32x2_t __attribute__((ext_vector_type(2)));
typedef __bf16 bf16x2_t __attribute__((ext_vector_type(2)));

DI unsigned pk_bf16(float lo, float hi) { f32x2_t v = {lo, hi}; bf16x2_t b = __builtin_convertvector(v, bf16x2_t); return __builtin_bit_cast(unsigned, b); }
DI float bf_lo(unsigned w) { return __uint_as_float(w << 16); }
DI float bf_hi(unsigned w) { return __uint_as_float(w & 0xffff0000u); }
DI float bf2f(bf16_t v) { return __uint_as_float(((unsigned)v) << 16); }
DI bf16_t f2bf(float f) { return (bf16_t)(pk_bf16(f, 0.f) & 0xffffu); }
DI float fast_exp(float x) { return __builtin_amdgcn_exp2f(x * 1.4426950408889634f); }
DI float fast_rcp(float x) { return __builtin_amdgcn_rcpf(x); }
DI float fast_sigmoid(float x) { return fast_rcp(1.0f + fast_exp(-x)); }
DI float wave_sum(float v) {
#pragma unroll
    for (int o = 1; o < 64; o <<= 1) v += __shfl_xor(v, o);
    return v;
}
DI int crow(int reg, int h) { return (reg & 3) + 8 * (reg >> 2) + 4 * h; }
#define MFMA32(a, b, c) __builtin_amdgcn_mfma_f32_32x32x16_bf16((a), (b), (c), 0, 0, 0)

namespace pg8 {
constexpr int BM = 256, BK = 64, HALF = 128, HTB = HALF * BK * 2  , STAGE_BYTES = 8 * HTB, NXCD = 8, WGM = 8;

DI int lds_byte(int r, int c) { const int st = (r >> 4) * 2 + (c >> 5), rr = r & 15, cc = c & 31, ob = rr * 64 + cc * 2; return st * 1024 + (ob ^ (((ob >> 9) & 1) << 5)); }
DI void stage_rc(int b, int& R, int& C) { const int st = b / 1024, sb = b % 1024, swz = sb ^ (((sb >> 9) & 1) << 5); R = (st >> 1) * 16 + swz / 64; C = (st & 1) * 32 + (swz % 64) / 2; }
DI int perm32(int rho) { const int n = rho >> 4, i = rho & 15; return 8 * (i >> 2) + 4 * n + (i & 3); }

struct Unit { int pm, pn, e, rb, nrow; };

struct StaticOrder {
    int nM, nN, nwg, G, c;
    DI void init(int M, int N, int G_, int c_) { nM = M / BM; nN = N / BM; nwg = nM * nN; G = G_; c = c_; }
    DI bool next(int i, int& pm, int& pn) const {
        const long L = (long)i * G + c; if (L >= nwg) return false;
        int wgid = (int)L; { const int q = nwg / NXCD, r = nwg % NXCD, xcd = wgid % NXCD, off = wgid / NXCD; wgid = (xcd < r ? xcd * (q + 1) : r * (q + 1) + (xcd - r) * q) + off; }
        const int nig = WGM * nN, gid = wgid / nig, fm = gid * WGM, gsz = (nM - fm) < WGM ? (nM - fm) : WGM;
        pm = fm + ((wgid % nig) % gsz); pn = (wgid % nig) / gsz; return true;
    }
};

struct DenseProb {
    const bf16_t* A; const bf16_t* Bt; int K; StaticOrder S;
    DI bool next(int i, Unit& u) const { int pm, pn; if (!S.next(i, pm, pn)) return false; u.pm = pm; u.pn = pn; u.e = 0; u.rb = 0; u.nrow = 256; return true; }
    DI const char* a_base(const Unit& u) const { return (const char*)A + (size_t)u.pm * 256 * K * 2; }
    DI const char* b_base(const Unit& u) const { return (const char*)Bt + (size_t)u.pn * 256 * K * 2; }
    DI void a_voff(const Unit&, const int (&R)[2], const int (&C)[2], unsigned (&v)[2][2]) const {
#pragma unroll
        for (int h = 0; h < 2; ++h)
#pragma unroll
            for (int i = 0; i < 2; ++i) v[h][i] = (unsigned)((h * HALF + R[i]) * K + C[i]) * 2u;
    }
};

template <class Prob, class Epi>
DI void gemm_phase(LAS unsigned char* lds, const Prob& P, const Epi& E) {
    const int tid = threadIdx.x, wid = __builtin_amdgcn_readfirstlane(tid >> 6), lane = tid & 63, wr = wid >> 2, wc = wid & 3, fr = lane & 15, fq = lane >> 4;
    const int K = P.K, nt = K / BK;
    int sR[2], sC[2]; unsigned voffB[2];
#pragma unroll
    for (int i = 0; i < 2; ++i) { int R, C; stage_rc(tid * 16 + i * 8192, R, C); const int Rb = Epi::PERM ? ((R & ~31) + perm32(R & 31)) : R; sR[i] = R; sC[i] = C; voffB[i] = (unsigned)(Rb * K + C) * 2u; }
    const size_t kstep = (size_t)(BK * 2);
    const size_t hstep = (size_t)HALF * K * 2;
    const unsigned ldsw = (unsigned)wid * 1024u;
    const int aoff = lds_byte(wr * 64 + fr, fq * 8), boff = lds_byte(wc * 32 + fr, fq * 8);
#define PG8_SA(b, h) (((b) * 2 + (h)) * HTB)
#define PG8_SB(b, h) ((4 + (b) * 2 + (h)) * HTB)
#define PG8_STAGE2(bufoff, gbase, v0, v1) do { \
        __builtin_amdgcn_global_load_lds((const unsigned*)((const char*)(gbase) + (v0)), (LAS unsigned*)(lds + (bufoff) + ldsw), 16, 0, 0); \
        __builtin_amdgcn_global_load_lds((const unsigned*)((const char*)(gbase) + (v1)), (LAS unsigned*)(lds + (bufoff) + ldsw + 8192), 16, 0, 0); } while (0)
#define PG8_STAGEB(bufoff, gbase) PG8_STAGE2(bufoff, gbase, voffB[0], voffB[1])
#define PG8_LDA(dst, b, h) do { _Pragma("unroll") for (int m = 0; m < 4; ++m) _Pragma("unroll") for (int k = 0; k < 2; ++k) dst[m][k] = *(const LAS bf16x8*)(lds + PG8_SA(b, h) + aoff + m * 2048 + k * 1024); } while (0)
#define PG8_LDB(dst, b, h) do { _Pragma("unroll") for (int n = 0; n < 2; ++n) _Pragma("unroll") for (int k = 0; k < 2; ++k) dst[n][k] = *(const LAS bf16x8*)(lds + PG8_SB(b, h) + boff + n * 2048 + k * 1024); } while (0)
#define PG8_MMA(ai, bj, At, Bt) do { __builtin_amdgcn_s_setprio(1); _Pragma("unroll") for (int m = 0; m < 4; ++m) _Pragma("unroll") for (int n = 0; n < 2; ++n) _Pragma("unroll") for (int k = 0; k < 2; ++k) \
        acc[ai][bj][m][n] = __builtin_amdgcn_mfma_f32_16x16x32_bf16(Bt[n][k], At[m][k], acc[ai][bj][m][n], 0, 0, 0); __builtin_amdgcn_s_setprio(0); } while (0)
#define PG8_WAIT_V(n) asm volatile("s_waitcnt vmcnt(" #n ")" ::: "memory")
#define PG8_WAIT_L(n) asm volatile("s_waitcnt lgkmcnt(" #n ")" ::: "memory")
#define PG8_BAR __builtin_amdgcn_s_barrier()
#define PG8_SCHED __builtin_amdgcn_sched_barrier(0)
    Unit cur, nxt; int ui = 0;
    if (!P.next(0, cur)) return;
    f32x4 acc[2][2][4][2];
#pragma unroll
    for (int a = 0; a < 2; ++a)
#pragma unroll
        for (int b = 0; b < 2; ++b)
#pragma unroll
            for (int m = 0; m < 4; ++m)
#pragma unroll
                for (int n = 0; n < 2; ++n) acc[a][b][m][n] = (f32x4){0.f, 0.f, 0.f, 0.f};
    bf16x8 At[4][2], B0[2][2], B1[2][2];
    const char* cA = P.a_base(cur); const char* cB = P.b_base(cur);
    unsigned vAc[2][2], vAn[2][2];
    P.a_voff(cur, sR, sC, vAc);
    PG8_STAGEB(PG8_SB(0, 0), cB); PG8_STAGEB(PG8_SB(0, 1), cB + hstep); PG8_STAGE2(PG8_SA(0, 0), cA, vAc[0][0], vAc[0][1]); PG8_STAGE2(PG8_SA(0, 1), cA, vAc[1][0], vAc[1][1]);
    if (wr == 1) PG8_BAR;
    PG8_WAIT_V(2); PG8_BAR;
    PG8_STAGEB(PG8_SB(1, 0), cB + kstep); PG8_STAGE2(PG8_SA(1, 0), cA + kstep, vAc[0][0], vAc[0][1]); PG8_STAGEB(PG8_SB(1, 1), cB + hstep + kstep);
    PG8_WAIT_V(6); PG8_BAR;
    for (;;) {
        const bool has_next = P.next(ui + 1, nxt);
        const char* nA = cA; const char* nB = cB;
        if (has_next) { nA = P.a_base(nxt); nB = P.b_base(nxt); P.a_voff(nxt, sR, sC, vAn); }
        else {
#pragma unroll
            for (int h = 0; h < 2; ++h)
#pragma unroll
                for (int i = 0; i < 2; ++i) vAn[h][i] = vAc[h][i];
        }
        for (int t = 0; t < nt; t += 2) {
            const bool last = (t == nt - 2);
            const char* a1 = cA + (size_t)(t + 1) * kstep;
            const char* a2 = last ? nA : cA + (size_t)(t + 2) * kstep; const char* b2 = last ? nB : cB + (size_t)(t + 2) * kstep;
            const char* a3 = a2 + kstep; const char* b3 = b2 + kstep;
            const unsigned w00 = last ? vAn[0][0] : vAc[0][0], w01 = last ? vAn[0][1] : vAc[0][1], w10 = last ? vAn[1][0] : vAc[1][0], w11 = last ? vAn[1][1] : vAc[1][1];
            PG8_LDB(B0, 0, 0); PG8_LDB(B1, 0, 1); PG8_SCHED; PG8_LDA(At, 0, 0); PG8_STAGE2(PG8_SA(1, 1), a1, vAc[1][0], vAc[1][1]);
            PG8_WAIT_V(8); PG8_WAIT_L(0); PG8_BAR; PG8_MMA(0, 0, At, B0); PG8_MMA(0, 1, At, B1); PG8_BAR; PG8_SCHED;
            PG8_LDA(At, 0, 1); PG8_STAGEB(PG8_SB(0, 0), b2); PG8_STAGEB(PG8_SB(0, 1), b2 + hstep); PG8_STAGE2(PG8_SA(0, 0), a2, w00, w01);
            PG8_WAIT_V(8); PG8_WAIT_L(0); PG8_BAR; PG8_MMA(1, 0, At, B0); PG8_MMA(1, 1, At, B1); PG8_BAR; PG8_SCHED;
            PG8_LDB(B0, 1, 0); PG8_LDB(B1, 1, 1); PG8_SCHED; PG8_LDA(At, 1, 0); PG8_STAGE2(PG8_SA(0, 1), a2, w10, w11);
            PG8_WAIT_V(8); PG8_WAIT_L(0); PG8_BAR; PG8_MMA(0, 0, At, B0); PG8_MMA(0, 1, At, B1); PG8_BAR; PG8_SCHED;
            PG8_LDA(At, 1, 1); PG8_STAGEB(PG8_SB(1, 0), b3); PG8_STAGEB(PG8_SB(1, 1), b3 + hstep); PG8_STAGE2(PG8_SA(1, 0), a3, w00, w01);
            PG8_WAIT_V(8); PG8_WAIT_L(0); PG8_BAR; PG8_MMA(1, 0, At, B0); PG8_MMA(1, 1, At, B1); PG8_BAR; PG8_SCHED;
        }
        if (wr == 0) PG8_BAR;
        E(acc, cur, wr, wc, fr, fq);
        if (!has_next) break;
#pragma unroll
        for (int a = 0; a < 2; ++a)
#pragma unroll
            for (int b = 0; b < 2; ++b)
#pragma unroll
                for (int m = 0; m < 4; ++m)
#pragma unroll
                    for (int n = 0; n < 2; ++n) acc[a][b][m][n] = (f32x4){0.f, 0.f, 0.f, 0.f};
        cur = nxt; cA = nA; cB = nB; ++ui;
#pragma unroll
        for (int h = 0; h < 2; ++h)
#pragma unroll
            for (int i = 0; i < 2; ++i) vAc[h][i] = vAn[h][i];
        if (wr == 1) PG8_BAR;
    }
    PG8_WAIT_V(0);
    PG8_BAR;
#undef PG8_SA
#undef PG8_SB
#undef PG8_STAGE2
#undef PG8_STAGEB
#undef PG8_LDA
#undef PG8_LDB
#undef PG8_MMA
#undef PG8_WAIT_V
#undef PG8_WAIT_L
#undef PG8_BAR
#undef PG8_SCHED
}
}
namespace pg8 {
struct EpiBf16Plain {
    static constexpr bool PERM = true;
    bf16_t* O; int ldc;
    DI void operator()(const f32x4 (&acc)[2][2][4][2], const Unit& u, int wr, int wc, int fr, int fq) const {
        const int row0 = u.pm * BM + wr * 64 + fr, col0 = u.pn * BM + wc * 32 + 8 * fq;
#pragma unroll
        for (int ai = 0; ai < 2; ++ai)
#pragma unroll
            for (int m = 0; m < 4; ++m) { bf16_t* rowp = O + (size_t)(row0 + ai * HALF + m * 16) * ldc + col0;
#pragma unroll
                for (int bj = 0; bj < 2; ++bj) { const f32x4 v0 = acc[ai][bj][m][0], v1 = acc[ai][bj][m][1];
                    u32x4 w; w.x = pk_bf16(v0[0], v0[1]); w.y = pk_bf16(v0[2], v0[3]); w.z = pk_bf16(v1[0], v1[1]); w.w = pk_bf16(v1[2], v1[3]);
                    *(u32x4*)(rowp + bj * HALF) = w; } }
    }
};
struct EpiResF32 {
    static constexpr bool PERM = false;
    const float* base; float* C; int ldc;
    DI void operator()(const f32x4 (&acc)[2][2][4][2], const Unit& u, int wr, int wc, int fr, int fq) const {
        const int row0 = u.pm * BM + wr * 64 + fr, col0 = u.pn * BM + wc * 32 + 4 * fq;
#pragma unroll
        for (int ai = 0; ai < 2; ++ai)
#pragma unroll
            for (int m = 0; m < 4; ++m) { const size_t off = (size_t)(row0 + ai * HALF + m * 16) * ldc + col0;
#pragma unroll
                for (int bj = 0; bj < 2; ++bj)
#pragma unroll
                    for (int n = 0; n < 2; ++n) { const f32x4 bs = *(const f32x4*)(base + off + bj * HALF + n * 16); *(f32x4*)(C + off + bj * HALF + n * 16) = bs + acc[ai][bj][m][n]; } }
    }
};
struct EpiGlu {
    static constexpr bool PERM = true;
    bf16_t* O; int ldc; const float* bias;
    DI void operator()(const f32x4 (&acc)[2][2][4][2], const Unit& u, int wr, int wc, int fr, int fq) const {
        const int row0 = u.pm * BM + wr * 64 + fr, colg = u.pn * HALF + wc * 32 + 8 * fq;
        const float* bg = bias + (size_t)u.e * 4096 + colg;
        f32x4 bgl[2], bln[2];
#pragma unroll
        for (int n = 0; n < 2; ++n) { bgl[n] = *(const f32x4*)(bg + 4 * n); bln[n] = *(const f32x4*)(bg + 2048 + 4 * n); }
#pragma unroll
        for (int ai = 0; ai < 2; ++ai)
#pragma unroll
            for (int m = 0; m < 4; ++m) { bf16_t* rowp = O + (size_t)(row0 + ai * HALF + m * 16) * ldc + colg;
                float r[8];
#pragma unroll
                for (int n = 0; n < 2; ++n)
#pragma unroll
                    for (int j = 0; j < 4; ++j) { float g = acc[ai][0][m][n][j] + bgl[n][j], l = acc[ai][1][m][n][j] + bln[n][j];
                        g = fminf(g, 7.0f); l = fminf(fmaxf(l, -7.0f), 7.0f);
                        r[4 * n + j] = g * fast_sigmoid(1.702f * g) * (l + 1.0f); }
                u32x4 w; w.x = pk_bf16(r[0], r[1]); w.y = pk_bf16(r[2], r[3]); w.z = pk_bf16(r[4], r[5]); w.w = pk_bf16(r[6], r[7]);
                *(u32x4*)rowp = w; }
    }
};
struct EpiBf16BiasE {
    static constexpr bool PERM = true;
    bf16_t* O; int ldc; const float* bias;
    DI void operator()(const f32x4 (&acc)[2][2][4][2], const Unit& u, int wr, int wc, int fr, int fq) const {
        const int row0 = u.pm * BM + wr * 64 + fr, col0 = u.pn * BM + wc * 32 + 8 * fq;
        const float* bp = bias + (size_t)u.e * 2048 + col0;
        f32x4 bv[2][2];
#pragma unroll
        for (int bj = 0; bj < 2; ++bj)
#pragma unroll
            for (int n = 0; n < 2; ++n) bv[bj][n] = *(const f32x4*)(bp + bj * HALF + 4 * n);
#pragma unroll
        for (int ai = 0; ai < 2; ++ai)
#pragma unroll
            for (int m = 0; m < 4; ++m) { bf16_t* rowp = O + (size_t)(row0 + ai * HALF + m * 16) * ldc + col0;
#pragma unroll
                for (int bj = 0; bj < 2; ++bj) { const f32x4 v0 = acc[ai][bj][m][0] + bv[bj][0], v1 = acc[ai][bj][m][1] + bv[bj][1];
                    u32x4 w; w.x = pk_bf16(v0[0], v0[1]); w.y = pk_bf16(v0[2], v0[3]); w.z = pk_bf16(v1[0], v1[1]); w.w = pk_bf16(v1[2], v1[3]);
                    *(u32x4*)(rowp + bj * HALF) = w; } }
    }
};
}
constexpr int NWAVES = 8;
constexpr int NTOK = 16384, DM = 2048, SEQ = 2048, NBATCH = 8;
constexpr int DIN = 12816, LDP = 13056;
constexpr int C_QA = 0, C_KA = 2048, C_VA = 2304, C_QB = 2560, C_KB = 3584, C_VB = 4608, C_RB = 6656, C_GA = 8704, C_GB = 10752, C_ALR = 12800;
constexpr int NEXP = 32, TOPK = 4, DFF = 2048;
constexpr int PMAX = 73728;
constexpr float EPS = 1e-5f;
constexpr float LOG2E = 1.4426950408889634f;

constexpr size_t MiB = 1u << 20;
constexpr size_t WS_CTL = 0, CTL_ZERO_BYTES = 1 * MiB;
constexpr size_t WS_TOPE = 1 * MiB;
constexpr size_t WS_TOPS = WS_TOPE + (size_t)NTOK * 4 * 4;
constexpr size_t WS_GATE = WS_TOPS + (size_t)NTOK * 4 * 4;
constexpr size_t WS_TOKL = WS_GATE + (size_t)NTOK * 4 * 4;
constexpr size_t WS_WIN  = 4 * MiB;
constexpr size_t WS_WOUT = WS_WIN + (size_t)LDP * DM * 2;
constexpr size_t WS_WGU  = WS_WOUT + (size_t)DM * DM * 2;
constexpr size_t WS_WDN  = WS_WGU + (size_t)NEXP * 4096 * DM * 2;
constexpr size_t WS_H    = WS_WDN + (size_t)NEXP * DM * DM * 2;
constexpr size_t WS_PROJ = WS_H + (size_t)NTOK * DM * 2;
constexpr size_t WS_OA   = WS_PROJ + (size_t)NTOK * LDP * 2;
constexpr size_t WS_OB   = WS_OA + (size_t)NTOK * DM * 2;
constexpr size_t WS_MIX  = WS_OB + (size_t)NTOK * DM * 2;
constexpr size_t WS_X1   = WS_MIX + (size_t)NTOK * DM * 2;
constexpr size_t WS_GQT  = WS_X1 + (size_t)NTOK * DM * 4;
constexpr size_t WS_GKT  = WS_GQT + (size_t)1024 * 16384 * 2;
constexpr size_t WS_GATT = WS_GKT + (size_t)1024 * 16384 * 2;
constexpr size_t WS_GDEC = WS_GATT + (size_t)1024 * 4096 * 2;
constexpr size_t WS_GVT  = WS_GDEC + (size_t)1024 * 256 * 4;
constexpr size_t WS_ACT  = WS_GVT + (size_t)1024 * 32768 * 2;
constexpr size_t WS_Y    = WS_ACT + (size_t)PMAX * DFF * 2;
constexpr size_t WS_END  = WS_Y + (size_t)PMAX * DM * 2;
static_assert(WS_TOKL + (size_t)NEXP * NTOK * 4 <= WS_WIN, "routing tables below the weight copies");
static_assert(WS_WIN % 256 == 0 && WS_WOUT % 256 == 0 && WS_WGU % 256 == 0 && WS_WDN % 256 == 0 && WS_H % 256 == 0 && WS_PROJ % 256 == 0 && WS_OA % 256 == 0 && WS_X1 % 256 == 0 &&
              WS_GQT % 256 == 0 && WS_GKT % 256 == 0 && WS_GATT % 256 == 0 && WS_GDEC % 256 == 0 && WS_GVT % 256 == 0 && WS_ACT % 256 == 0 && WS_Y % 256 == 0, "alignment");
constexpr int CW_TMO = 0, CW_CODE = 1;
constexpr int CW_BAR = 4096;
constexpr int CW_CNT = 8192;
constexpr int RING_OFF = 0, RING_BYTES = 131072;
constexpr int LDSCTL_OFF = RING_BYTES, MISC_OFF = LDSCTL_OFF + 320;
constexpr int TBL_OFF = LDSCTL_OFF + 1024;
constexpr int LDS_BYTES = 147456;
static_assert(MISC_OFF + 128 <= TBL_OFF && TBL_OFF + 4096 <= LDS_BYTES, "LDS map");

typedef GAS unsigned gu32;
#define RLX_AGENT __ATOMIC_RELAXED, __HIP_MEMORY_SCOPE_AGENT
#define LDS_WAIT() asm volatile("s_waitcnt lgkmcnt(0)" ::: "memory")
#define VM_WAIT() asm volatile("s_waitcnt vmcnt(0)" ::: "memory")

#define XB_TMO      128
#define XB_XCNT(j)  (256  + 64 * (j))
#define XB_XSUB(j)  (1280 + 64 * (j))
#define XB_XGEN(j)  (2304 + 64 * (j))
#define XB_TOP      3328
#define XB_TOPGEN   3392
#define XCD_BAR_WORDS 3456
#define XB_SPIN_CAP (1u << 18)

__device__ __forceinline__ unsigned xb_ld(unsigned* p)              { return __hip_atomic_load(p, __ATOMIC_RELAXED, __HIP_MEMORY_SCOPE_AGENT); }
__device__ __forceinline__ unsigned xb_add(unsigned* p, unsigned v) { return __hip_atomic_fetch_add(p, v, __ATOMIC_RELAXED, __HIP_MEMORY_SCOPE_AGENT); }
__device__ __forceinline__ unsigned xb_xcc_id() { return (unsigned)__builtin_amdgcn_s_getreg((3 << 11) | 20) & 0xFu; }
#define XB_SPIN(cond, bar) do { unsigned _sp = 0; while (cond) { __builtin_amdgcn_s_sleep(1); \
    if ((++_sp & 255u) == 0u) { if (xb_ld(&(bar)[XB_TMO])) break; if (_sp > XB_SPIN_CAP) { atomicAdd(&(bar)[XB_TMO], 1u); break; } } } } while (0)

struct XcdBarrier {
    unsigned* bar; unsigned x;
    volatile LAS unsigned* st;
};

__device__ __forceinline__ XcdBarrier xcd_barrier_post(unsigned* bar, volatile LAS unsigned* st) {
    XcdBarrier b; b.bar = bar; b.x = xb_xcc_id(); b.st = st;
    if (threadIdx.x == 0) (void)xb_add(&bar[XB_XCNT(b.x)], 1u);
    return b;
}
__device__ __forceinline__ void xcd_barrier_complete(unsigned* bar, unsigned x, unsigned& nloc, unsigned& nx) {
    const unsigned G = gridDim.x * gridDim.y * gridDim.z;
    unsigned sum, cnt, mine, sp = 0u;
    for (;;) {
        sum = 0u; cnt = 0u; mine = 0u;
#pragma unroll
        for (unsigned j = 0; j < 16; ++j) { const unsigned c = xb_ld(&bar[XB_XCNT(j)]); sum += c; cnt += (c > 0u) ? 1u : 0u; mine = (j == x) ? c : mine; }
        if (sum == G) break;
        __builtin_amdgcn_s_sleep(1);
        if ((++sp & 255u) == 0u) { if (xb_ld(&bar[XB_TMO])) break; if (sp > XB_SPIN_CAP) { atomicAdd(&bar[XB_TMO], 1u); break; } }
    }
    nloc = mine > 0u ? mine : 1u; nx = cnt > 0u ? cnt : 1u;
}

__device__ __forceinline__ void xcd_barrier(const XcdBarrier& b) {
    asm volatile("s_waitcnt vmcnt(0)" ::: "memory");
    __syncthreads();
    if (threadIdx.x == 0) {
        unsigned* bar = b.bar;
        __builtin_amdgcn_s_waitcnt(0);
        unsigned nloc = b.st[0], nx = b.st[1];
        if (nloc == 0u) { xcd_barrier_complete(bar, b.x, nloc, nx); b.st[0] = nloc; b.st[1] = nx; }
        const unsigned old = xb_add(&bar[XB_XSUB(b.x)], 1u);
        const unsigned gen = old / nloc;
        if (old + 1u == (gen + 1u) * nloc) {
            __builtin_amdgcn_fence(__ATOMIC_RELEASE, "agent");
            asm volatile("s_waitcnt vmcnt(0)" ::: "memory");
            const unsigned og = xb_add(&bar[XB_TOP], 1u);
            const unsigned tg = og / nx;
            if (og + 1u == (tg + 1u) * nx) xb_add(&bar[XB_TOPGEN], 1u);
            else XB_SPIN(xb_ld(&bar[XB_TOPGEN]) == tg, bar);
            __builtin_amdgcn_fence(__ATOMIC_ACQUIRE, "agent");
            xb_add(&bar[XB_XGEN(b.x)], 1u);
            asm volatile("s_waitcnt vmcnt(0)" ::: "memory");
        } else {
            XB_SPIN(xb_ld(&bar[XB_XGEN(b.x)]) == gen, bar);
            __builtin_amdgcn_fence(__ATOMIC_ACQUIRE, "agent");
            asm volatile("s_waitcnt vmcnt(0)" ::: "memory");
        }
    }
    __syncthreads();
}

struct Frame {
    LAS unsigned char* lds;
    gu32* ctl;
    int tid, lane, wave, vcu, G;
    const float *x, *attn_g, *w_in, *sinks, *w_alpha2, *b_alpha, *gla_g, *w_out, *ffn_g, *w_router, *b_router, *w_gu, *b_gu, *w_dn, *b_dn, *final_g;
    float* out;
    int *tope, *tops, *tokl; float* gate;
    bf16_t *Win, *Wout, *Wgu, *Wdn, *H, *PROJ, *OA, *OB, *MIX, *GQT, *GKT, *GATT, *GVT, *ACT, *Y;
    float *X1, *GDEC;
};
DI void p0_transpose_item(const float* Wsrc, int ldw, int srccol0, int nvalid, int k0, bf16_t* dst, int K, LAS float* scr, int lane) {
    const int krow = lane >> 3, n4 = lane & 7;
    const bool ok = 4 * n4 < nvalid;
#pragma unroll
    for (int i = 0; i < 8; ++i) { const int kk = 8 * i + krow; f32x4 v = (f32x4){0.f, 0.f, 0.f, 0.f};
        if (ok) v = *(const f32x4*)(Wsrc + (size_t)(k0 + kk) * ldw + srccol0 + 4 * n4);
        LAS float* d = scr + kk * 33 + 4 * n4; d[0] = v[0]; d[1] = v[1]; d[2] = v[2]; d[3] = v[3]; }
    LDS_WAIT(); asm volatile("" ::: "memory");
    const int c = lane & 7;
#pragma unroll
    for (int j = 0; j < 4; ++j) { const int n = (lane >> 3) + 8 * j; const LAS float* s = scr + (8 * c) * 33 + n;
        u32x4 o; o.x = pk_bf16(s[0 * 33], s[1 * 33]); o.y = pk_bf16(s[2 * 33], s[3 * 33]); o.z = pk_bf16(s[4 * 33], s[5 * 33]); o.w = pk_bf16(s[6 * 33], s[7 * 33]);
        *(u32x4*)(dst + (size_t)n * K + k0 + 8 * c) = o; }
    LDS_WAIT(); asm volatile("" ::: "memory");
}
DI void rms_row_to_bf16(const float* xrow, const float* g, bf16_t* orow, int lane) {
    const f32x4* xr = (const f32x4*)xrow + lane; const f32x4* gr = (const f32x4*)g + lane;
    f32x4 v[8]; float s = 0.f;
#pragma unroll
    for (int j = 0; j < 8; ++j) { v[j] = xr[64 * j]; s += (v[j].x * v[j].x + v[j].y * v[j].y) + (v[j].z * v[j].z + v[j].w * v[j].w); }
    const float r = 1.0f / sqrtf(wave_sum(s) * (1.f / DM) + EPS);
    u32x2* o8 = (u32x2*)orow + lane;
#pragma unroll
    for (int j = 0; j < 8; ++j) { const f32x4 gg = gr[64 * j]; u32x2 w; w.x = pk_bf16(v[j].x * r * gg.x, v[j].y * r * gg.y); w.y = pk_bf16(v[j].z * r * gg.z, v[j].w * r * gg.w); o8[64 * j] = w; }
}
DI void p0_prologue(Frame& F) {
    LAS float* scr = (LAS float*)(F.lds + RING_OFF + F.wave * 16384);
    const int gw = F.vcu * NWAVES + F.wave, NGW = F.G * NWAVES;
    constexpr int I_IN = 32 * 408, I_OUT = 32 * 64, I_GU = 32 * 32 * 128, I_DN = 32 * 32 * 64;
    constexpr int NITEMS = I_IN + I_OUT + I_GU + I_DN;
    for (int it = gw; it < NITEMS; it += NGW) {
        int r = it;
        if (r < I_IN) { const int kb = r / 408, nb = r % 408, n0 = 32 * nb; int sc = n0, nv = 32;
            if (n0 >= 8704 && n0 < 12800) sc = n0 + 16; else if (n0 == 12800) { sc = 8704; nv = 16; } else if (n0 > 12800) { sc = 0; nv = 0; }
            p0_transpose_item(F.w_in, DIN, sc, nv, 64 * kb, F.Win + (size_t)n0 * DM, DM, scr, F.lane); continue; }
        r -= I_IN;
        if (r < I_OUT) { const int kb = r / 64, nb = r % 64; p0_transpose_item(F.w_out, DM, 32 * nb, 32, 64 * kb, F.Wout + (size_t)(32 * nb) * DM, DM, scr, F.lane); continue; }
        r -= I_OUT;
        if (r < I_GU) { const int e = r / 4096, rr = r % 4096, kb = rr / 128, nb = rr % 128, n0 = 32 * nb, pn = n0 >> 8, i0 = n0 & 255;
            const int sc = (i0 < 128) ? (128 * pn + i0) : (2048 + 128 * pn + i0 - 128);
            p0_transpose_item(F.w_gu + (size_t)e * DM * 4096, 4096, sc, 32, 64 * kb, F.Wgu + ((size_t)e * 4096 + n0) * DM, DM, scr, F.lane); continue; }
        r -= I_GU;
        { const int e = r / 2048, rr = r % 2048, kb = rr / 64, nb = rr % 64;
            p0_transpose_item(F.w_dn + (size_t)e * DFF * DM, DM, 32 * nb, 32, 64 * kb, F.Wdn + ((size_t)e * DM + 32 * nb) * DFF, DFF, scr, F.lane); }
    }
    for (int m = gw; m < NTOK; m += NGW) rms_row_to_bf16(F.x + (size_t)m * DM, F.attn_g, F.H + (size_t)m * DM, F.lane);
}

DI s16x4 tr_read(const LAS unsigned char* p) { return __builtin_bit_cast(s16x4, __builtin_amdgcn_ds_read_tr16_b64_v4i16((LAS s16x4*)p)); }
DI bf16x8 pack8(const f32x16& x, int s) {
    u32x4 p; p.x = pk_bf16(x[8 * s + 0], x[8 * s + 1]); p.y = pk_bf16(x[8 * s + 2], x[8 * s + 3]); p.z = pk_bf16(x[8 * s + 4], x[8 * s + 5]); p.w = pk_bf16(x[8 * s + 6], x[8 * s + 7]);
    return __builtin_bit_cast(bf16x8, p);
}
DI void swa_phase(Frame& F) {
    LAS unsigned char* Ks = F.lds;
    LAS unsigned char* Vs = F.lds + 36864;
    const int lane = F.lane, w = F.wave, c31 = lane & 31, h = lane >> 5;
    const int i16 = lane & 15, q4 = i16 >> 2, p4 = i16 & 3, blk = (lane >> 4) & 1;
    for (int u = F.vcu; u < 512; u += F.G) {
        const int kh = u & 3, qb = (u >> 2) & 15, b = u >> 6;
        const size_t tokbase = (size_t)b * SEQ;
        const int pos0 = qb * 128 - 128;
#pragma unroll
        for (int i = 0; i < 4; ++i) { const int id = F.tid + 512 * i, row = id >> 3, ch = id & 7, pos = pos0 + row;
            u32x4 kv = (u32x4){0u, 0u, 0u, 0u}, vv = (u32x4){0u, 0u, 0u, 0u};
            if (pos >= 0) { const bf16_t* src = F.PROJ + (tokbase + pos) * LDP + C_KA + kh * 64 + ch * 8; kv = *(const u32x4*)src; vv = *(const u32x4*)(src + (C_VA - C_KA)); }
            *(LAS u32x4*)(Ks + row * 144 + ch * 16) = kv; *(LAS u32x4*)(Vs + row * 144 + ch * 16) = vv; }
        __syncthreads();
        const int head = kh * 8 + w;
        const float slope2 = __builtin_amdgcn_exp2f(-0.25f * (float)(head + 1)) * LOG2E;
        const float sink2 = F.sinks[head] * LOG2E;
        for (int qt = 0; qt < 4; ++qt) {
            const size_t qrow = tokbase + qb * 128 + qt * 32 + c31;
            bf16x8 bq[4];
#pragma unroll
            for (int ks = 0; ks < 4; ++ks) bq[ks] = *(const bf16x8*)(F.PROJ + qrow * LDP + C_QA + head * 64 + ks * 16 + h * 8);
            f32x16 S[5];
#pragma unroll
            for (int kt = 0; kt < 5; ++kt) { f32x16 acc;
#pragma unroll
                for (int i = 0; i < 16; ++i) acc[i] = 0.f;
#pragma unroll
                for (int ks = 0; ks < 4; ++ks) { const bf16x8 a = *(const LAS bf16x8*)(Ks + (32 * (qt + kt) + c31) * 144 + (ks * 16 + h * 8) * 2); acc = MFMA32(a, bq[ks], acc); }
                S[kt] = acc; }
            float mx = sink2;
#pragma unroll
            for (int kt = 0; kt < 5; ++kt)
#pragma unroll
                for (int i = 0; i < 16; ++i) { const int key = 32 * (qt + kt) + crow(i, h); const int dist = 32 * qt + c31 + 128 - key;
                    const bool valid = (dist >= 0) && (dist < 128) && (pos0 + key >= 0);
                    const float s = valid ? (S[kt][i] * (0.125f * LOG2E) - slope2 * (float)dist) : -INFINITY;
                    S[kt][i] = s; mx = fmaxf(mx, s); }
            mx = fmaxf(mx, __shfl_xor(mx, 32));
            float sum = 0.f;
#pragma unroll
            for (int kt = 0; kt < 5; ++kt)
#pragma unroll
                for (int i = 0; i < 16; ++i) { const float p = __builtin_amdgcn_exp2f(S[kt][i] - mx); S[kt][i] = p; sum += p; }
            sum += __shfl_xor(sum, 32); sum += __builtin_amdgcn_exp2f(sink2 - mx);
            const float inv = 1.0f / sum;
            f32x16 O[2];
#pragma unroll
            for (int dt = 0; dt < 2; ++dt)
#pragma unroll
                for (int i = 0; i < 16; ++i) O[dt][i] = 0.f;
#pragma unroll
            for (int kt = 0; kt < 5; ++kt)
#pragma unroll
                for (int s = 0; s < 2; ++s) { const bf16x8 bp = pack8(S[kt], s);
                    const int kb = 32 * (qt + kt) + 16 * s + 4 * h + q4;
#pragma unroll
                    for (int dt = 0; dt < 2; ++dt) { const LAS unsigned char* vp = Vs + kb * 144 + (32 * dt + 16 * blk + 4 * p4) * 2;
                        const s16x4 lo = tr_read(vp), hi = tr_read(vp + 8 * 144);
                        const bf16x8 a = __builtin_shufflevector(lo, hi, 0, 1, 2, 3, 4, 5, 6, 7);
                        O[dt] = MFMA32(a, bp, O[dt]); } }
            bf16_t* orow = F.OA + qrow * DM + head * 64 + 4 * h;
#pragma unroll
            for (int dt = 0; dt < 2; ++dt)
#pragma unroll
                for (int g4 = 0; g4 < 4; ++g4) { u32x2 wv; wv.x = pk_bf16(O[dt][4 * g4] * inv, O[dt][4 * g4 + 1] * inv); wv.y = pk_bf16(O[dt][4 * g4 + 2] * inv, O[dt][4 * g4 + 3] * inv);
                    *(u32x2*)(orow + 32 * dt + 8 * g4) = wv; }
        }
        __syncthreads();
    }
}

DI void gla_prep_phase(Frame& F) {
    LAS unsigned char* Qs = F.lds;
    LAS unsigned char* Kss = F.lds + 33792;
    LAS float* alr = (LAS float*)(F.lds + 67584);
    LAS float* tot = (LAS float*)(F.lds + 71680);
    const int tid = F.tid, lane = F.lane, w = F.wave, c31 = lane & 31, h = lane >> 5;
    for (int u = F.vcu; u < 1024; u += F.G) {
        const int hh = (u >> 5) & 3, b = u >> 7, c = u & 31;
        const size_t T0 = (size_t)b * SEQ + c * 64;
        if (tid < 128) { const int t = tid >> 1, hf = tid & 1; const u32x4 raw = *(const u32x4*)(F.PROJ + (T0 + t) * LDP + C_ALR + 8 * hf);
            LAS float* d = alr + t * 16 + 8 * hf;
            d[0] = bf_lo(raw.x); d[1] = bf_hi(raw.x); d[2] = bf_lo(raw.y); d[3] = bf_hi(raw.y); d[4] = bf_lo(raw.z); d[5] = bf_hi(raw.z); d[6] = bf_lo(raw.w); d[7] = bf_hi(raw.w); }
        __syncthreads();
        const int d = tid & 255, hf = tid >> 8;
        float w2[16];
#pragma unroll
        for (int r = 0; r < 16; ++r) w2[r] = F.w_alpha2[r * 1024 + hh * 256 + d];
        const float ba = F.b_alpha[hh * 256 + d];
        float bc[32]; float run = 0.f;
#pragma unroll
        for (int i = 0; i < 32; ++i) { const LAS f32x4* ar = (const LAS f32x4*)(alr + (32 * hf + i) * 16); float z = ba;
#pragma unroll
            for (int r4 = 0; r4 < 4; ++r4) { const f32x4 a = ar[r4]; z += a.x * w2[4 * r4] + a.y * w2[4 * r4 + 1] + a.z * w2[4 * r4 + 2] + a.w * w2[4 * r4 + 3]; }
            const float la = (fminf(z, 0.f) - __logf(1.0f + fast_exp(-fabsf(z)))) * (1.0f / 16.0f);
            run += la; bc[i] = run; }
        tot[hf * 256 + d] = run;
        __syncthreads();
        const float t0 = tot[d], t1 = tot[256 + d], blast = t0 + t1;
        if (hf) {
#pragma unroll
            for (int i = 0; i < 32; ++i) bc[i] += t0;
        } else F.GDEC[(size_t)u * 256 + d] = fast_exp(blast);
        const bf16_t* qsrc = F.PROJ + (T0 + 32 * hf) * LDP + C_QB + hh * 256 + d;
        unsigned kpk[16];
#pragma unroll
        for (int i2 = 0; i2 < 16; ++i2) { float kh2[2];
#pragma unroll
            for (int j = 0; j < 2; ++j) { const int i = 2 * i2 + j; const float q = bf2f(qsrc[(size_t)i * LDP]), k = bf2f(qsrc[(size_t)i * LDP + (C_KB - C_QB)]);
                const float e = fast_exp(bc[i]);
                *(LAS bf16_t*)(Qs + (32 * hf + i) * 528 + d * 2) = f2bf(q * e * 0.0625f);
                *(LAS bf16_t*)(Kss + (32 * hf + i) * 528 + d * 2) = f2bf(k * fast_exp(-bc[i]));
                kh2[j] = k * fast_exp(blast - bc[i]); }
            kpk[i2] = pk_bf16(kh2[0], kh2[1]); }
        { u32x4* dst = (u32x4*)(F.GKT + (size_t)u * 16384 + d * 64 + 32 * hf);
#pragma unroll
            for (int j = 0; j < 4; ++j) dst[j] = (u32x4){kpk[4 * j], kpk[4 * j + 1], kpk[4 * j + 2], kpk[4 * j + 3]}; }
        __syncthreads();
        if (w < 4) { const int m = w >> 1, n = w & 1; f32x16 acc;
#pragma unroll
            for (int i = 0; i < 16; ++i) acc[i] = 0.f;
#pragma unroll
            for (int ks = 0; ks < 16; ++ks) { const bf16x8 a = *(const LAS bf16x8*)(Qs + (32 * m + c31) * 528 + (16 * ks + 8 * h) * 2), bb = *(const LAS bf16x8*)(Kss + (32 * n + c31) * 528 + (16 * ks + 8 * h) * 2);
                acc = MFMA32(a, bb, acc); }
            bf16_t* ao = F.GATT + (size_t)u * 4096;
#pragma unroll
            for (int i = 0; i < 16; ++i) { const int t = 32 * m + crow(i, h), s = 32 * n + c31; ao[t * 64 + s] = f2bf(s <= t ? acc[i] : 0.f); }
        } else { const int t2 = tid - 256;
#pragma unroll
            for (int j = 0; j < 8; ++j) { const int id = t2 + 256 * j, row = id >> 5, ch = id & 31; *(u32x4*)(F.GQT + (size_t)u * 16384 + row * 256 + ch * 8) = *(const LAS u32x4*)(Qs + row * 528 + ch * 16); } }
        { const bf16_t* vsrc = F.PROJ + T0 * LDP + C_VB + hh * 512 + tid; u32x4* dst = (u32x4*)(F.GVT + (size_t)u * 32768 + tid * 64);
#pragma unroll
            for (int t8 = 0; t8 < 8; ++t8) { float v[8];
#pragma unroll
                for (int j = 0; j < 8; ++j) v[j] = bf2f(vsrc[(size_t)(8 * t8 + j) * LDP]);
                dst[t8] = (u32x4){pk_bf16(v[0], v[1]), pk_bf16(v[2], v[3]), pk_bf16(v[4], v[5]), pk_bf16(v[6], v[7])}; } }
        __syncthreads();
    }
}

DI void gla_scan_phase(Frame& F) {
    if (F.vcu >= 64) return;
    LAS unsigned char* Qs = F.lds;
    LAS unsigned char* KTs = F.lds + 33792;
    LAS unsigned char* ATs = F.lds + 70656;
    LAS float* DECs = (LAS float*)(F.lds + 79872);
    const int tid = F.tid, lane = F.lane, w = F.wave, c31 = lane & 31, h = lane >> 5;
    const int u = F.vcu, hf = u & 1, hh = (u >> 1) & 3, b = u >> 3;
    f32x16 S[8];
#pragma unroll
    for (int i = 0; i < 8; ++i)
#pragma unroll
        for (int j = 0; j < 16; ++j) S[i][j] = 0.f;
    const int vrow = hf * 256 + 32 * w + c31;
    for (int c = 0; c < 32; ++c) {
        const size_t item = (size_t)(b * 4 + hh) * 32 + c;
        const size_t T0 = (size_t)b * SEQ + c * 64;
#pragma unroll
        for (int j = 0; j < 4; ++j) { const int id = tid + 512 * j, row = id >> 5, ch = id & 31; *(LAS u32x4*)(Qs + row * 528 + ch * 16) = *(const u32x4*)(F.GQT + item * 16384 + row * 256 + ch * 8); }
#pragma unroll
        for (int j = 0; j < 4; ++j) { const int id = tid + 512 * j, row = id >> 3, ch = id & 7; *(LAS u32x4*)(KTs + row * 144 + ch * 16) = *(const u32x4*)(F.GKT + item * 16384 + row * 64 + ch * 8); }
        { const int row = tid >> 3, ch = tid & 7; *(LAS u32x4*)(ATs + row * 144 + ch * 16) = *(const u32x4*)(F.GATT + item * 4096 + row * 64 + ch * 8); }
        if (tid < 64) *(LAS f32x4*)(DECs + 4 * tid) = *(const f32x4*)(F.GDEC + item * 256 + 4 * tid);
        bf16x8 bv[4];
#pragma unroll
        for (int ks = 0; ks < 4; ++ks) bv[ks] = *(const bf16x8*)(F.GVT + item * 32768 + (size_t)vrow * 64 + 16 * ks + 8 * h);
        __syncthreads();
        f32x16 o[2];
#pragma unroll
        for (int m = 0; m < 2; ++m)
#pragma unroll
            for (int j = 0; j < 16; ++j) o[m][j] = 0.f;
#pragma unroll
        for (int i = 0; i < 8; ++i)
#pragma unroll
            for (int s = 0; s < 2; ++s) { const bf16x8 bs = pack8(S[i], s);
#pragma unroll
                for (int m = 0; m < 2; ++m) { const LAS unsigned char* ap = Qs + (32 * m + c31) * 528 + (32 * i + 16 * s + 4 * h) * 2;
                    const s16x4 lo = *(const LAS s16x4*)ap, hi = *(const LAS s16x4*)(ap + 16);
                    const bf16x8 a = __builtin_shufflevector(lo, hi, 0, 1, 2, 3, 4, 5, 6, 7);
                    o[m] = MFMA32(a, bs, o[m]); } }
#pragma unroll
        for (int ks = 0; ks < 4; ++ks)
#pragma unroll
            for (int m = 0; m < 2; ++m) { const bf16x8 a = *(const LAS bf16x8*)(ATs + (32 * m + c31) * 144 + (16 * ks + 8 * h) * 2); o[m] = MFMA32(a, bv[ks], o[m]); }
        { bf16_t* ob = F.OB + T0 * DM + hh * 512 + vrow;
#pragma unroll
            for (int m = 0; m < 2; ++m)
#pragma unroll
                for (int j = 0; j < 16; ++j) ob[(size_t)(32 * m + crow(j, h)) * DM] = f2bf(o[m][j]); }
#pragma unroll
        for (int i = 0; i < 8; ++i) {
#pragma unroll
            for (int g4 = 0; g4 < 4; ++g4) { const f32x4 dc = *(const LAS f32x4*)(DECs + 32 * i + 8 * g4 + 4 * h);
                S[i][4 * g4] *= dc.x; S[i][4 * g4 + 1] *= dc.y; S[i][4 * g4 + 2] *= dc.z; S[i][4 * g4 + 3] *= dc.w; }
#pragma unroll
            for (int ks = 0; ks < 4; ++ks) { const bf16x8 a = *(const LAS bf16x8*)(KTs + (32 * i + c31) * 144 + (16 * ks + 8 * h) * 2); S[i] = MFMA32(a, bv[ks], S[i]); } }
        __syncthreads();
    }
}

DI void merge_phase(Frame& F) {
    const int gw = F.vcu * NWAVES + F.wave, NGW = F.G * NWAVES, lane = F.lane;
    for (int m = gw; m < NTOK; m += NGW) {
        const bf16_t* pr = F.PROJ + (size_t)m * LDP;
#pragma unroll
        for (int j = 0; j < 4; ++j) { const int c0 = j * 512 + lane * 8;
            const u32x4 ob = *(const u32x4*)(F.OB + (size_t)m * DM + c0), oa = *(const u32x4*)(F.OA + (size_t)m * DM + c0);
            const u32x4 rb = *(const u32x4*)(pr + C_RB + c0), ga = *(const u32x4*)(pr + C_GA + c0), gb = *(const u32x4*)(pr + C_GB + c0);
            const f32x4 g0 = *(const f32x4*)(F.gla_g + lane * 8), g1 = *(const f32x4*)(F.gla_g + lane * 8 + 4);
            float vb[8] = {bf_lo(ob.x), bf_hi(ob.x), bf_lo(ob.y), bf_hi(ob.y), bf_lo(ob.z), bf_hi(ob.z), bf_lo(ob.w), bf_hi(ob.w)};
            const float va[8] = {bf_lo(oa.x), bf_hi(oa.x), bf_lo(oa.y), bf_hi(oa.y), bf_lo(oa.z), bf_hi(oa.z), bf_lo(oa.w), bf_hi(oa.w)};
            const float vr[8] = {bf_lo(rb.x), bf_hi(rb.x), bf_lo(rb.y), bf_hi(rb.y), bf_lo(rb.z), bf_hi(rb.z), bf_lo(rb.w), bf_hi(rb.w)};
            const float vga[8] = {bf_lo(ga.x), bf_hi(ga.x), bf_lo(ga.y), bf_hi(ga.y), bf_lo(ga.z), bf_hi(ga.z), bf_lo(ga.w), bf_hi(ga.w)};
            const float vgb[8] = {bf_lo(gb.x), bf_hi(gb.x), bf_lo(gb.y), bf_hi(gb.y), bf_lo(gb.z), bf_hi(gb.z), bf_lo(gb.w), bf_hi(gb.w)};
            const float gn[8] = {g0.x, g0.y, g0.z, g0.w, g1.x, g1.y, g1.z, g1.w};
            float ss = 0.f;
#pragma unroll
            for (int k = 0; k < 8; ++k) ss += vb[k] * vb[k];
            const float rn = 1.0f / sqrtf(wave_sum(ss) * (1.f / 512.f) + EPS);
            float r[8];
#pragma unroll
            for (int k = 0; k < 8; ++k) { const float obn = vb[k] * rn * gn[k]; const float sl = vr[k] * fast_sigmoid(vr[k]);
                r[k] = fast_sigmoid(vga[k]) * va[k] + fast_sigmoid(vgb[k]) * obn * sl; }
            *(u32x4*)(F.MIX + (size_t)m * DM + c0) = (u32x4){pk_bf16(r[0], r[1]), pk_bf16(r[2], r[3]), pk_bf16(r[4], r[5]), pk_bf16(r[6], r[7])}; }
    }
}

DI void router_phase(Frame& F) {
    LAS float* part = (LAS float*)F.lds;
    LAS float* ssp = (LAS float*)(F.lds + 34816);
    LAS float* rt = (LAS float*)(F.lds + 36864);
    LAS float* lg = (LAS float*)(F.lds + 37888);
    const int tid = F.tid, lane = F.lane, w = F.wave, c31 = lane & 31, h = lane >> 5;
    for (int tile = F.vcu; tile < NTOK / 32; tile += F.G) {
        const int t0 = tile * 32, kw = 256 * w;
        { const float* xr = F.X1 + (size_t)(t0 + c31) * DM + kw + 4 * h; const float* gp = F.ffn_g + kw + 4 * h; const float* wp = F.w_router + (size_t)(kw + 4 * h) * 32 + c31;
            f32x16 acc;
#pragma unroll
            for (int i = 0; i < 16; ++i) acc[i] = 0.f;
            float ss = 0.f;
#pragma unroll 4
            for (int m = 0; m < 32; ++m) { const f32x4 a = *(const f32x4*)(xr + 8 * m); const f32x4 g4 = *(const f32x4*)(gp + 8 * m); const float* wr_ = wp + (size_t)m * 256;
                const float b0 = g4.x * wr_[0], b1 = g4.y * wr_[32], b2 = g4.z * wr_[64], b3 = g4.w * wr_[96];
                ss += (a.x * a.x + a.y * a.y) + (a.z * a.z + a.w * a.w);
                acc = __builtin_amdgcn_mfma_f32_32x32x2f32(a.x, b0, acc, 0, 0, 0); acc = __builtin_amdgcn_mfma_f32_32x32x2f32(a.y, b1, acc, 0, 0, 0);
                acc = __builtin_amdgcn_mfma_f32_32x32x2f32(a.z, b2, acc, 0, 0, 0); acc = __builtin_amdgcn_mfma_f32_32x32x2f32(a.w, b3, acc, 0, 0, 0); }
            ss += __shfl_xor(ss, 32);
#pragma unroll
            for (int i = 0; i < 16; ++i) part[(w * 32 + crow(i, h)) * 33 + c31] = acc[i];
            if (h == 0) ssp[w * 32 + c31] = ss; }
        __syncthreads();
        { const int tok = tid >> 4, e0 = tid & 15; float s0 = 0.f, s1 = 0.f, sst = 0.f;
#pragma unroll
            for (int w2 = 0; w2 < 8; ++w2) { s0 += part[(w2 * 32 + tok) * 33 + e0]; s1 += part[(w2 * 32 + tok) * 33 + e0 + 16]; sst += ssp[w2 * 32 + tok]; }
            const float r = 1.0f / sqrtf(sst * (1.f / DM) + EPS);
            lg[tok * 33 + e0] = s0 * r + F.b_router[e0]; lg[tok * 33 + e0 + 16] = s1 * r + F.b_router[e0 + 16]; if (e0 == 0) rt[tok] = r; }
        __syncthreads();
#pragma unroll
        for (int it = 0; it < 2; ++it) { const int tok = 4 * w + 2 * it + h; const int m = t0 + tok;
            float v = lg[tok * 33 + c31]; float tv[4]; int ti[4];
#pragma unroll
            for (int k = 0; k < 4; ++k) { float bv = v; int bi = c31;
#pragma unroll
                for (int o = 1; o < 32; o <<= 1) { const float ov = __shfl_xor(bv, o); const int oi = __shfl_xor(bi, o); const bool take = (ov > bv) || (ov == bv && oi < bi); bv = take ? ov : bv; bi = take ? oi : bi; }
                tv[k] = bv; ti[k] = bi; v = (c31 == bi) ? -INFINITY : v; }
            const float e1 = fast_exp(tv[1] - tv[0]), e2 = fast_exp(tv[2] - tv[0]), e3 = fast_exp(tv[3] - tv[0]); const float inv = 1.0f / (1.0f + e1 + e2 + e3);
            if (c31 < 4) { const int ex = c31 == 0 ? ti[0] : c31 == 1 ? ti[1] : c31 == 2 ? ti[2] : ti[3]; const float gt = (c31 == 0 ? 1.0f : c31 == 1 ? e1 : c31 == 2 ? e2 : e3) * inv;
                const unsigned slot = __hip_atomic_fetch_add((unsigned*)(F.ctl + CW_CNT + 64 * ex), 1u, __ATOMIC_RELAXED, __HIP_MEMORY_SCOPE_AGENT);
                F.tokl[(size_t)ex * NTOK + slot] = m; F.tope[m * 4 + c31] = ex; F.tops[m * 4 + c31] = (int)slot; F.gate[m * 4 + c31] = gt; } }
#pragma unroll
        for (int q = 0; q < 4; ++q) { const int tok = 4 * w + q; const size_t m = (size_t)(t0 + tok); const float r = rt[tok];
            const f32x4* xr = (const f32x4*)(F.X1 + m * DM) + lane; const f32x4* gr = (const f32x4*)F.ffn_g + lane; u32x2* o8 = (u32x2*)(F.H + m * DM) + lane;
#pragma unroll
            for (int j = 0; j < 8; ++j) { const f32x4 xv = xr[64 * j], gg = gr[64 * j]; u32x2 wv; wv.x = pk_bf16(xv.x * r * gg.x, xv.y * r * gg.y); wv.y = pk_bf16(xv.z * r * gg.z, xv.w * r * gg.w); o8[64 * j] = wv; } }
        __syncthreads();
    }
}

DI void moe_tables(Frame& F) {
    LAS int* tb = (LAS int*)(F.lds + TBL_OFF);
    if (F.tid == 0) { int acc = 0;
        for (int e = 0; e < NEXP; ++e) { const int c = (int)__hip_atomic_load((unsigned*)(F.ctl + CW_CNT + 64 * e), __ATOMIC_RELAXED, __HIP_MEMORY_SCOPE_AGENT); tb[e] = acc; tb[40 + e] = c; acc += (c + 255) >> 8; }
        tb[32] = acc; }
    __syncthreads();
}
struct MoeProb {
    const bf16_t* A; const bf16_t* Bt; const int* tokl; const LAS int* tb; int K, NT  , brows  , G, c; bool gather;
    DI bool next(int i, pg8::Unit& u) const {
        const int L = i * G + c; const int nb = tb[32]; if (L >= nb * NT) return false;
        const int blk = L / NT, pn = L % NT; int e = 0;
        for (int j = 1; j < NEXP; ++j) e += (tb[j] <= blk) ? 1 : 0;
        const int rb = blk - tb[e]; int nr = tb[40 + e] - rb * 256; nr = nr > 256 ? 256 : nr;
        u.pm = blk; u.pn = pn; u.e = e; u.rb = rb; u.nrow = nr; return true;
    }
    DI const char* a_base(const pg8::Unit& u) const { return gather ? (const char*)A : (const char*)A + (size_t)u.pm * 256 * K * 2; }
    DI const char* b_base(const pg8::Unit& u) const { return (const char*)Bt + ((size_t)u.e * brows + (size_t)u.pn * 256) * K * 2; }
    DI void a_voff(const pg8::Unit& u, const int (&R)[2], const int (&C)[2], unsigned (&v)[2][2]) const {
#pragma unroll
        for (int h = 0; h < 2; ++h)
#pragma unroll
            for (int i = 0; i < 2; ++i) { const int r = h * 128 + R[i];
                if (gather) { int tok = 0; if (r < u.nrow) tok = tokl[(size_t)u.e * NTOK + u.rb * 256 + r]; v[h][i] = (unsigned)(tok * K + C[i]) * 2u; }
                else v[h][i] = (unsigned)(r * K + C[i]) * 2u; }
    }
};

DI void final_phase(Frame& F) {
    const LAS int* tb = (const LAS int*)(F.lds + TBL_OFF);
    const int gw = F.vcu * NWAVES + F.wave, NGW = F.G * NWAVES, lane = F.lane;
    for (int m = gw; m < NTOK; m += NGW) {
        const bf16_t* yr[4]; float gt[4];
#pragma unroll
        for (int k = 0; k < 4; ++k) { const int e = F.tope[m * 4 + k], sl = F.tops[m * 4 + k]; gt[k] = F.gate[m * 4 + k]; yr[k] = F.Y + ((size_t)tb[e] * 256 + sl) * DM; }
        float v[4][8]; float ss = 0.f;
#pragma unroll
        for (int j = 0; j < 4; ++j) { const int c0 = 8 * (lane + 64 * j);
            const f32x4 x0 = *(const f32x4*)(F.X1 + (size_t)m * DM + c0), x1 = *(const f32x4*)(F.X1 + (size_t)m * DM + c0 + 4);
            float a[8] = {x0.x, x0.y, x0.z, x0.w, x1.x, x1.y, x1.z, x1.w};
#pragma unroll
            for (int k = 0; k < 4; ++k) { const u32x4 y = *(const u32x4*)(yr[k] + c0);
                a[0] += gt[k] * bf_lo(y.x); a[1] += gt[k] * bf_hi(y.x); a[2] += gt[k] * bf_lo(y.y); a[3] += gt[k] * bf_hi(y.y);
                a[4] += gt[k] * bf_lo(y.z); a[5] += gt[k] * bf_hi(y.z); a[6] += gt[k] * bf_lo(y.w); a[7] += gt[k] * bf_hi(y.w); }
#pragma unroll
            for (int q = 0; q < 8; ++q) { v[j][q] = a[q]; ss += a[q] * a[q]; } }
        const float r = 1.0f / sqrtf(wave_sum(ss) * (1.f / DM) + EPS);
#pragma unroll
        for (int j = 0; j < 4; ++j) { const int c0 = 8 * (lane + 64 * j);
            const f32x4 g0 = *(const f32x4*)(F.final_g + c0), g1 = *(const f32x4*)(F.final_g + c0 + 4);
            *(f32x4*)(F.out + (size_t)m * DM + c0) = (f32x4){v[j][0] * r * g0.x, v[j][1] * r * g0.y, v[j][2] * r * g0.z, v[j][3] * r * g0.w};
            *(f32x4*)(F.out + (size_t)m * DM + c0 + 4) = (f32x4){v[j][4] * r * g1.x, v[j][5] * r * g1.y, v[j][6] * r * g1.z, v[j][7] * r * g1.w}; }
    }
}
#ifndef MK_N_LAUNCHES
#define MK_N_LAUNCHES 1
#endif
constexpr int N_PHASES = 10;
struct Args { const float* in[16]; float* out; unsigned char* ws; int ph_lo, ph_hi; };
static_assert(sizeof(Args) == 16 * 8 + 8 + 8 + 8, "Args has no padding");

__global__ void __launch_bounds__(NWAVES * 64, 2) fwd_kernel(Args args) {
    extern __shared__ __attribute__((aligned(16))) unsigned char lds_raw[];
    Frame F;
    F.lds = (LAS unsigned char*)lds_raw;
    F.tid = threadIdx.x; F.lane = F.tid & 63; F.wave = __builtin_amdgcn_readfirstlane(F.tid >> 6);
    F.G = gridDim.x; { const int bx = blockIdx.x; F.vcu = (F.G % 8 == 0) ? (bx % 8) * (F.G / 8) + bx / 8 : bx; }
    unsigned char* ws = args.ws;
    F.ctl = (gu32*)(ws + WS_CTL);
    F.x = args.in[0]; F.attn_g = args.in[1]; F.w_in = args.in[2]; F.sinks = args.in[3]; F.w_alpha2 = args.in[4]; F.b_alpha = args.in[5]; F.gla_g = args.in[6]; F.w_out = args.in[7];
    F.ffn_g = args.in[8]; F.w_router = args.in[9]; F.b_router = args.in[10]; F.w_gu = args.in[11]; F.b_gu = args.in[12]; F.w_dn = args.in[13]; F.b_dn = args.in[14]; F.final_g = args.in[15];
    F.out = args.out;
    F.tope = (int*)(ws + WS_TOPE); F.tops = (int*)(ws + WS_TOPS); F.gate = (float*)(ws + WS_GATE); F.tokl = (int*)(ws + WS_TOKL);
    F.Win = (bf16_t*)(ws + WS_WIN); F.Wout = (bf16_t*)(ws + WS_WOUT); F.Wgu = (bf16_t*)(ws + WS_WGU); F.Wdn = (bf16_t*)(ws + WS_WDN);
    F.H = (bf16_t*)(ws + WS_H); F.PROJ = (bf16_t*)(ws + WS_PROJ); F.OA = (bf16_t*)(ws + WS_OA); F.OB = (bf16_t*)(ws + WS_OB); F.MIX = (bf16_t*)(ws + WS_MIX);
    F.X1 = (float*)(ws + WS_X1); F.GQT = (bf16_t*)(ws + WS_GQT); F.GKT = (bf16_t*)(ws + WS_GKT); F.GATT = (bf16_t*)(ws + WS_GATT); F.GDEC = (float*)(ws + WS_GDEC); F.GVT = (bf16_t*)(ws + WS_GVT);
    F.ACT = (bf16_t*)(ws + WS_ACT); F.Y = (bf16_t*)(ws + WS_Y);
    for (int u = F.tid; u < (LDS_BYTES - LDSCTL_OFF) / 4; u += NWAVES * 64) ((LAS unsigned*)(F.lds + LDSCTL_OFF))[u] = 0u;
    __syncthreads();
    const int lo = args.ph_lo, hi = args.ph_hi;
    const bool use_bar = (hi - lo) > 1;
    XcdBarrier bar; bar.bar = (unsigned*)(F.ctl + CW_BAR); bar.x = 0; bar.st = nullptr;
    if (use_bar) bar = xcd_barrier_post((unsigned*)(F.ctl + CW_BAR), (volatile LAS unsigned*)(F.lds + MISC_OFF) + 8);
#define IN(k) (lo <= (k) && (k) < hi)
#define SEAM(k) do { if (IN(k) && IN((k) + 1)) xcd_barrier(bar); } while (0)

    if (IN(0)) { p0_prologue(F); }
    SEAM(0);
    if (IN(1)) {
        pg8::DenseProb P; P.A = F.H; P.Bt = F.Win; P.K = DM; P.S.init(NTOK, LDP, F.G, (int)blockIdx.x);
        pg8::EpiBf16Plain E{F.PROJ, LDP};
        pg8::gemm_phase(F.lds + RING_OFF, P, E);
    }
    SEAM(1);
    if (IN(2)) { swa_phase(F); gla_prep_phase(F); }
    SEAM(2);
    if (IN(3)) { gla_scan_phase(F); }
    SEAM(3);
    if (IN(4)) { merge_phase(F); }
    SEAM(4);
    if (IN(5)) {
        pg8::DenseProb P; P.A = F.MIX; P.Bt = F.Wout; P.K = DM; P.S.init(NTOK, DM, F.G, (int)blockIdx.x);
        pg8::EpiResF32 E{F.x, F.X1, DM};
        pg8::gemm_phase(F.lds + RING_OFF, P, E);
    }
    SEAM(5);
    if (IN(6)) { router_phase(F); }
    SEAM(6);
    if (IN(7)) {
        moe_tables(F);
        MoeProb P; P.A = F.H; P.Bt = F.Wgu; P.tokl = F.tokl; P.tb = (const LAS int*)(F.lds + TBL_OFF); P.K = DM; P.NT = 16; P.brows = 4096; P.G = F.G; P.c = (int)blockIdx.x; P.gather = true;
        pg8::EpiGlu E{F.ACT, DFF, F.b_gu};
        pg8::gemm_phase(F.lds + RING_OFF, P, E);
    }
    SEAM(7);
    if (IN(8)) {
        moe_tables(F);
        MoeProb P; P.A = F.ACT; P.Bt = F.Wdn; P.tokl = F.tokl; P.tb = (const LAS int*)(F.lds + TBL_OFF); P.K = DFF; P.NT = 8; P.brows = 2048; P.G = F.G; P.c = (int)blockIdx.x; P.gather = false;
        pg8::EpiBf16BiasE E{F.Y, DM, F.b_dn};
        pg8::gemm_phase(F.lds + RING_OFF, P, E);
    }
    SEAM(8);
    if (IN(9)) { moe_tables(F); final_phase(F); }
#undef IN
#undef SEAM
}

extern "C" void kernel_launch(void* const* d_in, const int* in_sizes, int n_in, void* d_out, int out_size, void* d_ws, size_t ws_size, hipStream_t stream) {
    static int grid = 0;
    if (grid == 0) {
        if (n_in != 16 || out_size != NTOK * DM || ws_size < WS_END) { fprintf(stderr, "kernel_launch: unexpected shapes (n_in %d, out %d, ws %zu, need %zu); nothing launched\n", n_in, out_size, ws_size, (size_t)WS_END); grid = -1; return; }
        int dev = 0, cus = 0, per_cu = 0;
        if (hipGetDevice(&dev) != hipSuccess || hipDeviceGetAttribute(&cus, hipDeviceAttributeMultiprocessorCount, dev) != hipSuccess) { fprintf(stderr, "kernel_launch: device query failed\n"); grid = -1; return; }
        if (hipFuncSetAttribute((const void*)fwd_kernel, hipFuncAttributeMaxDynamicSharedMemorySize, LDS_BYTES) != hipSuccess) { fprintf(stderr, "kernel_launch: hipFuncSetAttribute failed\n"); grid = -1; return; }
        if (hipOccupancyMaxActiveBlocksPerMultiprocessor(&per_cu, (const void*)fwd_kernel, NWAVES * 64, LDS_BYTES) != hipSuccess || per_cu < 1)
            fprintf(stderr, "kernel_launch: note: occupancy query reports %d workgroups per CU\n", per_cu);
        (void)hipGetLastError();
        grid = cus;
    }
    if (grid < 0) return;
    if (hipMemsetAsync((char*)d_ws + WS_CTL, 0, CTL_ZERO_BYTES, stream) != hipSuccess) { fprintf(stderr, "kernel_launch: hipMemsetAsync failed\n"); return; }
    Args a{};
    for (int i = 0; i < 16; ++i) a.in[i] = (const float*)d_in[i];
    a.out = (float*)d_out; a.ws = (unsigned char*)d_ws;
    if (MK_N_LAUNCHES == 1) { a.ph_lo = 0; a.ph_hi = N_PHASES; hipLaunchKernelGGL(fwd_kernel, dim3(grid), dim3(NWAVES * 64), LDS_BYTES, stream, a); }
    else for (int p = 0; p < N_PHASES; ++p) { a.ph_lo = p; a.ph_hi = p + 1; hipLaunchKernelGGL(fwd_kernel, dim3(grid), dim3(NWAVES * 64), LDS_BYTES, stream, a);
#ifdef MK_REPEAT_MASK
        if ((MK_REPEAT_MASK >> p) & 1) hipLaunchKernelGGL(fwd_kernel, dim3(grid), dim3(NWAVES * 64), LDS_BYTES, stream, a);
#endif
    }
    const hipError_t le = hipPeekAtLastError();
    if (le != hipSuccess) fprintf(stderr, "kernel_launch: launch failed: %s\n", hipGetErrorName(le));
}
```

```cpp
#define MK_N_LAUNCHES 1
#include <hip/hip_runtime.h>
#include <cstdio>
#include <cstdint>

#define DI __device__ __forceinline__
#define LAS __attribute__((address_space(3)))
#define GAS __attribute__((address_space(1)))
typedef unsigned short bf16_t;
typedef short bf16x8 __attribute__((ext_vector_type(8)));
typedef short s16x4 __attribute__((ext_vector_type(4)));
typedef float f32x4 __attribute__((ext_vector_type(4)));
typedef float f32x16 __attribute__((ext_vector_type(16)));
typedef unsigned u32x4 __attribute__((ext_vector_type(4)));
typedef unsigned u32x2 __attribute__((ext_vector_type(2)));
typedef float f32x2_t __attribute__((ext_vector_type(2)));
typedef __bf16 bf16x2_t __attribute__((ext_vector_type(2)));

DI unsigned pk_bf16(float lo, float hi) { f32x2_t v = {lo, hi}; bf16x2_t b = __builtin_convertvector(v, bf16x2_t); return __builtin_bit_cast(unsigned, b); }
DI float bf_lo(unsigned w) { return __uint_as_float(w << 16); }
DI float bf_hi(unsigned w) { return __uint_as_float(w & 0xffff0000u); }
DI float bf2f(bf16_t v) { return __uint_as_float(((unsigned)v) << 16); }
DI bf16_t f2bf(float f) { return (bf16_t)(pk_bf16(f, 0.f) & 0xffffu); }
DI float fast_exp(float x) { return __builtin_amdgcn_exp2f(x * 1.4426950408889634f); }
DI float fast_rcp(float x) { return __builtin_amdgcn_rcpf(x); }
DI float fast_sigmoid(float x) { return fast_rcp(1.0f + fast_exp(-x)); }
DI float wave_sum(float v) {
#pragma unroll
    for (int o = 1; o < 64; o <<= 1) v += __shfl_xor(v, o);
    return v;
}
DI int crow(int reg, int h) { return (reg & 3) + 8 * (reg >> 2) + 4 * h; }
#define MFMA32(a, b, c) __builtin_amdgcn_mfma_f32_32x32x16_bf16((a), (b), (c), 0, 0, 0)

namespace pg8 {
constexpr int BM = 256, BK = 64, HALF = 128, HTB = HALF * BK * 2  , STAGE_BYTES = 8 * HTB, NXCD = 8, WGM = 8;

DI int lds_byte(int r, int c) { const int st = (r >> 4) * 2 + (c >> 5), rr = r & 15, cc = c & 31, ob = rr * 64 + cc * 2; return st * 1024 + (ob ^ (((ob >> 9) & 1) << 5)); }
DI void stage_rc(int b, int& R, int& C) { const int st = b / 1024, sb = b % 1024, swz = sb ^ (((sb >> 9) & 1) << 5); R = (st >> 1) * 16 + swz / 64; C = (st & 1) * 32 + (swz % 64) / 2; }
DI int perm32(int rho) { const int n = rho >> 4, i = rho & 15; return 8 * (i >> 2) + 4 * n + (i & 3); }

struct Unit { int pm, pn, e, rb, nrow; };

struct StaticOrder {
    int nM, nN, nwg, G, c;
    DI void init(int M, int N, int G_, int c_) { nM = M / BM; nN = N / BM; nwg = nM * nN; G = G_; c = c_; }
    DI bool next(int i, int& pm, int& pn) const {
        const long L = (long)i * G + c; if (L >= nwg) return false;
        int wgid = (int)L; { const int q = nwg / NXCD, r = nwg % NXCD, xcd = wgid % NXCD, off = wgid / NXCD; wgid = (xcd < r ? xcd * (q + 1) : r * (q + 1) + (xcd - r) * q) + off; }
        const int nig = WGM * nN, gid = wgid / nig, fm = gid * WGM, gsz = (nM - fm) < WGM ? (nM - fm) : WGM;
        pm = fm + ((wgid % nig) % gsz); pn = (wgid % nig) / gsz; return true;
    }
};

struct DenseProb {
    const bf16_t* A; const bf16_t* Bt; int K; StaticOrder S;
    DI bool next(int i, Unit& u) const { int pm, pn; if (!S.next(i, pm, pn)) return false; u.pm = pm; u.pn = pn; u.e = 0; u.rb = 0; u.nrow = 256; return true; }
    DI const char* a_base(const Unit& u) const { return (const char*)A + (size_t)u.pm * 256 * K * 2; }
    DI const char* b_base(const Unit& u) const { return (const char*)Bt + (size_t)u.pn * 256 * K * 2; }
    DI void a_voff(const Unit&, const int (&R)[2], const int (&C)[2], unsigned (&v)[2][2]) const {
#pragma unroll
        for (int h = 0; h < 2; ++h)
#pragma unroll
            for (int i = 0; i < 2; ++i) v[h][i] = (unsigned)((h * HALF + R[i]) * K + C[i]) * 2u;
    }
};

template <class Prob, class Epi>
DI void gemm_phase(LAS unsigned char* lds, const Prob& P, const Epi& E) {
    const int tid = threadIdx.x, wid = __builtin_amdgcn_readfirstlane(tid >> 6), lane = tid & 63, wr = wid >> 2, wc = wid & 3, fr = lane & 15, fq = lane >> 4;
    const int K = P.K, nt = K / BK;
    int sR[2], sC[2]; unsigned voffB[2];
#pragma unroll
    for (int i = 0; i < 2; ++i) { int R, C; stage_rc(tid * 16 + i * 8192, R, C); const int Rb = Epi::PERM ? ((R & ~31) + perm32(R & 31)) : R; sR[i] = R; sC[i] = C; voffB[i] = (unsigned)(Rb * K + C) * 2u; }
    const size_t kstep = (size_t)(BK * 2);
    const size_t hstep = (size_t)HALF * K * 2;
    const unsigned ldsw = (unsigned)wid * 1024u;
    const int aoff = lds_byte(wr * 64 + fr, fq * 8), boff = lds_byte(wc * 32 + fr, fq * 8);
#define PG8_SA(b, h) (((b) * 2 + (h)) * HTB)
#define PG8_SB(b, h) ((4 + (b) * 2 + (h)) * HTB)
#define PG8_STAGE2(bufoff, gbase, v0, v1) do { \
        __builtin_amdgcn_global_load_lds((const unsigned*)((const char*)(gbase) + (v0)), (LAS unsigned*)(lds + (bufoff) + ldsw), 16, 0, 0); \
        __builtin_amdgcn_global_load_lds((const unsigned*)((const char*)(gbase) + (v1)), (LAS unsigned*)(lds + (bufoff) + ldsw + 8192), 16, 0, 0); } while (0)
#define PG8_STAGEB(bufoff, gbase) PG8_STAGE2(bufoff, gbase, voffB[0], voffB[1])
#define PG8_LDA(dst, b, h) do { _Pragma("unroll") for (int m = 0; m < 4; ++m) _Pragma("unroll") for (int k = 0; k < 2; ++k) dst[m][k] = *(const LAS bf16x8*)(lds + PG8_SA(b, h) + aoff + m * 2048 + k * 1024); } while (0)
#define PG8_LDB(dst, b, h) do { _Pragma("unroll") for (int n = 0; n < 2; ++n) _Pragma("unroll") for (int k = 0; k < 2; ++k) dst[n][k] = *(const LAS bf16x8*)(lds + PG8_SB(b, h) + boff + n * 2048 + k * 1024); } while (0)
#define PG8_MMA(ai, bj, At, Bt) do { __builtin_amdgcn_s_setprio(1); _Pragma("unroll") for (int m = 0; m < 4; ++m) _Pragma("unroll") for (int n = 0; n < 2; ++n) _Pragma("unroll") for (int k = 0; k < 2; ++k) \
        acc[ai][bj][m][n] = __builtin_amdgcn_mfma_f32_16x16x32_bf16(Bt[n][k], At[m][k], acc[ai][bj][m][n], 0, 0, 0); __builtin_amdgcn_s_setprio(0); } while (0)
#define PG8_WAIT_V(n) asm volatile("s_waitcnt vmcnt(" #n ")" ::: "memory")
#define PG8_WAIT_L(n) asm volatile("s_waitcnt lgkmcnt(" #n ")" ::: "memory")
#define PG8_BAR __builtin_amdgcn_s_barrier()
#define PG8_SCHED __builtin_amdgcn_sched_barrier(0)
    Unit cur, nxt; int ui = 0;
    if (!P.next(0, cur)) return;
    f32x4 acc[2][2][4][2];
#pragma unroll
    for (int a = 0; a < 2; ++a)
#pragma unroll
        for (int b = 0; b < 2; ++b)
#pragma unroll
            for (int m = 0; m < 4; ++m)
#pragma unroll
                for (int n = 0; n < 2; ++n) acc[a][b][m][n] = (f32x4){0.f, 0.f, 0.f, 0.f};
    bf16x8 At[4][2], B0[2][2], B1[2][2];
    const char* cA = P.a_base(cur); const char* cB = P.b_base(cur);
    unsigned vAc[2][2], vAn[2][2];
    P.a_voff(cur, sR, sC, vAc);
    PG8_STAGEB(PG8_SB(0, 0), cB); PG8_STAGEB(PG8_SB(0, 1), cB + hstep); PG8_STAGE2(PG8_SA(0, 0), cA, vAc[0][0], vAc[0][1]); PG8_STAGE2(PG8_SA(0, 1), cA, vAc[1][0], vAc[1][1]);
    if (wr == 1) PG8_BAR;
    PG8_WAIT_V(2); PG8_BAR;
    PG8_STAGEB(PG8_SB(1, 0), cB + kstep); PG8_STAGE2(PG8_SA(1, 0), cA + kstep, vAc[0][0], vAc[0][1]); PG8_STAGEB(PG8_SB(1, 1), cB + hstep + kstep);
    PG8_WAIT_V(6); PG8_BAR;
    for (;;) {
        const bool has_next = P.next(ui + 1, nxt);
        const char* nA = cA; const char* nB = cB;
        if (has_next) { nA = P.a_base(nxt); nB = P.b_base(nxt); P.a_voff(nxt, sR, sC, vAn); }
        else {
#pragma unroll
            for (int h = 0; h < 2; ++h)
#pragma unroll
                for (int i = 0; i < 2; ++i) vAn[h][i] = vAc[h][i];
        }
        for (int t = 0; t < nt; t += 2) {
            const bool last = (t == nt - 2);
            const char* a1 = cA + (size_t)(t + 1) * kstep;
            const char* a2 = last ? nA : cA + (size_t)(t + 2) * kstep; const char* b2 = last ? nB : cB + (size_t)(t + 2) * kstep;
            const char* a3 = a2 + kstep; const char* b3 = b2 + kstep;
            const unsigned w00 = last ? vAn[0][0] : vAc[0][0], w01 = last ? vAn[0][1] : vAc[0][1], w10 = last ? vAn[1][0] : vAc[1][0], w11 = last ? vAn[1][1] : vAc[1][1];
            PG8_LDB(B0, 0, 0); PG8_LDB(B1, 0, 1); PG8_SCHED; PG8_LDA(At, 0, 0); PG8_STAGE2(PG8_SA(1, 1), a1, vAc[1][0], vAc[1][1]);
            PG8_WAIT_V(8); PG8_WAIT_L(0); PG8_BAR; PG8_MMA(0, 0, At, B0); PG8_MMA(0, 1, At, B1); PG8_BAR; PG8_SCHED;
            PG8_LDA(At, 0, 1); PG8_STAGEB(PG8_SB(0, 0), b2); PG8_STAGEB(PG8_SB(0, 1), b2 + hstep); PG8_STAGE2(PG8_SA(0, 0), a2, w00, w01);
            PG8_WAIT_V(8); PG8_WAIT_L(0); PG8_BAR; PG8_MMA(1, 0, At, B0); PG8_MMA(1, 1, At, B1); PG8_BAR; PG8_SCHED;
            PG8_LDB(B0, 1, 0); PG8_LDB(B1, 1, 1); PG8_SCHED; PG8_LDA(At, 1, 0); PG8_STAGE2(PG8_SA(0, 1), a2, w10, w11);
            PG8_WAIT_V(8); PG8_WAIT_L(0); PG8_BAR; PG8_MMA(0, 0, At, B0); PG8_MMA(0, 1, At, B1); PG8_BAR; PG8_SCHED;
            PG8_LDA(At, 1, 1); PG8_STAGEB(PG8_SB(1, 0), b3); PG8_STAGEB(PG8_SB(1, 1), b3 + hstep); PG8_STAGE2(PG8_SA(1, 0), a3, w00, w01);
            PG8_WAIT_V(8); PG8_WAIT_L(0); PG8_BAR; PG8_MMA(1, 0, At, B0); PG8_MMA(1, 1, At, B1); PG8_BAR; PG8_SCHED;
        }
        if (wr == 0) PG8_BAR;
        E(acc, cur, wr, wc, fr, fq);
        if (!has_next) break;
#pragma unroll
        for (int a = 0; a < 2; ++a)
#pragma unroll
            for (int b = 0; b < 2; ++b)
#pragma unroll
                for (int m = 0; m < 4; ++m)
#pragma unroll
                    for (int n = 0; n < 2; ++n) acc[a][b][m][n] = (f32x4){0.f, 0.f, 0.f, 0.f};
        cur = nxt; cA = nA; cB = nB; ++ui;
#pragma unroll
        for (int h = 0; h < 2; ++h)
#pragma unroll
            for (int i = 0; i < 2; ++i) vAc[h][i] = vAn[h][i];
        if (wr == 1) PG8_BAR;
    }
    PG8_WAIT_V(0);
    PG8_BAR;
#undef PG8_SA
#undef PG8_SB
#undef PG8_STAGE2
#undef PG8_STAGEB
#undef PG8_LDA
#undef PG8_LDB
#undef PG8_MMA
#undef PG8_WAIT_V
#undef PG8_WAIT_L
#undef PG8_BAR
#undef PG8_SCHED
}
}
namespace pg8 {
struct EpiBf16Plain {
    static constexpr bool PERM = true;
    bf16_t* O; int ldc;
    DI void operator()(const f32x4 (&acc)[2][2][4][2], const Unit& u, int wr, int wc, int fr, int fq) const {
        const int row0 = u.pm * BM + wr * 64 + fr, col0 = u.pn * BM + wc * 32 + 8 * fq;
#pragma unroll
        for (int ai = 0; ai < 2; ++ai)
#pragma unroll
            for (int m = 0; m < 4; ++m) { bf16_t* rowp = O + (size_t)(row0 + ai * HALF + m * 16) * ldc + col0;
#pragma unroll
                for (int bj = 0; bj < 2; ++bj) { const f32x4 v0 = acc[ai][bj][m][0], v1 = acc[ai][bj][m][1];
                    u32x4 w; w.x = pk_bf16(v0[0], v0[1]); w.y = pk_bf16(v0[2], v0[3]); w.z = pk_bf16(v1[0], v1[1]); w.w = pk_bf16(v1[2], v1[3]);
                    *(u32x4*)(rowp + bj * HALF) = w; } }
    }
};
struct EpiResF32 {
    static constexpr bool PERM = false;
    const float* base; float* C; int ldc;
    DI void operator()(const f32x4 (&acc)[2][2][4][2], const Unit& u, int wr, int wc, int fr, int fq) const {
        const int row0 = u.pm * BM + wr * 64 + fr, col0 = u.pn * BM + wc * 32 + 4 * fq;
#pragma unroll
        for (int ai = 0; ai < 2; ++ai)
#pragma unroll
            for (int m = 0; m < 4; ++m) { const size_t off = (size_t)(row0 + ai * HALF + m * 16) * ldc + col0;
#pragma unroll
                for (int bj = 0; bj < 2; ++bj)
#pragma unroll
                    for (int n = 0; n < 2; ++n) { const f32x4 bs = *(const f32x4*)(base + off + bj * HALF + n * 16); *(f32x4*)(C + off + bj * HALF + n * 16) = bs + acc[ai][bj][m][n]; } }
    }
};
struct EpiGlu {
    static constexpr bool PERM = true;
    bf16_t* O; int ldc; const float* bias;
    DI void operator()(const f32x4 (&acc)[2][2][4][2], const Unit& u, int wr, int wc, int fr, int fq) const {
        const int row0 = u.pm * BM + wr * 64 + fr, colg = u.pn * HALF + wc * 32 + 8 * fq;
        const float* bg = bias + (size_t)u.e * 4096 + colg;
        f32x4 bgl[2], bln[2];
#pragma unroll
        for (int n = 0; n < 2; ++n) { bgl[n] = *(const f32x4*)(bg + 4 * n); bln[n] = *(const f32x4*)(bg + 2048 + 4 * n); }
#pragma unroll
        for (int ai = 0; ai < 2; ++ai)
#pragma unroll
            for (int m = 0; m < 4; ++m) { bf16_t* rowp = O + (size_t)(row0 + ai * HALF + m * 16) * ldc + colg;
                float r[8];
#pragma unroll
                for (int n = 0; n < 2; ++n)
#pragma unroll
                    for (int j = 0; j < 4; ++j) { float g = acc[ai][0][m][n][j] + bgl[n][j], l = acc[ai][1][m][n][j] + bln[n][j];
                        g = fminf(g, 7.0f); l = fminf(fmaxf(l, -7.0f), 7.0f);
                        r[4 * n + j] = g * fast_sigmoid(1.702f * g) * (l + 1.0f); }
                u32x4 w; w.x = pk_bf16(r[0], r[1]); w.y = pk_bf16(r[2], r[3]); w.z = pk_bf16(r[4], r[5]); w.w = pk_bf16(r[6], r[7]);
                *(u32x4*)rowp = w; }
    }
};
struct EpiBf16BiasE {
    static constexpr bool PERM = true;
    bf16_t* O; int ldc; const float* bias;
    DI void operator()(const f32x4 (&acc)[2][2][4][2], const Unit& u, int wr, int wc, int fr, int fq) const {
        const int row0 = u.pm * BM + wr * 64 + fr, col0 = u.pn * BM + wc * 32 + 8 * fq;
        const float* bp = bias + (size_t)u.e * 2048 + col0;
        f32x4 bv[2][2];
#pragma unroll
        for (int bj = 0; bj < 2; ++bj)
#pragma unroll
            for (int n = 0; n < 2; ++n) bv[bj][n] = *(const f32x4*)(bp + bj * HALF + 4 * n);
#pragma unroll
        for (int ai = 0; ai < 2; ++ai)
#pragma unroll
            for (int m = 0; m < 4; ++m) { bf16_t* rowp = O + (size_t)(row0 + ai * HALF + m * 16) * ldc + col0;
#pragma unroll
                for (int bj = 0; bj < 2; ++bj) { const f32x4 v0 = acc[ai][bj][m][0] + bv[bj][0], v1 = acc[ai][bj][m][1] + bv[bj][1];
                    u32x4 w; w.x = pk_bf16(v0[0], v0[1]); w.y = pk_bf16(v0[2], v0[3]); w.z = pk_bf16(v1[0], v1[1]); w.w = pk_bf16(v1[2], v1[3]);
                    *(u32x4*)(rowp + bj * HALF) = w; } }
    }
};
}
constexpr int NWAVES = 8;
constexpr int NTOK = 16384, DM = 2048, SEQ = 2048, NBATCH = 8;
constexpr int DIN = 12816, LDP = 13056;
constexpr int C_QA = 0, C_KA = 2048, C_VA = 2304, C_QB = 2560, C_KB = 3584, C_VB = 4608, C_RB = 6656, C_GA = 8704, C_GB = 10752, C_ALR = 12800;
constexpr int NEXP = 32, TOPK = 4, DFF = 2048;
constexpr int PMAX = 73728;
constexpr float EPS = 1e-5f;
constexpr float LOG2E = 1.4426950408889634f;

constexpr size_t MiB = 1u << 20;
constexpr size_t WS_CTL = 0, CTL_ZERO_BYTES = 1 * MiB;
constexpr size_t WS_TOPE = 1 * MiB;
constexpr size_t WS_TOPS = WS_TOPE + (size_t)NTOK * 4 * 4;
constexpr size_t WS_GATE = WS_TOPS + (size_t)NTOK * 4 * 4;
constexpr size_t WS_TOKL = WS_GATE + (size_t)NTOK * 4 * 4;
constexpr size_t WS_WIN  = 4 * MiB;
constexpr size_t WS_WOUT = WS_WIN + (size_t)LDP * DM * 2;
constexpr size_t WS_WGU  = WS_WOUT + (size_t)DM * DM * 2;
constexpr size_t WS_WDN  = WS_WGU + (size_t)NEXP * 4096 * DM * 2;
constexpr size_t WS_H    = WS_WDN + (size_t)NEXP * DM * DM * 2;
constexpr size_t WS_PROJ = WS_H + (size_t)NTOK * DM * 2;
constexpr size_t WS_OA   = WS_PROJ + (size_t)NTOK * LDP * 2;
constexpr size_t WS_OB   = WS_OA + (size_t)NTOK * DM * 2;
constexpr size_t WS_MIX  = WS_OB + (size_t)NTOK * DM * 2;
constexpr size_t WS_X1   = WS_MIX + (size_t)NTOK * DM * 2;
constexpr size_t WS_GQT  = WS_X1 + (size_t)NTOK * DM * 4;
constexpr size_t WS_GKT  = WS_GQT + (size_t)1024 * 16384 * 2;
constexpr size_t WS_GATT = WS_GKT + (size_t)1024 * 16384 * 2;
constexpr size_t WS_GDEC = WS_GATT + (size_t)1024 * 4096 * 2;
constexpr size_t WS_GVT  = WS_GDEC + (size_t)1024 * 256 * 4;
constexpr size_t WS_ACT  = WS_GVT + (size_t)1024 * 32768 * 2;
constexpr size_t WS_Y    = WS_ACT + (size_t)PMAX * DFF * 2;
constexpr size_t WS_END  = WS_Y + (size_t)PMAX * DM * 2;
static_assert(WS_TOKL + (size_t)NEXP * NTOK * 4 <= WS_WIN, "routing tables below the weight copies");
static_assert(WS_WIN % 256 == 0 && WS_WOUT % 256 == 0 && WS_WGU % 256 == 0 && WS_WDN % 256 == 0 && WS_H % 256 == 0 && WS_PROJ % 256 == 0 && WS_OA % 256 == 0 && WS_X1 % 256 == 0 &&
              WS_GQT % 256 == 0 && WS_GKT % 256 == 0 && WS_GATT % 256 == 0 && WS_GDEC % 256 == 0 && WS_GVT % 256 == 0 && WS_ACT % 256 == 0 && WS_Y % 256 == 0, "alignment");
constexpr int CW_TMO = 0, CW_CODE = 1;
constexpr int CW_BAR = 4096;
constexpr int CW_CNT = 8192;
constexpr int CW_SWAQ = CW_CNT + 64 * 40;
constexpr int RING_OFF = 0, RING_BYTES = 131072;
constexpr int LDSCTL_OFF = RING_BYTES, MISC_OFF = LDSCTL_OFF + 320;
constexpr int TBL_OFF = LDSCTL_OFF + 1024;
constexpr int LDS_BYTES = 147456;
static_assert(MISC_OFF + 128 <= TBL_OFF && TBL_OFF + 4096 <= LDS_BYTES, "LDS map");

typedef GAS unsigned gu32;
#define RLX_AGENT __ATOMIC_RELAXED, __HIP_MEMORY_SCOPE_AGENT
#define LDS_WAIT() asm volatile("s_waitcnt lgkmcnt(0)" ::: "memory")
#define VM_WAIT() asm volatile("s_waitcnt vmcnt(0)" ::: "memory")

#define XB_TMO      128
#define XB_XCNT(j)  (256  + 64 * (j))
#define XB_XSUB(j)  (1280 + 64 * (j))
#define XB_XGEN(j)  (2304 + 64 * (j))
#define XB_TOP      3328
#define XB_TOPGEN   3392
#define XCD_BAR_WORDS 3456
#define XB_SPIN_CAP (1u << 18)

__device__ __forceinline__ unsigned xb_ld(unsigned* p)              { return __hip_atomic_load(p, __ATOMIC_RELAXED, __HIP_MEMORY_SCOPE_AGENT); }
__device__ __forceinline__ unsigned xb_add(unsigned* p, unsigned v) { return __hip_atomic_fetch_add(p, v, __ATOMIC_RELAXED, __HIP_MEMORY_SCOPE_AGENT); }
__device__ __forceinline__ unsigned xb_xcc_id() { return (unsigned)__builtin_amdgcn_s_getreg((3 << 11) | 20) & 0xFu; }
#define XB_SPIN(cond, bar) do { unsigned _sp = 0; while (cond) { __builtin_amdgcn_s_sleep(1); \
    if ((++_sp & 255u) == 0u) { if (xb_ld(&(bar)[XB_TMO])) break; if (_sp > XB_SPIN_CAP) { atomicAdd(&(bar)[XB_TMO], 1u); break; } } } } while (0)

struct XcdBarrier {
    unsigned* bar; unsigned x;
    volatile LAS unsigned* st;
};

__device__ __forceinline__ XcdBarrier xcd_barrier_post(unsigned* bar, volatile LAS unsigned* st) {
    XcdBarrier b; b.bar = bar; b.x = xb_xcc_id(); b.st = st;
    if (threadIdx.x == 0) (void)xb_add(&bar[XB_XCNT(b.x)], 1u);
    return b;
}
__device__ __forceinline__ void xcd_barrier_complete(unsigned* bar, unsigned x, unsigned& nloc, unsigned& nx) {
    const unsigned G = gridDim.x * gridDim.y * gridDim.z;
    unsigned sum, cnt, mine, sp = 0u;
    for (;;) {
        sum = 0u; cnt = 0u; mine = 0u;
#pragma unroll
        for (unsigned j = 0; j < 16; ++j) { const unsigned c = xb_ld(&bar[XB_XCNT(j)]); sum += c; cnt += (c > 0u) ? 1u : 0u; mine = (j == x) ? c : mine; }
        if (sum == G) break;
        __builtin_amdgcn_s_sleep(1);
        if ((++sp & 255u) == 0u) { if (xb_ld(&bar[XB_TMO])) break; if (sp > XB_SPIN_CAP) { atomicAdd(&bar[XB_TMO], 1u); break; } }
    }
    nloc = mine > 0u ? mine : 1u; nx = cnt > 0u ? cnt : 1u;
}

__device__ __forceinline__ void xcd_barrier(const XcdBarrier& b) {
    asm volatile("s_waitcnt vmcnt(0)" ::: "memory");
    __syncthreads();
    if (threadIdx.x == 0) {
        unsigned* bar = b.bar;
        __builtin_amdgcn_s_waitcnt(0);
        unsigned nloc = b.st[0], nx = b.st[1];
        if (nloc == 0u) { xcd_barrier_complete(bar, b.x, nloc, nx); b.st[0] = nloc; b.st[1] = nx; }
        const unsigned old = xb_add(&bar[XB_XSUB(b.x)], 1u);
        const unsigned gen = old / nloc;
        if (old + 1u == (gen + 1u) * nloc) {
            __builtin_amdgcn_fence(__ATOMIC_RELEASE, "agent");
            asm volatile("s_waitcnt vmcnt(0)" ::: "memory");
            const unsigned og = xb_add(&bar[XB_TOP], 1u);
            const unsigned tg = og / nx;
            if (og + 1u == (tg + 1u) * nx) xb_add(&bar[XB_TOPGEN], 1u);
            else XB_SPIN(xb_ld(&bar[XB_TOPGEN]) == tg, bar);
            __builtin_amdgcn_fence(__ATOMIC_ACQUIRE, "agent");
            xb_add(&bar[XB_XGEN(b.x)], 1u);
            asm volatile("s_waitcnt vmcnt(0)" ::: "memory");
        } else {
            XB_SPIN(xb_ld(&bar[XB_XGEN(b.x)]) == gen, bar);
            __builtin_amdgcn_fence(__ATOMIC_ACQUIRE, "agent");
            asm volatile("s_waitcnt vmcnt(0)" ::: "memory");
        }
    }
    __syncthreads();
}

struct Frame {
    LAS unsigned char* lds;
    gu32* ctl;
    int tid, lane, wave, vcu, G;
    const float *x, *attn_g, *w_in, *sinks, *w_alpha2, *b_alpha, *gla_g, *w_out, *ffn_g, *w_router, *b_router, *w_gu, *b_gu, *w_dn, *b_dn, *final_g;
    float* out;
    int *tope, *tops, *tokl; float* gate;
    bf16_t *Win, *Wout, *Wgu, *Wdn, *H, *PROJ, *OA, *OB, *MIX, *GQT, *GKT, *GATT, *GVT, *ACT, *Y;
    float *X1, *GDEC;
};
DI void p0_transpose_item(const float* Wsrc, int ldw, int srccol0, int nvalid, int k0, bf16_t* dst, int K, LAS float* scr, int lane) {
    const int krow = lane >> 3, n4 = lane & 7;
    const bool ok = 4 * n4 < nvalid;
#pragma unroll
    for (int i = 0; i < 8; ++i) { const int kk = 8 * i + krow; f32x4 v = (f32x4){0.f, 0.f, 0.f, 0.f};
        if (ok) v = *(const f32x4*)(Wsrc + (size_t)(k0 + kk) * ldw + srccol0 + 4 * n4);
        LAS float* d = scr + kk * 33 + 4 * n4; d[0] = v[0]; d[1] = v[1]; d[2] = v[2]; d[3] = v[3]; }
    LDS_WAIT(); asm volatile("" ::: "memory");
    const int c = lane & 7;
#pragma unroll
    for (int j = 0; j < 4; ++j) { const int n = (lane >> 3) + 8 * j; const LAS float* s = scr + (8 * c) * 33 + n;
        u32x4 o; o.x = pk_bf16(s[0 * 33], s[1 * 33]); o.y = pk_bf16(s[2 * 33], s[3 * 33]); o.z = pk_bf16(s[4 * 33], s[5 * 33]); o.w = pk_bf16(s[6 * 33], s[7 * 33]);
        *(u32x4*)(dst + (size_t)n * K + k0 + 8 * c) = o; }
    LDS_WAIT(); asm volatile("" ::: "memory");
}
DI void rms_row_to_bf16(const float* xrow, const float* g, bf16_t* orow, int lane) {
    const f32x4* xr = (const f32x4*)xrow + lane; const f32x4* gr = (const f32x4*)g + lane;
    f32x4 v[8]; float s = 0.f;
#pragma unroll
    for (int j = 0; j < 8; ++j) { v[j] = xr[64 * j]; s += (v[j].x * v[j].x + v[j].y * v[j].y) + (v[j].z * v[j].z + v[j].w * v[j].w); }
    const float r = 1.0f / sqrtf(wave_sum(s) * (1.f / DM) + EPS);
    u32x2* o8 = (u32x2*)orow + lane;
#pragma unroll
    for (int j = 0; j < 8; ++j) { const f32x4 gg = gr[64 * j]; u32x2 w; w.x = pk_bf16(v[j].x * r * gg.x, v[j].y * r * gg.y); w.y = pk_bf16(v[j].z * r * gg.z, v[j].w * r * gg.w); o8[64 * j] = w; }
}
DI void p0_prologue(Frame& F) {
    LAS float* scr = (LAS float*)(F.lds + RING_OFF + F.wave * 16384);
    const int gw = F.vcu * NWAVES + F.wave, NGW = F.G * NWAVES;
    constexpr int I_IN = 32 * 408, I_OUT = 32 * 64, I_GU = 32 * 32 * 128, I_DN = 32 * 32 * 64;
    constexpr int NITEMS = I_IN + I_OUT + I_GU + I_DN;
    for (int it = gw; it < NITEMS; it += NGW) {
        int r = it;
        if (r < I_IN) { const int kb = r / 408, nb = r % 408, n0 = 32 * nb; int sc = n0, nv = 32;
            if (n0 >= 8704 && n0 < 12800) sc = n0 + 16; else if (n0 == 12800) { sc = 8704; nv = 16; } else if (n0 > 12800) { sc = 0; nv = 0; }
            p0_transpose_item(F.w_in, DIN, sc, nv, 64 * kb, F.Win + (size_t)n0 * DM, DM, scr, F.lane); continue; }
        r -= I_IN;
        if (r < I_OUT) { const int kb = r / 64, nb = r % 64; p0_transpose_item(F.w_out, DM, 32 * nb, 32, 64 * kb, F.Wout + (size_t)(32 * nb) * DM, DM, scr, F.lane); continue; }
        r -= I_OUT;
        if (r < I_GU) { const int e = r / 4096, rr = r % 4096, kb = rr / 128, nb = rr % 128, n0 = 32 * nb, pn = n0 >> 8, i0 = n0 & 255;
            const int sc = (i0 < 128) ? (128 * pn + i0) : (2048 + 128 * pn + i0 - 128);
            p0_transpose_item(F.w_gu + (size_t)e * DM * 4096, 4096, sc, 32, 64 * kb, F.Wgu + ((size_t)e * 4096 + n0) * DM, DM, scr, F.lane); continue; }
        r -= I_GU;
        { const int e = r / 2048, rr = r % 2048, kb = rr / 64, nb = rr % 64;
            p0_transpose_item(F.w_dn + (size_t)e * DFF * DM, DM, 32 * nb, 32, 64 * kb, F.Wdn + ((size_t)e * DM + 32 * nb) * DFF, DFF, scr, F.lane); }
    }
    for (int m = gw; m < NTOK; m += NGW) rms_row_to_bf16(F.x + (size_t)m * DM, F.attn_g, F.H + (size_t)m * DM, F.lane);
}

DI s16x4 tr_read(const LAS unsigned char* p) { return __builtin_bit_cast(s16x4, __builtin_amdgcn_ds_read_tr16_b64_v4i16((LAS s16x4*)p)); }
DI bf16x8 pack8(const f32x16& x, int s) {
    u32x4 p; p.x = pk_bf16(x[8 * s + 0], x[8 * s + 1]); p.y = pk_bf16(x[8 * s + 2], x[8 * s + 3]); p.z = pk_bf16(x[8 * s + 4], x[8 * s + 5]); p.w = pk_bf16(x[8 * s + 6], x[8 * s + 7]);
    return __builtin_bit_cast(bf16x8, p);
}
DI void swa_phase(Frame& F) {
    LAS unsigned char* Ks = F.lds;
    LAS unsigned char* Vs = F.lds + 36864;
    const int lane = F.lane, w = F.wave, c31 = lane & 31, h = lane >> 5;
    const int i16 = lane & 15, q4 = i16 >> 2, p4 = i16 & 3, blk = (lane >> 4) & 1;
    volatile LAS unsigned* qslot = (volatile LAS unsigned*)(F.lds + MISC_OFF) + 16;
    for (;;) {
        if (F.tid == 0) qslot[0] = __hip_atomic_fetch_add((unsigned*)(F.ctl + CW_SWAQ), 1u, __ATOMIC_RELAXED, __HIP_MEMORY_SCOPE_AGENT);
        __syncthreads();
        const int u = (int)qslot[0];
        if (u >= 512) break;
        const int kh = u & 3, qb = (u >> 2) & 15, b = u >> 6;
        const size_t tokbase = (size_t)b * SEQ;
        const int pos0 = qb * 128 - 128;
#pragma unroll
        for (int i = 0; i < 4; ++i) { const int id = F.tid + 512 * i, row = id >> 3, ch = id & 7, pos = pos0 + row;
            u32x4 kv = (u32x4){0u, 0u, 0u, 0u}, vv = (u32x4){0u, 0u, 0u, 0u};
            if (pos >= 0) { const bf16_t* src = F.PROJ + (tokbase + pos) * LDP + C_KA + kh * 64 + ch * 8; kv = *(const u32x4*)src; vv = *(const u32x4*)(src + (C_VA - C_KA)); }
            *(LAS u32x4*)(Ks + row * 144 + ch * 16) = kv; *(LAS u32x4*)(Vs + row * 144 + ch * 16) = vv; }
        __syncthreads();
        const int head = kh * 8 + w;
        const float slope2 = __builtin_amdgcn_exp2f(-0.25f * (float)(head + 1)) * LOG2E;
        const float sink2 = F.sinks[head] * LOG2E;
        for (int qt = 0; qt < 4; ++qt) {
            const size_t qrow = tokbase + qb * 128 + qt * 32 + c31;
            bf16x8 bq[4];
#pragma unroll
            for (int ks = 0; ks < 4; ++ks) bq[ks] = *(const bf16x8*)(F.PROJ + qrow * LDP + C_QA + head * 64 + ks * 16 + h * 8);
            f32x16 S[5];
#pragma unroll
            for (int kt = 0; kt < 5; ++kt) { f32x16 acc;
#pragma unroll
                for (int i = 0; i < 16; ++i) acc[i] = 0.f;
#pragma unroll
                for (int ks = 0; ks < 4; ++ks) { const bf16x8 a = *(const LAS bf16x8*)(Ks + (32 * (qt + kt) + c31) * 144 + (ks * 16 + h * 8) * 2); acc = MFMA32(a, bq[ks], acc); }
                S[kt] = acc; }
            float mx = sink2;
#pragma unroll
            for (int kt = 0; kt < 5; ++kt)
#pragma unroll
                for (int i = 0; i < 16; ++i) { const int key = 32 * (qt + kt) + crow(i, h); const int dist = 32 * qt + c31 + 128 - key;
                    const bool valid = (dist >= 0) && (dist < 128) && (pos0 + key >= 0);
                    const float s = valid ? (S[kt][i] * (0.125f * LOG2E) - slope2 * (float)dist) : -INFINITY;
                    S[kt][i] = s; mx = fmaxf(mx, s); }
            mx = fmaxf(mx, __shfl_xor(mx, 32));
            float sum = 0.f;
#pragma unroll
            for (int kt = 0; kt < 5; ++kt)
#pragma unroll
                for (int i = 0; i < 16; ++i) { const float p = __builtin_amdgcn_exp2f(S[kt][i] - mx); S[kt][i] = p; sum += p; }
            sum += __shfl_xor(sum, 32); sum += __builtin_amdgcn_exp2f(sink2 - mx);
            const float inv = 1.0f / sum;
            f32x16 O[2];
#pragma unroll
            for (int dt = 0; dt < 2; ++dt)
#pragma unroll
                for (int i = 0; i < 16; ++i) O[dt][i] = 0.f;
#pragma unroll
            for (int kt = 0; kt < 5; ++kt)
#pragma unroll
                for (int s = 0; s < 2; ++s) { const bf16x8 bp = pack8(S[kt], s);
                    const int kb = 32 * (qt + kt) + 16 * s + 4 * h + q4;
#pragma unroll
                    for (int dt = 0; dt < 2; ++dt) { const LAS unsigned char* vp = Vs + kb * 144 + (32 * dt + 16 * blk + 4 * p4) * 2;
                        const s16x4 lo = tr_read(vp), hi = tr_read(vp + 8 * 144);
                        const bf16x8 a = __builtin_shufflevector(lo, hi, 0, 1, 2, 3, 4, 5, 6, 7);
                        O[dt] = MFMA32(a, bp, O[dt]); } }
            bf16_t* orow = F.OA + qrow * DM + head * 64 + 4 * h;
#pragma unroll
            for (int dt = 0; dt < 2; ++dt)
#pragma unroll
                for (int g4 = 0; g4 < 4; ++g4) { u32x2 wv; wv.x = pk_bf16(O[dt][4 * g4] * inv, O[dt][4 * g4 + 1] * inv); wv.y = pk_bf16(O[dt][4 * g4 + 2] * inv, O[dt][4 * g4 + 3] * inv);
                    *(u32x2*)(orow + 32 * dt + 8 * g4) = wv; }
        }
        __syncthreads();
    }
}

DI void gla_prep_phase(Frame& F) {
    LAS unsigned char* Qs = F.lds;
    LAS unsigned char* Kss = F.lds + 33792;
    LAS float* alr = (LAS float*)(F.lds + 67584);
    LAS float* tot = (LAS float*)(F.lds + 71680);
    LAS unsigned char* Vr = F.lds;
    const int tid = F.tid, lane = F.lane, w = F.wave, c31 = lane & 31, h = lane >> 5;
    for (int u = F.vcu; u < 1024; u += F.G) {
        const int hh = (u >> 5) & 3, b = u >> 7, c = u & 31;
        const size_t T0 = (size_t)b * SEQ + c * 64;
#pragma unroll
        for (int j = 0; j < 4; ++j) { const int id = tid + 512 * j, row = id >> 5, ch = id & 31; const bf16_t* src = F.PROJ + (T0 + row) * LDP + C_QB + hh * 256 + ch * 8;
            *(LAS u32x4*)(Qs + row * 528 + ch * 16) = *(const u32x4*)src; *(LAS u32x4*)(Kss + row * 528 + ch * 16) = *(const u32x4*)(src + (C_KB - C_QB)); }
        u32x4 vreg[8];
#pragma unroll
        for (int j = 0; j < 8; ++j) { const int id = tid + 512 * j, row = id >> 6, ch = id & 63; vreg[j] = *(const u32x4*)(F.PROJ + (T0 + row) * LDP + C_VB + hh * 512 + ch * 8); }
        if (tid < 128) { const int t = tid >> 1, hf = tid & 1; const u32x4 raw = *(const u32x4*)(F.PROJ + (T0 + t) * LDP + C_ALR + 8 * hf);
            LAS float* d = alr + t * 16 + 8 * hf;
            d[0] = bf_lo(raw.x); d[1] = bf_hi(raw.x); d[2] = bf_lo(raw.y); d[3] = bf_hi(raw.y); d[4] = bf_lo(raw.z); d[5] = bf_hi(raw.z); d[6] = bf_lo(raw.w); d[7] = bf_hi(raw.w); }
        __syncthreads();
        const int d = tid & 255, hf = tid >> 8;
        float w2[16];
#pragma unroll
        for (int r = 0; r < 16; ++r) w2[r] = F.w_alpha2[r * 1024 + hh * 256 + d];
        const float ba = F.b_alpha[hh * 256 + d];
        float bc[32]; float run = 0.f;
#pragma unroll
        for (int i = 0; i < 32; ++i) { const LAS f32x4* ar = (const LAS f32x4*)(alr + (32 * hf + i) * 16); float z = ba;
#pragma unroll
            for (int r4 = 0; r4 < 4; ++r4) { const f32x4 a = ar[r4]; z += a.x * w2[4 * r4] + a.y * w2[4 * r4 + 1] + a.z * w2[4 * r4 + 2] + a.w * w2[4 * r4 + 3]; }
            const float la = (fminf(z, 0.f) - __logf(1.0f + fast_exp(-fabsf(z)))) * (1.0f / 16.0f);
            run += la; bc[i] = run; }
        tot[hf * 256 + d] = run;
        __syncthreads();
        const float t0 = tot[d], t1 = tot[256 + d], blast = t0 + t1;
        if (hf) {
#pragma unroll
            for (int i = 0; i < 32; ++i) bc[i] += t0;
        } else F.GDEC[(size_t)u * 256 + d] = fast_exp(blast);
        unsigned kpk[16];
#pragma unroll
        for (int i2 = 0; i2 < 16; ++i2) { float kh2[2];
#pragma unroll
            for (int j = 0; j < 2; ++j) { const int i = 2 * i2 + j; LAS bf16_t* qp = (LAS bf16_t*)(Qs + (32 * hf + i) * 528 + d * 2); LAS bf16_t* kp = (LAS bf16_t*)(Kss + (32 * hf + i) * 528 + d * 2);
                const float q = bf2f(*qp), k = bf2f(*kp);
                const float e = fast_exp(bc[i]);
                *qp = f2bf(q * e * 0.0625f);
                *kp = f2bf(k * fast_exp(-bc[i]));
                kh2[j] = k * fast_exp(blast - bc[i]); }
            kpk[i2] = pk_bf16(kh2[0], kh2[1]); }
        { u32x4* dst = (u32x4*)(F.GKT + (size_t)u * 16384 + d * 64 + 32 * hf);
#pragma unroll
            for (int j = 0; j < 4; ++j) dst[j] = (u32x4){kpk[4 * j], kpk[4 * j + 1], kpk[4 * j + 2], kpk[4 * j + 3]}; }
        __syncthreads();
        if (w < 4) { const int m = w >> 1, n = w & 1; f32x16 acc;
#pragma unroll
            for (int i = 0; i < 16; ++i) acc[i] = 0.f;
#pragma unroll
            for (int ks = 0; ks < 16; ++ks) { const bf16x8 a = *(const LAS bf16x8*)(Qs + (32 * m + c31) * 528 + (16 * ks + 8 * h) * 2), bb = *(const LAS bf16x8*)(Kss + (32 * n + c31) * 528 + (16 * ks + 8 * h) * 2);
                acc = MFMA32(a, bb, acc); }
            bf16_t* ao = F.GATT + (size_t)u * 4096;
#pragma unroll
            for (int i = 0; i < 16; ++i) { const int t = 32 * m + crow(i, h), s = 32 * n + c31; ao[t * 64 + s] = f2bf(s <= t ? acc[i] : 0.f); }
        } else { const int t2 = tid - 256;
#pragma unroll
            for (int j = 0; j < 8; ++j) { const int id = t2 + 256 * j, row = id >> 5, ch = id & 31; *(u32x4*)(F.GQT + (size_t)u * 16384 + row * 256 + ch * 8) = *(const LAS u32x4*)(Qs + row * 528 + ch * 16); } }
        __syncthreads();
#pragma unroll
        for (int j = 0; j < 8; ++j) { const int id = tid + 512 * j, row = id >> 6, ch = id & 63; *(LAS u32x4*)(Vr + row * 1040 + ch * 16) = vreg[j]; }
        __syncthreads();
        { u32x4* dst = (u32x4*)(F.GVT + (size_t)u * 32768 + tid * 64);
#pragma unroll
            for (int t8 = 0; t8 < 8; ++t8) { unsigned short v[8];
#pragma unroll
                for (int j = 0; j < 8; ++j) v[j] = *(const LAS bf16_t*)(Vr + (8 * t8 + j) * 1040 + tid * 2);
                dst[t8] = (u32x4){(unsigned)v[0] | ((unsigned)v[1] << 16), (unsigned)v[2] | ((unsigned)v[3] << 16), (unsigned)v[4] | ((unsigned)v[5] << 16), (unsigned)v[6] | ((unsigned)v[7] << 16)}; } }
        __syncthreads();
    }
}

DI void gla_scan_phase(Frame& F) {
    LAS unsigned char* Qs = F.lds;
    LAS unsigned char* KTs = F.lds + 33792;
    LAS unsigned char* ATs = F.lds + 70656;
    LAS float* DECs = (LAS float*)(F.lds + 79872);
    const int tid = F.tid, lane = F.lane, w = F.wave, c31 = lane & 31, h = lane >> 5;
    const int u = F.vcu, hf = u & 1, hh = (u >> 1) & 3, b = u >> 3;
    f32x16 S[8];
#pragma unroll
    for (int i = 0; i < 8; ++i)
#pragma unroll
        for (int j = 0; j < 16; ++j) S[i][j] = 0.f;
    const int vrow = hf * 256 + 32 * w + c31;
    for (int c = 0; c < 32; ++c) {
        const size_t item = (size_t)(b * 4 + hh) * 32 + c;
        const size_t T0 = (size_t)b * SEQ + c * 64;
#pragma unroll
        for (int j = 0; j < 4; ++j) { const int id = tid + 512 * j, row = id >> 5, ch = id & 31; *(LAS u32x4*)(Qs + row * 528 + ch * 16) = *(const u32x4*)(F.GQT + item * 16384 + row * 256 + ch * 8); }
#pragma unroll
        for (int j = 0; j < 4; ++j) { const int id = tid + 512 * j, row = id >> 3, ch = id & 7; *(LAS u32x4*)(KTs + row * 144 + ch * 16) = *(const u32x4*)(F.GKT + item * 16384 + row * 64 + ch * 8); }
        { const int row = tid >> 3, ch = tid & 7; *(LAS u32x4*)(ATs + row * 144 + ch * 16) = *(const u32x4*)(F.GATT + item * 4096 + row * 64 + ch * 8); }
        if (tid < 64) *(LAS f32x4*)(DECs + 4 * tid) = *(const f32x4*)(F.GDEC + item * 256 + 4 * tid);
        bf16x8 bv[4];
#pragma unroll
        for (int ks = 0; ks < 4; ++ks) bv[ks] = *(const bf16x8*)(F.GVT + item * 32768 + (size_t)vrow * 64 + 16 * ks + 8 * h);
        __syncthreads();
        f32x16 o[2];
#pragma unroll
        for (int m = 0; m < 2; ++m)
#pragma unroll
            for (int j = 0; j < 16; ++j) o[m][j] = 0.f;
#pragma unroll
        for (int i = 0; i < 8; ++i)
#pragma unroll
            for (int s = 0; s < 2; ++s) { const bf16x8 bs = pack8(S[i], s);
#pragma unroll
                for (int m = 0; m < 2; ++m) { const LAS unsigned char* ap = Qs + (32 * m + c31) * 528 + (32 * i + 16 * s + 4 * h) * 2;
                    const s16x4 lo = *(const LAS s16x4*)ap, hi = *(const LAS s16x4*)(ap + 16);
                    const bf16x8 a = __builtin_shufflevector(lo, hi, 0, 1, 2, 3, 4, 5, 6, 7);
                    o[m] = MFMA32(a, bs, o[m]); } }
#pragma unroll
        for (int ks = 0; ks < 4; ++ks)
#pragma unroll
            for (int m = 0; m < 2; ++m) { const bf16x8 a = *(const LAS bf16x8*)(ATs + (32 * m + c31) * 144 + (16 * ks + 8 * h) * 2); o[m] = MFMA32(a, bv[ks], o[m]); }
        { bf16_t* ob = F.OB + T0 * DM + hh * 512 + vrow;
#pragma unroll
            for (int m = 0; m < 2; ++m)
#pragma unroll
                for (int j = 0; j < 16; ++j) ob[(size_t)(32 * m + crow(j, h)) * DM] = f2bf(o[m][j]); }
#pragma unroll
        for (int i = 0; i < 8; ++i) {
#pragma unroll
            for (int g4 = 0; g4 < 4; ++g4) { const f32x4 dc = *(const LAS f32x4*)(DECs + 32 * i + 8 * g4 + 4 * h);
                S[i][4 * g4] *= dc.x; S[i][4 * g4 + 1] *= dc.y; S[i][4 * g4 + 2] *= dc.z; S[i][4 * g4 + 3] *= dc.w; }
#pragma unroll
            for (int ks = 0; ks < 4; ++ks) { const bf16x8 a = *(const LAS bf16x8*)(KTs + (32 * i + c31) * 144 + (16 * ks + 8 * h) * 2); S[i] = MFMA32(a, bv[ks], S[i]); } }
        __syncthreads();
    }
}

DI void merge_phase(Frame& F) {
    const int gw = F.vcu * NWAVES + F.wave, NGW = F.G * NWAVES, lane = F.lane;
    for (int m = gw; m < NTOK; m += NGW) {
        const bf16_t* pr = F.PROJ + (size_t)m * LDP;
#pragma unroll
        for (int j = 0; j < 4; ++j) { const int c0 = j * 512 + lane * 8;
            const u32x4 ob = *(const u32x4*)(F.OB + (size_t)m * DM + c0), oa = *(const u32x4*)(F.OA + (size_t)m * DM + c0);
            const u32x4 rb = *(const u32x4*)(pr + C_RB + c0), ga = *(const u32x4*)(pr + C_GA + c0), gb = *(const u32x4*)(pr + C_GB + c0);
            const f32x4 g0 = *(const f32x4*)(F.gla_g + lane * 8), g1 = *(const f32x4*)(F.gla_g + lane * 8 + 4);
            float vb[8] = {bf_lo(ob.x), bf_hi(ob.x), bf_lo(ob.y), bf_hi(ob.y), bf_lo(ob.z), bf_hi(ob.z), bf_lo(ob.w), bf_hi(ob.w)};
            const float va[8] = {bf_lo(oa.x), bf_hi(oa.x), bf_lo(oa.y), bf_hi(oa.y), bf_lo(oa.z), bf_hi(oa.z), bf_lo(oa.w), bf_hi(oa.w)};
            const float vr[8] = {bf_lo(rb.x), bf_hi(rb.x), bf_lo(rb.y), bf_hi(rb.y), bf_lo(rb.z), bf_hi(rb.z), bf_lo(rb.w), bf_hi(rb.w)};
            const float vga[8] = {bf_lo(ga.x), bf_hi(ga.x), bf_lo(ga.y), bf_hi(ga.y), bf_lo(ga.z), bf_hi(ga.z), bf_lo(ga.w), bf_hi(ga.w)};
            const float vgb[8] = {bf_lo(gb.x), bf_hi(gb.x), bf_lo(gb.y), bf_hi(gb.y), bf_lo(gb.z), bf_hi(gb.z), bf_lo(gb.w), bf_hi(gb.w)};
            const float gn[8] = {g0.x, g0.y, g0.z, g0.w, g1.x, g1.y, g1.z, g1.w};
            float ss = 0.f;
#pragma unroll
            for (int k = 0; k < 8; ++k) ss += vb[k] * vb[k];
            const float rn = 1.0f / sqrtf(wave_sum(ss) * (1.f / 512.f) + EPS);
            float r[8];
#pragma unroll
            for (int k = 0; k < 8; ++k) { const float obn = vb[k] * rn * gn[k]; const float sl = vr[k] * fast_sigmoid(vr[k]);
                r[k] = fast_sigmoid(vga[k]) * va[k] + fast_sigmoid(vgb[k]) * obn * sl; }
            *(u32x4*)(F.MIX + (size_t)m * DM + c0) = (u32x4){pk_bf16(r[0], r[1]), pk_bf16(r[2], r[3]), pk_bf16(r[4], r[5]), pk_bf16(r[6], r[7])}; }
    }
}

DI void router_phase(Frame& F) {
    LAS float* part = (LAS float*)F.lds;
    LAS float* ssp = (LAS float*)(F.lds + 34816);
    LAS float* rt = (LAS float*)(F.lds + 36864);
    LAS float* lg = (LAS float*)(F.lds + 37888);
    const int tid = F.tid, lane = F.lane, w = F.wave, c31 = lane & 31, h = lane >> 5;
    for (int tile = F.vcu; tile < NTOK / 32; tile += F.G) {
        const int t0 = tile * 32, kw = 256 * w;
        { const float* xr = F.X1 + (size_t)(t0 + c31) * DM + kw + 4 * h; const float* gp = F.ffn_g + kw + 4 * h; const float* wp = F.w_router + (size_t)(kw + 4 * h) * 32 + c31;
            f32x16 acc;
#pragma unroll
            for (int i = 0; i < 16; ++i) acc[i] = 0.f;
            float ss = 0.f;
#pragma unroll 4
            for (int m = 0; m < 32; ++m) { const f32x4 a = *(const f32x4*)(xr + 8 * m); const f32x4 g4 = *(const f32x4*)(gp + 8 * m); const float* wr_ = wp + (size_t)m * 256;
                const float b0 = g4.x * wr_[0], b1 = g4.y * wr_[32], b2 = g4.z * wr_[64], b3 = g4.w * wr_[96];
                ss += (a.x * a.x + a.y * a.y) + (a.z * a.z + a.w * a.w);
                acc = __builtin_amdgcn_mfma_f32_32x32x2f32(a.x, b0, acc, 0, 0, 0); acc = __builtin_amdgcn_mfma_f32_32x32x2f32(a.y, b1, acc, 0, 0, 0);
                acc = __builtin_amdgcn_mfma_f32_32x32x2f32(a.z, b2, acc, 0, 0, 0); acc = __builtin_amdgcn_mfma_f32_32x32x2f32(a.w, b3, acc, 0, 0, 0); }
            ss += __shfl_xor(ss, 32);
#pragma unroll
            for (int i = 0; i < 16; ++i) part[(w * 32 + crow(i, h)) * 33 + c31] = acc[i];
            if (h == 0) ssp[w * 32 + c31] = ss; }
        __syncthreads();
        { const int tok = tid >> 4, e0 = tid & 15; float s0 = 0.f, s1 = 0.f, sst = 0.f;
#pragma unroll
            for (int w2 = 0; w2 < 8; ++w2) { s0 += part[(w2 * 32 + tok) * 33 + e0]; s1 += part[(w2 * 32 + tok) * 33 + e0 + 16]; sst += ssp[w2 * 32 + tok]; }
            const float r = 1.0f / sqrtf(sst * (1.f / DM) + EPS);
            lg[tok * 33 + e0] = s0 * r + F.b_router[e0]; lg[tok * 33 + e0 + 16] = s1 * r + F.b_router[e0 + 16]; if (e0 == 0) rt[tok] = r; }
        __syncthreads();
#pragma unroll
        for (int it = 0; it < 2; ++it) { const int tok = 4 * w + 2 * it + h; const int m = t0 + tok;
            float v = lg[tok * 33 + c31]; float tv[4]; int ti[4];
#pragma unroll
            for (int k = 0; k < 4; ++k) { float bv = v; int bi = c31;
#pragma unroll
                for (int o = 1; o < 32; o <<= 1) { const float ov = __shfl_xor(bv, o); const int oi = __shfl_xor(bi, o); const bool take = (ov > bv) || (ov == bv && oi < bi); bv = take ? ov : bv; bi = take ? oi : bi; }
                tv[k] = bv; ti[k] = bi; v = (c31 == bi) ? -INFINITY : v; }
            const float e1 = fast_exp(tv[1] - tv[0]), e2 = fast_exp(tv[2] - tv[0]), e3 = fast_exp(tv[3] - tv[0]); const float inv = 1.0f / (1.0f + e1 + e2 + e3);
            if (c31 < 4) { const int ex = c31 == 0 ? ti[0] : c31 == 1 ? ti[1] : c31 == 2 ? ti[2] : ti[3]; const float gt = (c31 == 0 ? 1.0f : c31 == 1 ? e1 : c31 == 2 ? e2 : e3) * inv;
                const unsigned slot = __hip_atomic_fetch_add((unsigned*)(F.ctl + CW_CNT + 64 * ex), 1u, __ATOMIC_RELAXED, __HIP_MEMORY_SCOPE_AGENT);
                F.tokl[(size_t)ex * NTOK + slot] = m; F.tope[m * 4 + c31] = ex; F.tops[m * 4 + c31] = (int)slot; F.gate[m * 4 + c31] = gt; } }
#pragma unroll
        for (int q = 0; q < 4; ++q) { const int tok = 4 * w + q; const size_t m = (size_t)(t0 + tok); const float r = rt[tok];
            const f32x4* xr = (const f32x4*)(F.X1 + m * DM) + lane; const f32x4* gr = (const f32x4*)F.ffn_g + lane; u32x2* o8 = (u32x2*)(F.H + m * DM) + lane;
#pragma unroll
            for (int j = 0; j < 8; ++j) { const f32x4 xv = xr[64 * j], gg = gr[64 * j]; u32x2 wv; wv.x = pk_bf16(xv.x * r * gg.x, xv.y * r * gg.y); wv.y = pk_bf16(xv.z * r * gg.z, xv.w * r * gg.w); o8[64 * j] = wv; } }
        __syncthreads();
    }
}

DI void moe_tables(Frame& F) {
    LAS int* tb = (LAS int*)(F.lds + TBL_OFF);
    if (F.tid == 0) { int acc = 0;
        for (int e = 0; e < NEXP; ++e) { const int c = (int)__hip_atomic_load((unsigned*)(F.ctl + CW_CNT + 64 * e), __ATOMIC_RELAXED, __HIP_MEMORY_SCOPE_AGENT); tb[e] = acc; tb[40 + e] = c; acc += (c + 255) >> 8; }
        tb[32] = acc; }
    __syncthreads();
}
struct MoeProb {
    const bf16_t* A; const bf16_t* Bt; const int* tokl; const LAS int* tb; int K, NT  , brows  , G, c; bool gather;
    DI bool next(int i, pg8::Unit& u) const {
        const int L = i * G + c; const int nb = tb[32]; if (L >= nb * NT) return false;
        const int blk = L / NT, pn = L % NT; int e = 0;
        for (int j = 1; j < NEXP; ++j) e += (tb[j] <= blk) ? 1 : 0;
        const int rb = blk - tb[e]; int nr = tb[40 + e] - rb * 256; nr = nr > 256 ? 256 : nr;
        u.pm = blk; u.pn = pn; u.e = e; u.rb = rb; u.nrow = nr; return true;
    }
    DI const char* a_base(const pg8::Unit& u) const { return gather ? (const char*)A : (const char*)A + (size_t)u.pm * 256 * K * 2; }
    DI const char* b_base(const pg8::Unit& u) const { return (const char*)Bt + ((size_t)u.e * brows + (size_t)u.pn * 256) * K * 2; }
    DI void a_voff(const pg8::Unit& u, const int (&R)[2], const int (&C)[2], unsigned (&v)[2][2]) const {
#pragma unroll
        for (int h = 0; h < 2; ++h)
#pragma unroll
            for (int i = 0; i < 2; ++i) { const int r = h * 128 + R[i];
                if (gather) { int tok = 0; if (r < u.nrow) tok = tokl[(size_t)u.e * NTOK + u.rb * 256 + r]; v[h][i] = (unsigned)(tok * K + C[i]) * 2u; }
                else v[h][i] = (unsigned)(r * K + C[i]) * 2u; }
    }
};

DI void final_phase(Frame& F) {
    const LAS int* tb = (const LAS int*)(F.lds + TBL_OFF);
    const int gw = F.vcu * NWAVES + F.wave, NGW = F.G * NWAVES, lane = F.lane;
    for (int m = gw; m < NTOK; m += NGW) {
        const bf16_t* yr[4]; float gt[4];
#pragma unroll
        for (int k = 0; k < 4; ++k) { const int e = F.tope[m * 4 + k], sl = F.tops[m * 4 + k]; gt[k] = F.gate[m * 4 + k]; yr[k] = F.Y + ((size_t)tb[e] * 256 + sl) * DM; }
        float v[4][8]; float ss = 0.f;
#pragma unroll
        for (int j = 0; j < 4; ++j) { const int c0 = 8 * (lane + 64 * j);
            const f32x4 x0 = *(const f32x4*)(F.X1 + (size_t)m * DM + c0), x1 = *(const f32x4*)(F.X1 + (size_t)m * DM + c0 + 4);
            float a[8] = {x0.x, x0.y, x0.z, x0.w, x1.x, x1.y, x1.z, x1.w};
#pragma unroll
            for (int k = 0; k < 4; ++k) { const u32x4 y = *(const u32x4*)(yr[k] + c0);
                a[0] += gt[k] * bf_lo(y.x); a[1] += gt[k] * bf_hi(y.x); a[2] += gt[k] * bf_lo(y.y); a[3] += gt[k] * bf_hi(y.y);
                a[4] += gt[k] * bf_lo(y.z); a[5] += gt[k] * bf_hi(y.z); a[6] += gt[k] * bf_lo(y.w); a[7] += gt[k] * bf_hi(y.w); }
#pragma unroll
            for (int q = 0; q < 8; ++q) { v[j][q] = a[q]; ss += a[q] * a[q]; } }
        const float r = 1.0f / sqrtf(wave_sum(ss) * (1.f / DM) + EPS);
#pragma unroll
        for (int j = 0; j < 4; ++j) { const int c0 = 8 * (lane + 64 * j);
            const f32x4 g0 = *(const f32x4*)(F.final_g + c0), g1 = *(const f32x4*)(F.final_g + c0 + 4);
            *(f32x4*)(F.out + (size_t)m * DM + c0) = (f32x4){v[j][0] * r * g0.x, v[j][1] * r * g0.y, v[j][2] * r * g0.z, v[j][3] * r * g0.w};
            *(f32x4*)(F.out + (size_t)m * DM + c0 + 4) = (f32x4){v[j][4] * r * g1.x, v[j][5] * r * g1.y, v[j][6] * r * g1.z, v[j][7] * r * g1.w}; }
    }
}
#ifndef MK_N_LAUNCHES
#define MK_N_LAUNCHES 1
#endif
constexpr int N_PHASES = 10;
struct Args { const float* in[16]; float* out; unsigned char* ws; int ph_lo, ph_hi; };
static_assert(sizeof(Args) == 16 * 8 + 8 + 8 + 8, "Args has no padding");

__global__ void __launch_bounds__(NWAVES * 64, 2) fwd_kernel(Args args) {
    extern __shared__ __attribute__((aligned(16))) unsigned char lds_raw[];
    Frame F;
    F.lds = (LAS unsigned char*)lds_raw;
    F.tid = threadIdx.x; F.lane = F.tid & 63; F.wave = __builtin_amdgcn_readfirstlane(F.tid >> 6);
    F.G = gridDim.x; { const int bx = blockIdx.x; F.vcu = (F.G % 8 == 0) ? (bx % 8) * (F.G / 8) + bx / 8 : bx; }
    unsigned char* ws = args.ws;
    F.ctl = (gu32*)(ws + WS_CTL);
    F.x = args.in[0]; F.attn_g = args.in[1]; F.w_in = args.in[2]; F.sinks = args.in[3]; F.w_alpha2 = args.in[4]; F.b_alpha = args.in[5]; F.gla_g = args.in[6]; F.w_out = args.in[7];
    F.ffn_g = args.in[8]; F.w_router = args.in[9]; F.b_router = args.in[10]; F.w_gu = args.in[11]; F.b_gu = args.in[12]; F.w_dn = args.in[13]; F.b_dn = args.in[14]; F.final_g = args.in[15];
    F.out = args.out;
    F.tope = (int*)(ws + WS_TOPE); F.tops = (int*)(ws + WS_TOPS); F.gate = (float*)(ws + WS_GATE); F.tokl = (int*)(ws + WS_TOKL);
    F.Win = (bf16_t*)(ws + WS_WIN); F.Wout = (bf16_t*)(ws + WS_WOUT); F.Wgu = (bf16_t*)(ws + WS_WGU); F.Wdn = (bf16_t*)(ws + WS_WDN);
    F.H = (bf16_t*)(ws + WS_H); F.PROJ = (bf16_t*)(ws + WS_PROJ); F.OA = (bf16_t*)(ws + WS_OA); F.OB = (bf16_t*)(ws + WS_OB); F.MIX = (bf16_t*)(ws + WS_MIX);
    F.X1 = (float*)(ws + WS_X1); F.GQT = (bf16_t*)(ws + WS_GQT); F.GKT = (bf16_t*)(ws + WS_GKT); F.GATT = (bf16_t*)(ws + WS_GATT); F.GDEC = (float*)(ws + WS_GDEC); F.GVT = (bf16_t*)(ws + WS_GVT);
    F.ACT = (bf16_t*)(ws + WS_ACT); F.Y = (bf16_t*)(ws + WS_Y);
    for (int u = F.tid; u < (LDS_BYTES - LDSCTL_OFF) / 4; u += NWAVES * 64) ((LAS unsigned*)(F.lds + LDSCTL_OFF))[u] = 0u;
    __syncthreads();
    const int lo = args.ph_lo, hi = args.ph_hi;
    const bool use_bar = (hi - lo) > 1;
    XcdBarrier bar; bar.bar = (unsigned*)(F.ctl + CW_BAR); bar.x = 0; bar.st = nullptr;
    if (use_bar) bar = xcd_barrier_post((unsigned*)(F.ctl + CW_BAR), (volatile LAS unsigned*)(F.lds + MISC_OFF) + 8);
#define IN(k) (lo <= (k) && (k) < hi)
#define SEAM(k) do { if (IN(k) && IN((k) + 1)) xcd_barrier(bar); } while (0)

    if (IN(0)) { p0_prologue(F); }
    SEAM(0);
    if (IN(1)) {
        pg8::DenseProb P; P.A = F.H; P.Bt = F.Win; P.K = DM; P.S.init(NTOK, LDP, F.G, (int)blockIdx.x);
        pg8::EpiBf16Plain E{F.PROJ, LDP};
        pg8::gemm_phase(F.lds + RING_OFF, P, E);
    }
    SEAM(1);
    if (IN(2)) { gla_prep_phase(F); }
    SEAM(2);
    if (IN(3)) { if (F.vcu < 64) gla_scan_phase(F); swa_phase(F); }
    SEAM(3);
    if (IN(4)) { merge_phase(F); }
    SEAM(4);
    if (IN(5)) {
        pg8::DenseProb P; P.A = F.MIX; P.Bt = F.Wout; P.K = DM; P.S.init(NTOK, DM, F.G, (int)blockIdx.x);
        pg8::EpiResF32 E{F.x, F.X1, DM};
        pg8::gemm_phase(F.lds + RING_OFF, P, E);
    }
    SEAM(5);
    if (IN(6)) { router_phase(F); }
    SEAM(6);
    if (IN(7)) {
        moe_tables(F);
        MoeProb P; P.A = F.H; P.Bt = F.Wgu; P.tokl = F.tokl; P.tb = (const LAS int*)(F.lds + TBL_OFF); P.K = DM; P.NT = 16; P.brows = 4096; P.G = F.G; P.c = (int)blockIdx.x; P.gather = true;
        pg8::EpiGlu E{F.ACT, DFF, F.b_gu};
        pg8::gemm_phase(F.lds + RING_OFF, P, E);
    }
    SEAM(7);
    if (IN(8)) {
        moe_tables(F);
        MoeProb P; P.A = F.ACT; P.Bt = F.Wdn; P.tokl = F.tokl; P.tb = (const LAS int*)(F.lds + TBL_OFF); P.K = DFF; P.NT = 8; P.brows = 2048; P.G = F.G; P.c = (int)blockIdx.x; P.gather = false;
        pg8::EpiBf16BiasE E{F.Y, DM, F.b_dn};
        pg8::gemm_phase(F.lds + RING_OFF, P, E);
    }
    SEAM(8);
    if (IN(9)) { moe_tables(F); final_phase(F); }
#undef IN
#undef SEAM
}

extern "C" void kernel_launch(void* const* d_in, const int* in_sizes, int n_in, void* d_out, int out_size, void* d_ws, size_t ws_size, hipStream_t stream) {
    static int grid = 0;
    if (grid == 0) {
        if (n_in != 16 || out_size != NTOK * DM || ws_size < WS_END) { fprintf(stderr, "kernel_launch: unexpected shapes (n_in %d, out %d, ws %zu, need %zu); nothing launched\n", n_in, out_size, ws_size, (size_t)WS_END); grid = -1; return; }
        int dev = 0, cus = 0, per_cu = 0;
        if (hipGetDevice(&dev) != hipSuccess || hipDeviceGetAttribute(&cus, hipDeviceAttributeMultiprocessorCount, dev) != hipSuccess) { fprintf(stderr, "kernel_launch: device query failed\n"); grid = -1; return; }
        if (hipFuncSetAttribute((const void*)fwd_kernel, hipFuncAttributeMaxDynamicSharedMemorySize, LDS_BYTES) != hipSuccess) { fprintf(stderr, "kernel_launch: hipFuncSetAttribute failed\n"); grid = -1; return; }
        if (hipOccupancyMaxActiveBlocksPerMultiprocessor(&per_cu, (const void*)fwd_kernel, NWAVES * 64, LDS_BYTES) != hipSuccess || per_cu < 1)
            fprintf(stderr, "kernel_launch: note: occupancy query reports %d workgroups per CU\n", per_cu);
        (void)hipGetLastError();
        grid = cus;
    }
    if (grid < 0) return;
    if (hipMemsetAsync((char*)d_ws + WS_CTL, 0, CTL_ZERO_BYTES, stream) != hipSuccess) { fprintf(stderr, "kernel_launch: hipMemsetAsync failed\n"); return; }
    Args a{};
    for (int i = 0; i < 16; ++i) a.in[i] = (const float*)d_in[i];
    a.out = (float*)d_out; a.ws = (unsigned char*)d_ws;
    if (MK_N_LAUNCHES == 1) { a.ph_lo = 0; a.ph_hi = N_PHASES; hipLaunchKernelGGL(fwd_kernel, dim3(grid), dim3(NWAVES * 64), LDS_BYTES, stream, a); }
    else for (int p = 0; p < N_PHASES; ++p) { a.ph_lo = p; a.ph_hi = p + 1; hipLaunchKernelGGL(fwd_kernel, dim3(grid), dim3(NWAVES * 64), LDS_BYTES, stream, a);
#ifdef MK_REPEAT_MASK
        if ((MK_REPEAT_MASK >> p) & 1) hipLaunchKernelGGL(fwd_kernel, dim3(grid), dim3(NWAVES * 64), LDS_BYTES, stream, a);
#endif
    }
    const hipError_t le = hipPeekAtLastError();
    if (le != hipSuccess) fprintf(stderr, "kernel_launch: launch failed: %s\n", hipGetErrorName(le));
}
```

```cpp
#define MK_N_LAUNCHES 1
#include <hip/hip_runtime.h>
#include <cstdio>
#include <cstdint>

#define DI __device__ __forceinline__
#define LAS __attribute__((address_space(3)))
#define GAS __attribute__((address_space(1)))
typedef unsigned short bf16_t;
typedef short bf16x8 __attribute__((ext_vector_type(8)));
typedef short s16x4 __attribute__((ext_vector_type(4)));
typedef float f32x4 __attribute__((ext_vector_type(4)));
typedef float f32x16 __attribute__((ext_vector_type(16)));
typedef unsigned u32x4 __attribute__((ext_vector_type(4)));
typedef unsigned u32x2 __attribute__((ext_vector_type(2)));
typedef float f32x2_t __attribute__((ext_vector_type(2)));
typedef __bf16 bf16x2_t __attribute__((ext_vector_type(2)));
typedef int i32x4 __attribute__((ext_vector_type(4)));
typedef int i32x8 __attribute__((ext_vector_type(8)));
DI unsigned pk4_fp8(float a, float b, float c, float d) { int p = __builtin_amdgcn_cvt_pk_fp8_f32(a, b, 0, false); p = __builtin_amdgcn_cvt_pk_fp8_f32(c, d, p, true); return (unsigned)p; }
DI float clamp_fp8(float x) { return fminf(fmaxf(x, -448.0f), 448.0f); }
constexpr int F8_SCALE_W = 0x79797979;
constexpr int F8_SCALE_A = 0x7c7c7c7c;

DI unsigned pk_bf16(float lo, float hi) { f32x2_t v = {lo, hi}; bf16x2_t b = __builtin_convertvector(v, bf16x2_t); return __builtin_bit_cast(unsigned, b); }
DI float bf_lo(unsigned w) { return __uint_as_float(w << 16); }
DI float bf_hi(unsigned w) { return __uint_as_float(w & 0xffff0000u); }
DI float bf2f(bf16_t v) { return __uint_as_float(((unsigned)v) << 16); }
DI bf16_t f2bf(float f) { return (bf16_t)(pk_bf16(f, 0.f) & 0xffffu); }
DI float fast_exp(float x) { return __builtin_amdgcn_exp2f(x * 1.4426950408889634f); }
DI float fast_rcp(float x) { return __builtin_amdgcn_rcpf(x); }
DI float fast_sigmoid(float x) { return fast_rcp(1.0f + fast_exp(-x)); }
DI float wave_sum(float v) {
#pragma unroll
    for (int o = 1; o < 64; o <<= 1) v += __shfl_xor(v, o);
    return v;
}
DI int crow(int reg, int h) { return (reg & 3) + 8 * (reg >> 2) + 4 * h; }
#define MFMA32(a, b, c) __builtin_amdgcn_mfma_f32_32x32x16_bf16((a), (b), (c), 0, 0, 0)

namespace pg8 {
constexpr int BM = 256, BK = 64, HALF = 128, HTB = HALF * BK * 2  , STAGE_BYTES = 8 * HTB, NXCD = 8, WGM = 8;

DI int lds_byte(int r, int c) { const int st = (r >> 4) * 2 + (c >> 5), rr = r & 15, cc = c & 31, ob = rr * 64 + cc * 2; return st * 1024 + (ob ^ (((ob >> 9) & 1) << 5)); }
DI void stage_rc(int b, int& R, int& C) { const int st = b / 1024, sb = b % 1024, swz = sb ^ (((sb >> 9) & 1) << 5); R = (st >> 1) * 16 + swz / 64; C = (st & 1) * 32 + (swz % 64) / 2; }
DI int perm32(int rho) { const int n = rho >> 4, i = rho & 15; return 8 * (i >> 2) + 4 * n + (i & 3); }

struct Unit { int pm, pn, e, rb, nrow; };

struct StaticOrder {
    int nM, nN, nwg, G, c;
    DI void init(int M, int N, int G_, int c_) { nM = M / BM; nN = N / BM; nwg = nM * nN; G = G_; c = c_; }
    DI bool next(int i, int& pm, int& pn) const {
        const long L = (long)i * G + c; if (L >= nwg) return false;
        int wgid = (int)L; { const int q = nwg / NXCD, r = nwg % NXCD, xcd = wgid % NXCD, off = wgid / NXCD; wgid = (xcd < r ? xcd * (q + 1) : r * (q + 1) + (xcd - r) * q) + off; }
        const int nig = WGM * nN, gid = wgid / nig, fm = gid * WGM, gsz = (nM - fm) < WGM ? (nM - fm) : WGM;
        pm = fm + ((wgid % nig) % gsz); pn = (wgid % nig) / gsz; return true;
    }
};

struct DenseProb {
    const bf16_t* A; const bf16_t* Bt; int K; StaticOrder S;
    DI bool next(int i, Unit& u) const { int pm, pn; if (!S.next(i, pm, pn)) return false; u.pm = pm; u.pn = pn; u.e = 0; u.rb = 0; u.nrow = 256; return true; }
    DI const char* a_base(const Unit& u) const { return (const char*)A + (size_t)u.pm * 256 * K * 2; }
    DI const char* b_base(const Unit& u) const { return (const char*)Bt + (size_t)u.pn * 256 * K * 2; }
    DI void a_voff(const Unit&, const int (&R)[2], const int (&C)[2], unsigned (&v)[2][2]) const {
#pragma unroll
        for (int h = 0; h < 2; ++h)
#pragma unroll
            for (int i = 0; i < 2; ++i) v[h][i] = (unsigned)((h * HALF + R[i]) * K + C[i]) * 2u;
    }
};

template <bool F8, class Prob, class Epi>
DI void gemm_phase(LAS unsigned char* lds, const Prob& P, const Epi& E) {
    const int tid = threadIdx.x, wid = __builtin_amdgcn_readfirstlane(tid >> 6), lane = tid & 63, wr = wid >> 2, wc = wid & 3, fr = lane & 15, fq = lane >> 4;
    const int K = P.K, nt = K / BK;
    int sR[2], sC[2]; unsigned voffB[2];
#pragma unroll
    for (int i = 0; i < 2; ++i) { int R, C; stage_rc(tid * 16 + i * 8192, R, C); const int Rb = Epi::PERM ? ((R & ~31) + perm32(R & 31)) : R; sR[i] = R; sC[i] = C; voffB[i] = (unsigned)(Rb * K + C) * 2u; }
    const size_t kstep = (size_t)(BK * 2);
    const size_t hstep = (size_t)HALF * K * 2;
    const unsigned ldsw = (unsigned)wid * 1024u;
    const int aoff = lds_byte(wr * 64 + fr, fq * 8), boff = lds_byte(wc * 32 + fr, fq * 8);
#define PG8_SA(b, h) (((b) * 2 + (h)) * HTB)
#define PG8_SB(b, h) ((4 + (b) * 2 + (h)) * HTB)
#define PG8_STAGE2(bufoff, gbase, v0, v1) do { \
        __builtin_amdgcn_global_load_lds((const unsigned*)((const char*)(gbase) + (v0)), (LAS unsigned*)(lds + (bufoff) + ldsw), 16, 0, 0); \
        __builtin_amdgcn_global_load_lds((const unsigned*)((const char*)(gbase) + (v1)), (LAS unsigned*)(lds + (bufoff) + ldsw + 8192), 16, 0, 0); } while (0)
#define PG8_STAGEB(bufoff, gbase) PG8_STAGE2(bufoff, gbase, voffB[0], voffB[1])
#define PG8_LDA(dst, b, h) do { _Pragma("unroll") for (int m = 0; m < 4; ++m) { const i32x4 lo_ = *(const LAS i32x4*)(lds + PG8_SA(b, h) + aoff + m * 2048), hi_ = *(const LAS i32x4*)(lds + PG8_SA(b, h) + aoff + m * 2048 + 1024); \
        dst[m] = __builtin_shufflevector(lo_, hi_, 0, 1, 2, 3, 4, 5, 6, 7); } } while (0)
#define PG8_LDB(dst, b, h) do { _Pragma("unroll") for (int n = 0; n < 2; ++n) { const i32x4 lo_ = *(const LAS i32x4*)(lds + PG8_SB(b, h) + boff + n * 2048), hi_ = *(const LAS i32x4*)(lds + PG8_SB(b, h) + boff + n * 2048 + 1024); \
        dst[n] = __builtin_shufflevector(lo_, hi_, 0, 1, 2, 3, 4, 5, 6, 7); } } while (0)
#define PG8_MMA(ai, bj, At, Bt) do { __builtin_amdgcn_s_setprio(1); _Pragma("unroll") for (int m = 0; m < 4; ++m) _Pragma("unroll") for (int n = 0; n < 2; ++n) { \
        if constexpr (F8) asm volatile("v_mfma_scale_f32_16x16x128_f8f6f4 %0, %1, %2, %0, %3, %4 op_sel_hi:[0,0,0]" : "+v"(acc[ai][bj][m][n]) : "v"(Bt[n]), "v"(At[m]), "v"(f8sw), "v"(f8sa)); \
        else { acc[ai][bj][m][n] = __builtin_amdgcn_mfma_f32_16x16x32_bf16(__builtin_bit_cast(bf16x8, __builtin_shufflevector(Bt[n], Bt[n], 0, 1, 2, 3)), __builtin_bit_cast(bf16x8, __builtin_shufflevector(At[m], At[m], 0, 1, 2, 3)), acc[ai][bj][m][n], 0, 0, 0); \
               acc[ai][bj][m][n] = __builtin_amdgcn_mfma_f32_16x16x32_bf16(__builtin_bit_cast(bf16x8, __builtin_shufflevector(Bt[n], Bt[n], 4, 5, 6, 7)), __builtin_bit_cast(bf16x8, __builtin_shufflevector(At[m], At[m], 4, 5, 6, 7)), acc[ai][bj][m][n], 0, 0, 0); } } \
        __builtin_amdgcn_s_setprio(0); } while (0)
#define PG8_WAIT_V(n) asm volatile("s_waitcnt vmcnt(" #n ")" ::: "memory")
#define PG8_WAIT_L(n) asm volatile("s_waitcnt lgkmcnt(" #n ")" ::: "memory")
#define PG8_BAR __builtin_amdgcn_s_barrier()
#define PG8_SCHED __builtin_amdgcn_sched_barrier(0)
    Unit cur, nxt; int ui = 0;
    if (!P.next(0, cur)) return;
    f32x4 acc[2][2][4][2];
#pragma unroll
    for (int a = 0; a < 2; ++a)
#pragma unroll
        for (int b = 0; b < 2; ++b)
#pragma unroll
            for (int m = 0; m < 4; ++m)
#pragma unroll
                for (int n = 0; n < 2; ++n) acc[a][b][m][n] = (f32x4){0.f, 0.f, 0.f, 0.f};
    i32x8 At[4], B0[2], B1[2];
    const int f8sw = F8_SCALE_W, f8sa = F8_SCALE_A;
    const char* cA = P.a_base(cur); const char* cB = P.b_base(cur);
    unsigned vAc[2][2], vAn[2][2];
    P.a_voff(cur, sR, sC, vAc);
    PG8_STAGEB(PG8_SB(0, 0), cB); PG8_STAGEB(PG8_SB(0, 1), cB + hstep); PG8_STAGE2(PG8_SA(0, 0), cA, vAc[0][0], vAc[0][1]); PG8_STAGE2(PG8_SA(0, 1), cA, vAc[1][0], vAc[1][1]);
    if (wr == 1) PG8_BAR;
    PG8_WAIT_V(2); PG8_BAR;
    PG8_STAGEB(PG8_SB(1, 0), cB + kstep); PG8_STAGE2(PG8_SA(1, 0), cA + kstep, vAc[0][0], vAc[0][1]); PG8_STAGEB(PG8_SB(1, 1), cB + hstep + kstep);
    PG8_WAIT_V(6); PG8_BAR;
    for (;;) {
        const bool has_next = P.next(ui + 1, nxt);
        const char* nA = cA; const char* nB = cB;
        if (has_next) { nA = P.a_base(nxt); nB = P.b_base(nxt); P.a_voff(nxt, sR, sC, vAn); }
        else {
#pragma unroll
            for (int h = 0; h < 2; ++h)
#pragma unroll
                for (int i = 0; i < 2; ++i) vAn[h][i] = vAc[h][i];
        }
        for (int t = 0; t < nt; t += 2) {
            const bool last = (t == nt - 2);
            const char* a1 = cA + (size_t)(t + 1) * kstep;
            const char* a2 = last ? nA : cA + (size_t)(t + 2) * kstep; const char* b2 = last ? nB : cB + (size_t)(t + 2) * kstep;
            const char* a3 = a2 + kstep; const char* b3 = b2 + kstep;
            const unsigned w00 = last ? vAn[0][0] : vAc[0][0], w01 = last ? vAn[0][1] : vAc[0][1], w10 = last ? vAn[1][0] : vAc[1][0], w11 = last ? vAn[1][1] : vAc[1][1];
            PG8_LDB(B0, 0, 0); PG8_LDB(B1, 0, 1); PG8_SCHED; PG8_LDA(At, 0, 0); PG8_STAGE2(PG8_SA(1, 1), a1, vAc[1][0], vAc[1][1]);
            PG8_WAIT_V(8); PG8_WAIT_L(0); PG8_BAR; PG8_MMA(0, 0, At, B0); PG8_MMA(0, 1, At, B1); PG8_BAR; PG8_SCHED;
            PG8_LDA(At, 0, 1); PG8_STAGEB(PG8_SB(0, 0), b2); PG8_STAGEB(PG8_SB(0, 1), b2 + hstep); PG8_STAGE2(PG8_SA(0, 0), a2, w00, w01);
            PG8_WAIT_V(8); PG8_WAIT_L(0); PG8_BAR; PG8_MMA(1, 0, At, B0); PG8_MMA(1, 1, At, B1); PG8_BAR; PG8_SCHED;
            PG8_LDB(B0, 1, 0); PG8_LDB(B1, 1, 1); PG8_SCHED; PG8_LDA(At, 1, 0); PG8_STAGE2(PG8_SA(0, 1), a2, w10, w11);
            PG8_WAIT_V(8); PG8_WAIT_L(0); PG8_BAR; PG8_MMA(0, 0, At, B0); PG8_MMA(0, 1, At, B1); PG8_BAR; PG8_SCHED;
            PG8_LDA(At, 1, 1); PG8_STAGEB(PG8_SB(1, 0), b3); PG8_STAGEB(PG8_SB(1, 1), b3 + hstep); PG8_STAGE2(PG8_SA(1, 0), a3, w00, w01);
            PG8_WAIT_V(8); PG8_WAIT_L(0); PG8_BAR; PG8_MMA(1, 0, At, B0); PG8_MMA(1, 1, At, B1); PG8_BAR; PG8_SCHED;
        }
        if (wr == 0) PG8_BAR;
        if constexpr (F8) asm volatile("s_nop 15\n\ts_nop 15" ::: "memory");
        E(acc, cur, wr, wc, fr, fq);
        if (!has_next) break;
#pragma unroll
        for (int a = 0; a < 2; ++a)
#pragma unroll
            for (int b = 0; b < 2; ++b)
#pragma unroll
                for (int m = 0; m < 4; ++m)
#pragma unroll
                    for (int n = 0; n < 2; ++n) acc[a][b][m][n] = (f32x4){0.f, 0.f, 0.f, 0.f};
        cur = nxt; cA = nA; cB = nB; ++ui;
#pragma unroll
        for (int h = 0; h < 2; ++h)
#pragma unroll
            for (int i = 0; i < 2; ++i) vAc[h][i] = vAn[h][i];
        if (wr == 1) PG8_BAR;
    }
    PG8_WAIT_V(0);
    PG8_BAR;
#undef PG8_SA
#undef PG8_SB
#undef PG8_STAGE2
#undef PG8_STAGEB
#undef PG8_LDA
#undef PG8_LDB
#undef PG8_MMA
#undef PG8_WAIT_V
#undef PG8_WAIT_L
#undef PG8_BAR
#undef PG8_SCHED
}
}
namespace pg8 {
struct EpiBf16Plain {
    static constexpr bool PERM = true;
    bf16_t* O; int ldc;
    DI void operator()(const f32x4 (&acc)[2][2][4][2], const Unit& u, int wr, int wc, int fr, int fq) const {
        const int row0 = u.pm * BM + wr * 64 + fr, col0 = u.pn * BM + wc * 32 + 8 * fq;
#pragma unroll
        for (int ai = 0; ai < 2; ++ai)
#pragma unroll
            for (int m = 0; m < 4; ++m) { bf16_t* rowp = O + (size_t)(row0 + ai * HALF + m * 16) * ldc + col0;
#pragma unroll
                for (int bj = 0; bj < 2; ++bj) { const f32x4 v0 = acc[ai][bj][m][0], v1 = acc[ai][bj][m][1];
                    u32x4 w; w.x = pk_bf16(v0[0], v0[1]); w.y = pk_bf16(v0[2], v0[3]); w.z = pk_bf16(v1[0], v1[1]); w.w = pk_bf16(v1[2], v1[3]);
                    *(u32x4*)(rowp + bj * HALF) = w; } }
    }
};
struct EpiResF32 {
    static constexpr bool PERM = false;
    const float* base; float* C; int ldc;
    DI void operator()(const f32x4 (&acc)[2][2][4][2], const Unit& u, int wr, int wc, int fr, int fq) const {
        const int row0 = u.pm * BM + wr * 64 + fr, col0 = u.pn * BM + wc * 32 + 4 * fq;
#pragma unroll
        for (int ai = 0; ai < 2; ++ai)
#pragma unroll
            for (int m = 0; m < 4; ++m) { const size_t off = (size_t)(row0 + ai * HALF + m * 16) * ldc + col0;
#pragma unroll
                for (int bj = 0; bj < 2; ++bj)
#pragma unroll
                    for (int n = 0; n < 2; ++n) { const f32x4 bs = *(const f32x4*)(base + off + bj * HALF + n * 16); *(f32x4*)(C + off + bj * HALF + n * 16) = bs + acc[ai][bj][m][n]; } }
    }
};
struct EpiGlu {
    static constexpr bool PERM = true;
    unsigned char* O; int ldc; const float* bias;
    DI void operator()(const f32x4 (&acc)[2][2][4][2], const Unit& u, int wr, int wc, int fr, int fq) const {
        const int row0 = u.pm * BM + wr * 64 + fr, colg = u.pn * HALF + wc * 32 + 8 * fq;
        const float* bg = bias + (size_t)u.e * 4096 + colg;
        f32x4 bgl[2], bln[2];
#pragma unroll
        for (int n = 0; n < 2; ++n) { bgl[n] = *(const f32x4*)(bg + 4 * n); bln[n] = *(const f32x4*)(bg + 2048 + 4 * n); }
#pragma unroll
        for (int ai = 0; ai < 2; ++ai)
#pragma unroll
            for (int m = 0; m < 4; ++m) { unsigned char* rowp = O + (size_t)(row0 + ai * HALF + m * 16) * ldc + colg;
                float r[8];
#pragma unroll
                for (int n = 0; n < 2; ++n)
#pragma unroll
                    for (int j = 0; j < 4; ++j) { float g = acc[ai][0][m][n][j] + bgl[n][j], l = acc[ai][1][m][n][j] + bln[n][j];
                        g = fminf(g, 7.0f); l = fminf(fmaxf(l, -7.0f), 7.0f);
                        r[4 * n + j] = clamp_fp8(8.0f * (g * fast_sigmoid(1.702f * g) * (l + 1.0f))); }
                u32x2 w; w.x = pk4_fp8(r[0], r[1], r[2], r[3]); w.y = pk4_fp8(r[4], r[5], r[6], r[7]);
                *(u32x2*)rowp = w; }
    }
};
struct EpiBf16BiasE {
    static constexpr bool PERM = true;
    bf16_t* O; int ldc; const float* bias;
    DI void operator()(const f32x4 (&acc)[2][2][4][2], const Unit& u, int wr, int wc, int fr, int fq) const {
        const int row0 = u.pm * BM + wr * 64 + fr, col0 = u.pn * BM + wc * 32 + 8 * fq;
        const float* bp = bias + (size_t)u.e * 2048 + col0;
        f32x4 bv[2][2];
#pragma unroll
        for (int bj = 0; bj < 2; ++bj)
#pragma unroll
            for (int n = 0; n < 2; ++n) bv[bj][n] = *(const f32x4*)(bp + bj * HALF + 4 * n);
#pragma unroll
        for (int ai = 0; ai < 2; ++ai)
#pragma unroll
            for (int m = 0; m < 4; ++m) { bf16_t* rowp = O + (size_t)(row0 + ai * HALF + m * 16) * ldc + col0;
#pragma unroll
                for (int bj = 0; bj < 2; ++bj) { const f32x4 v0 = acc[ai][bj][m][0] + bv[bj][0], v1 = acc[ai][bj][m][1] + bv[bj][1];
                    u32x4 w; w.x = pk_bf16(v0[0], v0[1]); w.y = pk_bf16(v0[2], v0[3]); w.z = pk_bf16(v1[0], v1[1]); w.w = pk_bf16(v1[2], v1[3]);
                    *(u32x4*)(rowp + bj * HALF) = w; } }
    }
};
}
constexpr int NWAVES = 8;
constexpr int NTOK = 16384, DM = 2048, SEQ = 2048, NBATCH = 8;
constexpr int DIN = 12816, LDP = 13056;
constexpr int C_QA = 0, C_KA = 2048, C_VA = 2304, C_QB = 2560, C_KB = 3584, C_VB = 4608, C_RB = 6656, C_GA = 8704, C_GB = 10752, C_ALR = 12800;
constexpr int NEXP = 32, TOPK = 4, DFF = 2048;
constexpr int PMAX = 73728;
constexpr float EPS = 1e-5f;
constexpr float LOG2E = 1.4426950408889634f;

constexpr size_t MiB = 1u << 20;
constexpr size_t WS_CTL = 0, CTL_ZERO_BYTES = 1 * MiB;
constexpr size_t WS_TOPE = 1 * MiB;
constexpr size_t WS_TOPS = WS_TOPE + (size_t)NTOK * 4 * 4;
constexpr size_t WS_GATE = WS_TOPS + (size_t)NTOK * 4 * 4;
constexpr size_t WS_TOKL = WS_GATE + (size_t)NTOK * 4 * 4;
constexpr size_t WS_WIN  = 4 * MiB;
constexpr size_t WS_WOUT = WS_WIN + (size_t)LDP * DM * 2;
constexpr size_t WS_WGU  = WS_WOUT + (size_t)DM * DM * 2;
constexpr size_t WS_WDN  = WS_WGU + (size_t)NEXP * 4096 * DM * 2;
constexpr size_t WS_H    = WS_WDN + (size_t)NEXP * DM * DM * 2;
constexpr size_t WS_PROJ = WS_H + (size_t)NTOK * DM * 2;
constexpr size_t WS_OA   = WS_PROJ + (size_t)NTOK * LDP * 2;
constexpr size_t WS_OB   = WS_OA + (size_t)NTOK * DM * 2;
constexpr size_t WS_MIX  = WS_OB + (size_t)NTOK * DM * 2;
constexpr size_t WS_X1   = WS_MIX + (size_t)NTOK * DM * 2;
constexpr size_t WS_GQT  = WS_X1 + (size_t)NTOK * DM * 4;
constexpr size_t WS_GKT  = WS_GQT + (size_t)1024 * 16384 * 2;
constexpr size_t WS_GATT = WS_GKT + (size_t)1024 * 16384 * 2;
constexpr size_t WS_GDEC = WS_GATT + (size_t)1024 * 4096 * 2;
constexpr size_t WS_GVT  = WS_GDEC + (size_t)1024 * 256 * 4;
constexpr size_t WS_ACT  = WS_GVT + (size_t)1024 * 32768 * 2;
constexpr size_t WS_Y    = WS_ACT + (size_t)PMAX * DFF * 2;
constexpr size_t WS_END  = WS_Y + (size_t)PMAX * DM * 2;
static_assert(WS_TOKL + (size_t)NEXP * NTOK * 4 <= WS_WIN, "routing tables below the weight copies");
static_assert(WS_WIN % 256 == 0 && WS_WOUT % 256 == 0 && WS_WGU % 256 == 0 && WS_WDN % 256 == 0 && WS_H % 256 == 0 && WS_PROJ % 256 == 0 && WS_OA % 256 == 0 && WS_X1 % 256 == 0 &&
              WS_GQT % 256 == 0 && WS_GKT % 256 == 0 && WS_GATT % 256 == 0 && WS_GDEC % 256 == 0 && WS_GVT % 256 == 0 && WS_ACT % 256 == 0 && WS_Y % 256 == 0, "alignment");
constexpr int CW_TMO = 0, CW_CODE = 1;
constexpr int CW_BAR = 4096;
constexpr int CW_CNT = 8192;
constexpr int CW_SWAQ = CW_CNT + 64 * 40;
constexpr int RING_OFF = 0, RING_BYTES = 131072;
constexpr int LDSCTL_OFF = RING_BYTES, MISC_OFF = LDSCTL_OFF + 320;
constexpr int TBL_OFF = LDSCTL_OFF + 1024;
constexpr int LDS_BYTES = 147456;
static_assert(MISC_OFF + 128 <= TBL_OFF && TBL_OFF + 4096 <= LDS_BYTES, "LDS map");

typedef GAS unsigned gu32;
#define RLX_AGENT __ATOMIC_RELAXED, __HIP_MEMORY_SCOPE_AGENT
#define LDS_WAIT() asm volatile("s_waitcnt lgkmcnt(0)" ::: "memory")
#define VM_WAIT() asm volatile("s_waitcnt vmcnt(0)" ::: "memory")

#define XB_TMO      128
#define XB_XCNT(j)  (256  + 64 * (j))
#define XB_XSUB(j)  (1280 + 64 * (j))
#define XB_XGEN(j)  (2304 + 64 * (j))
#define XB_TOP      3328
#define XB_TOPGEN   3392
#define XCD_BAR_WORDS 3456
#define XB_SPIN_CAP (1u << 18)

__device__ __forceinline__ unsigned xb_ld(unsigned* p)              { return __hip_atomic_load(p, __ATOMIC_RELAXED, __HIP_MEMORY_SCOPE_AGENT); }
__device__ __forceinline__ unsigned xb_add(unsigned* p, unsigned v) { return __hip_atomic_fetch_add(p, v, __ATOMIC_RELAXED, __HIP_MEMORY_SCOPE_AGENT); }
__device__ __forceinline__ unsigned xb_xcc_id() { return (unsigned)__builtin_amdgcn_s_getreg((3 << 11) | 20) & 0xFu; }
#define XB_SPIN(cond, bar) do { unsigned _sp = 0; while (cond) { __builtin_amdgcn_s_sleep(1); \
    if ((++_sp & 255u) == 0u) { if (xb_ld(&(bar)[XB_TMO])) break; if (_sp > XB_SPIN_CAP) { atomicAdd(&(bar)[XB_TMO], 1u); break; } } } } while (0)

struct XcdBarrier {
    unsigned* bar; unsigned x;
    volatile LAS unsigned* st;
};

__device__ __forceinline__ XcdBarrier xcd_barrier_post(unsigned* bar, volatile LAS unsigned* st) {
    XcdBarrier b; b.bar = bar; b.x = xb_xcc_id(); b.st = st;
    if (threadIdx.x == 0) (void)xb_add(&bar[XB_XCNT(b.x)], 1u);
    return b;
}
__device__ __forceinline__ void xcd_barrier_complete(unsigned* bar, unsigned x, unsigned& nloc, unsigned& nx) {
    const unsigned G = gridDim.x * gridDim.y * gridDim.z;
    unsigned sum, cnt, mine, sp = 0u;
    for (;;) {
        sum = 0u; cnt = 0u; mine = 0u;
#pragma unroll
        for (unsigned j = 0; j < 16; ++j) { const unsigned c = xb_ld(&bar[XB_XCNT(j)]); sum += c; cnt += (c > 0u) ? 1u : 0u; mine = (j == x) ? c : mine; }
        if (sum == G) break;
        __builtin_amdgcn_s_sleep(1);
        if ((++sp & 255u) == 0u) { if (xb_ld(&bar[XB_TMO])) break; if (sp > XB_SPIN_CAP) { atomicAdd(&bar[XB_TMO], 1u); break; } }
    }
    nloc = mine > 0u ? mine : 1u; nx = cnt > 0u ? cnt : 1u;
}

__device__ __forceinline__ void xcd_barrier(const XcdBarrier& b) {
    asm volatile("s_waitcnt vmcnt(0)" ::: "memory");
    __syncthreads();
    if (threadIdx.x == 0) {
        unsigned* bar = b.bar;
        __builtin_amdgcn_s_waitcnt(0);
        unsigned nloc = b.st[0], nx = b.st[1];
        if (nloc == 0u) { xcd_barrier_complete(bar, b.x, nloc, nx); b.st[0] = nloc; b.st[1] = nx; }
        const unsigned old = xb_add(&bar[XB_XSUB(b.x)], 1u);
        const unsigned gen = old / nloc;
        if (old + 1u == (gen + 1u) * nloc) {
            __builtin_amdgcn_fence(__ATOMIC_RELEASE, "agent");
            asm volatile("s_waitcnt vmcnt(0)" ::: "memory");
            const unsigned og = xb_add(&bar[XB_TOP], 1u);
            const unsigned tg = og / nx;
            if (og + 1u == (tg + 1u) * nx) xb_add(&bar[XB_TOPGEN], 1u);
            else XB_SPIN(xb_ld(&bar[XB_TOPGEN]) == tg, bar);
            __builtin_amdgcn_fence(__ATOMIC_ACQUIRE, "agent");
            xb_add(&bar[XB_XGEN(b.x)], 1u);
            asm volatile("s_waitcnt vmcnt(0)" ::: "memory");
        } else {
            XB_SPIN(xb_ld(&bar[XB_XGEN(b.x)]) == gen, bar);
            __builtin_amdgcn_fence(__ATOMIC_ACQUIRE, "agent");
            asm volatile("s_waitcnt vmcnt(0)" ::: "memory");
        }
    }
    __syncthreads();
}

struct Frame {
    LAS unsigned char* lds;
    gu32* ctl;
    int tid, lane, wave, vcu, G;
    const float *x, *attn_g, *w_in, *sinks, *w_alpha2, *b_alpha, *gla_g, *w_out, *ffn_g, *w_router, *b_router, *w_gu, *b_gu, *w_dn, *b_dn, *final_g;
    float* out;
    int *tope, *tops, *tokl; float* gate;
    bf16_t *Win, *Wout, *Wgu, *Wdn, *H, *PROJ, *OA, *OB, *MIX, *GQT, *GKT, *GATT, *GVT, *ACT, *Y;
    float *X1, *GDEC;
};
DI void p0_transpose_item(const float* Wsrc, int ldw, int srccol0, int nvalid, int k0, bf16_t* dst, int K, LAS float* scr, int lane) {
    const int krow = lane >> 3, n4 = lane & 7;
    const bool ok = 4 * n4 < nvalid;
#pragma unroll
    for (int i = 0; i < 8; ++i) { const int kk = 8 * i + krow; f32x4 v = (f32x4){0.f, 0.f, 0.f, 0.f};
        if (ok) v = *(const f32x4*)(Wsrc + (size_t)(k0 + kk) * ldw + srccol0 + 4 * n4);
        LAS float* d = scr + kk * 33 + 4 * n4; d[0] = v[0]; d[1] = v[1]; d[2] = v[2]; d[3] = v[3]; }
    LDS_WAIT(); asm volatile("" ::: "memory");
    const int c = lane & 7;
#pragma unroll
    for (int j = 0; j < 4; ++j) { const int n = (lane >> 3) + 8 * j; const LAS float* s = scr + (8 * c) * 33 + n;
        u32x4 o; o.x = pk_bf16(s[0 * 33], s[1 * 33]); o.y = pk_bf16(s[2 * 33], s[3 * 33]); o.z = pk_bf16(s[4 * 33], s[5 * 33]); o.w = pk_bf16(s[6 * 33], s[7 * 33]);
        *(u32x4*)(dst + (size_t)n * K + k0 + 8 * c) = o; }
    LDS_WAIT(); asm volatile("" ::: "memory");
}
DI void rms_row_to_bf16(const float* xrow, const float* g, bf16_t* orow, int lane) {
    const f32x4* xr = (const f32x4*)xrow + lane; const f32x4* gr = (const f32x4*)g + lane;
    f32x4 v[8]; float s = 0.f;
#pragma unroll
    for (int j = 0; j < 8; ++j) { v[j] = xr[64 * j]; s += (v[j].x * v[j].x + v[j].y * v[j].y) + (v[j].z * v[j].z + v[j].w * v[j].w); }
    const float r = 1.0f / sqrtf(wave_sum(s) * (1.f / DM) + EPS);
    u32x2* o8 = (u32x2*)orow + lane;
#pragma unroll
    for (int j = 0; j < 8; ++j) { const f32x4 gg = gr[64 * j]; u32x2 w; w.x = pk_bf16(v[j].x * r * gg.x, v[j].y * r * gg.y); w.y = pk_bf16(v[j].z * r * gg.z, v[j].w * r * gg.w); o8[64 * j] = w; }
}
DI void p0_transpose_item_f8(const float* Wsrc, int ldw, int srccol0, int k0, unsigned char* dst, int K, LAS float* scr, int lane) {
    const int krow = lane >> 3, n4 = lane & 7;
#pragma unroll
    for (int i = 0; i < 8; ++i) { const int kk = 8 * i + krow; const f32x4 v = *(const f32x4*)(Wsrc + (size_t)(k0 + kk) * ldw + srccol0 + 4 * n4);
        LAS float* d = scr + kk * 33 + 4 * n4; d[0] = v[0]; d[1] = v[1]; d[2] = v[2]; d[3] = v[3]; }
    LDS_WAIT(); asm volatile("" ::: "memory");
    const int c = lane & 7;
#pragma unroll
    for (int j = 0; j < 4; ++j) { const int n = (lane >> 3) + 8 * j; const LAS float* s = scr + (8 * c) * 33 + n;
        u32x2 o; o.x = pk4_fp8(64.f * s[0 * 33], 64.f * s[1 * 33], 64.f * s[2 * 33], 64.f * s[3 * 33]); o.y = pk4_fp8(64.f * s[4 * 33], 64.f * s[5 * 33], 64.f * s[6 * 33], 64.f * s[7 * 33]);
        *(u32x2*)(dst + (size_t)n * K + k0 + 8 * c) = o; }
    LDS_WAIT(); asm volatile("" ::: "memory");
}
DI void p0_prologue(Frame& F) {
    LAS float* scr = (LAS float*)(F.lds + RING_OFF + F.wave * 16384);
    const int gw = F.vcu * NWAVES + F.wave, NGW = F.G * NWAVES;
    constexpr int I_IN = 32 * 408, I_OUT = 32 * 64, I_GU = 32 * 32 * 128, I_DN = 32 * 32 * 64;
    constexpr int NITEMS = I_IN + I_OUT + I_GU + I_DN;
    for (int it = gw; it < NITEMS; it += NGW) {
        int r = it;
        if (r < I_IN) { const int kb = r / 408, nb = r % 408, n0 = 32 * nb; int sc = n0, nv = 32;
            if (n0 >= 8704 && n0 < 12800) sc = n0 + 16; else if (n0 == 12800) { sc = 8704; nv = 16; } else if (n0 > 12800) { sc = 0; nv = 0; }
            p0_transpose_item(F.w_in, DIN, sc, nv, 64 * kb, F.Win + (size_t)n0 * DM, DM, scr, F.lane); continue; }
        r -= I_IN;
        if (r < I_OUT) { const int kb = r / 64, nb = r % 64; p0_transpose_item(F.w_out, DM, 32 * nb, 32, 64 * kb, F.Wout + (size_t)(32 * nb) * DM, DM, scr, F.lane); continue; }
        r -= I_OUT;
        if (r < I_GU) { const int e = r / 4096, rr = r % 4096, kb = rr / 128, nb = rr % 128, n0 = 32 * nb, pn = n0 >> 8, i0 = n0 & 255;
            const int sc = (i0 < 128) ? (128 * pn + i0) : (2048 + 128 * pn + i0 - 128);
            p0_transpose_item_f8(F.w_gu + (size_t)e * DM * 4096, 4096, sc, 64 * kb, (unsigned char*)F.Wgu + ((size_t)e * 4096 + n0) * DM, DM, scr, F.lane); continue; }
        r -= I_GU;
        { const int e = r / 2048, rr = r % 2048, kb = rr / 64, nb = rr % 64;
            p0_transpose_item_f8(F.w_dn + (size_t)e * DFF * DM, DM, 32 * nb, 64 * kb, (unsigned char*)F.Wdn + ((size_t)e * DM + 32 * nb) * DFF, DFF, scr, F.lane); }
    }
    for (int m = gw; m < NTOK; m += NGW) rms_row_to_bf16(F.x + (size_t)m * DM, F.attn_g, F.H + (size_t)m * DM, F.lane);
}

DI s16x4 tr_read(const LAS unsigned char* p) { return __builtin_bit_cast(s16x4, __builtin_amdgcn_ds_read_tr16_b64_v4i16((LAS s16x4*)p)); }
DI bf16x8 pack8(const f32x16& x, int s) {
    u32x4 p; p.x = pk_bf16(x[8 * s + 0], x[8 * s + 1]); p.y = pk_bf16(x[8 * s + 2], x[8 * s + 3]); p.z = pk_bf16(x[8 * s + 4], x[8 * s + 5]); p.w = pk_bf16(x[8 * s + 6], x[8 * s + 7]);
    return __builtin_bit_cast(bf16x8, p);
}
DI bf16x8 pack8_pinned(const f32x16& x, int s) {
    u32x4 p;
    asm volatile("v_cvt_pk_bf16_f32 %0, %4, %5\n\tv_cvt_pk_bf16_f32 %1, %6, %7\n\tv_cvt_pk_bf16_f32 %2, %8, %9\n\tv_cvt_pk_bf16_f32 %3, %10, %11\n\ts_nop 1"
                 : "=&v"(p[0]), "=&v"(p[1]), "=&v"(p[2]), "=&v"(p[3])
                 : "v"(x[8 * s]), "v"(x[8 * s + 1]), "v"(x[8 * s + 2]), "v"(x[8 * s + 3]), "v"(x[8 * s + 4]), "v"(x[8 * s + 5]), "v"(x[8 * s + 6]), "v"(x[8 * s + 7]));
    return __builtin_bit_cast(bf16x8, p);
}
DI void swa_phase(Frame& F) {
    LAS unsigned char* Ks = F.lds;
    LAS unsigned char* Vs = F.lds + 36864;
    const int lane = F.lane, w = F.wave, c31 = lane & 31, h = lane >> 5;
    const int i16 = lane & 15, q4 = i16 >> 2, p4 = i16 & 3, blk = (lane >> 4) & 1;
    volatile LAS unsigned* qslot = (volatile LAS unsigned*)(F.lds + MISC_OFF) + 16;
    for (;;) {
        if (F.tid == 0) qslot[0] = __hip_atomic_fetch_add((unsigned*)(F.ctl + CW_SWAQ), 1u, __ATOMIC_RELAXED, __HIP_MEMORY_SCOPE_AGENT);
        __syncthreads();
        const int u = (int)qslot[0];
        if (u >= 512) break;
        const int kh = u & 3, qb = (u >> 2) & 15, b = u >> 6;
        const size_t tokbase = (size_t)b * SEQ;
        const int pos0 = qb * 128 - 128;
#pragma unroll
        for (int i = 0; i < 4; ++i) { const int id = F.tid + 512 * i, row = id >> 3, ch = id & 7, pos = pos0 + row;
            u32x4 kv = (u32x4){0u, 0u, 0u, 0u}, vv = (u32x4){0u, 0u, 0u, 0u};
            if (pos >= 0) { const bf16_t* src = F.PROJ + (tokbase + pos) * LDP + C_KA + kh * 64 + ch * 8; kv = *(const u32x4*)src; vv = *(const u32x4*)(src + (C_VA - C_KA)); }
            *(LAS u32x4*)(Ks + row * 144 + ch * 16) = kv; *(LAS u32x4*)(Vs + row * 144 + ch * 16) = vv; }
        __syncthreads();
        const int head = kh * 8 + w;
        const float slope2 = __builtin_amdgcn_exp2f(-0.25f * (float)(head + 1)) * LOG2E;
        const float sink2 = F.sinks[head] * LOG2E;
        for (int qt = 0; qt < 4; ++qt) {
            const size_t qrow = tokbase + qb * 128 + qt * 32 + c31;
            bf16x8 bq[4];
#pragma unroll
            for (int ks = 0; ks < 4; ++ks) bq[ks] = *(const bf16x8*)(F.PROJ + qrow * LDP + C_QA + head * 64 + ks * 16 + h * 8);
            f32x16 S[5];
#pragma unroll
            for (int kt = 0; kt < 5; ++kt) { f32x16 acc;
#pragma unroll
                for (int i = 0; i < 16; ++i) acc[i] = 0.f;
#pragma unroll
                for (int ks = 0; ks < 4; ++ks) { const bf16x8 a = *(const LAS bf16x8*)(Ks + (32 * (qt + kt) + c31) * 144 + (ks * 16 + h * 8) * 2); acc = MFMA32(a, bq[ks], acc); }
                S[kt] = acc; }
            float mx = sink2;
#pragma unroll
            for (int kt = 0; kt < 5; ++kt)
#pragma unroll
                for (int i = 0; i < 16; ++i) { const int key = 32 * (qt + kt) + crow(i, h); const int dist = 32 * qt + c31 + 128 - key;
                    const bool valid = (dist >= 0) && (dist < 128) && (pos0 + key >= 0);
                    const float s = valid ? (S[kt][i] * (0.125f * LOG2E) - slope2 * (float)dist) : -INFINITY;
                    S[kt][i] = s; mx = fmaxf(mx, s); }
            mx = fmaxf(mx, __shfl_xor(mx, 32));
            float sum = 0.f;
#pragma unroll
            for (int kt = 0; kt < 5; ++kt)
#pragma unroll
                for (int i = 0; i < 16; ++i) { const float p = __builtin_amdgcn_exp2f(S[kt][i] - mx); S[kt][i] = p; sum += p; }
            sum += __shfl_xor(sum, 32); sum += __builtin_amdgcn_exp2f(sink2 - mx);
            const float inv = 1.0f / sum;
            f32x16 O[2];
#pragma unroll
            for (int dt = 0; dt < 2; ++dt)
#pragma unroll
                for (int i = 0; i < 16; ++i) O[dt][i] = 0.f;
#pragma unroll
            for (int kt = 0; kt < 5; ++kt)
#pragma unroll
                for (int s = 0; s < 2; ++s) { const bf16x8 bp = pack8(S[kt], s);
                    const int kb = 32 * (qt + kt) + 16 * s + 4 * h + q4;
#pragma unroll
                    for (int dt = 0; dt < 2; ++dt) { const LAS unsigned char* vp = Vs + kb * 144 + (32 * dt + 16 * blk + 4 * p4) * 2;
                        const s16x4 lo = tr_read(vp), hi = tr_read(vp + 8 * 144);
                        const bf16x8 a = __builtin_shufflevector(lo, hi, 0, 1, 2, 3, 4, 5, 6, 7);
                        O[dt] = MFMA32(a, bp, O[dt]); } }
            bf16_t* orow = F.OA + qrow * DM + head * 64 + 4 * h;
#pragma unroll
            for (int dt = 0; dt < 2; ++dt)
#pragma unroll
                for (int g4 = 0; g4 < 4; ++g4) { u32x2 wv; wv.x = pk_bf16(O[dt][4 * g4] * inv, O[dt][4 * g4 + 1] * inv); wv.y = pk_bf16(O[dt][4 * g4 + 2] * inv, O[dt][4 * g4 + 3] * inv);
                    *(u32x2*)(orow + 32 * dt + 8 * g4) = wv; }
        }
        __syncthreads();
    }
}

DI void gla_prep_phase(Frame& F) {
    LAS unsigned char* Qs = F.lds;
    LAS unsigned char* Kss = F.lds + 33792;
    LAS float* alr = (LAS float*)(F.lds + 67584);
    LAS float* tot = (LAS float*)(F.lds + 71680);
    LAS unsigned char* Vr = F.lds;
    const int tid = F.tid, lane = F.lane, w = F.wave, c31 = lane & 31, h = lane >> 5;
    for (int u = F.vcu; u < 1024; u += F.G) {
        const int hh = (u >> 5) & 3, b = u >> 7, c = u & 31;
        const size_t T0 = (size_t)b * SEQ + c * 64;
#pragma unroll
        for (int j = 0; j < 4; ++j) { const int id = tid + 512 * j, row = id >> 5, ch = id & 31; const bf16_t* src = F.PROJ + (T0 + row) * LDP + C_QB + hh * 256 + ch * 8;
            *(LAS u32x4*)(Qs + row * 528 + ch * 16) = *(const u32x4*)src; *(LAS u32x4*)(Kss + row * 528 + ch * 16) = *(const u32x4*)(src + (C_KB - C_QB)); }
        u32x4 vreg[8];
#pragma unroll
        for (int j = 0; j < 8; ++j) { const int id = tid + 512 * j, row = id >> 6, ch = id & 63; vreg[j] = *(const u32x4*)(F.PROJ + (T0 + row) * LDP + C_VB + hh * 512 + ch * 8); }
        if (tid < 128) { const int t = tid >> 1, hf = tid & 1; const u32x4 raw = *(const u32x4*)(F.PROJ + (T0 + t) * LDP + C_ALR + 8 * hf);
            LAS float* d = alr + t * 16 + 8 * hf;
            d[0] = bf_lo(raw.x); d[1] = bf_hi(raw.x); d[2] = bf_lo(raw.y); d[3] = bf_hi(raw.y); d[4] = bf_lo(raw.z); d[5] = bf_hi(raw.z); d[6] = bf_lo(raw.w); d[7] = bf_hi(raw.w); }
        __syncthreads();
        const int d = tid & 255, hf = tid >> 8;
        float w2[16];
#pragma unroll
        for (int r = 0; r < 16; ++r) w2[r] = F.w_alpha2[r * 1024 + hh * 256 + d];
        const float ba = F.b_alpha[hh * 256 + d];
        float bc[32]; float run = 0.f;
#pragma unroll
        for (int i = 0; i < 32; ++i) { const LAS f32x4* ar = (const LAS f32x4*)(alr + (32 * hf + i) * 16); float z = ba;
#pragma unroll
            for (int r4 = 0; r4 < 4; ++r4) { const f32x4 a = ar[r4]; z += a.x * w2[4 * r4] + a.y * w2[4 * r4 + 1] + a.z * w2[4 * r4 + 2] + a.w * w2[4 * r4 + 3]; }
            const float la = (fminf(z, 0.f) - __logf(1.0f + fast_exp(-fabsf(z)))) * (1.0f / 16.0f);
            run += la; bc[i] = run; }
        tot[hf * 256 + d] = run;
        __syncthreads();
        const float t0 = tot[d], t1 = tot[256 + d], blast = t0 + t1;
        if (hf) {
#pragma unroll
            for (int i = 0; i < 32; ++i) bc[i] += t0;
        } else F.GDEC[(size_t)u * 256 + d] = fast_exp(blast);
        unsigned kpk[16];
#pragma unroll
        for (int i2 = 0; i2 < 16; ++i2) { float kh2[2];
#pragma unroll
            for (int j = 0; j < 2; ++j) { const int i = 2 * i2 + j; LAS bf16_t* qp = (LAS bf16_t*)(Qs + (32 * hf + i) * 528 + d * 2); LAS bf16_t* kp = (LAS bf16_t*)(Kss + (32 * hf + i) * 528 + d * 2);
                const float q = bf2f(*qp), k = bf2f(*kp);
                const float e = fast_exp(bc[i]);
                *qp = f2bf(q * e * 0.0625f);
                *kp = f2bf(k * fast_exp(-bc[i]));
                kh2[j] = k * fast_exp(blast - bc[i]); }
            kpk[i2] = pk_bf16(kh2[0], kh2[1]); }
        { u32x4* dst = (u32x4*)(F.GKT + (size_t)u * 16384 + d * 64 + 32 * hf);
#pragma unroll
            for (int j = 0; j < 4; ++j) dst[j] = (u32x4){kpk[4 * j], kpk[4 * j + 1], kpk[4 * j + 2], kpk[4 * j + 3]}; }
        __syncthreads();
        if (w < 4) { const int m = w >> 1, n = w & 1; f32x16 acc;
#pragma unroll
            for (int i = 0; i < 16; ++i) acc[i] = 0.f;
#pragma unroll
            for (int ks = 0; ks < 16; ++ks) { const bf16x8 a = *(const LAS bf16x8*)(Qs + (32 * m + c31) * 528 + (16 * ks + 8 * h) * 2), bb = *(const LAS bf16x8*)(Kss + (32 * n + c31) * 528 + (16 * ks + 8 * h) * 2);
                acc = MFMA32(a, bb, acc); }
            bf16_t* ao = F.GATT + (size_t)u * 4096;
#pragma unroll
            for (int i = 0; i < 16; ++i) { const int t = 32 * m + crow(i, h), s = 32 * n + c31; ao[t * 64 + s] = f2bf(s <= t ? acc[i] : 0.f); }
        } else { const int t2 = tid - 256;
#pragma unroll
            for (int j = 0; j < 8; ++j) { const int id = t2 + 256 * j, row = id >> 5, ch = id & 31; *(u32x4*)(F.GQT + (size_t)u * 16384 + row * 256 + ch * 8) = *(const LAS u32x4*)(Qs + row * 528 + ch * 16); } }
        __syncthreads();
#pragma unroll
        for (int j = 0; j < 8; ++j) { const int id = tid + 512 * j, row = id >> 6, ch = id & 63; *(LAS u32x4*)(Vr + row * 1040 + ch * 16) = vreg[j]; }
        __syncthreads();
        { u32x4* dst = (u32x4*)(F.GVT + (size_t)u * 32768 + tid * 64);
#pragma unroll
            for (int t8 = 0; t8 < 8; ++t8) { unsigned short v[8];
#pragma unroll
                for (int j = 0; j < 8; ++j) v[j] = *(const LAS bf16_t*)(Vr + (8 * t8 + j) * 1040 + tid * 2);
                dst[t8] = (u32x4){(unsigned)v[0] | ((unsigned)v[1] << 16), (unsigned)v[2] | ((unsigned)v[3] << 16), (unsigned)v[4] | ((unsigned)v[5] << 16), (unsigned)v[6] | ((unsigned)v[7] << 16)}; } }
        __syncthreads();
    }
}

DI void gla_scan_phase(Frame& F) {
    LAS unsigned char* L = F.lds;
    const int lane = F.lane, w = F.wave, c31 = lane & 31, h = lane >> 5;
    const int u = F.vcu, hf = u & 1, hh = (u >> 1) & 3, b = u >> 3;
    f32x16 S[8];
#pragma unroll
    for (int i = 0; i < 8; ++i)
#pragma unroll
        for (int j = 0; j < 16; ++j) S[i][j] = 0.f;
    const size_t item0 = (size_t)(b * 4 + hh) * 32;
    const int vr0 = hf * 256 + 32 * w;
    unsigned tidv = (unsigned)F.tid;
    unsigned qrb = (unsigned)(c31 * 528 + 8 * h), krb = (unsigned)(c31 * 144 + 16 * h);
    u32x4 rq[4], rk[4], ra; f32x4 rd; u32x4 bvn[4];
#define BV(ks) (*(const LAS bf16x8*)(L + 80896 + w * 4608 + krb + 32 * (ks)))
#define SCAN_LOAD_A(item) do { const char* q0 = (const char*)(F.GQT + (item) * 16384); const char* k0 = (const char*)(F.GKT + (item) * 16384); asm volatile("" : "+v"(tidv)); const unsigned tb = tidv * 16u; \
        _Pragma("unroll") for (int j = 0; j < 4; ++j) { rq[j] = *(const u32x4*)(q0 + j * 8192 + tb); rk[j] = *(const u32x4*)(k0 + j * 8192 + tb); } } while (0)
#define SCAN_LOAD_B(item) do { const char* v0 = (const char*)(F.GVT + (item) * 32768 + (size_t)vr0 * 64); asm volatile("" : "+v"(tidv)); const unsigned tb = tidv * 16u, db = (tidv & 63u) * 16u, vb = (tidv & 31u) * 128u + ((tidv >> 5) & 1u) * 16u; \
        ra = *(const u32x4*)((const char*)(F.GATT + (item) * 4096) + tb); \
        rd = *(const f32x4*)((const char*)(F.GDEC + (item) * 256) + db); \
        _Pragma("unroll") for (int ks = 0; ks < 4; ++ks) bvn[ks] = *(const u32x4*)(v0 + 32 * ks + vb); } while (0)
#define SCAN_WRITE() do { asm volatile("" : "+v"(tidv)); const unsigned qwo = (tidv >> 5) * 528u + (tidv & 31u) * 16u, kwo = (tidv >> 3) * 144u + (tidv & 7u) * 16u; \
        _Pragma("unroll") for (int j = 0; j < 4; ++j) { *(LAS u32x4*)(L + qwo + j * 16 * 528) = rq[j]; *(LAS u32x4*)(L + 33792 + kwo + j * 64 * 144) = rk[j]; } \
        *(LAS u32x4*)(L + 70656 + kwo) = ra; \
        if (tidv < 64u) *(LAS f32x4*)(L + 79872 + tidv * 16u) = rd; \
        _Pragma("unroll") for (int ks = 0; ks < 4; ++ks) *(LAS u32x4*)(L + 80896 + w * 4608 + krb + 32 * ks) = bvn[ks]; } while (0)
    SCAN_LOAD_A(item0); SCAN_LOAD_B(item0);
    SCAN_WRITE();
    __syncthreads();
    for (int c = 0; c < 32; ++c) {
        const size_t nitem = item0 + (c < 31 ? c + 1 : c);
        SCAN_LOAD_A(nitem);
        asm volatile("" : "+v"(qrb), "+v"(krb));
#pragma unroll 1
        for (int m = 0; m < 2; ++m) { f32x16 o;
#pragma unroll
            for (int j = 0; j < 16; ++j) o[j] = 0.f;
#pragma unroll
            for (int i = 0; i < 8; ++i)
#pragma unroll
                for (int s = 0; s < 2; ++s) { const bf16x8 bs = pack8_pinned(S[i], s);
                    const LAS unsigned char* ap = L + qrb + (32 * m) * 528 + (32 * i + 16 * s) * 2;
                    const s16x4 lo = *(const LAS s16x4*)ap, hi = *(const LAS s16x4*)(ap + 16);
                    const bf16x8 a = __builtin_shufflevector(lo, hi, 0, 1, 2, 3, 4, 5, 6, 7);
                    o = MFMA32(a, bs, o); }
#pragma unroll
            for (int ks = 0; ks < 4; ++ks) { const bf16x8 a = *(const LAS bf16x8*)(L + 70656 + krb + (32 * m) * 144 + 32 * ks); o = MFMA32(a, BV(ks), o); }
            { asm volatile("" : "+v"(tidv)); const unsigned ovb = ((tidv >> 5) & 1u) * (4u * DM * 2u) + (tidv & 31u) * 2u;
                char* ob = (char*)(F.OB + ((size_t)b * SEQ + c * 64 + 32 * m) * DM + hh * 512 + vr0);
#pragma unroll
                for (int j = 0; j < 16; ++j) *(bf16_t*)(ob + ((j & 3) + 8 * (j >> 2)) * (DM * 2) + ovb) = f2bf(o[j]); } }
        asm volatile("" ::: "memory");
        SCAN_LOAD_B(nitem);
#pragma unroll
        for (int i = 0; i < 8; ++i) {
#pragma unroll
            for (int g4 = 0; g4 < 4; ++g4) { const f32x4 dc = *(const LAS f32x4*)(L + 79872 + (32 * i + 8 * g4) * 4 + (((tidv >> 5) & 1u) * 16u));
                S[i][4 * g4] *= dc.x; S[i][4 * g4 + 1] *= dc.y; S[i][4 * g4 + 2] *= dc.z; S[i][4 * g4 + 3] *= dc.w; }
#pragma unroll
            for (int ks = 0; ks < 4; ++ks) { const bf16x8 a = *(const LAS bf16x8*)(L + 33792 + krb + (32 * i) * 144 + 32 * ks); S[i] = MFMA32(a, BV(ks), S[i]); } }
        __syncthreads();
        SCAN_WRITE();
        __syncthreads();
    }
#undef SCAN_LOAD_A
#undef SCAN_LOAD_B
#undef SCAN_WRITE
#undef BV
}

DI void merge_phase(Frame& F) {
    const int gw = F.vcu * NWAVES + F.wave, NGW = F.G * NWAVES, lane = F.lane;
    for (int m = gw; m < NTOK; m += NGW) {
        const bf16_t* pr = F.PROJ + (size_t)m * LDP;
#pragma unroll
        for (int j = 0; j < 4; ++j) { const int c0 = j * 512 + lane * 8;
            const u32x4 ob = *(const u32x4*)(F.OB + (size_t)m * DM + c0), oa = *(const u32x4*)(F.OA + (size_t)m * DM + c0);
            const u32x4 rb = *(const u32x4*)(pr + C_RB + c0), ga = *(const u32x4*)(pr + C_GA + c0), gb = *(const u32x4*)(pr + C_GB + c0);
            const f32x4 g0 = *(const f32x4*)(F.gla_g + lane * 8), g1 = *(const f32x4*)(F.gla_g + lane * 8 + 4);
            float vb[8] = {bf_lo(ob.x), bf_hi(ob.x), bf_lo(ob.y), bf_hi(ob.y), bf_lo(ob.z), bf_hi(ob.z), bf_lo(ob.w), bf_hi(ob.w)};
            const float va[8] = {bf_lo(oa.x), bf_hi(oa.x), bf_lo(oa.y), bf_hi(oa.y), bf_lo(oa.z), bf_hi(oa.z), bf_lo(oa.w), bf_hi(oa.w)};
            const float vr[8] = {bf_lo(rb.x), bf_hi(rb.x), bf_lo(rb.y), bf_hi(rb.y), bf_lo(rb.z), bf_hi(rb.z), bf_lo(rb.w), bf_hi(rb.w)};
            const float vga[8] = {bf_lo(ga.x), bf_hi(ga.x), bf_lo(ga.y), bf_hi(ga.y), bf_lo(ga.z), bf_hi(ga.z), bf_lo(ga.w), bf_hi(ga.w)};
            const float vgb[8] = {bf_lo(gb.x), bf_hi(gb.x), bf_lo(gb.y), bf_hi(gb.y), bf_lo(gb.z), bf_hi(gb.z), bf_lo(gb.w), bf_hi(gb.w)};
            const float gn[8] = {g0.x, g0.y, g0.z, g0.w, g1.x, g1.y, g1.z, g1.w};
            float ss = 0.f;
#pragma unroll
            for (int k = 0; k < 8; ++k) ss += vb[k] * vb[k];
            const float rn = 1.0f / sqrtf(wave_sum(ss) * (1.f / 512.f) + EPS);
            float r[8];
#pragma unroll
            for (int k = 0; k < 8; ++k) { const float obn = vb[k] * rn * gn[k]; const float sl = vr[k] * fast_sigmoid(vr[k]);
                r[k] = fast_sigmoid(vga[k]) * va[k] + fast_sigmoid(vgb[k]) * obn * sl; }
            *(u32x4*)(F.MIX + (size_t)m * DM + c0) = (u32x4){pk_bf16(r[0], r[1]), pk_bf16(r[2], r[3]), pk_bf16(r[4], r[5]), pk_bf16(r[6], r[7])}; }
    }
}

DI void router_phase(Frame& F) {
    LAS float* part = (LAS float*)F.lds;
    LAS float* ssp = (LAS float*)(F.lds + 34816);
    LAS float* rt = (LAS float*)(F.lds + 36864);
    LAS float* lg = (LAS float*)(F.lds + 37888);
    const int tid = F.tid, lane = F.lane, w = F.wave, c31 = lane & 31, h = lane >> 5;
    for (int tile = F.vcu; tile < NTOK / 32; tile += F.G) {
        const int t0 = tile * 32, kw = 256 * w;
        { const float* xr = F.X1 + (size_t)(t0 + c31) * DM + kw + 4 * h; const float* gp = F.ffn_g + kw + 4 * h; const float* wp = F.w_router + (size_t)(kw + 4 * h) * 32 + c31;
            f32x16 acc;
#pragma unroll
            for (int i = 0; i < 16; ++i) acc[i] = 0.f;
            float ss = 0.f;
#pragma unroll 4
            for (int m = 0; m < 32; ++m) { const f32x4 a = *(const f32x4*)(xr + 8 * m); const f32x4 g4 = *(const f32x4*)(gp + 8 * m); const float* wr_ = wp + (size_t)m * 256;
                const float b0 = g4.x * wr_[0], b1 = g4.y * wr_[32], b2 = g4.z * wr_[64], b3 = g4.w * wr_[96];
                ss += (a.x * a.x + a.y * a.y) + (a.z * a.z + a.w * a.w);
                acc = __builtin_amdgcn_mfma_f32_32x32x2f32(a.x, b0, acc, 0, 0, 0); acc = __builtin_amdgcn_mfma_f32_32x32x2f32(a.y, b1, acc, 0, 0, 0);
                acc = __builtin_amdgcn_mfma_f32_32x32x2f32(a.z, b2, acc, 0, 0, 0); acc = __builtin_amdgcn_mfma_f32_32x32x2f32(a.w, b3, acc, 0, 0, 0); }
            ss += __shfl_xor(ss, 32);
#pragma unroll
            for (int i = 0; i < 16; ++i) part[(w * 32 + crow(i, h)) * 33 + c31] = acc[i];
            if (h == 0) ssp[w * 32 + c31] = ss; }
        __syncthreads();
        { const int tok = tid >> 4, e0 = tid & 15; float s0 = 0.f, s1 = 0.f, sst = 0.f;
#pragma unroll
            for (int w2 = 0; w2 < 8; ++w2) { s0 += part[(w2 * 32 + tok) * 33 + e0]; s1 += part[(w2 * 32 + tok) * 33 + e0 + 16]; sst += ssp[w2 * 32 + tok]; }
            const float r = 1.0f / sqrtf(sst * (1.f / DM) + EPS);
            lg[tok * 33 + e0] = s0 * r + F.b_router[e0]; lg[tok * 33 + e0 + 16] = s1 * r + F.b_router[e0 + 16]; if (e0 == 0) rt[tok] = r; }
        __syncthreads();
#pragma unroll
        for (int it = 0; it < 2; ++it) { const int tok = 4 * w + 2 * it + h; const int m = t0 + tok;
            float v = lg[tok * 33 + c31]; float tv[4]; int ti[4];
#pragma unroll
            for (int k = 0; k < 4; ++k) { float bv = v; int bi = c31;
#pragma unroll
                for (int o = 1; o < 32; o <<= 1) { const float ov = __shfl_xor(bv, o); const int oi = __shfl_xor(bi, o); const bool take = (ov > bv) || (ov == bv && oi < bi); bv = take ? ov : bv; bi = take ? oi : bi; }
                tv[k] = bv; ti[k] = bi; v = (c31 == bi) ? -INFINITY : v; }
            const float e1 = fast_exp(tv[1] - tv[0]), e2 = fast_exp(tv[2] - tv[0]), e3 = fast_exp(tv[3] - tv[0]); const float inv = 1.0f / (1.0f + e1 + e2 + e3);
            if (c31 < 4) { const int ex = c31 == 0 ? ti[0] : c31 == 1 ? ti[1] : c31 == 2 ? ti[2] : ti[3]; const float gt = (c31 == 0 ? 1.0f : c31 == 1 ? e1 : c31 == 2 ? e2 : e3) * inv;
                const unsigned slot = __hip_atomic_fetch_add((unsigned*)(F.ctl + CW_CNT + 64 * ex), 1u, __ATOMIC_RELAXED, __HIP_MEMORY_SCOPE_AGENT);
                F.tokl[(size_t)ex * NTOK + slot] = m; F.tope[m * 4 + c31] = ex; F.tops[m * 4 + c31] = (int)slot; F.gate[m * 4 + c31] = gt; } }
#pragma unroll
        for (int q = 0; q < 4; ++q) { const int tok = 4 * w + q; const size_t m = (size_t)(t0 + tok); const float r = rt[tok];
            const f32x4* xr = (const f32x4*)(F.X1 + m * DM) + lane; const f32x4* gr = (const f32x4*)F.ffn_g + lane; unsigned* o4 = (unsigned*)((unsigned char*)F.H + m * DM) + lane;
            const float r8 = 8.0f * r;
#pragma unroll
            for (int j = 0; j < 8; ++j) { const f32x4 xv = xr[64 * j], gg = gr[64 * j];
                o4[64 * j] = pk4_fp8(clamp_fp8(xv.x * r8 * gg.x), clamp_fp8(xv.y * r8 * gg.y), clamp_fp8(xv.z * r8 * gg.z), clamp_fp8(xv.w * r8 * gg.w)); } }
        __syncthreads();
    }
}

DI void moe_tables(Frame& F) {
    LAS int* tb = (LAS int*)(F.lds + TBL_OFF);
    if (F.tid == 0) { int acc = 0;
        for (int e = 0; e < NEXP; ++e) { const int c = (int)__hip_atomic_load((unsigned*)(F.ctl + CW_CNT + 64 * e), __ATOMIC_RELAXED, __HIP_MEMORY_SCOPE_AGENT); tb[e] = acc; tb[40 + e] = c; acc += (c + 255) >> 8; }
        tb[32] = acc; }
    __syncthreads();
}
struct MoeProb {
    const bf16_t* A; const bf16_t* Bt; const int* tokl; const LAS int* tb; int K, NT  , brows  , G, c; bool gather;
    DI bool next(int i, pg8::Unit& u) const {
        const int L = i * G + c; const int nb = tb[32]; if (L >= nb * NT) return false;
        const int blk = L / NT, pn = L % NT; int e = 0;
        for (int j = 1; j < NEXP; ++j) e += (tb[j] <= blk) ? 1 : 0;
        const int rb = blk - tb[e]; int nr = tb[40 + e] - rb * 256; nr = nr > 256 ? 256 : nr;
        u.pm = blk; u.pn = pn; u.e = e; u.rb = rb; u.nrow = nr; return true;
    }
    DI const char* a_base(const pg8::Unit& u) const { return gather ? (const char*)A : (const char*)A + (size_t)u.pm * 256 * K * 2; }
    DI const char* b_base(const pg8::Unit& u) const { return (const char*)Bt + ((size_t)u.e * brows + (size_t)u.pn * 256) * K * 2; }
    DI void a_voff(const pg8::Unit& u, const int (&R)[2], const int (&C)[2], unsigned (&v)[2][2]) const {
#pragma unroll
        for (int h = 0; h < 2; ++h)
#pragma unroll
            for (int i = 0; i < 2; ++i) { const int r = h * 128 + R[i];
                if (gather) { int tok = 0; if (r < u.nrow) tok = tokl[(size_t)u.e * NTOK + u.rb * 256 + r]; v[h][i] = (unsigned)(tok * K + C[i]) * 2u; }
                else v[h][i] = (unsigned)(r * K + C[i]) * 2u; }
    }
};

DI void final_phase(Frame& F) {
    const LAS int* tb = (const LAS int*)(F.lds + TBL_OFF);
    const int gw = F.vcu * NWAVES + F.wave, NGW = F.G * NWAVES, lane = F.lane;
    for (int m = gw; m < NTOK; m += NGW) {
        const bf16_t* yr[4]; float gt[4];
#pragma unroll
        for (int k = 0; k < 4; ++k) { const int e = F.tope[m * 4 + k], sl = F.tops[m * 4 + k]; gt[k] = F.gate[m * 4 + k]; yr[k] = F.Y + ((size_t)tb[e] * 256 + sl) * DM; }
        float v[4][8]; float ss = 0.f;
#pragma unroll
        for (int j = 0; j < 4; ++j) { const int c0 = 8 * (lane + 64 * j);
            const f32x4 x0 = *(const f32x4*)(F.X1 + (size_t)m * DM + c0), x1 = *(const f32x4*)(F.X1 + (size_t)m * DM + c0 + 4);
            float a[8] = {x0.x, x0.y, x0.z, x0.w, x1.x, x1.y, x1.z, x1.w};
#pragma unroll
            for (int k = 0; k < 4; ++k) { const u32x4 y = *(const u32x4*)(yr[k] + c0);
                a[0] += gt[k] * bf_lo(y.x); a[1] += gt[k] * bf_hi(y.x); a[2] += gt[k] * bf_lo(y.y); a[3] += gt[k] * bf_hi(y.y);
                a[4] += gt[k] * bf_lo(y.z); a[5] += gt[k] * bf_hi(y.z); a[6] += gt[k] * bf_lo(y.w); a[7] += gt[k] * bf_hi(y.w); }
#pragma unroll
            for (int q = 0; q < 8; ++q) { v[j][q] = a[q]; ss += a[q] * a[q]; } }
        const float r = 1.0f / sqrtf(wave_sum(ss) * (1.f / DM) + EPS);
#pragma unroll
        for (int j = 0; j < 4; ++j) { const int c0 = 8 * (lane + 64 * j);
            const f32x4 g0 = *(const f32x4*)(F.final_g + c0), g1 = *(const f32x4*)(F.final_g + c0 + 4);
            *(f32x4*)(F.out + (size_t)m * DM + c0) = (f32x4){v[j][0] * r * g0.x, v[j][1] * r * g0.y, v[j][2] * r * g0.z, v[j][3] * r * g0.w};
            *(f32x4*)(F.out + (size_t)m * DM + c0 + 4) = (f32x4){v[j][4] * r * g1.x, v[j][5] * r * g1.y, v[j][6] * r * g1.z, v[j][7] * r * g1.w}; }
    }
}
#ifndef MK_N_LAUNCHES
#define MK_N_LAUNCHES 1
#endif
constexpr int N_PHASES = 10;
struct Args { const float* in[16]; float* out; unsigned char* ws; int ph_lo, ph_hi; };
static_assert(sizeof(Args) == 16 * 8 + 8 + 8 + 8, "Args has no padding");

__global__ void __launch_bounds__(NWAVES * 64, 2) fwd_kernel(Args args) {
    extern __shared__ __attribute__((aligned(16))) unsigned char lds_raw[];
    Frame F;
    F.lds = (LAS unsigned char*)lds_raw;
    F.tid = threadIdx.x; F.lane = F.tid & 63; F.wave = __builtin_amdgcn_readfirstlane(F.tid >> 6);
    F.G = gridDim.x; { const int bx = blockIdx.x; F.vcu = (F.G % 8 == 0) ? (bx % 8) * (F.G / 8) + bx / 8 : bx; }
    unsigned char* ws = args.ws;
    F.ctl = (gu32*)(ws + WS_CTL);
    F.x = args.in[0]; F.attn_g = args.in[1]; F.w_in = args.in[2]; F.sinks = args.in[3]; F.w_alpha2 = args.in[4]; F.b_alpha = args.in[5]; F.gla_g = args.in[6]; F.w_out = args.in[7];
    F.ffn_g = args.in[8]; F.w_router = args.in[9]; F.b_router = args.in[10]; F.w_gu = args.in[11]; F.b_gu = args.in[12]; F.w_dn = args.in[13]; F.b_dn = args.in[14]; F.final_g = args.in[15];
    F.out = args.out;
    F.tope = (int*)(ws + WS_TOPE); F.tops = (int*)(ws + WS_TOPS); F.gate = (float*)(ws + WS_GATE); F.tokl = (int*)(ws + WS_TOKL);
    F.Win = (bf16_t*)(ws + WS_WIN); F.Wout = (bf16_t*)(ws + WS_WOUT); F.Wgu = (bf16_t*)(ws + WS_WGU); F.Wdn = (bf16_t*)(ws + WS_WDN);
    F.H = (bf16_t*)(ws + WS_H); F.PROJ = (bf16_t*)(ws + WS_PROJ); F.OA = (bf16_t*)(ws + WS_OA); F.OB = (bf16_t*)(ws + WS_OB); F.MIX = (bf16_t*)(ws + WS_MIX);
    F.X1 = (float*)(ws + WS_X1); F.GQT = (bf16_t*)(ws + WS_GQT); F.GKT = (bf16_t*)(ws + WS_GKT); F.GATT = (bf16_t*)(ws + WS_GATT); F.GDEC = (float*)(ws + WS_GDEC); F.GVT = (bf16_t*)(ws + WS_GVT);
    F.ACT = (bf16_t*)(ws + WS_ACT); F.Y = (bf16_t*)(ws + WS_Y);
    for (int u = F.tid; u < (LDS_BYTES - LDSCTL_OFF) / 4; u += NWAVES * 64) ((LAS unsigned*)(F.lds + LDSCTL_OFF))[u] = 0u;
    __syncthreads();
    const int lo = args.ph_lo, hi = args.ph_hi;
    const bool use_bar = (hi - lo) > 1;
    XcdBarrier bar; bar.bar = (unsigned*)(F.ctl + CW_BAR); bar.x = 0; bar.st = nullptr;
    if (use_bar) bar = xcd_barrier_post((unsigned*)(F.ctl + CW_BAR), (volatile LAS unsigned*)(F.lds + MISC_OFF) + 8);
#define IN(k) (lo <= (k) && (k) < hi)
#define SEAM(k) do { if (IN(k) && IN((k) + 1)) xcd_barrier(bar); } while (0)

    if (IN(0)) { p0_prologue(F); }
    SEAM(0);
    if (IN(1)) {
        pg8::DenseProb P; P.A = F.H; P.Bt = F.Win; P.K = DM; P.S.init(NTOK, LDP, F.G, (int)blockIdx.x);
        pg8::EpiBf16Plain E{F.PROJ, LDP};
        pg8::gemm_phase<false>(F.lds + RING_OFF, P, E);
    }
    SEAM(1);
    if (IN(2)) { gla_prep_phase(F); }
    SEAM(2);
    if (IN(3)) { if (F.vcu < 64) gla_scan_phase(F); swa_phase(F); }
    SEAM(3);
    if (IN(4)) { merge_phase(F); }
    SEAM(4);
    if (IN(5)) {
        pg8::DenseProb P; P.A = F.MIX; P.Bt = F.Wout; P.K = DM; P.S.init(NTOK, DM, F.G, (int)blockIdx.x);
        pg8::EpiResF32 E{F.x, F.X1, DM};
        pg8::gemm_phase<false>(F.lds + RING_OFF, P, E);
    }
    SEAM(5);
    if (IN(6)) { router_phase(F); }
    SEAM(6);
    if (IN(7)) {
        moe_tables(F);
        MoeProb P; P.A = F.H; P.Bt = F.Wgu; P.tokl = F.tokl; P.tb = (const LAS int*)(F.lds + TBL_OFF); P.K = DM / 2; P.NT = 16; P.brows = 4096; P.G = F.G; P.c = (int)blockIdx.x; P.gather = true;
        pg8::EpiGlu E{(unsigned char*)F.ACT, DFF, F.b_gu};
        pg8::gemm_phase<true>(F.lds + RING_OFF, P, E);
    }
    SEAM(7);
    if (IN(8)) {
        moe_tables(F);
        MoeProb P; P.A = F.ACT; P.Bt = F.Wdn; P.tokl = F.tokl; P.tb = (const LAS int*)(F.lds + TBL_OFF); P.K = DFF / 2; P.NT = 8; P.brows = 2048; P.G = F.G; P.c = (int)blockIdx.x; P.gather = false;
        pg8::EpiBf16BiasE E{F.Y, DM, F.b_dn};
        pg8::gemm_phase<true>(F.lds + RING_OFF, P, E);
    }
    SEAM(8);
    if (IN(9)) { moe_tables(F); final_phase(F); }
#undef IN
#undef SEAM
}

extern "C" void kernel_launch(void* const* d_in, const int* in_sizes, int n_in, void* d_out, int out_size, void* d_ws, size_t ws_size, hipStream_t stream) {
    static int grid = 0;
    if (grid == 0) {
        if (n_in != 16 || out_size != NTOK * DM || ws_size < WS_END) { fprintf(stderr, "kernel_launch: unexpected shapes (n_in %d, out %d, ws %zu, need %zu); nothing launched\n", n_in, out_size, ws_size, (size_t)WS_END); grid = -1; return; }
        int dev = 0, cus = 0, per_cu = 0;
        if (hipGetDevice(&dev) != hipSuccess || hipDeviceGetAttribute(&cus, hipDeviceAttributeMultiprocessorCount, dev) != hipSuccess) { fprintf(stderr, "kernel_launch: device query failed\n"); grid = -1; return; }
        if (hipFuncSetAttribute((const void*)fwd_kernel, hipFuncAttributeMaxDynamicSharedMemorySize, LDS_BYTES) != hipSuccess) { fprintf(stderr, "kernel_launch: hipFuncSetAttribute failed\n"); grid = -1; return; }
        if (hipOccupancyMaxActiveBlocksPerMultiprocessor(&per_cu, (const void*)fwd_kernel, NWAVES * 64, LDS_BYTES) != hipSuccess || per_cu < 1)
            fprintf(stderr, "kernel_launch: note: occupancy query reports %d workgroups per CU\n", per_cu);
        (void)hipGetLastError();
        grid = cus;
    }
    if (grid < 0) return;
    if (hipMemsetAsync((char*)d_ws + WS_CTL, 0, CTL_ZERO_BYTES, stream) != hipSuccess) { fprintf(stderr, "kernel_launch: hipMemsetAsync failed\n"); return; }
    Args a{};
    for (int i = 0; i < 16; ++i) a.in[i] = (const float*)d_in[i];
    a.out = (float*)d_out; a.ws = (unsigned char*)d_ws;
    if (MK_N_LAUNCHES == 1) { a.ph_lo = 0; a.ph_hi = N_PHASES; hipLaunchKernelGGL(fwd_kernel, dim3(grid), dim3(NWAVES * 64), LDS_BYTES, stream, a); }
    else for (int p = 0; p < N_PHASES; ++p) { a.ph_lo = p; a.ph_hi = p + 1; hipLaunchKernelGGL(fwd_kernel, dim3(grid), dim3(NWAVES * 64), LDS_BYTES, stream, a);
#ifdef MK_REPEAT_MASK
        if ((MK_REPEAT_MASK >> p) & 1) hipLaunchKernelGGL(fwd_kernel, dim3(grid), dim3(NWAVES * 64), LDS_BYTES, stream, a);
#endif
    }
    const hipError_t le = hipPeekAtLastError();
    if (le != hipSuccess) fprintf(stderr, "kernel_launch: launch failed: %s\n", hipGetErrorName(le));
}
```

```cpp
#define MK_N_LAUNCHES 1
#include <hip/hip_runtime.h>
#include <cstdio>
#include <cstdint>

#define DI __device__ __forceinline__
#define LAS __attribute__((address_space(3)))
#define GAS __attribute__((address_space(1)))
typedef unsigned short bf16_t;
typedef short bf16x8 __attribute__((ext_vector_type(8)));
typedef short s16x4 __attribute__((ext_vector_type(4)));
typedef float f32x4 __attribute__((ext_vector_type(4)));
typedef float f32x16 __attribute__((ext_vector_type(16)));
typedef unsigned u32x4 __attribute__((ext_vector_type(4)));
typedef unsigned u32x2 __attribute__((ext_vector_type(2)));
typedef float f32x2_t __attribute__((ext_vector_type(2)));
typedef __bf16 bf16x2_t __attribute__((ext_vector_type(2)));
typedef int i32x4 __attribute__((ext_vector_type(4)));
typedef int i32x8 __attribute__((ext_vector_type(8)));
DI unsigned pk4_fp8(float a, float b, float c, float d) { int p = __builtin_amdgcn_cvt_pk_fp8_f32(a, b, 0, false); p = __builtin_amdgcn_cvt_pk_fp8_f32(c, d, p, true); return (unsigned)p; }
DI float clamp_fp8(float x) { return fminf(fmaxf(x, -448.0f), 448.0f); }
constexpr int F8_SCALE_W = 0x79797979;
constexpr int F8_SCALE_A = 0x7c7c7c7c;
DI unsigned pk4_i8(float a, float b, float c, float d) {
    const int ia = (int)__builtin_rintf(fminf(fmaxf(a, -127.f), 127.f)), ib = (int)__builtin_rintf(fminf(fmaxf(b, -127.f), 127.f));
    const int ic = (int)__builtin_rintf(fminf(fmaxf(c, -127.f), 127.f)), id = (int)__builtin_rintf(fminf(fmaxf(d, -127.f), 127.f));
    return ((unsigned)ia & 0xffu) | (((unsigned)ib & 0xffu) << 8) | (((unsigned)ic & 0xffu) << 16) | ((unsigned)id << 24);
}
DI float wave_max(float v) {
#pragma unroll
    for (int o = 1; o < 64; o <<= 1) v = fmaxf(v, __shfl_xor(v, o));
    return v;
}
constexpr int GM_BF16 = 0, GM_FP8 = 1, GM_I8 = 2;

DI unsigned pk_bf16(float lo, float hi) { f32x2_t v = {lo, hi}; bf16x2_t b = __builtin_convertvector(v, bf16x2_t); return __builtin_bit_cast(unsigned, b); }
DI float bf_lo(unsigned w) { return __uint_as_float(w << 16); }
DI float bf_hi(unsigned w) { return __uint_as_float(w & 0xffff0000u); }
DI float bf2f(bf16_t v) { return __uint_as_float(((unsigned)v) << 16); }
DI bf16_t f2bf(float f) { return (bf16_t)(pk_bf16(f, 0.f) & 0xffffu); }
DI float fast_exp(float x) { return __builtin_amdgcn_exp2f(x * 1.4426950408889634f); }
DI float fast_rcp(float x) { return __builtin_amdgcn_rcpf(x); }
DI float fast_sigmoid(float x) { return fast_rcp(1.0f + fast_exp(-x)); }
DI float wave_sum(float v) {
#pragma unroll
    for (int o = 1; o < 64; o <<= 1) v += __shfl_xor(v, o);
    return v;
}
DI int crow(int reg, int h) { return (reg & 3) + 8 * (reg >> 2) + 4 * h; }
#define MFMA32(a, b, c) __builtin_amdgcn_mfma_f32_32x32x16_bf16((a), (b), (c), 0, 0, 0)

namespace pg8 {
constexpr int BM = 256, BK = 64, HALF = 128, HTB = HALF * BK * 2  , STAGE_BYTES = 8 * HTB, NXCD = 8, WGM = 8;

DI int lds_byte(int r, int c) { const int st = (r >> 4) * 2 + (c >> 5), rr = r & 15, cc = c & 31, ob = rr * 64 + cc * 2; return st * 1024 + (ob ^ (((ob >> 9) & 1) << 5)); }
DI void stage_rc(int b, int& R, int& C) { const int st = b / 1024, sb = b % 1024, swz = sb ^ (((sb >> 9) & 1) << 5); R = (st >> 1) * 16 + swz / 64; C = (st & 1) * 32 + (swz % 64) / 2; }
DI int perm32(int rho) { const int n = rho >> 4, i = rho & 15; return 8 * (i >> 2) + 4 * n + (i & 3); }

struct Unit { int pm, pn, e, rb, nrow; };

struct StaticOrder {
    int nM, nN, nwg, G, c;
    DI void init(int M, int N, int G_, int c_) { nM = M / BM; nN = N / BM; nwg = nM * nN; G = G_; c = c_; }
    DI bool next(int i, int& pm, int& pn) const {
        const long L = (long)i * G + c; if (L >= nwg) return false;
        int wgid = (int)L; { const int q = nwg / NXCD, r = nwg % NXCD, xcd = wgid % NXCD, off = wgid / NXCD; wgid = (xcd < r ? xcd * (q + 1) : r * (q + 1) + (xcd - r) * q) + off; }
        const int nig = WGM * nN, gid = wgid / nig, fm = gid * WGM, gsz = (nM - fm) < WGM ? (nM - fm) : WGM;
        pm = fm + ((wgid % nig) % gsz); pn = (wgid % nig) / gsz; return true;
    }
};

struct DenseProb {
    const bf16_t* A; const bf16_t* Bt; int K; StaticOrder S; int vsplit = 1 << 30, pnA = 0, pnB = 0;
    DI bool next(int i, Unit& u) const { int pm, pn; if (!S.next(i, pm, pn)) return false; u.pm = pm; u.pn = (pn < vsplit) ? pnA + pn : pnB + pn - vsplit; u.e = 0; u.rb = 0; u.nrow = 256; return true; }
    DI const char* a_base(const Unit& u) const { return (const char*)A + (size_t)u.pm * 256 * K * 2; }
    DI const char* b_base(const Unit& u) const { return (const char*)Bt + (size_t)u.pn * 256 * K * 2; }
    DI void a_voff(const Unit&, const int (&R)[2], const int (&C)[2], unsigned (&v)[2][2]) const {
#pragma unroll
        for (int h = 0; h < 2; ++h)
#pragma unroll
            for (int i = 0; i < 2; ++i) v[h][i] = (unsigned)((h * HALF + R[i]) * K + C[i]) * 2u;
    }
};

template <int MODE, class Prob, class Epi>
DI void gemm_phase(LAS unsigned char* lds, const Prob& P, const Epi& E) {
    constexpr bool F8 = (MODE == GM_FP8);
    const int tid = threadIdx.x, wid = __builtin_amdgcn_readfirstlane(tid >> 6), lane = tid & 63, wr = wid >> 2, wc = wid & 3, fr = lane & 15, fq = lane >> 4;
    const int K = P.K, nt = K / BK;
    int sR[2], sC[2]; unsigned voffB[2];
#pragma unroll
    for (int i = 0; i < 2; ++i) { int R, C; stage_rc(tid * 16 + i * 8192, R, C); const int Rb = Epi::PERM ? ((R & ~31) + perm32(R & 31)) : R; sR[i] = R; sC[i] = C; voffB[i] = (unsigned)(Rb * K + C) * 2u; }
    const size_t kstep = (size_t)(BK * 2);
    const size_t hstep = (size_t)HALF * K * 2;
    const unsigned ldsw = (unsigned)wid * 1024u;
    const int aoff = lds_byte(wr * 64 + fr, fq * 8), boff = lds_byte(wc * 32 + fr, fq * 8);
#define PG8_SA(b, h) (((b) * 2 + (h)) * HTB)
#define PG8_SB(b, h) ((4 + (b) * 2 + (h)) * HTB)
#define PG8_STAGE2(bufoff, gbase, v0, v1) do { \
        __builtin_amdgcn_global_load_lds((const unsigned*)((const char*)(gbase) + (v0)), (LAS unsigned*)(lds + (bufoff) + ldsw), 16, 0, 0); \
        __builtin_amdgcn_global_load_lds((const unsigned*)((const char*)(gbase) + (v1)), (LAS unsigned*)(lds + (bufoff) + ldsw + 8192), 16, 0, 0); } while (0)
#define PG8_STAGEB(bufoff, gbase) PG8_STAGE2(bufoff, gbase, voffB[0], voffB[1])
#define PG8_LDA(dst, b, h) do { _Pragma("unroll") for (int m = 0; m < 4; ++m) { const i32x4 lo_ = *(const LAS i32x4*)(lds + PG8_SA(b, h) + aoff + m * 2048), hi_ = *(const LAS i32x4*)(lds + PG8_SA(b, h) + aoff + m * 2048 + 1024); \
        dst[m] = __builtin_shufflevector(lo_, hi_, 0, 1, 2, 3, 4, 5, 6, 7); } } while (0)
#define PG8_LDB(dst, b, h) do { _Pragma("unroll") for (int n = 0; n < 2; ++n) { const i32x4 lo_ = *(const LAS i32x4*)(lds + PG8_SB(b, h) + boff + n * 2048), hi_ = *(const LAS i32x4*)(lds + PG8_SB(b, h) + boff + n * 2048 + 1024); \
        dst[n] = __builtin_shufflevector(lo_, hi_, 0, 1, 2, 3, 4, 5, 6, 7); } } while (0)
#define PG8_MMA(ai, bj, At, Bt) do { __builtin_amdgcn_s_setprio(1); _Pragma("unroll") for (int m = 0; m < 4; ++m) _Pragma("unroll") for (int n = 0; n < 2; ++n) { \
        if constexpr (F8) asm volatile("v_mfma_scale_f32_16x16x128_f8f6f4 %0, %1, %2, %0, %3, %4 op_sel_hi:[0,0,0]" : "+v"(acc[ai][bj][m][n]) : "v"(Bt[n]), "v"(At[m]), "v"(f8sw), "v"(f8sa)); \
        else if constexpr (MODE == GM_I8) { i32x4 ci = __builtin_bit_cast(i32x4, acc[ai][bj][m][n]); \
               ci = __builtin_amdgcn_mfma_i32_16x16x64_i8(__builtin_shufflevector(Bt[n], Bt[n], 0, 1, 2, 3), __builtin_shufflevector(At[m], At[m], 0, 1, 2, 3), ci, 0, 0, 0); \
               ci = __builtin_amdgcn_mfma_i32_16x16x64_i8(__builtin_shufflevector(Bt[n], Bt[n], 4, 5, 6, 7), __builtin_shufflevector(At[m], At[m], 4, 5, 6, 7), ci, 0, 0, 0); acc[ai][bj][m][n] = __builtin_bit_cast(f32x4, ci); } \
        else { acc[ai][bj][m][n] = __builtin_amdgcn_mfma_f32_16x16x32_bf16(__builtin_bit_cast(bf16x8, __builtin_shufflevector(Bt[n], Bt[n], 0, 1, 2, 3)), __builtin_bit_cast(bf16x8, __builtin_shufflevector(At[m], At[m], 0, 1, 2, 3)), acc[ai][bj][m][n], 0, 0, 0); \
               acc[ai][bj][m][n] = __builtin_amdgcn_mfma_f32_16x16x32_bf16(__builtin_bit_cast(bf16x8, __builtin_shufflevector(Bt[n], Bt[n], 4, 5, 6, 7)), __builtin_bit_cast(bf16x8, __builtin_shufflevector(At[m], At[m], 4, 5, 6, 7)), acc[ai][bj][m][n], 0, 0, 0); } } \
        __builtin_amdgcn_s_setprio(0); } while (0)
#define PG8_WAIT_V(n) asm volatile("s_waitcnt vmcnt(" #n ")" ::: "memory")
#define PG8_WAIT_L(n) asm volatile("s_waitcnt lgkmcnt(" #n ")" ::: "memory")
#define PG8_BAR __builtin_amdgcn_s_barrier()
#define PG8_SCHED __builtin_amdgcn_sched_barrier(0)
    Unit cur, nxt; int ui = 0;
    if (!P.next(0, cur)) return;
    f32x4 acc[2][2][4][2];
#pragma unroll
    for (int a = 0; a < 2; ++a)
#pragma unroll
        for (int b = 0; b < 2; ++b)
#pragma unroll
            for (int m = 0; m < 4; ++m)
#pragma unroll
                for (int n = 0; n < 2; ++n) acc[a][b][m][n] = (f32x4){0.f, 0.f, 0.f, 0.f};
    i32x8 At[4], B0[2], B1[2];
    const int f8sw = F8_SCALE_W, f8sa = F8_SCALE_A;
    const char* cA = P.a_base(cur); const char* cB = P.b_base(cur);
    unsigned vAc[2][2], vAn[2][2];
    P.a_voff(cur, sR, sC, vAc);
    PG8_STAGEB(PG8_SB(0, 0), cB); PG8_STAGEB(PG8_SB(0, 1), cB + hstep); PG8_STAGE2(PG8_SA(0, 0), cA, vAc[0][0], vAc[0][1]); PG8_STAGE2(PG8_SA(0, 1), cA, vAc[1][0], vAc[1][1]);
    if (wr == 1) PG8_BAR;
    PG8_WAIT_V(2); PG8_BAR;
    PG8_STAGEB(PG8_SB(1, 0), cB + kstep); PG8_STAGE2(PG8_SA(1, 0), cA + kstep, vAc[0][0], vAc[0][1]); PG8_STAGEB(PG8_SB(1, 1), cB + hstep + kstep);
    PG8_WAIT_V(6); PG8_BAR;
    for (;;) {
        const bool has_next = P.next(ui + 1, nxt);
        const char* nA = cA; const char* nB = cB;
        if (has_next) { nA = P.a_base(nxt); nB = P.b_base(nxt); P.a_voff(nxt, sR, sC, vAn); }
        else {
#pragma unroll
            for (int h = 0; h < 2; ++h)
#pragma unroll
                for (int i = 0; i < 2; ++i) vAn[h][i] = vAc[h][i];
        }
        for (int t = 0; t < nt; t += 2) {
            const bool last = (t == nt - 2);
            const char* a1 = cA + (size_t)(t + 1) * kstep;
            const char* a2 = last ? nA : cA + (size_t)(t + 2) * kstep; const char* b2 = last ? nB : cB + (size_t)(t + 2) * kstep;
            const char* a3 = a2 + kstep; const char* b3 = b2 + kstep;
            const unsigned w00 = last ? vAn[0][0] : vAc[0][0], w01 = last ? vAn[0][1] : vAc[0][1], w10 = last ? vAn[1][0] : vAc[1][0], w11 = last ? vAn[1][1] : vAc[1][1];
            PG8_LDB(B0, 0, 0); PG8_LDB(B1, 0, 1); PG8_SCHED; PG8_LDA(At, 0, 0); PG8_STAGE2(PG8_SA(1, 1), a1, vAc[1][0], vAc[1][1]);
            PG8_WAIT_V(8); PG8_WAIT_L(0); PG8_BAR; PG8_MMA(0, 0, At, B0); PG8_MMA(0, 1, At, B1); PG8_BAR; PG8_SCHED;
            PG8_LDA(At, 0, 1); PG8_STAGEB(PG8_SB(0, 0), b2); PG8_STAGEB(PG8_SB(0, 1), b2 + hstep); PG8_STAGE2(PG8_SA(0, 0), a2, w00, w01);
            PG8_WAIT_V(8); PG8_WAIT_L(0); PG8_BAR; PG8_MMA(1, 0, At, B0); PG8_MMA(1, 1, At, B1); PG8_BAR; PG8_SCHED;
            PG8_LDB(B0, 1, 0); PG8_LDB(B1, 1, 1); PG8_SCHED; PG8_LDA(At, 1, 0); PG8_STAGE2(PG8_SA(0, 1), a2, w10, w11);
            PG8_WAIT_V(8); PG8_WAIT_L(0); PG8_BAR; PG8_MMA(0, 0, At, B0); PG8_MMA(0, 1, At, B1); PG8_BAR; PG8_SCHED;
            PG8_LDA(At, 1, 1); PG8_STAGEB(PG8_SB(1, 0), b3); PG8_STAGEB(PG8_SB(1, 1), b3 + hstep); PG8_STAGE2(PG8_SA(1, 0), a3, w00, w01);
            PG8_WAIT_V(8); PG8_WAIT_L(0); PG8_BAR; PG8_MMA(1, 0, At, B0); PG8_MMA(1, 1, At, B1); PG8_BAR; PG8_SCHED;
        }
        if (wr == 0) PG8_BAR;
        if constexpr (F8) asm volatile("s_nop 15\n\ts_nop 15" ::: "memory");
        E(acc, cur, wr, wc, fr, fq);
        if (!has_next) break;
#pragma unroll
        for (int a = 0; a < 2; ++a)
#pragma unroll
            for (int b = 0; b < 2; ++b)
#pragma unroll
                for (int m = 0; m < 4; ++m)
#pragma unroll
                    for (int n = 0; n < 2; ++n) acc[a][b][m][n] = (f32x4){0.f, 0.f, 0.f, 0.f};
        cur = nxt; cA = nA; cB = nB; ++ui;
#pragma unroll
        for (int h = 0; h < 2; ++h)
#pragma unroll
            for (int i = 0; i < 2; ++i) vAc[h][i] = vAn[h][i];
        if (wr == 1) PG8_BAR;
    }
    PG8_WAIT_V(0);
    PG8_BAR;
#undef PG8_SA
#undef PG8_SB
#undef PG8_STAGE2
#undef PG8_STAGEB
#undef PG8_LDA
#undef PG8_LDB
#undef PG8_MMA
#undef PG8_WAIT_V
#undef PG8_WAIT_L
#undef PG8_BAR
#undef PG8_SCHED
}
}
namespace pg8 {
template <bool I8> struct EpiBf16Plain {
    static constexpr bool PERM = true;
    bf16_t* O; int ldc; const float* sa; const float* cm;
    DI void operator()(const f32x4 (&acc)[2][2][4][2], const Unit& u, int wr, int wc, int fr, int fq) const {
        const int row0 = u.pm * BM + wr * 64 + fr, col0 = u.pn * BM + wc * 32 + 8 * fq;
        f32x4 sb[2][2];
        if constexpr (I8) {
#pragma unroll
            for (int bj = 0; bj < 2; ++bj)
#pragma unroll
                for (int n = 0; n < 2; ++n) sb[bj][n] = *(const f32x4*)(cm + col0 + bj * HALF + 4 * n) * (1.0f / 127.0f); }
#pragma unroll
        for (int ai = 0; ai < 2; ++ai)
#pragma unroll
            for (int m = 0; m < 4; ++m) { const int row = row0 + ai * HALF + m * 16; bf16_t* rowp = O + (size_t)row * ldc + col0; float sr = 1.f; if constexpr (I8) sr = sa[row];
#pragma unroll
                for (int bj = 0; bj < 2; ++bj) { f32x4 v0 = acc[ai][bj][m][0], v1 = acc[ai][bj][m][1];
                    if constexpr (I8) { const i32x4 i0 = __builtin_bit_cast(i32x4, v0), i1 = __builtin_bit_cast(i32x4, v1);
                        v0 = (f32x4){(float)i0[0], (float)i0[1], (float)i0[2], (float)i0[3]} * sb[bj][0] * sr; v1 = (f32x4){(float)i1[0], (float)i1[1], (float)i1[2], (float)i1[3]} * sb[bj][1] * sr; }
                    u32x4 w; w.x = pk_bf16(v0[0], v0[1]); w.y = pk_bf16(v0[2], v0[3]); w.z = pk_bf16(v1[0], v1[1]); w.w = pk_bf16(v1[2], v1[3]);
                    *(u32x4*)(rowp + bj * HALF) = w; } }
    }
};
template <bool I8> struct EpiResF32 {
    static constexpr bool PERM = false;
    const float* base; float* C; int ldc; const float* sa; const float* cm;
    DI void operator()(const f32x4 (&acc)[2][2][4][2], const Unit& u, int wr, int wc, int fr, int fq) const {
        const int row0 = u.pm * BM + wr * 64 + fr, col0 = u.pn * BM + wc * 32 + 4 * fq;
        f32x4 sb[2][2];
        if constexpr (I8) {
#pragma unroll
            for (int bj = 0; bj < 2; ++bj)
#pragma unroll
                for (int n = 0; n < 2; ++n) sb[bj][n] = *(const f32x4*)(cm + col0 + bj * HALF + n * 16) * (1.0f / 127.0f); }
#pragma unroll
        for (int ai = 0; ai < 2; ++ai)
#pragma unroll
            for (int m = 0; m < 4; ++m) { const int row = row0 + ai * HALF + m * 16; const size_t off = (size_t)row * ldc + col0; float sr = 1.f; if constexpr (I8) sr = sa[row];
#pragma unroll
                for (int bj = 0; bj < 2; ++bj)
#pragma unroll
                    for (int n = 0; n < 2; ++n) { f32x4 v = acc[ai][bj][m][n];
                        if constexpr (I8) { const i32x4 iv = __builtin_bit_cast(i32x4, v); v = (f32x4){(float)iv[0], (float)iv[1], (float)iv[2], (float)iv[3]} * sb[bj][n] * sr; }
                        const f32x4 bs = *(const f32x4*)(base + off + bj * HALF + n * 16); *(f32x4*)(C + off + bj * HALF + n * 16) = bs + v; } }
    }
};
struct EpiGlu {
    static constexpr bool PERM = true;
    unsigned char* O; int ldc; const float* bias;
    DI void operator()(const f32x4 (&acc)[2][2][4][2], const Unit& u, int wr, int wc, int fr, int fq) const {
        const int row0 = u.pm * BM + wr * 64 + fr, colg = u.pn * HALF + wc * 32 + 8 * fq;
        const float* bg = bias + (size_t)u.e * 4096 + colg;
        f32x4 bgl[2], bln[2];
#pragma unroll
        for (int n = 0; n < 2; ++n) { bgl[n] = *(const f32x4*)(bg + 4 * n); bln[n] = *(const f32x4*)(bg + 2048 + 4 * n); }
#pragma unroll
        for (int ai = 0; ai < 2; ++ai)
#pragma unroll
            for (int m = 0; m < 4; ++m) { unsigned char* rowp = O + (size_t)(row0 + ai * HALF + m * 16) * ldc + colg;
                float r[8];
#pragma unroll
                for (int n = 0; n < 2; ++n)
#pragma unroll
                    for (int j = 0; j < 4; ++j) { float g = acc[ai][0][m][n][j] + bgl[n][j], l = acc[ai][1][m][n][j] + bln[n][j];
                        g = fminf(g, 7.0f); l = fminf(fmaxf(l, -7.0f), 7.0f);
                        r[4 * n + j] = clamp_fp8(8.0f * (g * fast_sigmoid(1.702f * g) * (l + 1.0f))); }
                u32x2 w; w.x = pk4_fp8(r[0], r[1], r[2], r[3]); w.y = pk4_fp8(r[4], r[5], r[6], r[7]);
                *(u32x2*)rowp = w; }
    }
};
struct EpiBf16BiasE {
    static constexpr bool PERM = true;
    bf16_t* O; int ldc; const float* bias;
    DI void operator()(const f32x4 (&acc)[2][2][4][2], const Unit& u, int wr, int wc, int fr, int fq) const {
        const int row0 = u.pm * BM + wr * 64 + fr, col0 = u.pn * BM + wc * 32 + 8 * fq;
        const float* bp = bias + (size_t)u.e * 2048 + col0;
        f32x4 bv[2][2];
#pragma unroll
        for (int bj = 0; bj < 2; ++bj)
#pragma unroll
            for (int n = 0; n < 2; ++n) bv[bj][n] = *(const f32x4*)(bp + bj * HALF + 4 * n);
#pragma unroll
        for (int ai = 0; ai < 2; ++ai)
#pragma unroll
            for (int m = 0; m < 4; ++m) { bf16_t* rowp = O + (size_t)(row0 + ai * HALF + m * 16) * ldc + col0;
#pragma unroll
                for (int bj = 0; bj < 2; ++bj) { const f32x4 v0 = acc[ai][bj][m][0] + bv[bj][0], v1 = acc[ai][bj][m][1] + bv[bj][1];
                    u32x4 w; w.x = pk_bf16(v0[0], v0[1]); w.y = pk_bf16(v0[2], v0[3]); w.z = pk_bf16(v1[0], v1[1]); w.w = pk_bf16(v1[2], v1[3]);
                    *(u32x4*)(rowp + bj * HALF) = w; } }
    }
};
}
constexpr int NWAVES = 8;
constexpr int NTOK = 16384, DM = 2048, SEQ = 2048, NBATCH = 8;
constexpr int DIN = 12816, LDP = 13056;
constexpr int C_QA = 0, C_KA = 2048, C_VA = 2304, C_QB = 2560, C_KB = 3584, C_VB = 4608, C_RB = 6656, C_GA = 8704, C_GB = 10752, C_ALR = 12800;
constexpr int NEXP = 32, TOPK = 4, DFF = 2048;
constexpr int PMAX = 73728;
constexpr float EPS = 1e-5f;
constexpr float LOG2E = 1.4426950408889634f;
#ifndef MK_I8_P1
#define MK_I8_P1 1
#endif
#ifndef MK_I8_P5
#define MK_I8_P5 0
#endif
constexpr bool I8_P1 = MK_I8_P1 != 0, I8_P5 = MK_I8_P5 != 0;
constexpr bool I8_DENSE = I8_P1 || I8_P5;

constexpr size_t MiB = 1u << 20;
constexpr size_t WS_CTL = 0, CTL_ZERO_BYTES = 1 * MiB;
constexpr size_t WS_TOPE = 1 * MiB;
constexpr size_t WS_TOPS = WS_TOPE + (size_t)NTOK * 4 * 4;
constexpr size_t WS_GATE = WS_TOPS + (size_t)NTOK * 4 * 4;
constexpr size_t WS_TOKL = WS_GATE + (size_t)NTOK * 4 * 4;
constexpr size_t WS_WIN  = 4 * MiB;
constexpr size_t WS_WOUT = WS_WIN + (size_t)LDP * DM * 2;
constexpr size_t WS_WGU  = WS_WOUT + (size_t)DM * DM * 2;
constexpr size_t WS_WDN  = WS_WGU + (size_t)NEXP * 4096 * DM * 2;
constexpr size_t WS_H    = WS_WDN + (size_t)NEXP * DM * DM * 2;
constexpr size_t WS_PROJ = WS_H + (size_t)NTOK * DM * 2;
constexpr size_t WS_OA   = WS_PROJ + (size_t)NTOK * LDP * 2;
constexpr size_t WS_OB   = WS_OA + (size_t)NTOK * DM * 2;
constexpr size_t WS_MIX  = WS_OB + (size_t)NTOK * DM * 2;
constexpr size_t WS_X1   = WS_MIX + (size_t)NTOK * DM * 2;
constexpr size_t WS_GQT  = WS_X1 + (size_t)NTOK * DM * 4;
constexpr size_t WS_GKT  = WS_GQT + (size_t)1024 * 16384 * 2;
constexpr size_t WS_GATT = WS_GKT + (size_t)1024 * 16384 * 2;
constexpr size_t WS_GDEC = WS_GATT + (size_t)1024 * 4096 * 2;
constexpr size_t WS_GVT  = WS_GDEC + (size_t)1024 * 256 * 4;
constexpr size_t WS_ACT  = WS_GVT + (size_t)1024 * 32768 * 2;
constexpr size_t WS_Y    = WS_ACT + (size_t)PMAX * DFF * 2;
constexpr size_t WS_END  = WS_Y + (size_t)PMAX * DM * 2;
constexpr size_t WS_SAH  = WS_TOKL + (size_t)NEXP * NTOK * 4;
constexpr size_t WS_SAMIX = WS_SAH + (size_t)NTOK * 4;
static_assert(WS_SAMIX + (size_t)NTOK * 4 <= WS_WIN, "row scales below the weight copies");
static_assert(WS_WIN % 256 == 0 && WS_WOUT % 256 == 0 && WS_WGU % 256 == 0 && WS_WDN % 256 == 0 && WS_H % 256 == 0 && WS_PROJ % 256 == 0 && WS_OA % 256 == 0 && WS_X1 % 256 == 0 &&
              WS_GQT % 256 == 0 && WS_GKT % 256 == 0 && WS_GATT % 256 == 0 && WS_GDEC % 256 == 0 && WS_GVT % 256 == 0 && WS_ACT % 256 == 0 && WS_Y % 256 == 0, "alignment");
constexpr int CW_TMO = 0, CW_CODE = 1;
constexpr int CW_BAR = 4096;
constexpr int CW_CNT = 8192;
constexpr int CW_SWAQ = CW_CNT + 64 * 40;
constexpr int CW_CMAX_IN = 16384, CW_CMAX_OUT = CW_CMAX_IN + LDP;
static_assert((CW_CMAX_OUT + DM) * 4 <= (int)CTL_ZERO_BYTES, "CTL words inside the memset region");
constexpr int RING_OFF = 0, RING_BYTES = 131072;
constexpr int LDSCTL_OFF = RING_BYTES, MISC_OFF = LDSCTL_OFF + 320;
constexpr int TBL_OFF = LDSCTL_OFF + 1024;
constexpr int LDS_BYTES = 147456;
static_assert(MISC_OFF + 128 <= TBL_OFF && TBL_OFF + 4096 <= LDS_BYTES, "LDS map");

typedef GAS unsigned gu32;
#define RLX_AGENT __ATOMIC_RELAXED, __HIP_MEMORY_SCOPE_AGENT
#define LDS_WAIT() asm volatile("s_waitcnt lgkmcnt(0)" ::: "memory")
#define VM_WAIT() asm volatile("s_waitcnt vmcnt(0)" ::: "memory")

#define XB_TMO      128
#define XB_XCNT(j)  (256  + 64 * (j))
#define XB_XSUB(j)  (1280 + 64 * (j))
#define XB_XGEN(j)  (2304 + 64 * (j))
#define XB_TOP      3328
#define XB_TOPGEN   3392
#define XCD_BAR_WORDS 3456
#define XB_SPIN_CAP (1u << 18)

__device__ __forceinline__ unsigned xb_ld(unsigned* p)              { return __hip_atomic_load(p, __ATOMIC_RELAXED, __HIP_MEMORY_SCOPE_AGENT); }
__device__ __forceinline__ unsigned xb_add(unsigned* p, unsigned v) { return __hip_atomic_fetch_add(p, v, __ATOMIC_RELAXED, __HIP_MEMORY_SCOPE_AGENT); }
__device__ __forceinline__ unsigned xb_xcc_id() { return (unsigned)__builtin_amdgcn_s_getreg((3 << 11) | 20) & 0xFu; }
#define XB_SPIN(cond, bar) do { unsigned _sp = 0; while (cond) { __builtin_amdgcn_s_sleep(1); \
    if ((++_sp & 255u) == 0u) { if (xb_ld(&(bar)[XB_TMO])) break; if (_sp > XB_SPIN_CAP) { atomicAdd(&(bar)[XB_TMO], 1u); break; } } } } while (0)

struct XcdBarrier {
    unsigned* bar; unsigned x;
    volatile LAS unsigned* st;
};

__device__ __forceinline__ XcdBarrier xcd_barrier_post(unsigned* bar, volatile LAS unsigned* st) {
    XcdBarrier b; b.bar = bar; b.x = xb_xcc_id(); b.st = st;
    if (threadIdx.x == 0) (void)xb_add(&bar[XB_XCNT(b.x)], 1u);
    return b;
}
__device__ __forceinline__ void xcd_barrier_complete(unsigned* bar, unsigned x, unsigned& nloc, unsigned& nx) {
    const unsigned G = gridDim.x * gridDim.y * gridDim.z;
    unsigned sum, cnt, mine, sp = 0u;
    for (;;) {
        sum = 0u; cnt = 0u; mine = 0u;
#pragma unroll
        for (unsigned j = 0; j < 16; ++j) { const unsigned c = xb_ld(&bar[XB_XCNT(j)]); sum += c; cnt += (c > 0u) ? 1u : 0u; mine = (j == x) ? c : mine; }
        if (sum == G) break;
        __builtin_amdgcn_s_sleep(1);
        if ((++sp & 255u) == 0u) { if (xb_ld(&bar[XB_TMO])) break; if (sp > XB_SPIN_CAP) { atomicAdd(&bar[XB_TMO], 1u); break; } }
    }
    nloc = mine > 0u ? mine : 1u; nx = cnt > 0u ? cnt : 1u;
}

__device__ __forceinline__ void xcd_barrier(const XcdBarrier& b) {
    asm volatile("s_waitcnt vmcnt(0)" ::: "memory");
    __syncthreads();
    if (threadIdx.x == 0) {
        unsigned* bar = b.bar;
        __builtin_amdgcn_s_waitcnt(0);
        unsigned nloc = b.st[0], nx = b.st[1];
        if (nloc == 0u) { xcd_barrier_complete(bar, b.x, nloc, nx); b.st[0] = nloc; b.st[1] = nx; }
        const unsigned old = xb_add(&bar[XB_XSUB(b.x)], 1u);
        const unsigned gen = old / nloc;
        if (old + 1u == (gen + 1u) * nloc) {
            __builtin_amdgcn_fence(__ATOMIC_RELEASE, "agent");
            asm volatile("s_waitcnt vmcnt(0)" ::: "memory");
            const unsigned og = xb_add(&bar[XB_TOP], 1u);
            const unsigned tg = og / nx;
            if (og + 1u == (tg + 1u) * nx) xb_add(&bar[XB_TOPGEN], 1u);
            else XB_SPIN(xb_ld(&bar[XB_TOPGEN]) == tg, bar);
            __builtin_amdgcn_fence(__ATOMIC_ACQUIRE, "agent");
            xb_add(&bar[XB_XGEN(b.x)], 1u);
            asm volatile("s_waitcnt vmcnt(0)" ::: "memory");
        } else {
            XB_SPIN(xb_ld(&bar[XB_XGEN(b.x)]) == gen, bar);
            __builtin_amdgcn_fence(__ATOMIC_ACQUIRE, "agent");
            asm volatile("s_waitcnt vmcnt(0)" ::: "memory");
        }
    }
    __syncthreads();
}

struct Frame {
    LAS unsigned char* lds;
    gu32* ctl;
    int tid, lane, wave, vcu, G;
    const float *x, *attn_g, *w_in, *sinks, *w_alpha2, *b_alpha, *gla_g, *w_out, *ffn_g, *w_router, *b_router, *w_gu, *b_gu, *w_dn, *b_dn, *final_g;
    float* out;
    int *tope, *tops, *tokl; float* gate;
    float *sa_h, *sa_mix;
    bf16_t *Win, *Wout, *Wgu, *Wdn, *H, *PROJ, *OA, *OB, *MIX, *GQT, *GKT, *GATT, *GVT, *ACT, *Y;
    float *X1, *GDEC;
};
DI void p0_transpose_item(const float* Wsrc, int ldw, int srccol0, int nvalid, int k0, bf16_t* dst, int K, LAS float* scr, int lane) {
    const int krow = lane >> 3, n4 = lane & 7;
    const bool ok = 4 * n4 < nvalid;
#pragma unroll
    for (int i = 0; i < 8; ++i) { const int kk = 8 * i + krow; f32x4 v = (f32x4){0.f, 0.f, 0.f, 0.f};
        if (ok) v = *(const f32x4*)(Wsrc + (size_t)(k0 + kk) * ldw + srccol0 + 4 * n4);
        LAS float* d = scr + kk * 33 + 4 * n4; d[0] = v[0]; d[1] = v[1]; d[2] = v[2]; d[3] = v[3]; }
    LDS_WAIT(); asm volatile("" ::: "memory");
    const int c = lane & 7;
#pragma unroll
    for (int j = 0; j < 4; ++j) { const int n = (lane >> 3) + 8 * j; const LAS float* s = scr + (8 * c) * 33 + n;
        u32x4 o; o.x = pk_bf16(s[0 * 33], s[1 * 33]); o.y = pk_bf16(s[2 * 33], s[3 * 33]); o.z = pk_bf16(s[4 * 33], s[5 * 33]); o.w = pk_bf16(s[6 * 33], s[7 * 33]);
        *(u32x4*)(dst + (size_t)n * K + k0 + 8 * c) = o; }
    LDS_WAIT(); asm volatile("" ::: "memory");
}
DI void rms_row_to_bf16(const float* xrow, const float* g, bf16_t* orow, int lane) {
    const f32x4* xr = (const f32x4*)xrow + lane; const f32x4* gr = (const f32x4*)g + lane;
    f32x4 v[8]; float s = 0.f;
#pragma unroll
    for (int j = 0; j < 8; ++j) { v[j] = xr[64 * j]; s += (v[j].x * v[j].x + v[j].y * v[j].y) + (v[j].z * v[j].z + v[j].w * v[j].w); }
    const float r = 1.0f / sqrtf(wave_sum(s) * (1.f / DM) + EPS);
    u32x2* o8 = (u32x2*)orow + lane;
#pragma unroll
    for (int j = 0; j < 8; ++j) { const f32x4 gg = gr[64 * j]; u32x2 w; w.x = pk_bf16(v[j].x * r * gg.x, v[j].y * r * gg.y); w.y = pk_bf16(v[j].z * r * gg.z, v[j].w * r * gg.w); o8[64 * j] = w; }
}
DI void p0_transpose_item_f8(const float* Wsrc, int ldw, int srccol0, int nvalid, int k0, unsigned char* dst, int K, LAS float* scr, int lane) {
    const int krow = lane >> 3, n4 = lane & 7;
    const bool ok = 4 * n4 < nvalid;
#pragma unroll
    for (int i = 0; i < 8; ++i) { const int kk = 8 * i + krow; f32x4 v = (f32x4){0.f, 0.f, 0.f, 0.f};
        if (ok) v = *(const f32x4*)(Wsrc + (size_t)(k0 + kk) * ldw + srccol0 + 4 * n4);
        LAS float* d = scr + kk * 33 + 4 * n4; d[0] = v[0]; d[1] = v[1]; d[2] = v[2]; d[3] = v[3]; }
    LDS_WAIT(); asm volatile("" ::: "memory");
    const int c = lane & 7;
#pragma unroll
    for (int j = 0; j < 4; ++j) { const int n = (lane >> 3) + 8 * j; const LAS float* s = scr + (8 * c) * 33 + n;
        u32x2 o; o.x = pk4_fp8(64.f * s[0 * 33], 64.f * s[1 * 33], 64.f * s[2 * 33], 64.f * s[3 * 33]); o.y = pk4_fp8(64.f * s[4 * 33], 64.f * s[5 * 33], 64.f * s[6 * 33], 64.f * s[7 * 33]);
        *(u32x2*)(dst + (size_t)n * K + k0 + 8 * c) = o; }
    LDS_WAIT(); asm volatile("" ::: "memory");
}
DI void rms_row_to_f8(const float* xrow, const float* g, unsigned char* orow, int lane) {
    const f32x4* xr = (const f32x4*)xrow + lane; const f32x4* gr = (const f32x4*)g + lane;
    f32x4 v[8]; float s = 0.f;
#pragma unroll
    for (int j = 0; j < 8; ++j) { v[j] = xr[64 * j]; s += (v[j].x * v[j].x + v[j].y * v[j].y) + (v[j].z * v[j].z + v[j].w * v[j].w); }
    const float r = 8.0f / sqrtf(wave_sum(s) * (1.f / DM) + EPS);
    unsigned* o4 = (unsigned*)orow + lane;
#pragma unroll
    for (int j = 0; j < 8; ++j) { const f32x4 gg = gr[64 * j]; o4[64 * j] = pk4_fp8(clamp_fp8(v[j].x * r * gg.x), clamp_fp8(v[j].y * r * gg.y), clamp_fp8(v[j].z * r * gg.z), clamp_fp8(v[j].w * r * gg.w)); }
}
struct P0Item { const float* src; unsigned char* dst; int ldw, pitch, mode; bool ok, live; f32x4 inv; };
DI f32x4 p0_inv(const float* cmax) { const f32x4 c = *(const f32x4*)cmax; return (f32x4){127.f / fmaxf(c.x, 1e-30f), 127.f / fmaxf(c.y, 1e-30f), 127.f / fmaxf(c.z, 1e-30f), 127.f / fmaxf(c.w, 1e-30f)}; }
DI P0Item p0_decode(Frame& F, int it, int nitems, int lane) {
    constexpr int I_IN = 32 * 408, I_OUT = 32 * 64, I_GU = 32 * 32 * 128;
    const int kc = lane >> 3, n4 = lane & 7;
    P0Item d; d.live = it < nitems; d.ok = true; d.mode = GM_FP8; d.ldw = DM; d.pitch = DM; d.src = F.w_in; d.dst = (unsigned char*)F.Win; d.inv = (f32x4){0.f, 0.f, 0.f, 0.f};
    if (!d.live) { d.ok = false; return d; }
    int r = it;
    int dmode = I8_P1 ? GM_I8 : GM_BF16, esz = I8_P1 ? 1 : 2;
    if (r < I_IN) { const int kb = r / 408, nb = r % 408, n0 = 32 * nb; int sc = n0, nv = 32;
        if (n0 >= 8704 && n0 < 12800) sc = n0 + 16; else if (n0 == 12800) { sc = 8704; nv = 16; } else if (n0 > 12800) { sc = 0; nv = 0; }
        d.mode = dmode; d.ok = 4 * n4 < nv; d.ldw = DIN; d.src = F.w_in + (size_t)(64 * kb + 8 * kc) * DIN + sc + 4 * n4;
        if (I8_P1) d.inv = p0_inv((const float*)(F.ctl + CW_CMAX_IN) + n0 + 4 * n4);
        d.pitch = DM * esz; d.dst = (unsigned char*)F.Win + (size_t)(n0 + 4 * n4) * d.pitch + (64 * kb + 8 * kc) * esz; return d; }
    r -= I_IN; dmode = I8_P5 ? GM_I8 : GM_BF16; esz = I8_P5 ? 1 : 2;
    if (r < I_OUT) { const int kb = r / 64, nb = r % 64; d.mode = dmode; d.ldw = DM; d.src = F.w_out + (size_t)(64 * kb + 8 * kc) * DM + 32 * nb + 4 * n4;
        if (I8_P5) d.inv = p0_inv((const float*)(F.ctl + CW_CMAX_OUT) + 32 * nb + 4 * n4);
        d.pitch = DM * esz; d.dst = (unsigned char*)F.Wout + (size_t)(32 * nb + 4 * n4) * d.pitch + (64 * kb + 8 * kc) * esz; return d; }
    r -= I_OUT;
    if (r < I_GU) { const int e = r / 4096, rr = r % 4096, kb = rr / 128, nb = rr % 128, n0 = 32 * nb, pn = n0 >> 8, i0 = n0 & 255;
        const int sc = (i0 < 128) ? (128 * pn + i0) : (2048 + 128 * pn + i0 - 128);
        d.ldw = 4096; d.src = F.w_gu + (size_t)e * DM * 4096 + (size_t)(64 * kb + 8 * kc) * 4096 + sc + 4 * n4; d.pitch = DM;
        d.dst = (unsigned char*)F.Wgu + ((size_t)e * 4096 + n0 + 4 * n4) * DM + 64 * kb + 8 * kc; return d; }
    r -= I_GU;
    { const int e = r / 2048, rr = r % 2048, kb = rr / 64, nb = rr % 64;
        d.ldw = DM; d.src = F.w_dn + (size_t)e * DFF * DM + (size_t)(64 * kb + 8 * kc) * DM + 32 * nb + 4 * n4; d.pitch = DFF;
        d.dst = (unsigned char*)F.Wdn + ((size_t)e * DM + 32 * nb + 4 * n4) * DFF + 64 * kb + 8 * kc; return d; }
}
DI void p0_load(const P0Item& d, f32x4 (&v)[8]) {
#pragma unroll
    for (int j = 0; j < 8; ++j) { v[j] = (f32x4){0.f, 0.f, 0.f, 0.f}; if (d.ok) v[j] = __builtin_nontemporal_load((const f32x4*)(d.src + (size_t)j * d.ldw)); }
}
DI void p0_store(const P0Item& d, const f32x4 (&v)[8]) {
    if (!d.live) return;
    if (d.mode == GM_FP8) {
#pragma unroll
        for (int q = 0; q < 4; ++q) { u32x2 o; o.x = pk4_fp8(64.f * v[0][q], 64.f * v[1][q], 64.f * v[2][q], 64.f * v[3][q]); o.y = pk4_fp8(64.f * v[4][q], 64.f * v[5][q], 64.f * v[6][q], 64.f * v[7][q]);
            *(u32x2*)(d.dst + (size_t)q * d.pitch) = o; }
    } else if (d.mode == GM_I8) {
#pragma unroll
        for (int q = 0; q < 4; ++q) { const float s = d.inv[q]; u32x2 o; o.x = pk4_i8(s * v[0][q], s * v[1][q], s * v[2][q], s * v[3][q]); o.y = pk4_i8(s * v[4][q], s * v[5][q], s * v[6][q], s * v[7][q]);
            *(u32x2*)(d.dst + (size_t)q * d.pitch) = o; }
    } else {
#pragma unroll
        for (int q = 0; q < 4; ++q) { u32x4 o; o.x = pk_bf16(v[0][q], v[1][q]); o.y = pk_bf16(v[2][q], v[3][q]); o.z = pk_bf16(v[4][q], v[5][q]); o.w = pk_bf16(v[6][q], v[7][q]);
            *(u32x4*)(d.dst + (size_t)q * d.pitch) = o; }
    }
}
DI void rms_row_to_i8(const float* xrow, const float* g, unsigned char* orow, float* sa, int lane) {
    const f32x4* xr = (const f32x4*)xrow + lane; const f32x4* gr = (const f32x4*)g + lane;
    f32x4 v[8]; float s = 0.f;
#pragma unroll
    for (int j = 0; j < 8; ++j) { v[j] = xr[64 * j]; s += (v[j].x * v[j].x + v[j].y * v[j].y) + (v[j].z * v[j].z + v[j].w * v[j].w); }
    const float r = 1.0f / sqrtf(wave_sum(s) * (1.f / DM) + EPS);
    float am = 0.f;
#pragma unroll
    for (int j = 0; j < 8; ++j) { const f32x4 gg = gr[64 * j]; v[j] = v[j] * gg * r; am = fmaxf(am, fmaxf(fmaxf(fabsf(v[j].x), fabsf(v[j].y)), fmaxf(fabsf(v[j].z), fabsf(v[j].w)))); }
    am = fmaxf(wave_max(am), 1e-30f);
    const float inv = 127.f / am;
    if (lane == 0) *sa = am * (1.f / 127.f);
    unsigned* o4 = (unsigned*)orow + lane;
#pragma unroll
    for (int j = 0; j < 8; ++j) o4[64 * j] = pk4_i8(v[j].x * inv, v[j].y * inv, v[j].z * inv, v[j].w * inv);
}
DI void colmax_phase(Frame& F) {
    if (!I8_DENSE) return;
    const int gw = F.vcu * NWAVES + F.wave, NGW = F.G * NWAVES, lane = F.lane, kc = lane >> 4, n4 = lane & 15;
    constexpr int NB_IN = (DIN + 63) / 64, I_IN = 32 * NB_IN, I_OUT = 32 * 32;
    for (int it = gw; it < I_IN + I_OUT; it += NGW) {
        const bool in = it < I_IN; const int r = in ? it : it - I_IN, nbs = in ? NB_IN : 32, kb = r / nbs, nb = r % nbs, ldw = in ? DIN : DM, c0 = 64 * nb + 4 * n4;
        const bool ok = c0 < ldw;
        const float* src = (in ? F.w_in : F.w_out) + (size_t)(64 * kb + kc) * ldw + c0;
        f32x4 m = (f32x4){0.f, 0.f, 0.f, 0.f};
        if (ok) {
#pragma unroll
            for (int j = 0; j < 16; ++j) { const f32x4 v = *(const f32x4*)(src + (size_t)(4 * j) * ldw); m.x = fmaxf(m.x, fabsf(v.x)); m.y = fmaxf(m.y, fabsf(v.y)); m.z = fmaxf(m.z, fabsf(v.z)); m.w = fmaxf(m.w, fabsf(v.w)); } }
#pragma unroll
        for (int q = 0; q < 4; ++q) { m[q] = fmaxf(m[q], __shfl_xor(m[q], 16)); m[q] = fmaxf(m[q], __shfl_xor(m[q], 32)); }
        if (ok && kc == 0) { int n = c0; if (in) { if (c0 >= 8720) n = c0 - 16; else if (c0 >= 8704) n = 12800 + c0 - 8704; }
            unsigned* dst = (unsigned*)(F.ctl + (in ? CW_CMAX_IN : CW_CMAX_OUT)) + n;
#pragma unroll
            for (int q = 0; q < 4; ++q) __hip_atomic_fetch_max(dst + q, __float_as_uint(m[q]), __ATOMIC_RELAXED, __HIP_MEMORY_SCOPE_AGENT); }
    }
}
DI void p0_prologue(Frame& F) {
    const int gw = F.vcu * NWAVES + F.wave, NGW = F.G * NWAVES;
    constexpr int NITEMS = 32 * 408 + 32 * 64 + 32 * 32 * 128 + 32 * 32 * 64;
    f32x4 va[8], vb[8];
    P0Item da = p0_decode(F, gw, NITEMS, F.lane), db;
    p0_load(da, va);
    for (int it = gw; it < NITEMS; it += 2 * NGW) {
        db = p0_decode(F, it + NGW, NITEMS, F.lane); p0_load(db, vb);
        p0_store(da, va);
        da = p0_decode(F, it + 2 * NGW, NITEMS, F.lane); p0_load(da, va);
        p0_store(db, vb);
    }
    for (int m = gw; m < NTOK; m += NGW) { if (I8_P1) rms_row_to_i8(F.x + (size_t)m * DM, F.attn_g, (unsigned char*)F.H + (size_t)m * DM, F.sa_h + m, F.lane); else rms_row_to_bf16(F.x + (size_t)m * DM, F.attn_g, F.H + (size_t)m * DM, F.lane); }
}

DI s16x4 tr_read(const LAS unsigned char* p) { return __builtin_bit_cast(s16x4, __builtin_amdgcn_ds_read_tr16_b64_v4i16((LAS s16x4*)p)); }
DI bf16x8 pack8(const f32x16& x, int s) {
    u32x4 p; p.x = pk_bf16(x[8 * s + 0], x[8 * s + 1]); p.y = pk_bf16(x[8 * s + 2], x[8 * s + 3]); p.z = pk_bf16(x[8 * s + 4], x[8 * s + 5]); p.w = pk_bf16(x[8 * s + 6], x[8 * s + 7]);
    return __builtin_bit_cast(bf16x8, p);
}
DI bf16x8 pack8_pinned(const f32x16& x, int s) {
    u32x4 p;
    asm volatile("v_cvt_pk_bf16_f32 %0, %4, %5\n\tv_cvt_pk_bf16_f32 %1, %6, %7\n\tv_cvt_pk_bf16_f32 %2, %8, %9\n\tv_cvt_pk_bf16_f32 %3, %10, %11\n\ts_nop 1"
                 : "=&v"(p[0]), "=&v"(p[1]), "=&v"(p[2]), "=&v"(p[3])
                 : "v"(x[8 * s]), "v"(x[8 * s + 1]), "v"(x[8 * s + 2]), "v"(x[8 * s + 3]), "v"(x[8 * s + 4]), "v"(x[8 * s + 5]), "v"(x[8 * s + 6]), "v"(x[8 * s + 7]));
    return __builtin_bit_cast(bf16x8, p);
}
DI void swa_phase(Frame& F) {
    LAS unsigned char* Ks = F.lds;
    LAS unsigned char* Vs = F.lds + 36864;
    const int lane = F.lane, w = F.wave, c31 = lane & 31, h = lane >> 5;
    const int i16 = lane & 15, q4 = i16 >> 2, p4 = i16 & 3, blk = (lane >> 4) & 1;
    volatile LAS unsigned* qslot = (volatile LAS unsigned*)(F.lds + MISC_OFF) + 16;
    for (;;) {
        if (F.tid == 0) qslot[0] = __hip_atomic_fetch_add((unsigned*)(F.ctl + CW_SWAQ), 1u, __ATOMIC_RELAXED, __HIP_MEMORY_SCOPE_AGENT);
        __syncthreads();
        const int u = (int)qslot[0];
        if (u >= 512) break;
        const int kh = u & 3, qb = (u >> 2) & 15, b = u >> 6;
        const size_t tokbase = (size_t)b * SEQ;
        const int pos0 = qb * 128 - 128;
#pragma unroll
        for (int i = 0; i < 4; ++i) { const int id = F.tid + 512 * i, row = id >> 3, ch = id & 7, pos = pos0 + row;
            u32x4 kv = (u32x4){0u, 0u, 0u, 0u}, vv = (u32x4){0u, 0u, 0u, 0u};
            if (pos >= 0) { const bf16_t* src = F.PROJ + (tokbase + pos) * LDP + C_KA + kh * 64 + ch * 8; kv = *(const u32x4*)src; vv = *(const u32x4*)(src + (C_VA - C_KA)); }
            *(LAS u32x4*)(Ks + row * 144 + ch * 16) = kv; *(LAS u32x4*)(Vs + row * 144 + ch * 16) = vv; }
        __syncthreads();
        const int head = kh * 8 + w;
        const float slope2 = __builtin_amdgcn_exp2f(-0.25f * (float)(head + 1)) * LOG2E;
        const float sink2 = F.sinks[head] * LOG2E;
        for (int qt = 0; qt < 4; ++qt) {
            const size_t qrow = tokbase + qb * 128 + qt * 32 + c31;
            bf16x8 bq[4];
#pragma unroll
            for (int ks = 0; ks < 4; ++ks) bq[ks] = *(const bf16x8*)(F.PROJ + qrow * LDP + C_QA + head * 64 + ks * 16 + h * 8);
            f32x16 S[5];
#pragma unroll
            for (int kt = 0; kt < 5; ++kt) { f32x16 acc;
#pragma unroll
                for (int i = 0; i < 16; ++i) acc[i] = 0.f;
#pragma unroll
                for (int ks = 0; ks < 4; ++ks) { const bf16x8 a = *(const LAS bf16x8*)(Ks + (32 * (qt + kt) + c31) * 144 + (ks * 16 + h * 8) * 2); acc = MFMA32(a, bq[ks], acc); }
                S[kt] = acc; }
            float mx = sink2;
#pragma unroll
            for (int kt = 0; kt < 5; ++kt)
#pragma unroll
                for (int i = 0; i < 16; ++i) { const int key = 32 * (qt + kt) + crow(i, h); const int dist = 32 * qt + c31 + 128 - key;
                    const bool valid = (dist >= 0) && (dist < 128) && (pos0 + key >= 0);
                    const float s = valid ? (S[kt][i] * (0.125f * LOG2E) - slope2 * (float)dist) : -INFINITY;
                    S[kt][i] = s; mx = fmaxf(mx, s); }
            mx = fmaxf(mx, __shfl_xor(mx, 32));
            float sum = 0.f;
#pragma unroll
            for (int kt = 0; kt < 5; ++kt)
#pragma unroll
                for (int i = 0; i < 16; ++i) { const float p = __builtin_amdgcn_exp2f(S[kt][i] - mx); S[kt][i] = p; sum += p; }
            sum += __shfl_xor(sum, 32); sum += __builtin_amdgcn_exp2f(sink2 - mx);
            const float inv = 1.0f / sum;
            f32x16 O[2];
#pragma unroll
            for (int dt = 0; dt < 2; ++dt)
#pragma unroll
                for (int i = 0; i < 16; ++i) O[dt][i] = 0.f;
#pragma unroll
            for (int kt = 0; kt < 5; ++kt)
#pragma unroll
                for (int s = 0; s < 2; ++s) { const bf16x8 bp = pack8(S[kt], s);
                    const int kb = 32 * (qt + kt) + 16 * s + 4 * h + q4;
#pragma unroll
                    for (int dt = 0; dt < 2; ++dt) { const LAS unsigned char* vp = Vs + kb * 144 + (32 * dt + 16 * blk + 4 * p4) * 2;
                        const s16x4 lo = tr_read(vp), hi = tr_read(vp + 8 * 144);
                        const bf16x8 a = __builtin_shufflevector(lo, hi, 0, 1, 2, 3, 4, 5, 6, 7);
                        O[dt] = MFMA32(a, bp, O[dt]); } }
            bf16_t* orow = F.OA + qrow * DM + head * 64 + 4 * h;
#pragma unroll
            for (int dt = 0; dt < 2; ++dt)
#pragma unroll
                for (int g4 = 0; g4 < 4; ++g4) { u32x2 wv; wv.x = pk_bf16(O[dt][4 * g4] * inv, O[dt][4 * g4 + 1] * inv); wv.y = pk_bf16(O[dt][4 * g4 + 2] * inv, O[dt][4 * g4 + 3] * inv);
                    *(u32x2*)(orow + 32 * dt + 8 * g4) = wv; }
        }
        __syncthreads();
    }
}

DI void gla_prep_phase(Frame& F) {
    LAS unsigned char* Qs = F.lds;
    LAS unsigned char* Kss = F.lds + 33792;
    LAS float* alr = (LAS float*)(F.lds + 67584);
    LAS float* tot = (LAS float*)(F.lds + 71680);
    LAS unsigned char* Vr = F.lds;
    const int tid = F.tid, lane = F.lane, w = F.wave, c31 = lane & 31, h = lane >> 5;
    for (int u = F.vcu; u < 1024; u += F.G) {
        const int hh = (u >> 5) & 3, b = u >> 7, c = u & 31;
        const size_t T0 = (size_t)b * SEQ + c * 64;
#pragma unroll
        for (int j = 0; j < 4; ++j) { const int id = tid + 512 * j, row = id >> 5, ch = id & 31; const bf16_t* src = F.PROJ + (T0 + row) * LDP + C_QB + hh * 256 + ch * 8;
            *(LAS u32x4*)(Qs + row * 528 + ch * 16) = *(const u32x4*)src; *(LAS u32x4*)(Kss + row * 528 + ch * 16) = *(const u32x4*)(src + (C_KB - C_QB)); }
        u32x4 vreg[8];
#pragma unroll
        for (int j = 0; j < 8; ++j) { const int id = tid + 512 * j, row = id >> 6, ch = id & 63; vreg[j] = *(const u32x4*)(F.PROJ + (T0 + row) * LDP + C_VB + hh * 512 + ch * 8); }
        if (tid < 128) { const int t = tid >> 1, hf = tid & 1; const u32x4 raw = *(const u32x4*)(F.PROJ + (T0 + t) * LDP + C_ALR + 8 * hf);
            LAS float* d = alr + t * 16 + 8 * hf;
            d[0] = bf_lo(raw.x); d[1] = bf_hi(raw.x); d[2] = bf_lo(raw.y); d[3] = bf_hi(raw.y); d[4] = bf_lo(raw.z); d[5] = bf_hi(raw.z); d[6] = bf_lo(raw.w); d[7] = bf_hi(raw.w); }
        __syncthreads();
        const int d = tid & 255, hf = tid >> 8;
        float w2[16];
#pragma unroll
        for (int r = 0; r < 16; ++r) w2[r] = F.w_alpha2[r * 1024 + hh * 256 + d];
        const float ba = F.b_alpha[hh * 256 + d];
        float bc[32]; float run = 0.f;
#pragma unroll
        for (int i = 0; i < 32; ++i) { const LAS f32x4* ar = (const LAS f32x4*)(alr + (32 * hf + i) * 16); float z = ba;
#pragma unroll
            for (int r4 = 0; r4 < 4; ++r4) { const f32x4 a = ar[r4]; z += a.x * w2[4 * r4] + a.y * w2[4 * r4 + 1] + a.z * w2[4 * r4 + 2] + a.w * w2[4 * r4 + 3]; }
            const float la = (fminf(z, 0.f) - __logf(1.0f + fast_exp(-fabsf(z)))) * (1.0f / 16.0f);
            run += la; bc[i] = run; }
        tot[hf * 256 + d] = run;
        __syncthreads();
        const float t0 = tot[d], t1 = tot[256 + d], blast = t0 + t1;
        if (hf) {
#pragma unroll
            for (int i = 0; i < 32; ++i) bc[i] += t0;
        } else F.GDEC[(size_t)u * 256 + d] = fast_exp(blast);
        unsigned kpk[16];
#pragma unroll
        for (int i2 = 0; i2 < 16; ++i2) { float kh2[2];
#pragma unroll
            for (int j = 0; j < 2; ++j) { const int i = 2 * i2 + j; LAS bf16_t* qp = (LAS bf16_t*)(Qs + (32 * hf + i) * 528 + d * 2); LAS bf16_t* kp = (LAS bf16_t*)(Kss + (32 * hf + i) * 528 + d * 2);
                const float q = bf2f(*qp), k = bf2f(*kp);
                const float e = fast_exp(bc[i]);
                *qp = f2bf(q * e * 0.0625f);
                *kp = f2bf(k * fast_exp(-bc[i]));
                kh2[j] = k * fast_exp(blast - bc[i]); }
            kpk[i2] = pk_bf16(kh2[0], kh2[1]); }
        { u32x4* dst = (u32x4*)(F.GKT + (size_t)u * 16384 + d * 64 + 32 * hf);
#pragma unroll
            for (int j = 0; j < 4; ++j) dst[j] = (u32x4){kpk[4 * j], kpk[4 * j + 1], kpk[4 * j + 2], kpk[4 * j + 3]}; }
        __syncthreads();
        if (w < 4) { const int m = w >> 1, n = w & 1; f32x16 acc;
#pragma unroll
            for (int i = 0; i < 16; ++i) acc[i] = 0.f;
#pragma unroll
            for (int ks = 0; ks < 16; ++ks) { const bf16x8 a = *(const LAS bf16x8*)(Qs + (32 * m + c31) * 528 + (16 * ks + 8 * h) * 2), bb = *(const LAS bf16x8*)(Kss + (32 * n + c31) * 528 + (16 * ks + 8 * h) * 2);
                acc = MFMA32(a, bb, acc); }
            bf16_t* ao = F.GATT + (size_t)u * 4096;
#pragma unroll
            for (int i = 0; i < 16; ++i) { const int t = 32 * m + crow(i, h), s = 32 * n + c31; ao[t * 64 + s] = f2bf(s <= t ? acc[i] : 0.f); }
        } else { const int t2 = tid - 256;
#pragma unroll
            for (int j = 0; j < 8; ++j) { const int id = t2 + 256 * j, row = id >> 5, ch = id & 31; *(u32x4*)(F.GQT + (size_t)u * 16384 + row * 256 + ch * 8) = *(const LAS u32x4*)(Qs + row * 528 + ch * 16); } }
        __syncthreads();
#pragma unroll
        for (int j = 0; j < 8; ++j) { const int id = tid + 512 * j, row = id >> 6, ch = id & 63; *(LAS u32x4*)(Vr + row * 1040 + ch * 16) = vreg[j]; }
        __syncthreads();
        { u32x4* dst = (u32x4*)(F.GVT + (size_t)u * 32768 + tid * 64);
#pragma unroll
            for (int t8 = 0; t8 < 8; ++t8) { unsigned short v[8];
#pragma unroll
                for (int j = 0; j < 8; ++j) v[j] = *(const LAS bf16_t*)(Vr + (8 * t8 + j) * 1040 + tid * 2);
                dst[t8] = (u32x4){(unsigned)v[0] | ((unsigned)v[1] << 16), (unsigned)v[2] | ((unsigned)v[3] << 16), (unsigned)v[4] | ((unsigned)v[5] << 16), (unsigned)v[6] | ((unsigned)v[7] << 16)}; } }
        __syncthreads();
    }
}

DI void gla_scan_phase(Frame& F) {
    LAS unsigned char* L = F.lds;
    const int lane = F.lane, w = F.wave, c31 = lane & 31, h = lane >> 5;
    const int u = F.vcu, hf = u & 1, hh = (u >> 1) & 3, b = u >> 3;
    f32x16 S[8];
#pragma unroll
    for (int i = 0; i < 8; ++i)
#pragma unroll
        for (int j = 0; j < 16; ++j) S[i][j] = 0.f;
    const size_t item0 = (size_t)(b * 4 + hh) * 32;
    const int vr0 = hf * 256 + 32 * w;
    unsigned tidv = (unsigned)F.tid;
    unsigned qrb = (unsigned)(c31 * 528 + 8 * h), krb = (unsigned)(c31 * 144 + 16 * h);
    u32x4 rq[4], rk[4], ra; f32x4 rd; u32x4 bvn[4];
#define BV(ks) (*(const LAS bf16x8*)(L + 80896 + w * 4608 + krb + 32 * (ks)))
#define SCAN_LOAD_A(item) do { const char* q0 = (const char*)(F.GQT + (item) * 16384); const char* k0 = (const char*)(F.GKT + (item) * 16384); asm volatile("" : "+v"(tidv)); const unsigned tb = tidv * 16u; \
        _Pragma("unroll") for (int j = 0; j < 4; ++j) { rq[j] = *(const u32x4*)(q0 + j * 8192 + tb); rk[j] = *(const u32x4*)(k0 + j * 8192 + tb); } } while (0)
#define SCAN_LOAD_B(item) do { const char* v0 = (const char*)(F.GVT + (item) * 32768 + (size_t)vr0 * 64); asm volatile("" : "+v"(tidv)); const unsigned tb = tidv * 16u, db = (tidv & 63u) * 16u, vb = (tidv & 31u) * 128u + ((tidv >> 5) & 1u) * 16u; \
        ra = *(const u32x4*)((const char*)(F.GATT + (item) * 4096) + tb); \
        rd = *(const f32x4*)((const char*)(F.GDEC + (item) * 256) + db); \
        _Pragma("unroll") for (int ks = 0; ks < 4; ++ks) bvn[ks] = *(const u32x4*)(v0 + 32 * ks + vb); } while (0)
#define SCAN_WRITE() do { asm volatile("" : "+v"(tidv)); const unsigned qwo = (tidv >> 5) * 528u + (tidv & 31u) * 16u, kwo = (tidv >> 3) * 144u + (tidv & 7u) * 16u; \
        _Pragma("unroll") for (int j = 0; j < 4; ++j) { *(LAS u32x4*)(L + qwo + j * 16 * 528) = rq[j]; *(LAS u32x4*)(L + 33792 + kwo + j * 64 * 144) = rk[j]; } \
        *(LAS u32x4*)(L + 70656 + kwo) = ra; \
        if (tidv < 64u) *(LAS f32x4*)(L + 79872 + tidv * 16u) = rd; \
        _Pragma("unroll") for (int ks = 0; ks < 4; ++ks) *(LAS u32x4*)(L + 80896 + w * 4608 + krb + 32 * ks) = bvn[ks]; } while (0)
    SCAN_LOAD_A(item0); SCAN_LOAD_B(item0);
    SCAN_WRITE();
    __syncthreads();
    for (int c = 0; c < 32; ++c) {
        const size_t nitem = item0 + (c < 31 ? c + 1 : c);
        SCAN_LOAD_A(nitem);
        asm volatile("" : "+v"(qrb), "+v"(krb));
#pragma unroll 1
        for (int m = 0; m < 2; ++m) { f32x16 o;
#pragma unroll
            for (int j = 0; j < 16; ++j) o[j] = 0.f;
#pragma unroll
            for (int i = 0; i < 8; ++i)
#pragma unroll
                for (int s = 0; s < 2; ++s) { const bf16x8 bs = pack8_pinned(S[i], s);
                    const LAS unsigned char* ap = L + qrb + (32 * m) * 528 + (32 * i + 16 * s) * 2;
                    const s16x4 lo = *(const LAS s16x4*)ap, hi = *(const LAS s16x4*)(ap + 16);
                    const bf16x8 a = __builtin_shufflevector(lo, hi, 0, 1, 2, 3, 4, 5, 6, 7);
                    o = MFMA32(a, bs, o); }
#pragma unroll
            for (int ks = 0; ks < 4; ++ks) { const bf16x8 a = *(const LAS bf16x8*)(L + 70656 + krb + (32 * m) * 144 + 32 * ks); o = MFMA32(a, BV(ks), o); }
            { asm volatile("" : "+v"(tidv)); const unsigned ovb = ((tidv >> 5) & 1u) * (4u * DM * 2u) + (tidv & 31u) * 2u;
                char* ob = (char*)(F.OB + ((size_t)b * SEQ + c * 64 + 32 * m) * DM + hh * 512 + vr0);
#pragma unroll
                for (int j = 0; j < 16; ++j) *(bf16_t*)(ob + ((j & 3) + 8 * (j >> 2)) * (DM * 2) + ovb) = f2bf(o[j]); } }
        asm volatile("" ::: "memory");
        SCAN_LOAD_B(nitem);
#pragma unroll
        for (int i = 0; i < 8; ++i) {
#pragma unroll
            for (int g4 = 0; g4 < 4; ++g4) { const f32x4 dc = *(const LAS f32x4*)(L + 79872 + (32 * i + 8 * g4) * 4 + (((tidv >> 5) & 1u) * 16u));
                S[i][4 * g4] *= dc.x; S[i][4 * g4 + 1] *= dc.y; S[i][4 * g4 + 2] *= dc.z; S[i][4 * g4 + 3] *= dc.w; }
#pragma unroll
            for (int ks = 0; ks < 4; ++ks) { const bf16x8 a = *(const LAS bf16x8*)(L + 33792 + krb + (32 * i) * 144 + 32 * ks); S[i] = MFMA32(a, BV(ks), S[i]); } }
        __syncthreads();
        SCAN_WRITE();
        __syncthreads();
    }
#undef SCAN_LOAD_A
#undef SCAN_LOAD_B
#undef SCAN_WRITE
#undef BV
}

DI void merge_phase(Frame& F) {
    const int gw = F.vcu * NWAVES + F.wave, NGW = F.G * NWAVES, lane = F.lane;
    for (int m = gw; m < NTOK; m += NGW) {
        const bf16_t* pr = F.PROJ + (size_t)m * LDP;
        float rr[4][8]; float am = 0.f;
#pragma unroll
        for (int j = 0; j < 4; ++j) { const int c0 = j * 512 + lane * 8;
            const u32x4 ob = *(const u32x4*)(F.OB + (size_t)m * DM + c0), oa = *(const u32x4*)(F.OA + (size_t)m * DM + c0);
            const u32x4 rb = *(const u32x4*)(pr + C_RB + c0), ga = *(const u32x4*)(pr + C_GA + c0), gb = *(const u32x4*)(pr + C_GB + c0);
            const f32x4 g0 = *(const f32x4*)(F.gla_g + lane * 8), g1 = *(const f32x4*)(F.gla_g + lane * 8 + 4);
            float vb[8] = {bf_lo(ob.x), bf_hi(ob.x), bf_lo(ob.y), bf_hi(ob.y), bf_lo(ob.z), bf_hi(ob.z), bf_lo(ob.w), bf_hi(ob.w)};
            const float va[8] = {bf_lo(oa.x), bf_hi(oa.x), bf_lo(oa.y), bf_hi(oa.y), bf_lo(oa.z), bf_hi(oa.z), bf_lo(oa.w), bf_hi(oa.w)};
            const float vr[8] = {bf_lo(rb.x), bf_hi(rb.x), bf_lo(rb.y), bf_hi(rb.y), bf_lo(rb.z), bf_hi(rb.z), bf_lo(rb.w), bf_hi(rb.w)};
            const float vga[8] = {bf_lo(ga.x), bf_hi(ga.x), bf_lo(ga.y), bf_hi(ga.y), bf_lo(ga.z), bf_hi(ga.z), bf_lo(ga.w), bf_hi(ga.w)};
            const float vgb[8] = {bf_lo(gb.x), bf_hi(gb.x), bf_lo(gb.y), bf_hi(gb.y), bf_lo(gb.z), bf_hi(gb.z), bf_lo(gb.w), bf_hi(gb.w)};
            const float gn[8] = {g0.x, g0.y, g0.z, g0.w, g1.x, g1.y, g1.z, g1.w};
            float ss = 0.f;
#pragma unroll
            for (int k = 0; k < 8; ++k) ss += vb[k] * vb[k];
            const float rn = 1.0f / sqrtf(wave_sum(ss) * (1.f / 512.f) + EPS);
#pragma unroll
            for (int k = 0; k < 8; ++k) { const float obn = vb[k] * rn * gn[k]; const float sl = vr[k] * fast_sigmoid(vr[k]);
                rr[j][k] = fast_sigmoid(vga[k]) * va[k] + fast_sigmoid(vgb[k]) * obn * sl; am = fmaxf(am, fabsf(rr[j][k])); }
            if (!I8_P5) *(u32x4*)(F.MIX + (size_t)m * DM + c0) = (u32x4){pk_bf16(rr[j][0], rr[j][1]), pk_bf16(rr[j][2], rr[j][3]), pk_bf16(rr[j][4], rr[j][5]), pk_bf16(rr[j][6], rr[j][7])}; }
        if (I8_P5) { am = fmaxf(wave_max(am), 1e-30f); const float inv = 127.f / am; if (lane == 0) F.sa_mix[m] = am * (1.f / 127.f);
#pragma unroll
            for (int j = 0; j < 4; ++j) { u32x2 wv; wv.x = pk4_i8(rr[j][0] * inv, rr[j][1] * inv, rr[j][2] * inv, rr[j][3] * inv); wv.y = pk4_i8(rr[j][4] * inv, rr[j][5] * inv, rr[j][6] * inv, rr[j][7] * inv);
                *(u32x2*)((unsigned char*)F.MIX + (size_t)m * DM + j * 512 + lane * 8) = wv; }
        }
    }
}

DI void router_phase(Frame& F) {
    LAS float* part = (LAS float*)F.lds;
    LAS float* ssp = (LAS float*)(F.lds + 34816);
    LAS float* rt = (LAS float*)(F.lds + 36864);
    LAS float* lg = (LAS float*)(F.lds + 37888);
    const int tid = F.tid, lane = F.lane, w = F.wave, c31 = lane & 31, h = lane >> 5;
    for (int tile = F.vcu; tile < NTOK / 32; tile += F.G) {
        const int t0 = tile * 32, kw = 256 * w;
        { const float* xr = F.X1 + (size_t)(t0 + c31) * DM + kw + 4 * h; const float* gp = F.ffn_g + kw + 4 * h; const float* wp = F.w_router + (size_t)(kw + 4 * h) * 32 + c31;
            f32x16 acc;
#pragma unroll
            for (int i = 0; i < 16; ++i) acc[i] = 0.f;
            float ss = 0.f;
#pragma unroll 4
            for (int m = 0; m < 32; ++m) { const f32x4 a = *(const f32x4*)(xr + 8 * m); const f32x4 g4 = *(const f32x4*)(gp + 8 * m); const float* wr_ = wp + (size_t)m * 256;
                const float b0 = g4.x * wr_[0], b1 = g4.y * wr_[32], b2 = g4.z * wr_[64], b3 = g4.w * wr_[96];
                ss += (a.x * a.x + a.y * a.y) + (a.z * a.z + a.w * a.w);
                acc = __builtin_amdgcn_mfma_f32_32x32x2f32(a.x, b0, acc, 0, 0, 0); acc = __builtin_amdgcn_mfma_f32_32x32x2f32(a.y, b1, acc, 0, 0, 0);
                acc = __builtin_amdgcn_mfma_f32_32x32x2f32(a.z, b2, acc, 0, 0, 0); acc = __builtin_amdgcn_mfma_f32_32x32x2f32(a.w, b3, acc, 0, 0, 0); }
            ss += __shfl_xor(ss, 32);
#pragma unroll
            for (int i = 0; i < 16; ++i) part[(w * 32 + crow(i, h)) * 33 + c31] = acc[i];
            if (h == 0) ssp[w * 32 + c31] = ss; }
        __syncthreads();
        { const int tok = tid >> 4, e0 = tid & 15; float s0 = 0.f, s1 = 0.f, sst = 0.f;
#pragma unroll
            for (int w2 = 0; w2 < 8; ++w2) { s0 += part[(w2 * 32 + tok) * 33 + e0]; s1 += part[(w2 * 32 + tok) * 33 + e0 + 16]; sst += ssp[w2 * 32 + tok]; }
            const float r = 1.0f / sqrtf(sst * (1.f / DM) + EPS);
            lg[tok * 33 + e0] = s0 * r + F.b_router[e0]; lg[tok * 33 + e0 + 16] = s1 * r + F.b_router[e0 + 16]; if (e0 == 0) rt[tok] = r; }
        __syncthreads();
#pragma unroll
        for (int it = 0; it < 2; ++it) { const int tok = 4 * w + 2 * it + h; const int m = t0 + tok;
            float v = lg[tok * 33 + c31]; float tv[4]; int ti[4];
#pragma unroll
            for (int k = 0; k < 4; ++k) { float bv = v; int bi = c31;
#pragma unroll
                for (int o = 1; o < 32; o <<= 1) { const float ov = __shfl_xor(bv, o); const int oi = __shfl_xor(bi, o); const bool take = (ov > bv) || (ov == bv && oi < bi); bv = take ? ov : bv; bi = take ? oi : bi; }
                tv[k] = bv; ti[k] = bi; v = (c31 == bi) ? -INFINITY : v; }
            const float e1 = fast_exp(tv[1] - tv[0]), e2 = fast_exp(tv[2] - tv[0]), e3 = fast_exp(tv[3] - tv[0]); const float inv = 1.0f / (1.0f + e1 + e2 + e3);
            if (c31 < 4) { const int ex = c31 == 0 ? ti[0] : c31 == 1 ? ti[1] : c31 == 2 ? ti[2] : ti[3]; const float gt = (c31 == 0 ? 1.0f : c31 == 1 ? e1 : c31 == 2 ? e2 : e3) * inv;
                const unsigned slot = __hip_atomic_fetch_add((unsigned*)(F.ctl + CW_CNT + 64 * ex), 1u, __ATOMIC_RELAXED, __HIP_MEMORY_SCOPE_AGENT);
                F.tokl[(size_t)ex * NTOK + slot] = m; F.tope[m * 4 + c31] = ex; F.tops[m * 4 + c31] = (int)slot; F.gate[m * 4 + c31] = gt; } }
#pragma unroll
        for (int q = 0; q < 4; ++q) { const int tok = 4 * w + q; const size_t m = (size_t)(t0 + tok); const float r = rt[tok];
            const f32x4* xr = (const f32x4*)(F.X1 + m * DM) + lane; const f32x4* gr = (const f32x4*)F.ffn_g + lane; unsigned* o4 = (unsigned*)((unsigned char*)F.H + m * DM) + lane;
            const float r8 = 8.0f * r;
#pragma unroll
            for (int j = 0; j < 8; ++j) { const f32x4 xv = xr[64 * j], gg = gr[64 * j];
                o4[64 * j] = pk4_fp8(clamp_fp8(xv.x * r8 * gg.x), clamp_fp8(xv.y * r8 * gg.y), clamp_fp8(xv.z * r8 * gg.z), clamp_fp8(xv.w * r8 * gg.w)); } }
        __syncthreads();
    }
}

DI void moe_tables(Frame& F) {
    LAS int* tb = (LAS int*)(F.lds + TBL_OFF);
    if (F.tid == 0) { int acc = 0;
        for (int e = 0; e < NEXP; ++e) { const int c = (int)__hip_atomic_load((unsigned*)(F.ctl + CW_CNT + 64 * e), __ATOMIC_RELAXED, __HIP_MEMORY_SCOPE_AGENT); tb[e] = acc; tb[40 + e] = c; acc += (c + 255) >> 8; }
        tb[32] = acc; }
    __syncthreads();
}
struct MoeProb {
    const bf16_t* A; const bf16_t* Bt; const int* tokl; const LAS int* tb; int K, NT  , brows  , G, c; bool gather;
    DI bool next(int i, pg8::Unit& u) const {
        const int L = i * G + c; const int nb = tb[32]; if (L >= nb * NT) return false;
        const int blk = L / NT, pn = L % NT; int e = 0;
        for (int j = 1; j < NEXP; ++j) e += (tb[j] <= blk) ? 1 : 0;
        const int rb = blk - tb[e]; int nr = tb[40 + e] - rb * 256; nr = nr > 256 ? 256 : nr;
        u.pm = blk; u.pn = pn; u.e = e; u.rb = rb; u.nrow = nr; return true;
    }
    DI const char* a_base(const pg8::Unit& u) const { return gather ? (const char*)A : (const char*)A + (size_t)u.pm * 256 * K * 2; }
    DI const char* b_base(const pg8::Unit& u) const { return (const char*)Bt + ((size_t)u.e * brows + (size_t)u.pn * 256) * K * 2; }
    DI void a_voff(const pg8::Unit& u, const int (&R)[2], const int (&C)[2], unsigned (&v)[2][2]) const {
#pragma unroll
        for (int h = 0; h < 2; ++h)
#pragma unroll
            for (int i = 0; i < 2; ++i) { const int r = h * 128 + R[i];
                if (gather) { int tok = 0; if (r < u.nrow) tok = tokl[(size_t)u.e * NTOK + u.rb * 256 + r]; v[h][i] = (unsigned)(tok * K + C[i]) * 2u; }
                else v[h][i] = (unsigned)(r * K + C[i]) * 2u; }
    }
};

DI void final_phase(Frame& F) {
    const LAS int* tb = (const LAS int*)(F.lds + TBL_OFF);
    const int gw = F.vcu * NWAVES + F.wave, NGW = F.G * NWAVES, lane = F.lane;
    for (int m = gw; m < NTOK; m += NGW) {
        const bf16_t* yr[4]; float gt[4];
#pragma unroll
        for (int k = 0; k < 4; ++k) { const int e = F.tope[m * 4 + k], sl = F.tops[m * 4 + k]; gt[k] = F.gate[m * 4 + k]; yr[k] = F.Y + ((size_t)tb[e] * 256 + sl) * DM; }
        float v[4][8]; float ss = 0.f;
#pragma unroll
        for (int j = 0; j < 4; ++j) { const int c0 = 8 * (lane + 64 * j);
            const f32x4 x0 = *(const f32x4*)(F.X1 + (size_t)m * DM + c0), x1 = *(const f32x4*)(F.X1 + (size_t)m * DM + c0 + 4);
            float a[8] = {x0.x, x0.y, x0.z, x0.w, x1.x, x1.y, x1.z, x1.w};
#pragma unroll
            for (int k = 0; k < 4; ++k) { const u32x4 y = *(const u32x4*)(yr[k] + c0);
                a[0] += gt[k] * bf_lo(y.x); a[1] += gt[k] * bf_hi(y.x); a[2] += gt[k] * bf_lo(y.y); a[3] += gt[k] * bf_hi(y.y);
                a[4] += gt[k] * bf_lo(y.z); a[5] += gt[k] * bf_hi(y.z); a[6] += gt[k] * bf_lo(y.w); a[7] += gt[k] * bf_hi(y.w); }
#pragma unroll
            for (int q = 0; q < 8; ++q) { v[j][q] = a[q]; ss += a[q] * a[q]; } }
        const float r = 1.0f / sqrtf(wave_sum(ss) * (1.f / DM) + EPS);
#pragma unroll
        for (int j = 0; j < 4; ++j) { const int c0 = 8 * (lane + 64 * j);
            const f32x4 g0 = *(const f32x4*)(F.final_g + c0), g1 = *(const f32x4*)(F.final_g + c0 + 4);
            *(f32x4*)(F.out + (size_t)m * DM + c0) = (f32x4){v[j][0] * r * g0.x, v[j][1] * r * g0.y, v[j][2] * r * g0.z, v[j][3] * r * g0.w};
            *(f32x4*)(F.out + (size_t)m * DM + c0 + 4) = (f32x4){v[j][4] * r * g1.x, v[j][5] * r * g1.y, v[j][6] * r * g1.z, v[j][7] * r * g1.w}; }
    }
}
#ifndef MK_N_LAUNCHES
#define MK_N_LAUNCHES 1
#endif
constexpr int N_PHASES = 11;
struct Args { const float* in[16]; float* out; unsigned char* ws; int ph_lo, ph_hi; };
static_assert(sizeof(Args) == 16 * 8 + 8 + 8 + 8, "Args has no padding");

__global__ void __launch_bounds__(NWAVES * 64, 2) fwd_kernel(Args args) {
    extern __shared__ __attribute__((aligned(16))) unsigned char lds_raw[];
    Frame F;
    F.lds = (LAS unsigned char*)lds_raw;
    F.tid = threadIdx.x; F.lane = F.tid & 63; F.wave = __builtin_amdgcn_readfirstlane(F.tid >> 6);
    F.G = gridDim.x; { const int bx = blockIdx.x; F.vcu = (F.G % 8 == 0) ? (bx % 8) * (F.G / 8) + bx / 8 : bx; }
    unsigned char* ws = args.ws;
    F.ctl = (gu32*)(ws + WS_CTL);
    F.x = args.in[0]; F.attn_g = args.in[1]; F.w_in = args.in[2]; F.sinks = args.in[3]; F.w_alpha2 = args.in[4]; F.b_alpha = args.in[5]; F.gla_g = args.in[6]; F.w_out = args.in[7];
    F.ffn_g = args.in[8]; F.w_router = args.in[9]; F.b_router = args.in[10]; F.w_gu = args.in[11]; F.b_gu = args.in[12]; F.w_dn = args.in[13]; F.b_dn = args.in[14]; F.final_g = args.in[15];
    F.out = args.out;
    F.tope = (int*)(ws + WS_TOPE); F.tops = (int*)(ws + WS_TOPS); F.gate = (float*)(ws + WS_GATE); F.tokl = (int*)(ws + WS_TOKL);
    F.Win = (bf16_t*)(ws + WS_WIN); F.Wout = (bf16_t*)(ws + WS_WOUT); F.Wgu = (bf16_t*)(ws + WS_WGU); F.Wdn = (bf16_t*)(ws + WS_WDN);
    F.sa_h = (float*)(ws + WS_SAH); F.sa_mix = (float*)(ws + WS_SAMIX);
    F.H = (bf16_t*)(ws + WS_H); F.PROJ = (bf16_t*)(ws + WS_PROJ); F.OA = (bf16_t*)(ws + WS_OA); F.OB = (bf16_t*)(ws + WS_OB); F.MIX = (bf16_t*)(ws + WS_MIX);
    F.X1 = (float*)(ws + WS_X1); F.GQT = (bf16_t*)(ws + WS_GQT); F.GKT = (bf16_t*)(ws + WS_GKT); F.GATT = (bf16_t*)(ws + WS_GATT); F.GDEC = (float*)(ws + WS_GDEC); F.GVT = (bf16_t*)(ws + WS_GVT);
    F.ACT = (bf16_t*)(ws + WS_ACT); F.Y = (bf16_t*)(ws + WS_Y);
    for (int u = F.tid; u < (LDS_BYTES - LDSCTL_OFF) / 4; u += NWAVES * 64) ((LAS unsigned*)(F.lds + LDSCTL_OFF))[u] = 0u;
    __syncthreads();
    const int lo = args.ph_lo, hi = args.ph_hi;
    const bool use_bar = (hi - lo) > 1;
    XcdBarrier bar; bar.bar = (unsigned*)(F.ctl + CW_BAR); bar.x = 0; bar.st = nullptr;
    if (use_bar) bar = xcd_barrier_post((unsigned*)(F.ctl + CW_BAR), (volatile LAS unsigned*)(F.lds + MISC_OFF) + 8);
#define IN(k) (lo <= (k) && (k) < hi)
#define SEAM(k) do { if (IN(k) && IN((k) + 1)) xcd_barrier(bar); } while (0)

    if (IN(0)) { colmax_phase(F); }
    SEAM(0);
    if (IN(1)) { p0_prologue(F); }
    SEAM(1);
    if (IN(2)) {
        pg8::DenseProb P; P.A = F.H; P.Bt = F.Win; P.K = I8_P1 ? DM / 2 : DM; P.S.init(NTOK, LDP, F.G, (int)blockIdx.x);
        pg8::EpiBf16Plain<I8_P1> E{F.PROJ, LDP, F.sa_h, (const float*)(F.ctl + CW_CMAX_IN)};
        pg8::gemm_phase<I8_P1 ? GM_I8 : GM_BF16>(F.lds + RING_OFF, P, E);
    }
    SEAM(2);
    if (IN(3)) { gla_prep_phase(F); }
    SEAM(3);
    if (IN(4)) { if (F.vcu < 64) gla_scan_phase(F); swa_phase(F); }
    SEAM(4);
    if (IN(5)) { merge_phase(F); }
    SEAM(5);
    if (IN(6)) {
        pg8::DenseProb P; P.A = F.MIX; P.Bt = F.Wout; P.K = I8_P5 ? DM / 2 : DM; P.S.init(NTOK, DM, F.G, (int)blockIdx.x);
        pg8::EpiResF32<I8_P5> E{F.x, F.X1, DM, F.sa_mix, (const float*)(F.ctl + CW_CMAX_OUT)};
        pg8::gemm_phase<I8_P5 ? GM_I8 : GM_BF16>(F.lds + RING_OFF, P, E);
    }
    SEAM(6);
    if (IN(7)) { router_phase(F); }
    SEAM(7);
    if (IN(8)) {
        moe_tables(F);
        MoeProb P; P.A = F.H; P.Bt = F.Wgu; P.tokl = F.tokl; P.tb = (const LAS int*)(F.lds + TBL_OFF); P.K = DM / 2; P.NT = 16; P.brows = 4096; P.G = F.G; P.c = (int)blockIdx.x; P.gather = true;
        pg8::EpiGlu E{(unsigned char*)F.ACT, DFF, F.b_gu};
        pg8::gemm_phase<GM_FP8>(F.lds + RING_OFF, P, E);
    }
    SEAM(8);
    if (IN(9)) {
        moe_tables(F);
        MoeProb P; P.A = F.ACT; P.Bt = F.Wdn; P.tokl = F.tokl; P.tb = (const LAS int*)(F.lds + TBL_OFF); P.K = DFF / 2; P.NT = 8; P.brows = 2048; P.G = F.G; P.c = (int)blockIdx.x; P.gather = false;
        pg8::EpiBf16BiasE E{F.Y, DM, F.b_dn};
        pg8::gemm_phase<GM_FP8>(F.lds + RING_OFF, P, E);
    }
    SEAM(9);
    if (IN(10)) { moe_tables(F); final_phase(F); }
#undef IN
#undef SEAM
}

extern "C" void kernel_launch(void* const* d_in, const int* in_sizes, int n_in, void* d_out, int out_size, void* d_ws, size_t ws_size, hipStream_t stream) {
    static int grid = 0;
    if (grid == 0) {
        if (n_in != 16 || out_size != NTOK * DM || ws_size < WS_END) { fprintf(stderr, "kernel_launch: unexpected shapes (n_in %d, out %d, ws %zu, need %zu); nothing launched\n", n_in, out_size, ws_size, (size_t)WS_END); grid = -1; return; }
        int dev = 0, cus = 0, per_cu = 0;
        if (hipGetDevice(&dev) != hipSuccess || hipDeviceGetAttribute(&cus, hipDeviceAttributeMultiprocessorCount, dev) != hipSuccess) { fprintf(stderr, "kernel_launch: device query failed\n"); grid = -1; return; }
        if (hipFuncSetAttribute((const void*)fwd_kernel, hipFuncAttributeMaxDynamicSharedMemorySize, LDS_BYTES) != hipSuccess) { fprintf(stderr, "kernel_launch: hipFuncSetAttribute failed\n"); grid = -1; return; }
        if (hipOccupancyMaxActiveBlocksPerMultiprocessor(&per_cu, (const void*)fwd_kernel, NWAVES * 64, LDS_BYTES) != hipSuccess || per_cu < 1)
            fprintf(stderr, "kernel_launch: note: occupancy query reports %d workgroups per CU\n", per_cu);
        (void)hipGetLastError();
        grid = cus;
    }
    if (grid < 0) return;
    if (hipMemsetAsync((char*)d_ws + WS_CTL, 0, CTL_ZERO_BYTES, stream) != hipSuccess) { fprintf(stderr, "kernel_launch: hipMemsetAsync failed\n"); return; }
    Args a{};
    for (int i = 0; i < 16; ++i) a.in[i] = (const float*)d_in[i];
    a.out = (float*)d_out; a.ws = (unsigned char*)d_ws;
    if (MK_N_LAUNCHES == 1) { a.ph_lo = 0; a.ph_hi = N_PHASES; hipLaunchKernelGGL(fwd_kernel, dim3(grid), dim3(NWAVES * 64), LDS_BYTES, stream, a); }
    else for (int p = 0; p < N_PHASES; ++p) { a.ph_lo = p; a.ph_hi = p + 1; hipLaunchKernelGGL(fwd_kernel, dim3(grid), dim3(NWAVES * 64), LDS_BYTES, stream, a);
#ifdef MK_REPEAT_MASK
        if ((MK_REPEAT_MASK >> p) & 1) hipLaunchKernelGGL(fwd_kernel, dim3(grid), dim3(NWAVES * 64), LDS_BYTES, stream, a);
#endif
    }
    const hipError_t le = hipPeekAtLastError();
    if (le != hipSuccess) fprintf(stderr, "kernel_launch: launch failed: %s\n", hipGetErrorName(le));
}
```

```cpp
#define MK_N_LAUNCHES 1
#include <hip/hip_runtime.h>
#include <cstdio>
#include <cstdint>

#define DI __device__ __forceinline__
#define LAS __attribute__((address_space(3)))
#define GAS __attribute__((address_space(1)))
typedef unsigned short bf16_t;
typedef short bf16x8 __attribute__((ext_vector_type(8)));
typedef short s16x4 __attribute__((ext_vector_type(4)));
typedef float f32x4 __attribute__((ext_vector_type(4)));
typedef float f32x16 __attribute__((ext_vector_type(16)));
typedef unsigned u32x4 __attribute__((ext_vector_type(4)));
typedef unsigned u32x2 __attribute__((ext_vector_type(2)));
typedef float f32x2_t __attribute__((ext_vector_type(2)));
typedef __bf16 bf16x2_t __attribute__((ext_vector_type(2)));
typedef int i32x4 __attribute__((ext_vector_type(4)));
typedef int i32x8 __attribute__((ext_vector_type(8)));
DI unsigned pk4_fp8(float a, float b, float c, float d) { int p = __builtin_amdgcn_cvt_pk_fp8_f32(a, b, 0, false); p = __builtin_amdgcn_cvt_pk_fp8_f32(c, d, p, true); return (unsigned)p; }
DI float clamp_fp8(float x) { return fminf(fmaxf(x, -448.0f), 448.0f); }
constexpr int F8_SCALE_W = 0x79797979;
constexpr int F8_SCALE_A = 0x7c7c7c7c;
DI unsigned pk4_i8(float a, float b, float c, float d) {
    const int ia = (int)__builtin_rintf(fminf(fmaxf(a, -127.f), 127.f)), ib = (int)__builtin_rintf(fminf(fmaxf(b, -127.f), 127.f));
    const int ic = (int)__builtin_rintf(fminf(fmaxf(c, -127.f), 127.f)), id = (int)__builtin_rintf(fminf(fmaxf(d, -127.f), 127.f));
    return ((unsigned)ia & 0xffu) | (((unsigned)ib & 0xffu) << 8) | (((unsigned)ic & 0xffu) << 16) | ((unsigned)id << 24);
}
DI float wave_max(float v) {
#pragma unroll
    for (int o = 1; o < 64; o <<= 1) v = fmaxf(v, __shfl_xor(v, o));
    return v;
}
constexpr int GM_BF16 = 0, GM_FP8 = 1, GM_I8 = 2;

DI unsigned pk_bf16(float lo, float hi) { f32x2_t v = {lo, hi}; bf16x2_t b = __builtin_convertvector(v, bf16x2_t); return __builtin_bit_cast(unsigned, b); }
DI float bf_lo(unsigned w) { return __uint_as_float(w << 16); }
DI float bf_hi(unsigned w) { return __uint_as_float(w & 0xffff0000u); }
DI float bf2f(bf16_t v) { return __uint_as_float(((unsigned)v) << 16); }
DI bf16_t f2bf(float f) { return (bf16_t)(pk_bf16(f, 0.f) & 0xffffu); }
DI float fast_exp(float x) { return __builtin_amdgcn_exp2f(x * 1.4426950408889634f); }
DI float fast_rcp(float x) { return __builtin_amdgcn_rcpf(x); }
DI float fast_sigmoid(float x) { return fast_rcp(1.0f + fast_exp(-x)); }
DI float wave_sum(float v) {
#pragma unroll
    for (int o = 1; o < 64; o <<= 1) v += __shfl_xor(v, o);
    return v;
}
DI int crow(int reg, int h) { return (reg & 3) + 8 * (reg >> 2) + 4 * h; }
#define MFMA32(a, b, c) __builtin_amdgcn_mfma_f32_32x32x16_bf16((a), (b), (c), 0, 0, 0)

namespace pg8 {
constexpr int BM = 256, BK = 64, HALF = 128, HTB = HALF * BK * 2  , STAGE_BYTES = 8 * HTB, NXCD = 8, WGM = 8;

DI int lds_byte(int r, int c) { const int st = (r >> 4) * 2 + (c >> 5), rr = r & 15, cc = c & 31, ob = rr * 64 + cc * 2; return st * 1024 + (ob ^ (((ob >> 9) & 1) << 5)); }
DI void stage_rc(int b, int& R, int& C) { const int st = b / 1024, sb = b % 1024, swz = sb ^ (((sb >> 9) & 1) << 5); R = (st >> 1) * 16 + swz / 64; C = (st & 1) * 32 + (swz % 64) / 2; }
DI int perm32(int rho) { const int n = rho >> 4, i = rho & 15; return 8 * (i >> 2) + 4 * n + (i & 3); }

struct Unit { int pm, pn, e, rb, nrow; };

struct StaticOrder {
    int nM, nN, nwg, G, c;
    DI void init(int M, int N, int G_, int c_) { nM = M / BM; nN = N / BM; nwg = nM * nN; G = G_; c = c_; }
    DI bool next(int i, int& pm, int& pn) const {
        const long L = (long)i * G + c; if (L >= nwg) return false;
        int wgid = (int)L; { const int q = nwg / NXCD, r = nwg % NXCD, xcd = wgid % NXCD, off = wgid / NXCD; wgid = (xcd < r ? xcd * (q + 1) : r * (q + 1) + (xcd - r) * q) + off; }
        const int nig = WGM * nN, gid = wgid / nig, fm = gid * WGM, gsz = (nM - fm) < WGM ? (nM - fm) : WGM;
        pm = fm + ((wgid % nig) % gsz); pn = (wgid % nig) / gsz; return true;
    }
};

struct DenseProb {
    const bf16_t* A; const bf16_t* Bt; int K; StaticOrder S; int vsplit = 1 << 30, pnA = 0, pnB = 0;
    DI bool next(int i, Unit& u) const { int pm, pn; if (!S.next(i, pm, pn)) return false; u.pm = pm; u.pn = (pn < vsplit) ? pnA + pn : pnB + pn - vsplit; u.e = 0; u.rb = 0; u.nrow = 256; return true; }
    DI const char* a_base(const Unit& u) const { return (const char*)A + (size_t)u.pm * 256 * K * 2; }
    DI const char* b_base(const Unit& u) const { return (const char*)Bt + (size_t)u.pn * 256 * K * 2; }
    DI void a_voff(const Unit&, const int (&R)[2], const int (&C)[2], unsigned (&v)[2][2]) const {
#pragma unroll
        for (int h = 0; h < 2; ++h)
#pragma unroll
            for (int i = 0; i < 2; ++i) v[h][i] = (unsigned)((h * HALF + R[i]) * K + C[i]) * 2u;
    }
};

template <int MODE, class Prob, class Epi>
DI void gemm_phase(LAS unsigned char* lds, const Prob& P, const Epi& E) {
    constexpr bool F8 = (MODE == GM_FP8);
    const int tid = threadIdx.x, wid = __builtin_amdgcn_readfirstlane(tid >> 6), lane = tid & 63, wr = wid >> 2, wc = wid & 3, fr = lane & 15, fq = lane >> 4;
    const int K = P.K, nt = K / BK;
    int sR[2], sC[2]; unsigned voffB[2];
#pragma unroll
    for (int i = 0; i < 2; ++i) { int R, C; stage_rc(tid * 16 + i * 8192, R, C); const int Rb = Epi::PERM ? ((R & ~31) + perm32(R & 31)) : R; sR[i] = R; sC[i] = C; voffB[i] = (unsigned)(Rb * K + C) * 2u; }
    const size_t kstep = (size_t)(BK * 2);
    const size_t hstep = (size_t)HALF * K * 2;
    const unsigned ldsw = (unsigned)wid * 1024u;
    const int aoff = lds_byte(wr * 64 + fr, fq * 8), boff = lds_byte(wc * 32 + fr, fq * 8);
#define PG8_SA(b, h) (((b) * 2 + (h)) * HTB)
#define PG8_SB(b, h) ((4 + (b) * 2 + (h)) * HTB)
#define PG8_STAGE2(bufoff, gbase, v0, v1) do { \
        __builtin_amdgcn_global_load_lds((const unsigned*)((const char*)(gbase) + (v0)), (LAS unsigned*)(lds + (bufoff) + ldsw), 16, 0, 0); \
        __builtin_amdgcn_global_load_lds((const unsigned*)((const char*)(gbase) + (v1)), (LAS unsigned*)(lds + (bufoff) + ldsw + 8192), 16, 0, 0); } while (0)
#define PG8_STAGEB(bufoff, gbase) PG8_STAGE2(bufoff, gbase, voffB[0], voffB[1])
#define PG8_LDA(dst, b, h) do { _Pragma("unroll") for (int m = 0; m < 4; ++m) { const i32x4 lo_ = *(const LAS i32x4*)(lds + PG8_SA(b, h) + aoff + m * 2048), hi_ = *(const LAS i32x4*)(lds + PG8_SA(b, h) + aoff + m * 2048 + 1024); \
        dst[m] = __builtin_shufflevector(lo_, hi_, 0, 1, 2, 3, 4, 5, 6, 7); } } while (0)
#define PG8_LDB(dst, b, h) do { _Pragma("unroll") for (int n = 0; n < 2; ++n) { const i32x4 lo_ = *(const LAS i32x4*)(lds + PG8_SB(b, h) + boff + n * 2048), hi_ = *(const LAS i32x4*)(lds + PG8_SB(b, h) + boff + n * 2048 + 1024); \
        dst[n] = __builtin_shufflevector(lo_, hi_, 0, 1, 2, 3, 4, 5, 6, 7); } } while (0)
#define PG8_MMA(ai, bj, At, Bt) do { __builtin_amdgcn_s_setprio(1); _Pragma("unroll") for (int m = 0; m < 4; ++m) _Pragma("unroll") for (int n = 0; n < 2; ++n) { \
        if constexpr (F8) asm volatile("v_mfma_scale_f32_16x16x128_f8f6f4 %0, %1, %2, %0, %3, %4 op_sel_hi:[0,0,0]" : "+v"(acc[ai][bj][m][n]) : "v"(Bt[n]), "v"(At[m]), "v"(f8sw), "v"(f8sa)); \
        else if constexpr (MODE == GM_I8) { i32x4 ci = __builtin_bit_cast(i32x4, acc[ai][bj][m][n]); \
               ci = __builtin_amdgcn_mfma_i32_16x16x64_i8(__builtin_shufflevector(Bt[n], Bt[n], 0, 1, 2, 3), __builtin_shufflevector(At[m], At[m], 0, 1, 2, 3), ci, 0, 0, 0); \
               ci = __builtin_amdgcn_mfma_i32_16x16x64_i8(__builtin_shufflevector(Bt[n], Bt[n], 4, 5, 6, 7), __builtin_shufflevector(At[m], At[m], 4, 5, 6, 7), ci, 0, 0, 0); acc[ai][bj][m][n] = __builtin_bit_cast(f32x4, ci); } \
        else { acc[ai][bj][m][n] = __builtin_amdgcn_mfma_f32_16x16x32_bf16(__builtin_bit_cast(bf16x8, __builtin_shufflevector(Bt[n], Bt[n], 0, 1, 2, 3)), __builtin_bit_cast(bf16x8, __builtin_shufflevector(At[m], At[m], 0, 1, 2, 3)), acc[ai][bj][m][n], 0, 0, 0); \
               acc[ai][bj][m][n] = __builtin_amdgcn_mfma_f32_16x16x32_bf16(__builtin_bit_cast(bf16x8, __builtin_shufflevector(Bt[n], Bt[n], 4, 5, 6, 7)), __builtin_bit_cast(bf16x8, __builtin_shufflevector(At[m], At[m], 4, 5, 6, 7)), acc[ai][bj][m][n], 0, 0, 0); } } \
        __builtin_amdgcn_s_setprio(0); } while (0)
#define PG8_WAIT_V(n) asm volatile("s_waitcnt vmcnt(" #n ")" ::: "memory")
#define PG8_WAIT_L(n) asm volatile("s_waitcnt lgkmcnt(" #n ")" ::: "memory")
#define PG8_BAR __builtin_amdgcn_s_barrier()
#define PG8_SCHED __builtin_amdgcn_sched_barrier(0)
    Unit cur, nxt; int ui = 0;
    if (!P.next(0, cur)) return;
    f32x4 acc[2][2][4][2];
#pragma unroll
    for (int a = 0; a < 2; ++a)
#pragma unroll
        for (int b = 0; b < 2; ++b)
#pragma unroll
            for (int m = 0; m < 4; ++m)
#pragma unroll
                for (int n = 0; n < 2; ++n) acc[a][b][m][n] = (f32x4){0.f, 0.f, 0.f, 0.f};
    i32x8 At[4], B0[2], B1[2];
    const int f8sw = F8_SCALE_W, f8sa = F8_SCALE_A;
    const char* cA = P.a_base(cur); const char* cB = P.b_base(cur);
    unsigned vAc[2][2], vAn[2][2];
    P.a_voff(cur, sR, sC, vAc);
    PG8_STAGEB(PG8_SB(0, 0), cB); PG8_STAGEB(PG8_SB(0, 1), cB + hstep); PG8_STAGE2(PG8_SA(0, 0), cA, vAc[0][0], vAc[0][1]); PG8_STAGE2(PG8_SA(0, 1), cA, vAc[1][0], vAc[1][1]);
    if (wr == 1) PG8_BAR;
    PG8_WAIT_V(2); PG8_BAR;
    PG8_STAGEB(PG8_SB(1, 0), cB + kstep); PG8_STAGE2(PG8_SA(1, 0), cA + kstep, vAc[0][0], vAc[0][1]); PG8_STAGEB(PG8_SB(1, 1), cB + hstep + kstep);
    PG8_WAIT_V(6); PG8_BAR;
    for (;;) {
        const bool has_next = P.next(ui + 1, nxt);
        const char* nA = cA; const char* nB = cB;
        if (has_next) { nA = P.a_base(nxt); nB = P.b_base(nxt); P.a_voff(nxt, sR, sC, vAn); }
        else {
#pragma unroll
            for (int h = 0; h < 2; ++h)
#pragma unroll
                for (int i = 0; i < 2; ++i) vAn[h][i] = vAc[h][i];
        }
        for (int t = 0; t < nt; t += 2) {
            const bool last = (t == nt - 2);
            const char* a1 = cA + (size_t)(t + 1) * kstep;
            const char* a2 = last ? nA : cA + (size_t)(t + 2) * kstep; const char* b2 = last ? nB : cB + (size_t)(t + 2) * kstep;
            const char* a3 = a2 + kstep; const char* b3 = b2 + kstep;
            const unsigned w00 = last ? vAn[0][0] : vAc[0][0], w01 = last ? vAn[0][1] : vAc[0][1], w10 = last ? vAn[1][0] : vAc[1][0], w11 = last ? vAn[1][1] : vAc[1][1];
            PG8_LDB(B0, 0, 0); PG8_LDB(B1, 0, 1); PG8_SCHED; PG8_LDA(At, 0, 0); PG8_STAGE2(PG8_SA(1, 1), a1, vAc[1][0], vAc[1][1]);
            PG8_WAIT_V(8); PG8_WAIT_L(0); PG8_BAR; PG8_MMA(0, 0, At, B0); PG8_MMA(0, 1, At, B1); PG8_BAR; PG8_SCHED;
            PG8_LDA(At, 0, 1); PG8_STAGEB(PG8_SB(0, 0), b2); PG8_STAGEB(PG8_SB(0, 1), b2 + hstep); PG8_STAGE2(PG8_SA(0, 0), a2, w00, w01);
            PG8_WAIT_V(8); PG8_WAIT_L(0); PG8_BAR; PG8_MMA(1, 0, At, B0); PG8_MMA(1, 1, At, B1); PG8_BAR; PG8_SCHED;
            PG8_LDB(B0, 1, 0); PG8_LDB(B1, 1, 1); PG8_SCHED; PG8_LDA(At, 1, 0); PG8_STAGE2(PG8_SA(0, 1), a2, w10, w11);
            PG8_WAIT_V(8); PG8_WAIT_L(0); PG8_BAR; PG8_MMA(0, 0, At, B0); PG8_MMA(0, 1, At, B1); PG8_BAR; PG8_SCHED;
            PG8_LDA(At, 1, 1); PG8_STAGEB(PG8_SB(1, 0), b3); PG8_STAGEB(PG8_SB(1, 1), b3 + hstep); PG8_STAGE2(PG8_SA(1, 0), a3, w00, w01);
            PG8_WAIT_V(8); PG8_WAIT_L(0); PG8_BAR; PG8_MMA(1, 0, At, B0); PG8_MMA(1, 1, At, B1); PG8_BAR; PG8_SCHED;
        }
        if (wr == 0) PG8_BAR;
        if constexpr (F8) asm volatile("s_nop 15\n\ts_nop 15" ::: "memory");
        E(acc, cur, wr, wc, fr, fq);
        if (!has_next) break;
#pragma unroll
        for (int a = 0; a < 2; ++a)
#pragma unroll
            for (int b = 0; b < 2; ++b)
#pragma unroll
                for (int m = 0; m < 4; ++m)
#pragma unroll
                    for (int n = 0; n < 2; ++n) acc[a][b][m][n] = (f32x4){0.f, 0.f, 0.f, 0.f};
        cur = nxt; cA = nA; cB = nB; ++ui;
#pragma unroll
        for (int h = 0; h < 2; ++h)
#pragma unroll
            for (int i = 0; i < 2; ++i) vAc[h][i] = vAn[h][i];
        if (wr == 1) PG8_BAR;
    }
    PG8_WAIT_V(0);
    PG8_BAR;
#undef PG8_SA
#undef PG8_SB
#undef PG8_STAGE2
#undef PG8_STAGEB
#undef PG8_LDA
#undef PG8_LDB
#undef PG8_MMA
#undef PG8_WAIT_V
#undef PG8_WAIT_L
#undef PG8_BAR
#undef PG8_SCHED
}
}
namespace pg8 {
template <bool I8> struct EpiBf16Plain {
    static constexpr bool PERM = true;
    bf16_t* O; int ldc; const float* sa; const float* cm;
    DI void operator()(const f32x4 (&acc)[2][2][4][2], const Unit& u, int wr, int wc, int fr, int fq) const {
        const int row0 = u.pm * BM + wr * 64 + fr, col0 = u.pn * BM + wc * 32 + 8 * fq;
        f32x4 sb[2][2];
        if constexpr (I8) {
#pragma unroll
            for (int bj = 0; bj < 2; ++bj)
#pragma unroll
                for (int n = 0; n < 2; ++n) sb[bj][n] = *(const f32x4*)(cm + col0 + bj * HALF + 4 * n) * (1.0f / 127.0f); }
#pragma unroll
        for (int ai = 0; ai < 2; ++ai)
#pragma unroll
            for (int m = 0; m < 4; ++m) { const int row = row0 + ai * HALF + m * 16; bf16_t* rowp = O + (size_t)row * ldc + col0; float sr = 1.f; if constexpr (I8) sr = sa[row];
#pragma unroll
                for (int bj = 0; bj < 2; ++bj) { f32x4 v0 = acc[ai][bj][m][0], v1 = acc[ai][bj][m][1];
                    if constexpr (I8) { const i32x4 i0 = __builtin_bit_cast(i32x4, v0), i1 = __builtin_bit_cast(i32x4, v1);
                        v0 = (f32x4){(float)i0[0], (float)i0[1], (float)i0[2], (float)i0[3]} * sb[bj][0] * sr; v1 = (f32x4){(float)i1[0], (float)i1[1], (float)i1[2], (float)i1[3]} * sb[bj][1] * sr; }
                    u32x4 w; w.x = pk_bf16(v0[0], v0[1]); w.y = pk_bf16(v0[2], v0[3]); w.z = pk_bf16(v1[0], v1[1]); w.w = pk_bf16(v1[2], v1[3]);
                    *(u32x4*)(rowp + bj * HALF) = w; } }
    }
};
template <bool I8> struct EpiResF32 {
    static constexpr bool PERM = false;
    const float* base; float* C; int ldc; const float* sa; const float* cm;
    DI void operator()(const f32x4 (&acc)[2][2][4][2], const Unit& u, int wr, int wc, int fr, int fq) const {
        const int row0 = u.pm * BM + wr * 64 + fr, col0 = u.pn * BM + wc * 32 + 4 * fq;
        f32x4 sb[2][2];
        if constexpr (I8) {
#pragma unroll
            for (int bj = 0; bj < 2; ++bj)
#pragma unroll
                for (int n = 0; n < 2; ++n) sb[bj][n] = *(const f32x4*)(cm + col0 + bj * HALF + n * 16) * (1.0f / 127.0f); }
#pragma unroll
        for (int ai = 0; ai < 2; ++ai)
#pragma unroll
            for (int m = 0; m < 4; ++m) { const int row = row0 + ai * HALF + m * 16; const size_t off = (size_t)row * ldc + col0; float sr = 1.f; if constexpr (I8) sr = sa[row];
#pragma unroll
                for (int bj = 0; bj < 2; ++bj)
#pragma unroll
                    for (int n = 0; n < 2; ++n) { f32x4 v = acc[ai][bj][m][n];
                        if constexpr (I8) { const i32x4 iv = __builtin_bit_cast(i32x4, v); v = (f32x4){(float)iv[0], (float)iv[1], (float)iv[2], (float)iv[3]} * sb[bj][n] * sr; }
                        const f32x4 bs = *(const f32x4*)(base + off + bj * HALF + n * 16); *(f32x4*)(C + off + bj * HALF + n * 16) = bs + v; } }
    }
};
struct EpiGlu {
    static constexpr bool PERM = true;
    unsigned char* O; int ldc; const float* bias;
    DI void operator()(const f32x4 (&acc)[2][2][4][2], const Unit& u, int wr, int wc, int fr, int fq) const {
        const int row0 = u.pm * BM + wr * 64 + fr, colg = u.pn * HALF + wc * 32 + 8 * fq;
        const float* bg = bias + (size_t)u.e * 4096 + colg;
        f32x4 bgl[2], bln[2];
#pragma unroll
        for (int n = 0; n < 2; ++n) { bgl[n] = *(const f32x4*)(bg + 4 * n); bln[n] = *(const f32x4*)(bg + 2048 + 4 * n); }
#pragma unroll
        for (int ai = 0; ai < 2; ++ai)
#pragma unroll
            for (int m = 0; m < 4; ++m) { unsigned char* rowp = O + (size_t)(row0 + ai * HALF + m * 16) * ldc + colg;
                float r[8];
#pragma unroll
                for (int n = 0; n < 2; ++n)
#pragma unroll
                    for (int j = 0; j < 4; ++j) { float g = acc[ai][0][m][n][j] + bgl[n][j], l = acc[ai][1][m][n][j] + bln[n][j];
                        g = fminf(g, 7.0f); l = fminf(fmaxf(l, -7.0f), 7.0f);
                        r[4 * n + j] = clamp_fp8(8.0f * (g * fast_sigmoid(1.702f * g) * (l + 1.0f))); }
                u32x2 w; w.x = pk4_fp8(r[0], r[1], r[2], r[3]); w.y = pk4_fp8(r[4], r[5], r[6], r[7]);
                *(u32x2*)rowp = w; }
    }
};
struct EpiBf16BiasE {
    static constexpr bool PERM = true;
    bf16_t* O; int ldc; const float* bias;
    DI void operator()(const f32x4 (&acc)[2][2][4][2], const Unit& u, int wr, int wc, int fr, int fq) const {
        const int row0 = u.pm * BM + wr * 64 + fr, col0 = u.pn * BM + wc * 32 + 8 * fq;
        const float* bp = bias + (size_t)u.e * 2048 + col0;
        f32x4 bv[2][2];
#pragma unroll
        for (int bj = 0; bj < 2; ++bj)
#pragma unroll
            for (int n = 0; n < 2; ++n) bv[bj][n] = *(const f32x4*)(bp + bj * HALF + 4 * n);
#pragma unroll
        for (int ai = 0; ai < 2; ++ai)
#pragma unroll
            for (int m = 0; m < 4; ++m) { bf16_t* rowp = O + (size_t)(row0 + ai * HALF + m * 16) * ldc + col0;
#pragma unroll
                for (int bj = 0; bj < 2; ++bj) { const f32x4 v0 = acc[ai][bj][m][0] + bv[bj][0], v1 = acc[ai][bj][m][1] + bv[bj][1];
                    u32x4 w; w.x = pk_bf16(v0[0], v0[1]); w.y = pk_bf16(v0[2], v0[3]); w.z = pk_bf16(v1[0], v1[1]); w.w = pk_bf16(v1[2], v1[3]);
                    *(u32x4*)(rowp + bj * HALF) = w; } }
    }
};
}
constexpr int NWAVES = 8;
constexpr int NTOK = 16384, DM = 2048, SEQ = 2048, NBATCH = 8;
constexpr int DIN = 12816, LDP = 13056;
constexpr int C_QA = 0, C_KA = 2048, C_VA = 2304, C_QB = 2560, C_KB = 3584, C_VB = 4608, C_RB = 6656, C_GA = 8704, C_GB = 10752, C_ALR = 12800;
constexpr int NEXP = 32, TOPK = 4, DFF = 2048;
constexpr int PMAX = 73728;
constexpr float EPS = 1e-5f;
constexpr float LOG2E = 1.4426950408889634f;
#ifndef MK_I8_P1
#define MK_I8_P1 1
#endif
#ifndef MK_I8_P5
#define MK_I8_P5 0
#endif
constexpr bool I8_P1 = MK_I8_P1 != 0, I8_P5 = MK_I8_P5 != 0;
constexpr bool I8_DENSE = I8_P1 || I8_P5;

constexpr size_t MiB = 1u << 20;
constexpr size_t WS_CTL = 0, CTL_ZERO_BYTES = 1 * MiB;
constexpr size_t WS_TOPE = 1 * MiB;
constexpr size_t WS_TOPS = WS_TOPE + (size_t)NTOK * 4 * 4;
constexpr size_t WS_GATE = WS_TOPS + (size_t)NTOK * 4 * 4;
constexpr size_t WS_TOKL = WS_GATE + (size_t)NTOK * 4 * 4;
constexpr size_t WS_WIN  = 4 * MiB;
constexpr size_t WS_WOUT = WS_WIN + (size_t)LDP * DM * 2;
constexpr size_t WS_WGU  = WS_WOUT + (size_t)DM * DM * 2;
constexpr size_t WS_WDN  = WS_WGU + (size_t)NEXP * 4096 * DM * 2;
constexpr size_t WS_H    = WS_WDN + (size_t)NEXP * DM * DM * 2;
constexpr size_t WS_PROJ = WS_H + (size_t)NTOK * DM * 2;
constexpr size_t WS_OA   = WS_PROJ + (size_t)NTOK * LDP * 2;
constexpr size_t WS_OB   = WS_OA + (size_t)NTOK * DM * 2;
constexpr size_t WS_MIX  = WS_OB + (size_t)NTOK * DM * 2;
constexpr size_t WS_X1   = WS_MIX + (size_t)NTOK * DM * 2;
constexpr size_t WS_GQT  = WS_X1 + (size_t)NTOK * DM * 4;
constexpr size_t WS_GKT  = WS_GQT + (size_t)1024 * 16384 * 2;
constexpr size_t WS_GATT = WS_GKT + (size_t)1024 * 16384 * 2;
constexpr size_t WS_GDEC = WS_GATT + (size_t)1024 * 4096 * 2;
constexpr size_t WS_GVT  = WS_GDEC + (size_t)1024 * 256 * 4;
constexpr size_t WS_ACT  = WS_GVT + (size_t)1024 * 32768 * 2;
constexpr size_t WS_Y    = WS_ACT + (size_t)PMAX * DFF * 2;
constexpr size_t WS_END  = WS_Y + (size_t)PMAX * DM * 2;
constexpr size_t WS_SAH  = WS_TOKL + (size_t)NEXP * NTOK * 4;
constexpr size_t WS_SAMIX = WS_SAH + (size_t)NTOK * 4;
static_assert(WS_SAMIX + (size_t)NTOK * 4 <= WS_WIN, "row scales below the weight copies");
static_assert(WS_WIN % 256 == 0 && WS_WOUT % 256 == 0 && WS_WGU % 256 == 0 && WS_WDN % 256 == 0 && WS_H % 256 == 0 && WS_PROJ % 256 == 0 && WS_OA % 256 == 0 && WS_X1 % 256 == 0 &&
              WS_GQT % 256 == 0 && WS_GKT % 256 == 0 && WS_GATT % 256 == 0 && WS_GDEC % 256 == 0 && WS_GVT % 256 == 0 && WS_ACT % 256 == 0 && WS_Y % 256 == 0, "alignment");
constexpr int CW_TMO = 0, CW_CODE = 1;
constexpr int CW_BAR = 4096;
constexpr int CW_CNT = 8192;
constexpr int CW_SWAQ = CW_CNT + 64 * 40;
constexpr int CW_CVQ = CW_CNT + 64 * 41;
constexpr int P0_NITEMS = 32 * 408 + 32 * 64 + 32 * 32 * 128 + 32 * 32 * 64;
constexpr int P0_LATE = 65536;
constexpr int CV_GROUP = 16, CV_NGROUPS = P0_LATE / CV_GROUP;
constexpr int CW_CMAX_IN = 16384, CW_CMAX_OUT = CW_CMAX_IN + LDP;
static_assert((CW_CMAX_OUT + DM) * 4 <= (int)CTL_ZERO_BYTES, "CTL words inside the memset region");
constexpr int RING_OFF = 0, RING_BYTES = 131072;
constexpr int LDSCTL_OFF = RING_BYTES, MISC_OFF = LDSCTL_OFF + 320;
constexpr int TBL_OFF = LDSCTL_OFF + 1024;
constexpr int LDS_BYTES = 147456;
static_assert(MISC_OFF + 128 <= TBL_OFF && TBL_OFF + 4096 <= LDS_BYTES, "LDS map");

typedef GAS unsigned gu32;
#define RLX_AGENT __ATOMIC_RELAXED, __HIP_MEMORY_SCOPE_AGENT
#define LDS_WAIT() asm volatile("s_waitcnt lgkmcnt(0)" ::: "memory")
#define VM_WAIT() asm volatile("s_waitcnt vmcnt(0)" ::: "memory")

#define XB_TMO      128
#define XB_XCNT(j)  (256  + 64 * (j))
#define XB_XSUB(j)  (1280 + 64 * (j))
#define XB_XGEN(j)  (2304 + 64 * (j))
#define XB_TOP      3328
#define XB_TOPGEN   3392
#define XCD_BAR_WORDS 3456
#define XB_SPIN_CAP (1u << 18)

__device__ __forceinline__ unsigned xb_ld(unsigned* p)              { return __hip_atomic_load(p, __ATOMIC_RELAXED, __HIP_MEMORY_SCOPE_AGENT); }
__device__ __forceinline__ unsigned xb_add(unsigned* p, unsigned v) { return __hip_atomic_fetch_add(p, v, __ATOMIC_RELAXED, __HIP_MEMORY_SCOPE_AGENT); }
__device__ __forceinline__ unsigned xb_xcc_id() { return (unsigned)__builtin_amdgcn_s_getreg((3 << 11) | 20) & 0xFu; }
#define XB_SPIN(cond, bar) do { unsigned _sp = 0; while (cond) { __builtin_amdgcn_s_sleep(1); \
    if ((++_sp & 255u) == 0u) { if (xb_ld(&(bar)[XB_TMO])) break; if (_sp > XB_SPIN_CAP) { atomicAdd(&(bar)[XB_TMO], 1u); break; } } } } while (0)

struct XcdBarrier {
    unsigned* bar; unsigned x;
    volatile LAS unsigned* st;
};

__device__ __forceinline__ XcdBarrier xcd_barrier_post(unsigned* bar, volatile LAS unsigned* st) {
    XcdBarrier b; b.bar = bar; b.x = xb_xcc_id(); b.st = st;
    if (threadIdx.x == 0) (void)xb_add(&bar[XB_XCNT(b.x)], 1u);
    return b;
}
__device__ __forceinline__ void xcd_barrier_complete(unsigned* bar, unsigned x, unsigned& nloc, unsigned& nx) {
    const unsigned G = gridDim.x * gridDim.y * gridDim.z;
    unsigned sum, cnt, mine, sp = 0u;
    for (;;) {
        sum = 0u; cnt = 0u; mine = 0u;
#pragma unroll
        for (unsigned j = 0; j < 16; ++j) { const unsigned c = xb_ld(&bar[XB_XCNT(j)]); sum += c; cnt += (c > 0u) ? 1u : 0u; mine = (j == x) ? c : mine; }
        if (sum == G) break;
        __builtin_amdgcn_s_sleep(1);
        if ((++sp & 255u) == 0u) { if (xb_ld(&bar[XB_TMO])) break; if (sp > XB_SPIN_CAP) { atomicAdd(&bar[XB_TMO], 1u); break; } }
    }
    nloc = mine > 0u ? mine : 1u; nx = cnt > 0u ? cnt : 1u;
}

__device__ __forceinline__ void xcd_barrier(const XcdBarrier& b) {
    asm volatile("s_waitcnt vmcnt(0)" ::: "memory");
    __syncthreads();
    if (threadIdx.x == 0) {
        unsigned* bar = b.bar;
        __builtin_amdgcn_s_waitcnt(0);
        unsigned nloc = b.st[0], nx = b.st[1];
        if (nloc == 0u) { xcd_barrier_complete(bar, b.x, nloc, nx); b.st[0] = nloc; b.st[1] = nx; }
        const unsigned old = xb_add(&bar[XB_XSUB(b.x)], 1u);
        const unsigned gen = old / nloc;
        if (old + 1u == (gen + 1u) * nloc) {
            __builtin_amdgcn_fence(__ATOMIC_RELEASE, "agent");
            asm volatile("s_waitcnt vmcnt(0)" ::: "memory");
            const unsigned og = xb_add(&bar[XB_TOP], 1u);
            const unsigned tg = og / nx;
            if (og + 1u == (tg + 1u) * nx) xb_add(&bar[XB_TOPGEN], 1u);
            else XB_SPIN(xb_ld(&bar[XB_TOPGEN]) == tg, bar);
            __builtin_amdgcn_fence(__ATOMIC_ACQUIRE, "agent");
            xb_add(&bar[XB_XGEN(b.x)], 1u);
            asm volatile("s_waitcnt vmcnt(0)" ::: "memory");
        } else {
            XB_SPIN(xb_ld(&bar[XB_XGEN(b.x)]) == gen, bar);
            __builtin_amdgcn_fence(__ATOMIC_ACQUIRE, "agent");
            asm volatile("s_waitcnt vmcnt(0)" ::: "memory");
        }
    }
    __syncthreads();
}

struct Frame {
    LAS unsigned char* lds;
    gu32* ctl;
    int tid, lane, wave, vcu, G;
    const float *x, *attn_g, *w_in, *sinks, *w_alpha2, *b_alpha, *gla_g, *w_out, *ffn_g, *w_router, *b_router, *w_gu, *b_gu, *w_dn, *b_dn, *final_g;
    float* out;
    int *tope, *tops, *tokl; float* gate;
    float *sa_h, *sa_mix;
    bf16_t *Win, *Wout, *Wgu, *Wdn, *H, *PROJ, *OA, *OB, *MIX, *GQT, *GKT, *GATT, *GVT, *ACT, *Y;
    float *X1, *GDEC;
};
DI void p0_transpose_item(const float* Wsrc, int ldw, int srccol0, int nvalid, int k0, bf16_t* dst, int K, LAS float* scr, int lane) {
    const int krow = lane >> 3, n4 = lane & 7;
    const bool ok = 4 * n4 < nvalid;
#pragma unroll
    for (int i = 0; i < 8; ++i) { const int kk = 8 * i + krow; f32x4 v = (f32x4){0.f, 0.f, 0.f, 0.f};
        if (ok) v = *(const f32x4*)(Wsrc + (size_t)(k0 + kk) * ldw + srccol0 + 4 * n4);
        LAS float* d = scr + kk * 33 + 4 * n4; d[0] = v[0]; d[1] = v[1]; d[2] = v[2]; d[3] = v[3]; }
    LDS_WAIT(); asm volatile("" ::: "memory");
    const int c = lane & 7;
#pragma unroll
    for (int j = 0; j < 4; ++j) { const int n = (lane >> 3) + 8 * j; const LAS float* s = scr + (8 * c) * 33 + n;
        u32x4 o; o.x = pk_bf16(s[0 * 33], s[1 * 33]); o.y = pk_bf16(s[2 * 33], s[3 * 33]); o.z = pk_bf16(s[4 * 33], s[5 * 33]); o.w = pk_bf16(s[6 * 33], s[7 * 33]);
        *(u32x4*)(dst + (size_t)n * K + k0 + 8 * c) = o; }
    LDS_WAIT(); asm volatile("" ::: "memory");
}
DI void rms_row_to_bf16(const float* xrow, const float* g, bf16_t* orow, int lane) {
    const f32x4* xr = (const f32x4*)xrow + lane; const f32x4* gr = (const f32x4*)g + lane;
    f32x4 v[8]; float s = 0.f;
#pragma unroll
    for (int j = 0; j < 8; ++j) { v[j] = xr[64 * j]; s += (v[j].x * v[j].x + v[j].y * v[j].y) + (v[j].z * v[j].z + v[j].w * v[j].w); }
    const float r = 1.0f / sqrtf(wave_sum(s) * (1.f / DM) + EPS);
    u32x2* o8 = (u32x2*)orow + lane;
#pragma unroll
    for (int j = 0; j < 8; ++j) { const f32x4 gg = gr[64 * j]; u32x2 w; w.x = pk_bf16(v[j].x * r * gg.x, v[j].y * r * gg.y); w.y = pk_bf16(v[j].z * r * gg.z, v[j].w * r * gg.w); o8[64 * j] = w; }
}
DI void p0_transpose_item_f8(const float* Wsrc, int ldw, int srccol0, int nvalid, int k0, unsigned char* dst, int K, LAS float* scr, int lane) {
    const int krow = lane >> 3, n4 = lane & 7;
    const bool ok = 4 * n4 < nvalid;
#pragma unroll
    for (int i = 0; i < 8; ++i) { const int kk = 8 * i + krow; f32x4 v = (f32x4){0.f, 0.f, 0.f, 0.f};
        if (ok) v = *(const f32x4*)(Wsrc + (size_t)(k0 + kk) * ldw + srccol0 + 4 * n4);
        LAS float* d = scr + kk * 33 + 4 * n4; d[0] = v[0]; d[1] = v[1]; d[2] = v[2]; d[3] = v[3]; }
    LDS_WAIT(); asm volatile("" ::: "memory");
    const int c = lane & 7;
#pragma unroll
    for (int j = 0; j < 4; ++j) { const int n = (lane >> 3) + 8 * j; const LAS float* s = scr + (8 * c) * 33 + n;
        u32x2 o; o.x = pk4_fp8(64.f * s[0 * 33], 64.f * s[1 * 33], 64.f * s[2 * 33], 64.f * s[3 * 33]); o.y = pk4_fp8(64.f * s[4 * 33], 64.f * s[5 * 33], 64.f * s[6 * 33], 64.f * s[7 * 33]);
        *(u32x2*)(dst + (size_t)n * K + k0 + 8 * c) = o; }
    LDS_WAIT(); asm volatile("" ::: "memory");
}
DI void rms_row_to_f8(const float* xrow, const float* g, unsigned char* orow, int lane) {
    const f32x4* xr = (const f32x4*)xrow + lane; const f32x4* gr = (const f32x4*)g + lane;
    f32x4 v[8]; float s = 0.f;
#pragma unroll
    for (int j = 0; j < 8; ++j) { v[j] = xr[64 * j]; s += (v[j].x * v[j].x + v[j].y * v[j].y) + (v[j].z * v[j].z + v[j].w * v[j].w); }
    const float r = 8.0f / sqrtf(wave_sum(s) * (1.f / DM) + EPS);
    unsigned* o4 = (unsigned*)orow + lane;
#pragma unroll
    for (int j = 0; j < 8; ++j) { const f32x4 gg = gr[64 * j]; o4[64 * j] = pk4_fp8(clamp_fp8(v[j].x * r * gg.x), clamp_fp8(v[j].y * r * gg.y), clamp_fp8(v[j].z * r * gg.z), clamp_fp8(v[j].w * r * gg.w)); }
}
struct P0Item { const float* src; unsigned char* dst; int ldw, pitch, mode; bool ok, live; f32x4 inv; };
DI f32x4 p0_inv(const float* cmax) { const f32x4 c = *(const f32x4*)cmax; return (f32x4){127.f / fmaxf(c.x, 1e-30f), 127.f / fmaxf(c.y, 1e-30f), 127.f / fmaxf(c.z, 1e-30f), 127.f / fmaxf(c.w, 1e-30f)}; }
DI P0Item p0_decode(Frame& F, int it, int nitems, int lane) {
    constexpr int I_IN = 32 * 408, I_OUT = 32 * 64, I_GU = 32 * 32 * 128;
    const int kc = lane >> 3, n4 = lane & 7;
    P0Item d; d.live = it < nitems; d.ok = true; d.mode = GM_FP8; d.ldw = DM; d.pitch = DM; d.src = F.w_in; d.dst = (unsigned char*)F.Win; d.inv = (f32x4){0.f, 0.f, 0.f, 0.f};
    if (!d.live) { d.ok = false; return d; }
    int r = it;
    int dmode = I8_P1 ? GM_I8 : GM_BF16, esz = I8_P1 ? 1 : 2;
    if (r < I_IN) { const int kb = r / 408, nb = r % 408, n0 = 32 * nb; int sc = n0, nv = 32;
        if (n0 >= 8704 && n0 < 12800) sc = n0 + 16; else if (n0 == 12800) { sc = 8704; nv = 16; } else if (n0 > 12800) { sc = 0; nv = 0; }
        d.mode = dmode; d.ok = 4 * n4 < nv; d.ldw = DIN; d.src = F.w_in + (size_t)(64 * kb + 8 * kc) * DIN + sc + 4 * n4;
        if (I8_P1) d.inv = p0_inv((const float*)(F.ctl + CW_CMAX_IN) + n0 + 4 * n4);
        d.pitch = DM * esz; d.dst = (unsigned char*)F.Win + (size_t)(n0 + 4 * n4) * d.pitch + (64 * kb + 8 * kc) * esz; return d; }
    r -= I_IN; dmode = I8_P5 ? GM_I8 : GM_BF16; esz = I8_P5 ? 1 : 2;
    if (r < I_OUT) { const int kb = r / 64, nb = r % 64; d.mode = dmode; d.ldw = DM; d.src = F.w_out + (size_t)(64 * kb + 8 * kc) * DM + 32 * nb + 4 * n4;
        if (I8_P5) d.inv = p0_inv((const float*)(F.ctl + CW_CMAX_OUT) + 32 * nb + 4 * n4);
        d.pitch = DM * esz; d.dst = (unsigned char*)F.Wout + (size_t)(32 * nb + 4 * n4) * d.pitch + (64 * kb + 8 * kc) * esz; return d; }
    r -= I_OUT;
    if (r < I_GU) { const int e = r / 4096, rr = r % 4096, kb = rr / 128, nb = rr % 128, n0 = 32 * nb, pn = n0 >> 8, i0 = n0 & 255;
        const int sc = (i0 < 128) ? (128 * pn + i0) : (2048 + 128 * pn + i0 - 128);
        d.ldw = 4096; d.src = F.w_gu + (size_t)e * DM * 4096 + (size_t)(64 * kb + 8 * kc) * 4096 + sc + 4 * n4; d.pitch = DM;
        d.dst = (unsigned char*)F.Wgu + ((size_t)e * 4096 + n0 + 4 * n4) * DM + 64 * kb + 8 * kc; return d; }
    r -= I_GU;
    { const int e = r / 2048, rr = r % 2048, kb = rr / 64, nb = rr % 64;
        d.ldw = DM; d.src = F.w_dn + (size_t)e * DFF * DM + (size_t)(64 * kb + 8 * kc) * DM + 32 * nb + 4 * n4; d.pitch = DFF;
        d.dst = (unsigned char*)F.Wdn + ((size_t)e * DM + 32 * nb + 4 * n4) * DFF + 64 * kb + 8 * kc; return d; }
}
DI void p0_load(const P0Item& d, f32x4 (&v)[8]) {
#pragma unroll
    for (int j = 0; j < 8; ++j) { v[j] = (f32x4){0.f, 0.f, 0.f, 0.f}; if (d.ok) v[j] = __builtin_nontemporal_load((const f32x4*)(d.src + (size_t)j * d.ldw)); }
}
DI void p0_store(const P0Item& d, const f32x4 (&v)[8]) {
    if (!d.live) return;
    if (d.mode == GM_FP8) {
#pragma unroll
        for (int q = 0; q < 4; ++q) { u32x2 o; o.x = pk4_fp8(64.f * v[0][q], 64.f * v[1][q], 64.f * v[2][q], 64.f * v[3][q]); o.y = pk4_fp8(64.f * v[4][q], 64.f * v[5][q], 64.f * v[6][q], 64.f * v[7][q]);
            *(u32x2*)(d.dst + (size_t)q * d.pitch) = o; }
    } else if (d.mode == GM_I8) {
#pragma unroll
        for (int q = 0; q < 4; ++q) { const float s = d.inv[q]; u32x2 o; o.x = pk4_i8(s * v[0][q], s * v[1][q], s * v[2][q], s * v[3][q]); o.y = pk4_i8(s * v[4][q], s * v[5][q], s * v[6][q], s * v[7][q]);
            *(u32x2*)(d.dst + (size_t)q * d.pitch) = o; }
    } else {
#pragma unroll
        for (int q = 0; q < 4; ++q) { u32x4 o; o.x = pk_bf16(v[0][q], v[1][q]); o.y = pk_bf16(v[2][q], v[3][q]); o.z = pk_bf16(v[4][q], v[5][q]); o.w = pk_bf16(v[6][q], v[7][q]);
            *(u32x4*)(d.dst + (size_t)q * d.pitch) = o; }
    }
}
DI void rms_row_to_i8(const float* xrow, const float* g, unsigned char* orow, float* sa, int lane) {
    const f32x4* xr = (const f32x4*)xrow + lane; const f32x4* gr = (const f32x4*)g + lane;
    f32x4 v[8]; float s = 0.f;
#pragma unroll
    for (int j = 0; j < 8; ++j) { v[j] = xr[64 * j]; s += (v[j].x * v[j].x + v[j].y * v[j].y) + (v[j].z * v[j].z + v[j].w * v[j].w); }
    const float r = 1.0f / sqrtf(wave_sum(s) * (1.f / DM) + EPS);
    float am = 0.f;
#pragma unroll
    for (int j = 0; j < 8; ++j) { const f32x4 gg = gr[64 * j]; v[j] = v[j] * gg * r; am = fmaxf(am, fmaxf(fmaxf(fabsf(v[j].x), fabsf(v[j].y)), fmaxf(fabsf(v[j].z), fabsf(v[j].w)))); }
    am = fmaxf(wave_max(am), 1e-30f);
    const float inv = 127.f / am;
    if (lane == 0) *sa = am * (1.f / 127.f);
    unsigned* o4 = (unsigned*)orow + lane;
#pragma unroll
    for (int j = 0; j < 8; ++j) o4[64 * j] = pk4_i8(v[j].x * inv, v[j].y * inv, v[j].z * inv, v[j].w * inv);
}
DI void colmax_phase(Frame& F) {
    if (!I8_DENSE) return;
    const int gw = F.vcu * NWAVES + F.wave, NGW = F.G * NWAVES, lane = F.lane, kc = lane >> 4, n4 = lane & 15;
    constexpr int NB_IN = (DIN + 63) / 64, I_IN = 32 * NB_IN, I_OUT = 32 * 32;
    for (int it = gw; it < I_IN + I_OUT; it += NGW) {
        const bool in = it < I_IN; const int r = in ? it : it - I_IN, nbs = in ? NB_IN : 32, kb = r / nbs, nb = r % nbs, ldw = in ? DIN : DM, c0 = 64 * nb + 4 * n4;
        const bool ok = c0 < ldw;
        const float* src = (in ? F.w_in : F.w_out) + (size_t)(64 * kb + kc) * ldw + c0;
        f32x4 m = (f32x4){0.f, 0.f, 0.f, 0.f};
        if (ok) {
#pragma unroll
            for (int j = 0; j < 16; ++j) { const f32x4 v = *(const f32x4*)(src + (size_t)(4 * j) * ldw); m.x = fmaxf(m.x, fabsf(v.x)); m.y = fmaxf(m.y, fabsf(v.y)); m.z = fmaxf(m.z, fabsf(v.z)); m.w = fmaxf(m.w, fabsf(v.w)); } }
#pragma unroll
        for (int q = 0; q < 4; ++q) { m[q] = fmaxf(m[q], __shfl_xor(m[q], 16)); m[q] = fmaxf(m[q], __shfl_xor(m[q], 32)); }
        if (ok && kc == 0) { int n = c0; if (in) { if (c0 >= 8720) n = c0 - 16; else if (c0 >= 8704) n = 12800 + c0 - 8704; }
            unsigned* dst = (unsigned*)(F.ctl + (in ? CW_CMAX_IN : CW_CMAX_OUT)) + n;
#pragma unroll
            for (int q = 0; q < 4; ++q) __hip_atomic_fetch_max(dst + q, __float_as_uint(m[q]), __ATOMIC_RELAXED, __HIP_MEMORY_SCOPE_AGENT); }
    }
}
DI void p0_prologue(Frame& F) {
    const int gw = F.vcu * NWAVES + F.wave, NGW = F.G * NWAVES;
    constexpr int NITEMS = P0_NITEMS - P0_LATE;
    f32x4 va[8], vb[8];
    P0Item da = p0_decode(F, gw, NITEMS, F.lane), db;
    p0_load(da, va);
    for (int it = gw; it < NITEMS; it += 2 * NGW) {
        db = p0_decode(F, it + NGW, NITEMS, F.lane); p0_load(db, vb);
        p0_store(da, va);
        da = p0_decode(F, it + 2 * NGW, NITEMS, F.lane); p0_load(da, va);
        p0_store(db, vb);
    }
    for (int m = gw; m < NTOK; m += NGW) { if (I8_P1) rms_row_to_i8(F.x + (size_t)m * DM, F.attn_g, (unsigned char*)F.H + (size_t)m * DM, F.sa_h + m, F.lane); else rms_row_to_bf16(F.x + (size_t)m * DM, F.attn_g, F.H + (size_t)m * DM, F.lane); }
}

DI void late_copy_phase(Frame& F) {
    volatile LAS unsigned* qslot = (volatile LAS unsigned*)(F.lds + MISC_OFF) + 16;
    for (;;) {
        if (F.tid == 0) qslot[0] = __hip_atomic_fetch_add((unsigned*)(F.ctl + CW_CVQ), 1u, __ATOMIC_RELAXED, __HIP_MEMORY_SCOPE_AGENT);
        __syncthreads();
        const int g = (int)qslot[0];
        __syncthreads();
        if (g >= CV_NGROUPS) break;
        const int base = P0_NITEMS - P0_LATE + g * CV_GROUP + F.wave;
        f32x4 va[8], vb[8];
        const P0Item da = p0_decode(F, base, P0_NITEMS, F.lane), db = p0_decode(F, base + 8, P0_NITEMS, F.lane);
        p0_load(da, va); p0_load(db, vb);
        p0_store(da, va); p0_store(db, vb);
    }
}
DI s16x4 tr_read(const LAS unsigned char* p) { return __builtin_bit_cast(s16x4, __builtin_amdgcn_ds_read_tr16_b64_v4i16((LAS s16x4*)p)); }
DI bf16x8 pack8(const f32x16& x, int s) {
    u32x4 p; p.x = pk_bf16(x[8 * s + 0], x[8 * s + 1]); p.y = pk_bf16(x[8 * s + 2], x[8 * s + 3]); p.z = pk_bf16(x[8 * s + 4], x[8 * s + 5]); p.w = pk_bf16(x[8 * s + 6], x[8 * s + 7]);
    return __builtin_bit_cast(bf16x8, p);
}
DI bf16x8 pack8_pinned(const f32x16& x, int s) {
    u32x4 p;
    asm volatile("v_cvt_pk_bf16_f32 %0, %4, %5\n\tv_cvt_pk_bf16_f32 %1, %6, %7\n\tv_cvt_pk_bf16_f32 %2, %8, %9\n\tv_cvt_pk_bf16_f32 %3, %10, %11\n\ts_nop 1"
                 : "=&v"(p[0]), "=&v"(p[1]), "=&v"(p[2]), "=&v"(p[3])
                 : "v"(x[8 * s]), "v"(x[8 * s + 1]), "v"(x[8 * s + 2]), "v"(x[8 * s + 3]), "v"(x[8 * s + 4]), "v"(x[8 * s + 5]), "v"(x[8 * s + 6]), "v"(x[8 * s + 7]));
    return __builtin_bit_cast(bf16x8, p);
}
DI void swa_phase(Frame& F) {
    LAS unsigned char* Ks = F.lds;
    LAS unsigned char* Vs = F.lds + 36864;
    const int lane = F.lane, w = F.wave, c31 = lane & 31, h = lane >> 5;
    const int i16 = lane & 15, q4 = i16 >> 2, p4 = i16 & 3, blk = (lane >> 4) & 1;
    volatile LAS unsigned* qslot = (volatile LAS unsigned*)(F.lds + MISC_OFF) + 16;
    for (;;) {
        if (F.tid == 0) qslot[0] = __hip_atomic_fetch_add((unsigned*)(F.ctl + CW_SWAQ), 1u, __ATOMIC_RELAXED, __HIP_MEMORY_SCOPE_AGENT);
        __syncthreads();
        const int u = (int)qslot[0];
        if (u >= 512) break;
        const int kh = u & 3, qb = (u >> 2) & 15, b = u >> 6;
        const size_t tokbase = (size_t)b * SEQ;
        const int pos0 = qb * 128 - 128;
#pragma unroll
        for (int i = 0; i < 4; ++i) { const int id = F.tid + 512 * i, row = id >> 3, ch = id & 7, pos = pos0 + row;
            u32x4 kv = (u32x4){0u, 0u, 0u, 0u}, vv = (u32x4){0u, 0u, 0u, 0u};
            if (pos >= 0) { const bf16_t* src = F.PROJ + (tokbase + pos) * LDP + C_KA + kh * 64 + ch * 8; kv = *(const u32x4*)src; vv = *(const u32x4*)(src + (C_VA - C_KA)); }
            *(LAS u32x4*)(Ks + row * 144 + ch * 16) = kv; *(LAS u32x4*)(Vs + row * 144 + ch * 16) = vv; }
        __syncthreads();
        const int head = kh * 8 + w;
        const float slope2 = __builtin_amdgcn_exp2f(-0.25f * (float)(head + 1)) * LOG2E;
        const float sink2 = F.sinks[head] * LOG2E;
        for (int qt = 0; qt < 4; ++qt) {
            const size_t qrow = tokbase + qb * 128 + qt * 32 + c31;
            bf16x8 bq[4];
#pragma unroll
            for (int ks = 0; ks < 4; ++ks) bq[ks] = *(const bf16x8*)(F.PROJ + qrow * LDP + C_QA + head * 64 + ks * 16 + h * 8);
            f32x16 S[5];
#pragma unroll
            for (int kt = 0; kt < 5; ++kt) { f32x16 acc;
#pragma unroll
                for (int i = 0; i < 16; ++i) acc[i] = 0.f;
#pragma unroll
                for (int ks = 0; ks < 4; ++ks) { const bf16x8 a = *(const LAS bf16x8*)(Ks + (32 * (qt + kt) + c31) * 144 + (ks * 16 + h * 8) * 2); acc = MFMA32(a, bq[ks], acc); }
                S[kt] = acc; }
            float mx = sink2;
#pragma unroll
            for (int kt = 0; kt < 5; ++kt)
#pragma unroll
                for (int i = 0; i < 16; ++i) { const int key = 32 * (qt + kt) + crow(i, h); const int dist = 32 * qt + c31 + 128 - key;
                    const bool valid = (dist >= 0) && (dist < 128) && (pos0 + key >= 0);
                    const float s = valid ? (S[kt][i] * (0.125f * LOG2E) - slope2 * (float)dist) : -INFINITY;
                    S[kt][i] = s; mx = fmaxf(mx, s); }
            mx = fmaxf(mx, __shfl_xor(mx, 32));
            float sum = 0.f;
#pragma unroll
            for (int kt = 0; kt < 5; ++kt)
#pragma unroll
                for (int i = 0; i < 16; ++i) { const float p = __builtin_amdgcn_exp2f(S[kt][i] - mx); S[kt][i] = p; sum += p; }
            sum += __shfl_xor(sum, 32); sum += __builtin_amdgcn_exp2f(sink2 - mx);
            const float inv = 1.0f / sum;
            f32x16 O[2];
#pragma unroll
            for (int dt = 0; dt < 2; ++dt)
#pragma unroll
                for (int i = 0; i < 16; ++i) O[dt][i] = 0.f;
#pragma unroll
            for (int kt = 0; kt < 5; ++kt)
#pragma unroll
                for (int s = 0; s < 2; ++s) { const bf16x8 bp = pack8(S[kt], s);
                    const int kb = 32 * (qt + kt) + 16 * s + 4 * h + q4;
#pragma unroll
                    for (int dt = 0; dt < 2; ++dt) { const LAS unsigned char* vp = Vs + kb * 144 + (32 * dt + 16 * blk + 4 * p4) * 2;
                        const s16x4 lo = tr_read(vp), hi = tr_read(vp + 8 * 144);
                        const bf16x8 a = __builtin_shufflevector(lo, hi, 0, 1, 2, 3, 4, 5, 6, 7);
                        O[dt] = MFMA32(a, bp, O[dt]); } }
            bf16_t* orow = F.OA + qrow * DM + head * 64 + 4 * h;
#pragma unroll
            for (int dt = 0; dt < 2; ++dt)
#pragma unroll
                for (int g4 = 0; g4 < 4; ++g4) { u32x2 wv; wv.x = pk_bf16(O[dt][4 * g4] * inv, O[dt][4 * g4 + 1] * inv); wv.y = pk_bf16(O[dt][4 * g4 + 2] * inv, O[dt][4 * g4 + 3] * inv);
                    *(u32x2*)(orow + 32 * dt + 8 * g4) = wv; }
        }
        __syncthreads();
    }
}

DI void gla_prep_phase(Frame& F) {
    LAS unsigned char* Qs = F.lds;
    LAS unsigned char* Kss = F.lds + 33792;
    LAS float* alr = (LAS float*)(F.lds + 67584);
    LAS float* tot = (LAS float*)(F.lds + 71680);
    LAS unsigned char* Vr = F.lds;
    const int tid = F.tid, lane = F.lane, w = F.wave, c31 = lane & 31, h = lane >> 5;
    for (int u = F.vcu; u < 1024; u += F.G) {
        const int hh = (u >> 5) & 3, b = u >> 7, c = u & 31;
        const size_t T0 = (size_t)b * SEQ + c * 64;
#pragma unroll
        for (int j = 0; j < 4; ++j) { const int id = tid + 512 * j, row = id >> 5, ch = id & 31; const bf16_t* src = F.PROJ + (T0 + row) * LDP + C_QB + hh * 256 + ch * 8;
            *(LAS u32x4*)(Qs + row * 528 + ch * 16) = *(const u32x4*)src; *(LAS u32x4*)(Kss + row * 528 + ch * 16) = *(const u32x4*)(src + (C_KB - C_QB)); }
        u32x4 vreg[8];
#pragma unroll
        for (int j = 0; j < 8; ++j) { const int id = tid + 512 * j, row = id >> 6, ch = id & 63; vreg[j] = *(const u32x4*)(F.PROJ + (T0 + row) * LDP + C_VB + hh * 512 + ch * 8); }
        if (tid < 128) { const int t = tid >> 1, hf = tid & 1; const u32x4 raw = *(const u32x4*)(F.PROJ + (T0 + t) * LDP + C_ALR + 8 * hf);
            LAS float* d = alr + t * 16 + 8 * hf;
            d[0] = bf_lo(raw.x); d[1] = bf_hi(raw.x); d[2] = bf_lo(raw.y); d[3] = bf_hi(raw.y); d[4] = bf_lo(raw.z); d[5] = bf_hi(raw.z); d[6] = bf_lo(raw.w); d[7] = bf_hi(raw.w); }
        __syncthreads();
        const int d = tid & 255, hf = tid >> 8;
        float w2[16];
#pragma unroll
        for (int r = 0; r < 16; ++r) w2[r] = F.w_alpha2[r * 1024 + hh * 256 + d];
        const float ba = F.b_alpha[hh * 256 + d];
        float bc[32]; float run = 0.f;
#pragma unroll
        for (int i = 0; i < 32; ++i) { const LAS f32x4* ar = (const LAS f32x4*)(alr + (32 * hf + i) * 16); float z = ba;
#pragma unroll
            for (int r4 = 0; r4 < 4; ++r4) { const f32x4 a = ar[r4]; z += a.x * w2[4 * r4] + a.y * w2[4 * r4 + 1] + a.z * w2[4 * r4 + 2] + a.w * w2[4 * r4 + 3]; }
            const float la = (fminf(z, 0.f) - __logf(1.0f + fast_exp(-fabsf(z)))) * (1.0f / 16.0f);
            run += la; bc[i] = run; }
        tot[hf * 256 + d] = run;
        __syncthreads();
        const float t0 = tot[d], t1 = tot[256 + d], blast = t0 + t1;
        if (hf) {
#pragma unroll
            for (int i = 0; i < 32; ++i) bc[i] += t0;
        } else F.GDEC[(size_t)u * 256 + d] = fast_exp(blast);
        unsigned kpk[16];
#pragma unroll
        for (int i2 = 0; i2 < 16; ++i2) { float kh2[2];
#pragma unroll
            for (int j = 0; j < 2; ++j) { const int i = 2 * i2 + j; LAS bf16_t* qp = (LAS bf16_t*)(Qs + (32 * hf + i) * 528 + d * 2); LAS bf16_t* kp = (LAS bf16_t*)(Kss + (32 * hf + i) * 528 + d * 2);
                const float q = bf2f(*qp), k = bf2f(*kp);
                const float e = fast_exp(bc[i]);
                *qp = f2bf(q * e * 0.0625f);
                *kp = f2bf(k * fast_exp(-bc[i]));
                kh2[j] = k * fast_exp(blast - bc[i]); }
            kpk[i2] = pk_bf16(kh2[0], kh2[1]); }
        { u32x4* dst = (u32x4*)(F.GKT + (size_t)u * 16384 + d * 64 + 32 * hf);
#pragma unroll
            for (int j = 0; j < 4; ++j) dst[j] = (u32x4){kpk[4 * j], kpk[4 * j + 1], kpk[4 * j + 2], kpk[4 * j + 3]}; }
        __syncthreads();
        if (w < 4) { const int m = w >> 1, n = w & 1; f32x16 acc;
#pragma unroll
            for (int i = 0; i < 16; ++i) acc[i] = 0.f;
#pragma unroll
            for (int ks = 0; ks < 16; ++ks) { const bf16x8 a = *(const LAS bf16x8*)(Qs + (32 * m + c31) * 528 + (16 * ks + 8 * h) * 2), bb = *(const LAS bf16x8*)(Kss + (32 * n + c31) * 528 + (16 * ks + 8 * h) * 2);
                acc = MFMA32(a, bb, acc); }
            bf16_t* ao = F.GATT + (size_t)u * 4096;
#pragma unroll
            for (int i = 0; i < 16; ++i) { const int t = 32 * m + crow(i, h), s = 32 * n + c31; ao[t * 64 + s] = f2bf(s <= t ? acc[i] : 0.f); }
        } else { const int t2 = tid - 256;
#pragma unroll
            for (int j = 0; j < 8; ++j) { const int id = t2 + 256 * j, row = id >> 5, ch = id & 31; *(u32x4*)(F.GQT + (size_t)u * 16384 + row * 256 + ch * 8) = *(const LAS u32x4*)(Qs + row * 528 + ch * 16); } }
        __syncthreads();
#pragma unroll
        for (int j = 0; j < 8; ++j) { const int id = tid + 512 * j, row = id >> 6, ch = id & 63; *(LAS u32x4*)(Vr + row * 1040 + ch * 16) = vreg[j]; }
        __syncthreads();
        { u32x4* dst = (u32x4*)(F.GVT + (size_t)u * 32768 + tid * 64);
#pragma unroll
            for (int t8 = 0; t8 < 8; ++t8) { unsigned short v[8];
#pragma unroll
                for (int j = 0; j < 8; ++j) v[j] = *(const LAS bf16_t*)(Vr + (8 * t8 + j) * 1040 + tid * 2);
                dst[t8] = (u32x4){(unsigned)v[0] | ((unsigned)v[1] << 16), (unsigned)v[2] | ((unsigned)v[3] << 16), (unsigned)v[4] | ((unsigned)v[5] << 16), (unsigned)v[6] | ((unsigned)v[7] << 16)}; } }
        __syncthreads();
    }
}

DI void gla_scan_phase(Frame& F) {
    LAS unsigned char* L = F.lds;
    const int lane = F.lane, w = F.wave, c31 = lane & 31, h = lane >> 5;
    const int u = F.vcu, hf = u & 1, hh = (u >> 1) & 3, b = u >> 3;
    f32x16 S[8];
#pragma unroll
    for (int i = 0; i < 8; ++i)
#pragma unroll
        for (int j = 0; j < 16; ++j) S[i][j] = 0.f;
    const size_t item0 = (size_t)(b * 4 + hh) * 32;
    const int vr0 = hf * 256 + 32 * w;
    unsigned tidv = (unsigned)F.tid;
    unsigned qrb = (unsigned)(c31 * 528 + 8 * h), krb = (unsigned)(c31 * 144 + 16 * h);
    u32x4 rq[4], rk[4], ra; f32x4 rd; u32x4 bvn[4];
#define BV(ks) (*(const LAS bf16x8*)(L + 80896 + w * 4608 + krb + 32 * (ks)))
#define SCAN_LOAD_A(item) do { const char* q0 = (const char*)(F.GQT + (item) * 16384); const char* k0 = (const char*)(F.GKT + (item) * 16384); asm volatile("" : "+v"(tidv)); const unsigned tb = tidv * 16u; \
        _Pragma("unroll") for (int j = 0; j < 4; ++j) { rq[j] = *(const u32x4*)(q0 + j * 8192 + tb); rk[j] = *(const u32x4*)(k0 + j * 8192 + tb); } } while (0)
#define SCAN_LOAD_B(item) do { const char* v0 = (const char*)(F.GVT + (item) * 32768 + (size_t)vr0 * 64); asm volatile("" : "+v"(tidv)); const unsigned tb = tidv * 16u, db = (tidv & 63u) * 16u, vb = (tidv & 31u) * 128u + ((tidv >> 5) & 1u) * 16u; \
        ra = *(const u32x4*)((const char*)(F.GATT + (item) * 4096) + tb); \
        rd = *(const f32x4*)((const char*)(F.GDEC + (item) * 256) + db); \
        _Pragma("unroll") for (int ks = 0; ks < 4; ++ks) bvn[ks] = *(const u32x4*)(v0 + 32 * ks + vb); } while (0)
#define SCAN_WRITE() do { asm volatile("" : "+v"(tidv)); const unsigned qwo = (tidv >> 5) * 528u + (tidv & 31u) * 16u, kwo = (tidv >> 3) * 144u + (tidv & 7u) * 16u; \
        _Pragma("unroll") for (int j = 0; j < 4; ++j) { *(LAS u32x4*)(L + qwo + j * 16 * 528) = rq[j]; *(LAS u32x4*)(L + 33792 + kwo + j * 64 * 144) = rk[j]; } \
        *(LAS u32x4*)(L + 70656 + kwo) = ra; \
        if (tidv < 64u) *(LAS f32x4*)(L + 79872 + tidv * 16u) = rd; \
        _Pragma("unroll") for (int ks = 0; ks < 4; ++ks) *(LAS u32x4*)(L + 80896 + w * 4608 + krb + 32 * ks) = bvn[ks]; } while (0)
    SCAN_LOAD_A(item0); SCAN_LOAD_B(item0);
    SCAN_WRITE();
    __syncthreads();
    for (int c = 0; c < 32; ++c) {
        const size_t nitem = item0 + (c < 31 ? c + 1 : c);
        SCAN_LOAD_A(nitem);
        asm volatile("" : "+v"(qrb), "+v"(krb));
#pragma unroll 1
        for (int m = 0; m < 2; ++m) { f32x16 o;
#pragma unroll
            for (int j = 0; j < 16; ++j) o[j] = 0.f;
#pragma unroll
            for (int i = 0; i < 8; ++i)
#pragma unroll
                for (int s = 0; s < 2; ++s) { const bf16x8 bs = pack8_pinned(S[i], s);
                    const LAS unsigned char* ap = L + qrb + (32 * m) * 528 + (32 * i + 16 * s) * 2;
                    const s16x4 lo = *(const LAS s16x4*)ap, hi = *(const LAS s16x4*)(ap + 16);
                    const bf16x8 a = __builtin_shufflevector(lo, hi, 0, 1, 2, 3, 4, 5, 6, 7);
                    o = MFMA32(a, bs, o); }
#pragma unroll
            for (int ks = 0; ks < 4; ++ks) { const bf16x8 a = *(const LAS bf16x8*)(L + 70656 + krb + (32 * m) * 144 + 32 * ks); o = MFMA32(a, BV(ks), o); }
            { asm volatile("" : "+v"(tidv)); const unsigned ovb = ((tidv >> 5) & 1u) * (4u * DM * 2u) + (tidv & 31u) * 2u;
                char* ob = (char*)(F.OB + ((size_t)b * SEQ + c * 64 + 32 * m) * DM + hh * 512 + vr0);
#pragma unroll
                for (int j = 0; j < 16; ++j) *(bf16_t*)(ob + ((j & 3) + 8 * (j >> 2)) * (DM * 2) + ovb) = f2bf(o[j]); } }
        asm volatile("" ::: "memory");
        SCAN_LOAD_B(nitem);
#pragma unroll
        for (int i = 0; i < 8; ++i) {
#pragma unroll
            for (int g4 = 0; g4 < 4; ++g4) { const f32x4 dc = *(const LAS f32x4*)(L + 79872 + (32 * i + 8 * g4) * 4 + (((tidv >> 5) & 1u) * 16u));
                S[i][4 * g4] *= dc.x; S[i][4 * g4 + 1] *= dc.y; S[i][4 * g4 + 2] *= dc.z; S[i][4 * g4 + 3] *= dc.w; }
        }
#pragma unroll
        for (int ks = 0; ks < 4; ++ks) { const bf16x8 bvk = BV(ks);
#pragma unroll
            for (int i = 0; i < 8; ++i) { const bf16x8 a = *(const LAS bf16x8*)(L + 33792 + krb + (32 * i) * 144 + 32 * ks); S[i] = MFMA32(a, bvk, S[i]); } }
        __syncthreads();
        SCAN_WRITE();
        __syncthreads();
    }
#undef SCAN_LOAD_A
#undef SCAN_LOAD_B
#undef SCAN_WRITE
#undef BV
}

DI void merge_phase(Frame& F) {
    const int gw = F.vcu * NWAVES + F.wave, NGW = F.G * NWAVES, lane = F.lane;
    for (int m = gw; m < NTOK; m += NGW) {
        const bf16_t* pr = F.PROJ + (size_t)m * LDP;
        float rr[4][8]; float am = 0.f;
#pragma unroll
        for (int j = 0; j < 4; ++j) { const int c0 = j * 512 + lane * 8;
            const u32x4 ob = *(const u32x4*)(F.OB + (size_t)m * DM + c0), oa = *(const u32x4*)(F.OA + (size_t)m * DM + c0);
            const u32x4 rb = *(const u32x4*)(pr + C_RB + c0), ga = *(const u32x4*)(pr + C_GA + c0), gb = *(const u32x4*)(pr + C_GB + c0);
            const f32x4 g0 = *(const f32x4*)(F.gla_g + lane * 8), g1 = *(const f32x4*)(F.gla_g + lane * 8 + 4);
            float vb[8] = {bf_lo(ob.x), bf_hi(ob.x), bf_lo(ob.y), bf_hi(ob.y), bf_lo(ob.z), bf_hi(ob.z), bf_lo(ob.w), bf_hi(ob.w)};
            const float va[8] = {bf_lo(oa.x), bf_hi(oa.x), bf_lo(oa.y), bf_hi(oa.y), bf_lo(oa.z), bf_hi(oa.z), bf_lo(oa.w), bf_hi(oa.w)};
            const float vr[8] = {bf_lo(rb.x), bf_hi(rb.x), bf_lo(rb.y), bf_hi(rb.y), bf_lo(rb.z), bf_hi(rb.z), bf_lo(rb.w), bf_hi(rb.w)};
            const float vga[8] = {bf_lo(ga.x), bf_hi(ga.x), bf_lo(ga.y), bf_hi(ga.y), bf_lo(ga.z), bf_hi(ga.z), bf_lo(ga.w), bf_hi(ga.w)};
            const float vgb[8] = {bf_lo(gb.x), bf_hi(gb.x), bf_lo(gb.y), bf_hi(gb.y), bf_lo(gb.z), bf_hi(gb.z), bf_lo(gb.w), bf_hi(gb.w)};
            const float gn[8] = {g0.x, g0.y, g0.z, g0.w, g1.x, g1.y, g1.z, g1.w};
            float ss = 0.f;
#pragma unroll
            for (int k = 0; k < 8; ++k) ss += vb[k] * vb[k];
            const float rn = 1.0f / sqrtf(wave_sum(ss) * (1.f / 512.f) + EPS);
#pragma unroll
            for (int k = 0; k < 8; ++k) { const float obn = vb[k] * rn * gn[k]; const float sl = vr[k] * fast_sigmoid(vr[k]);
                rr[j][k] = fast_sigmoid(vga[k]) * va[k] + fast_sigmoid(vgb[k]) * obn * sl; am = fmaxf(am, fabsf(rr[j][k])); }
            if (!I8_P5) *(u32x4*)(F.MIX + (size_t)m * DM + c0) = (u32x4){pk_bf16(rr[j][0], rr[j][1]), pk_bf16(rr[j][2], rr[j][3]), pk_bf16(rr[j][4], rr[j][5]), pk_bf16(rr[j][6], rr[j][7])}; }
        if (I8_P5) { am = fmaxf(wave_max(am), 1e-30f); const float inv = 127.f / am; if (lane == 0) F.sa_mix[m] = am * (1.f / 127.f);
#pragma unroll
            for (int j = 0; j < 4; ++j) { u32x2 wv; wv.x = pk4_i8(rr[j][0] * inv, rr[j][1] * inv, rr[j][2] * inv, rr[j][3] * inv); wv.y = pk4_i8(rr[j][4] * inv, rr[j][5] * inv, rr[j][6] * inv, rr[j][7] * inv);
                *(u32x2*)((unsigned char*)F.MIX + (size_t)m * DM + j * 512 + lane * 8) = wv; }
        }
    }
}

DI void router_phase(Frame& F) {
    LAS float* part = (LAS float*)F.lds;
    LAS float* ssp = (LAS float*)(F.lds + 34816);
    LAS float* rt = (LAS float*)(F.lds + 36864);
    LAS float* lg = (LAS float*)(F.lds + 37888);
    const int tid = F.tid, lane = F.lane, w = F.wave, c31 = lane & 31, h = lane >> 5;
    for (int tile = F.vcu; tile < NTOK / 32; tile += F.G) {
        const int t0 = tile * 32, kw = 256 * w;
        { const float* xr = F.X1 + (size_t)(t0 + c31) * DM + kw + 4 * h; const float* gp = F.ffn_g + kw + 4 * h; const float* wp = F.w_router + (size_t)(kw + 4 * h) * 32 + c31;
            f32x16 acc;
#pragma unroll
            for (int i = 0; i < 16; ++i) acc[i] = 0.f;
            float ss = 0.f;
#pragma unroll 4
            for (int m = 0; m < 32; ++m) { const f32x4 a = *(const f32x4*)(xr + 8 * m); const f32x4 g4 = *(const f32x4*)(gp + 8 * m); const float* wr_ = wp + (size_t)m * 256;
                const float b0 = g4.x * wr_[0], b1 = g4.y * wr_[32], b2 = g4.z * wr_[64], b3 = g4.w * wr_[96];
                ss += (a.x * a.x + a.y * a.y) + (a.z * a.z + a.w * a.w);
                acc = __builtin_amdgcn_mfma_f32_32x32x2f32(a.x, b0, acc, 0, 0, 0); acc = __builtin_amdgcn_mfma_f32_32x32x2f32(a.y, b1, acc, 0, 0, 0);
                acc = __builtin_amdgcn_mfma_f32_32x32x2f32(a.z, b2, acc, 0, 0, 0); acc = __builtin_amdgcn_mfma_f32_32x32x2f32(a.w, b3, acc, 0, 0, 0); }
            ss += __shfl_xor(ss, 32);
#pragma unroll
            for (int i = 0; i < 16; ++i) part[(w * 32 + crow(i, h)) * 33 + c31] = acc[i];
            if (h == 0) ssp[w * 32 + c31] = ss; }
        __syncthreads();
        { const int tok = tid >> 4, e0 = tid & 15; float s0 = 0.f, s1 = 0.f, sst = 0.f;
#pragma unroll
            for (int w2 = 0; w2 < 8; ++w2) { s0 += part[(w2 * 32 + tok) * 33 + e0]; s1 += part[(w2 * 32 + tok) * 33 + e0 + 16]; sst += ssp[w2 * 32 + tok]; }
            const float r = 1.0f / sqrtf(sst * (1.f / DM) + EPS);
            lg[tok * 33 + e0] = s0 * r + F.b_router[e0]; lg[tok * 33 + e0 + 16] = s1 * r + F.b_router[e0 + 16]; if (e0 == 0) rt[tok] = r; }
        __syncthreads();
#pragma unroll
        for (int it = 0; it < 2; ++it) { const int tok = 4 * w + 2 * it + h; const int m = t0 + tok;
            float v = lg[tok * 33 + c31]; float tv[4]; int ti[4];
#pragma unroll
            for (int k = 0; k < 4; ++k) { float bv = v; int bi = c31;
#pragma unroll
                for (int o = 1; o < 32; o <<= 1) { const float ov = __shfl_xor(bv, o); const int oi = __shfl_xor(bi, o); const bool take = (ov > bv) || (ov == bv && oi < bi); bv = take ? ov : bv; bi = take ? oi : bi; }
                tv[k] = bv; ti[k] = bi; v = (c31 == bi) ? -INFINITY : v; }
            const float e1 = fast_exp(tv[1] - tv[0]), e2 = fast_exp(tv[2] - tv[0]), e3 = fast_exp(tv[3] - tv[0]); const float inv = 1.0f / (1.0f + e1 + e2 + e3);
            if (c31 < 4) { const int ex = c31 == 0 ? ti[0] : c31 == 1 ? ti[1] : c31 == 2 ? ti[2] : ti[3]; const float gt = (c31 == 0 ? 1.0f : c31 == 1 ? e1 : c31 == 2 ? e2 : e3) * inv;
                const unsigned slot = __hip_atomic_fetch_add((unsigned*)(F.ctl + CW_CNT + 64 * ex), 1u, __ATOMIC_RELAXED, __HIP_MEMORY_SCOPE_AGENT);
                F.tokl[(size_t)ex * NTOK + slot] = m; F.tope[m * 4 + c31] = ex; F.tops[m * 4 + c31] = (int)slot; F.gate[m * 4 + c31] = gt; } }
#pragma unroll
        for (int q = 0; q < 4; ++q) { const int tok = 4 * w + q; const size_t m = (size_t)(t0 + tok); const float r = rt[tok];
            const f32x4* xr = (const f32x4*)(F.X1 + m * DM) + lane; const f32x4* gr = (const f32x4*)F.ffn_g + lane; unsigned* o4 = (unsigned*)((unsigned char*)F.H + m * DM) + lane;
            const float r8 = 8.0f * r;
#pragma unroll
            for (int j = 0; j < 8; ++j) { const f32x4 xv = xr[64 * j], gg = gr[64 * j];
                o4[64 * j] = pk4_fp8(clamp_fp8(xv.x * r8 * gg.x), clamp_fp8(xv.y * r8 * gg.y), clamp_fp8(xv.z * r8 * gg.z), clamp_fp8(xv.w * r8 * gg.w)); } }
        __syncthreads();
    }
}

DI void moe_tables(Frame& F) {
    LAS int* tb = (LAS int*)(F.lds + TBL_OFF);
    if (F.tid == 0) { int acc = 0;
        for (int e = 0; e < NEXP; ++e) { const int c = (int)__hip_atomic_load((unsigned*)(F.ctl + CW_CNT + 64 * e), __ATOMIC_RELAXED, __HIP_MEMORY_SCOPE_AGENT); tb[e] = acc; tb[40 + e] = c; acc += (c + 255) >> 8; }
        tb[32] = acc; }
    __syncthreads();
}
struct MoeProb {
    const bf16_t* A; const bf16_t* Bt; const int* tokl; const LAS int* tb; int K, NT  , brows  , G, c; bool gather;
    DI bool next_linear(int L, pg8::Unit& u) const {
        const int blk = L / NT, pn = L % NT; int e = 0;
        for (int j = 1; j < NEXP; ++j) e += (tb[j] <= blk) ? 1 : 0;
        const int rb = blk - tb[e]; int nr = tb[40 + e] - rb * 256; nr = nr > 256 ? 256 : nr;
        u.pm = blk; u.pn = pn; u.e = e; u.rb = rb; u.nrow = nr; return true;
    }
    DI bool next(int i, pg8::Unit& u) const {
        const int nb = tb[32]; const int x = c & 7, j = c >> 3, T = i * 8 + x, nsp = NT >> 3;
        const int blk = 4 * (T / nsp) + (j & 3), pn = 8 * (T % nsp) + (j >> 2);
        if (G != 256 || blk >= nb) { if (G == 256) return false; const int L = i * G + c; if (L >= nb * NT) return false; return next_linear(L, u); }
        int e = 0;
        for (int j = 1; j < NEXP; ++j) e += (tb[j] <= blk) ? 1 : 0;
        const int rb = blk - tb[e]; int nr = tb[40 + e] - rb * 256; nr = nr > 256 ? 256 : nr;
        u.pm = blk; u.pn = pn; u.e = e; u.rb = rb; u.nrow = nr; return true;
    }
    DI const char* a_base(const pg8::Unit& u) const { return gather ? (const char*)A : (const char*)A + (size_t)u.pm * 256 * K * 2; }
    DI const char* b_base(const pg8::Unit& u) const { return (const char*)Bt + ((size_t)u.e * brows + (size_t)u.pn * 256) * K * 2; }
    DI void a_voff(const pg8::Unit& u, const int (&R)[2], const int (&C)[2], unsigned (&v)[2][2]) const {
#pragma unroll
        for (int h = 0; h < 2; ++h)
#pragma unroll
            for (int i = 0; i < 2; ++i) { const int r = h * 128 + R[i];
                if (gather) { int tok = 0; if (r < u.nrow) tok = tokl[(size_t)u.e * NTOK + u.rb * 256 + r]; v[h][i] = (unsigned)(tok * K + C[i]) * 2u; }
                else v[h][i] = (unsigned)(r * K + C[i]) * 2u; }
    }
};

DI void final_phase(Frame& F) {
    const LAS int* tb = (const LAS int*)(F.lds + TBL_OFF);
    const int gw = F.vcu * NWAVES + F.wave, NGW = F.G * NWAVES, lane = F.lane;
    for (int m = gw; m < NTOK; m += NGW) {
        const bf16_t* yr[4]; float gt[4];
#pragma unroll
        for (int k = 0; k < 4; ++k) { const int e = F.tope[m * 4 + k], sl = F.tops[m * 4 + k]; gt[k] = F.gate[m * 4 + k]; yr[k] = F.Y + ((size_t)tb[e] * 256 + sl) * DM; }
        float v[4][8]; float ss = 0.f;
#pragma unroll
        for (int j = 0; j < 4; ++j) { const int c0 = 8 * (lane + 64 * j);
            const f32x4 x0 = *(const f32x4*)(F.X1 + (size_t)m * DM + c0), x1 = *(const f32x4*)(F.X1 + (size_t)m * DM + c0 + 4);
            float a[8] = {x0.x, x0.y, x0.z, x0.w, x1.x, x1.y, x1.z, x1.w};
#pragma unroll
            for (int k = 0; k < 4; ++k) { const u32x4 y = *(const u32x4*)(yr[k] + c0);
                a[0] += gt[k] * bf_lo(y.x); a[1] += gt[k] * bf_hi(y.x); a[2] += gt[k] * bf_lo(y.y); a[3] += gt[k] * bf_hi(y.y);
                a[4] += gt[k] * bf_lo(y.z); a[5] += gt[k] * bf_hi(y.z); a[6] += gt[k] * bf_lo(y.w); a[7] += gt[k] * bf_hi(y.w); }
#pragma unroll
            for (int q = 0; q < 8; ++q) { v[j][q] = a[q]; ss += a[q] * a[q]; } }
        const float r = 1.0f / sqrtf(wave_sum(ss) * (1.f / DM) + EPS);
#pragma unroll
        for (int j = 0; j < 4; ++j) { const int c0 = 8 * (lane + 64 * j);
            const f32x4 g0 = *(const f32x4*)(F.final_g + c0), g1 = *(const f32x4*)(F.final_g + c0 + 4);
            *(f32x4*)(F.out + (size_t)m * DM + c0) = (f32x4){v[j][0] * r * g0.x, v[j][1] * r * g0.y, v[j][2] * r * g0.z, v[j][3] * r * g0.w};
            *(f32x4*)(F.out + (size_t)m * DM + c0 + 4) = (f32x4){v[j][4] * r * g1.x, v[j][5] * r * g1.y, v[j][6] * r * g1.z, v[j][7] * r * g1.w}; }
    }
}
#ifndef MK_N_LAUNCHES
#define MK_N_LAUNCHES 1
#endif
constexpr int N_PHASES = 11;
struct Args { const float* in[16]; float* out; unsigned char* ws; int ph_lo, ph_hi; };
static_assert(sizeof(Args) == 16 * 8 + 8 + 8 + 8, "Args has no padding");

__global__ void __launch_bounds__(NWAVES * 64, 2) fwd_kernel(Args args) {
    extern __shared__ __attribute__((aligned(16))) unsigned char lds_raw[];
    Frame F;
    F.lds = (LAS unsigned char*)lds_raw;
    F.tid = threadIdx.x; F.lane = F.tid & 63; F.wave = __builtin_amdgcn_readfirstlane(F.tid >> 6);
    F.G = gridDim.x; { const int bx = blockIdx.x; F.vcu = (F.G % 8 == 0) ? (bx % 8) * (F.G / 8) + bx / 8 : bx; }
    unsigned char* ws = args.ws;
    F.ctl = (gu32*)(ws + WS_CTL);
    F.x = args.in[0]; F.attn_g = args.in[1]; F.w_in = args.in[2]; F.sinks = args.in[3]; F.w_alpha2 = args.in[4]; F.b_alpha = args.in[5]; F.gla_g = args.in[6]; F.w_out = args.in[7];
    F.ffn_g = args.in[8]; F.w_router = args.in[9]; F.b_router = args.in[10]; F.w_gu = args.in[11]; F.b_gu = args.in[12]; F.w_dn = args.in[13]; F.b_dn = args.in[14]; F.final_g = args.in[15];
    F.out = args.out;
    F.tope = (int*)(ws + WS_TOPE); F.tops = (int*)(ws + WS_TOPS); F.gate = (float*)(ws + WS_GATE); F.tokl = (int*)(ws + WS_TOKL);
    F.Win = (bf16_t*)(ws + WS_WIN); F.Wout = (bf16_t*)(ws + WS_WOUT); F.Wgu = (bf16_t*)(ws + WS_WGU); F.Wdn = (bf16_t*)(ws + WS_WDN);
    F.sa_h = (float*)(ws + WS_SAH); F.sa_mix = (float*)(ws + WS_SAMIX);
    F.H = (bf16_t*)(ws + WS_H); F.PROJ = (bf16_t*)(ws + WS_PROJ); F.OA = (bf16_t*)(ws + WS_OA); F.OB = (bf16_t*)(ws + WS_OB); F.MIX = (bf16_t*)(ws + WS_MIX);
    F.X1 = (float*)(ws + WS_X1); F.GQT = (bf16_t*)(ws + WS_GQT); F.GKT = (bf16_t*)(ws + WS_GKT); F.GATT = (bf16_t*)(ws + WS_GATT); F.GDEC = (float*)(ws + WS_GDEC); F.GVT = (bf16_t*)(ws + WS_GVT);
    F.ACT = (bf16_t*)(ws + WS_ACT); F.Y = (bf16_t*)(ws + WS_Y);
    for (int u = F.tid; u < (LDS_BYTES - LDSCTL_OFF) / 4; u += NWAVES * 64) ((LAS unsigned*)(F.lds + LDSCTL_OFF))[u] = 0u;
    __syncthreads();
    const int lo = args.ph_lo, hi = args.ph_hi;
    const bool use_bar = (hi - lo) > 1;
    XcdBarrier bar; bar.bar = (unsigned*)(F.ctl + CW_BAR); bar.x = 0; bar.st = nullptr;
    if (use_bar) bar = xcd_barrier_post((unsigned*)(F.ctl + CW_BAR), (volatile LAS unsigned*)(F.lds + MISC_OFF) + 8);
#define IN(k) (lo <= (k) && (k) < hi)
#define SEAM(k) do { if (IN(k) && IN((k) + 1)) xcd_barrier(bar); } while (0)

    if (IN(0)) { colmax_phase(F); }
    SEAM(0);
    if (IN(1)) { p0_prologue(F); }
    SEAM(1);
    if (IN(2)) {
        pg8::DenseProb P; P.A = F.H; P.Bt = F.Win; P.K = I8_P1 ? DM / 2 : DM; P.S.init(NTOK, LDP, F.G, (int)blockIdx.x);
        pg8::EpiBf16Plain<I8_P1> E{F.PROJ, LDP, F.sa_h, (const float*)(F.ctl + CW_CMAX_IN)};
        pg8::gemm_phase<I8_P1 ? GM_I8 : GM_BF16>(F.lds + RING_OFF, P, E);
    }
    SEAM(2);
    if (IN(3)) { gla_prep_phase(F); }
    SEAM(3);
    if (IN(4)) { if (F.vcu < 64) gla_scan_phase(F); swa_phase(F); late_copy_phase(F); }
    SEAM(4);
    if (IN(5)) { merge_phase(F); }
    SEAM(5);
    if (IN(6)) {
        pg8::DenseProb P; P.A = F.MIX; P.Bt = F.Wout; P.K = I8_P5 ? DM / 2 : DM; P.S.init(NTOK, DM, F.G, (int)blockIdx.x);
        pg8::EpiResF32<I8_P5> E{F.x, F.X1, DM, F.sa_mix, (const float*)(F.ctl + CW_CMAX_OUT)};
        pg8::gemm_phase<I8_P5 ? GM_I8 : GM_BF16>(F.lds + RING_OFF, P, E);
    }
    SEAM(6);
    if (IN(7)) { router_phase(F); }
    SEAM(7);
    if (IN(8)) {
        moe_tables(F);
        MoeProb P; P.A = F.H; P.Bt = F.Wgu; P.tokl = F.tokl; P.tb = (const LAS int*)(F.lds + TBL_OFF); P.K = DM / 2; P.NT = 16; P.brows = 4096; P.G = F.G; P.c = (int)blockIdx.x; P.gather = true;
        pg8::EpiGlu E{(unsigned char*)F.ACT, DFF, F.b_gu};
        pg8::gemm_phase<GM_FP8>(F.lds + RING_OFF, P, E);
    }
    SEAM(8);
    if (IN(9)) {
        moe_tables(F);
        MoeProb P; P.A = F.ACT; P.Bt = F.Wdn; P.tokl = F.tokl; P.tb = (const LAS int*)(F.lds + TBL_OFF); P.K = DFF / 2; P.NT = 8; P.brows = 2048; P.G = F.G; P.c = (int)blockIdx.x; P.gather = false;
        pg8::EpiBf16BiasE E{F.Y, DM, F.b_dn};
        pg8::gemm_phase<GM_FP8>(F.lds + RING_OFF, P, E);
    }
    SEAM(9);
    if (IN(10)) { moe_tables(F); final_phase(F); }
#undef IN
#undef SEAM
}

extern "C" void kernel_launch(void* const* d_in, const int* in_sizes, int n_in, void* d_out, int out_size, void* d_ws, size_t ws_size, hipStream_t stream) {
    static int grid = 0;
    if (grid == 0) {
        if (n_in != 16 || out_size != NTOK * DM || ws_size < WS_END) { fprintf(stderr, "kernel_launch: unexpected shapes (n_in %d, out %d, ws %zu, need %zu); nothing launched\n", n_in, out_size, ws_size, (size_t)WS_END); grid = -1; return; }
        int dev = 0, cus = 0, per_cu = 0;
        if (hipGetDevice(&dev) != hipSuccess || hipDeviceGetAttribute(&cus, hipDeviceAttributeMultiprocessorCount, dev) != hipSuccess) { fprintf(stderr, "kernel_launch: device query failed\n"); grid = -1; return; }
        if (hipFuncSetAttribute((const void*)fwd_kernel, hipFuncAttributeMaxDynamicSharedMemorySize, LDS_BYTES) != hipSuccess) { fprintf(stderr, "kernel_launch: hipFuncSetAttribute failed\n"); grid = -1; return; }
        if (hipOccupancyMaxActiveBlocksPerMultiprocessor(&per_cu, (const void*)fwd_kernel, NWAVES * 64, LDS_BYTES) != hipSuccess || per_cu < 1)
            fprintf(stderr, "kernel_launch: note: occupancy query reports %d workgroups per CU\n", per_cu);
        (void)hipGetLastError();
        grid = cus;
    }
    if (grid < 0) return;
    if (hipMemsetAsync((char*)d_ws + WS_CTL, 0, CTL_ZERO_BYTES, stream) != hipSuccess) { fprintf(stderr, "kernel_launch: hipMemsetAsync failed\n"); return; }
    Args a{};
    for (int i = 0; i < 16; ++i) a.in[i] = (const float*)d_in[i];
    a.out = (float*)d_out; a.ws = (unsigned char*)d_ws;
    if (MK_N_LAUNCHES == 1) { a.ph_lo = 0; a.ph_hi = N_PHASES; hipLaunchKernelGGL(fwd_kernel, dim3(grid), dim3(NWAVES * 64), LDS_BYTES, stream, a); }
    else for (int p = 0; p < N_PHASES; ++p) { a.ph_lo = p; a.ph_hi = p + 1; hipLaunchKernelGGL(fwd_kernel, dim3(grid), dim3(NWAVES * 64), LDS_BYTES, stream, a);
#ifdef MK_REPEAT_MASK
        if ((MK_REPEAT_MASK >> p) & 1) hipLaunchKernelGGL(fwd_kernel, dim3(grid), dim3(NWAVES * 64), LDS_BYTES, stream, a);
#endif
    }
    const hipError_t le = hipPeekAtLastError();
    if (le != hipSuccess) fprintf(stderr, "kernel_launch: launch failed: %s\n", hipGetErrorName(le));
}
```

```cpp
#define MK_N_LAUNCHES 1
#include <hip/hip_runtime.h>
#include <cstdio>
#include <cstdint>

#define DI __device__ __forceinline__
#define LAS __attribute__((address_space(3)))
#define GAS __attribute__((address_space(1)))
typedef unsigned short bf16_t;
typedef short bf16x8 __attribute__((ext_vector_type(8)));
typedef short s16x4 __attribute__((ext_vector_type(4)));
typedef float f32x4 __attribute__((ext_vector_type(4)));
typedef float f32x16 __attribute__((ext_vector_type(16)));
typedef unsigned u32x4 __attribute__((ext_vector_type(4)));
typedef unsigned u32x2 __attribute__((ext_vector_type(2)));
typedef float f32x2_t __attribute__((ext_vector_type(2)));
typedef __bf16 bf16x2_t __attribute__((ext_vector_type(2)));
typedef int i32x4 __attribute__((ext_vector_type(4)));
typedef int i32x8 __attribute__((ext_vector_type(8)));
DI unsigned pk4_fp8(float a, float b, float c, float d) { int p = __builtin_amdgcn_cvt_pk_fp8_f32(a, b, 0, false); p = __builtin_amdgcn_cvt_pk_fp8_f32(c, d, p, true); return (unsigned)p; }
DI float clamp_fp8(float x) { return fminf(fmaxf(x, -448.0f), 448.0f); }
constexpr int F8_SCALE_W = 0x79797979;
constexpr int F8_SCALE_A = 0x7c7c7c7c;
DI unsigned pk4_i8(float a, float b, float c, float d) {
    const int ia = (int)__builtin_rintf(fminf(fmaxf(a, -127.f), 127.f)), ib = (int)__builtin_rintf(fminf(fmaxf(b, -127.f), 127.f));
    const int ic = (int)__builtin_rintf(fminf(fmaxf(c, -127.f), 127.f)), id = (int)__builtin_rintf(fminf(fmaxf(d, -127.f), 127.f));
    return ((unsigned)ia & 0xffu) | (((unsigned)ib & 0xffu) << 8) | (((unsigned)ic & 0xffu) << 16) | ((unsigned)id << 24);
}
DI float wave_max(float v) {
#pragma unroll
    for (int o = 1; o < 64; o <<= 1) v = fmaxf(v, __shfl_xor(v, o));
    return v;
}
constexpr int GM_BF16 = 0, GM_FP8 = 1, GM_I8 = 2;

DI unsigned pk_bf16(float lo, float hi) { f32x2_t v = {lo, hi}; bf16x2_t b = __builtin_convertvector(v, bf16x2_t); return __builtin_bit_cast(unsigned, b); }
DI float bf_lo(unsigned w) { return __uint_as_float(w << 16); }
DI float bf_hi(unsigned w) { return __uint_as_float(w & 0xffff0000u); }
DI float bf2f(bf16_t v) { return __uint_as_float(((unsigned)v) << 16); }
DI bf16_t f2bf(float f) { return (bf16_t)(pk_bf16(f, 0.f) & 0xffffu); }
DI float fast_exp(float x) { return __builtin_amdgcn_exp2f(x * 1.4426950408889634f); }
DI float fast_rcp(float x) { return __builtin_amdgcn_rcpf(x); }
DI float fast_sigmoid(float x) { return fast_rcp(1.0f + fast_exp(-x)); }
DI float wave_sum(float v) {
#pragma unroll
    for (int o = 1; o < 64; o <<= 1) v += __shfl_xor(v, o);
    return v;
}
DI int crow(int reg, int h) { return (reg & 3) + 8 * (reg >> 2) + 4 * h; }
#define MFMA32(a, b, c) __builtin_amdgcn_mfma_f32_32x32x16_bf16((a), (b), (c), 0, 0, 0)

namespace pg8 {
constexpr int BM = 256, BK = 64, HALF = 128, HTB = HALF * BK * 2  , STAGE_BYTES = 8 * HTB, NXCD = 8, WGM = 8;

DI int lds_byte(int r, int c) { const int st = (r >> 4) * 2 + (c >> 5), rr = r & 15, cc = c & 31, ob = rr * 64 + cc * 2; return st * 1024 + (ob ^ (((ob >> 9) & 1) << 5)); }
DI void stage_rc(int b, int& R, int& C) { const int st = b / 1024, sb = b % 1024, swz = sb ^ (((sb >> 9) & 1) << 5); R = (st >> 1) * 16 + swz / 64; C = (st & 1) * 32 + (swz % 64) / 2; }
DI int perm32(int rho) { const int n = rho >> 4, i = rho & 15; return 8 * (i >> 2) + 4 * n + (i & 3); }

struct Unit { int pm, pn, e, rb, nrow; };

struct StaticOrder {
    int nM, nN, nwg, G, c;
    DI void init(int M, int N, int G_, int c_) { nM = M / BM; nN = N / BM; nwg = nM * nN; G = G_; c = c_; }
    DI bool next(int i, int& pm, int& pn) const {
        const long L = (long)i * G + c; if (L >= nwg) return false;
        int wgid = (int)L; { const int q = nwg / NXCD, r = nwg % NXCD, xcd = wgid % NXCD, off = wgid / NXCD; wgid = (xcd < r ? xcd * (q + 1) : r * (q + 1) + (xcd - r) * q) + off; }
        const int nig = WGM * nN, gid = wgid / nig, fm = gid * WGM, gsz = (nM - fm) < WGM ? (nM - fm) : WGM;
        pm = fm + ((wgid % nig) % gsz); pn = (wgid % nig) / gsz; return true;
    }
};

struct DenseProb {
    const bf16_t* A; const bf16_t* Bt; int K; StaticOrder S; int i0 = 0, i1 = 1 << 30;
    DI bool next(int i, Unit& u) const { int pm, pn; if (i + i0 >= i1 || !S.next(i + i0, pm, pn)) return false; u.pm = pm; u.pn = pn; u.e = 0; u.rb = 0; u.nrow = 256; return true; }
    DI const char* a_base(const Unit& u) const { return (const char*)A + (size_t)u.pm * 256 * K * 2; }
    DI const char* b_base(const Unit& u) const { return (const char*)Bt + (size_t)u.pn * 256 * K * 2; }
    DI void a_voff(const Unit&, const int (&R)[2], const int (&C)[2], unsigned (&v)[2][2]) const {
#pragma unroll
        for (int h = 0; h < 2; ++h)
#pragma unroll
            for (int i = 0; i < 2; ++i) v[h][i] = (unsigned)((h * HALF + R[i]) * K + C[i]) * 2u;
    }
};

template <int MODE, class Prob, class Epi>
DI void gemm_phase(LAS unsigned char* lds, const Prob& P, const Epi& E) {
    constexpr bool F8 = (MODE == GM_FP8);
    const int tid = threadIdx.x, wid = __builtin_amdgcn_readfirstlane(tid >> 6), lane = tid & 63, wr = wid >> 2, wc = wid & 3, fr = lane & 15, fq = lane >> 4;
    const int K = P.K, nt = K / BK;
    int sR[2], sC[2]; unsigned voffB[2];
#pragma unroll
    for (int i = 0; i < 2; ++i) { int R, C; stage_rc(tid * 16 + i * 8192, R, C); const int Rb = Epi::PERM ? ((R & ~31) + perm32(R & 31)) : R; sR[i] = R; sC[i] = C; voffB[i] = (unsigned)(Rb * K + C) * 2u; }
    const size_t kstep = (size_t)(BK * 2);
    const size_t hstep = (size_t)HALF * K * 2;
    const unsigned ldsw = (unsigned)wid * 1024u;
    const int aoff = lds_byte(wr * 64 + fr, fq * 8), boff = lds_byte(wc * 32 + fr, fq * 8);
#define PG8_SA(b, h) (((b) * 2 + (h)) * HTB)
#define PG8_SB(b, h) ((4 + (b) * 2 + (h)) * HTB)
#define PG8_STAGE2(bufoff, gbase, v0, v1) do { \
        __builtin_amdgcn_global_load_lds((const unsigned*)((const char*)(gbase) + (v0)), (LAS unsigned*)(lds + (bufoff) + ldsw), 16, 0, 0); \
        __builtin_amdgcn_global_load_lds((const unsigned*)((const char*)(gbase) + (v1)), (LAS unsigned*)(lds + (bufoff) + ldsw + 8192), 16, 0, 0); } while (0)
#define PG8_STAGEB(bufoff, gbase) PG8_STAGE2(bufoff, gbase, voffB[0], voffB[1])
#define PG8_LDA(dst, b, h) do { _Pragma("unroll") for (int m = 0; m < 4; ++m) { const i32x4 lo_ = *(const LAS i32x4*)(lds + PG8_SA(b, h) + aoff + m * 2048), hi_ = *(const LAS i32x4*)(lds + PG8_SA(b, h) + aoff + m * 2048 + 1024); \
        dst[m] = __builtin_shufflevector(lo_, hi_, 0, 1, 2, 3, 4, 5, 6, 7); } } while (0)
#define PG8_LDB(dst, b, h) do { _Pragma("unroll") for (int n = 0; n < 2; ++n) { const i32x4 lo_ = *(const LAS i32x4*)(lds + PG8_SB(b, h) + boff + n * 2048), hi_ = *(const LAS i32x4*)(lds + PG8_SB(b, h) + boff + n * 2048 + 1024); \
        dst[n] = __builtin_shufflevector(lo_, hi_, 0, 1, 2, 3, 4, 5, 6, 7); } } while (0)
#define PG8_MMA(ai, bj, At, Bt) do { __builtin_amdgcn_s_setprio(1); _Pragma("unroll") for (int m = 0; m < 4; ++m) _Pragma("unroll") for (int n = 0; n < 2; ++n) { \
        if constexpr (F8) asm volatile("v_mfma_scale_f32_16x16x128_f8f6f4 %0, %1, %2, %0, %3, %4 op_sel_hi:[0,0,0]" : "+v"(acc[ai][bj][m][n]) : "v"(Bt[n]), "v"(At[m]), "v"(f8sw), "v"(f8sa)); \
        else if constexpr (MODE == GM_I8) { i32x4 ci = __builtin_bit_cast(i32x4, acc[ai][bj][m][n]); \
               ci = __builtin_amdgcn_mfma_i32_16x16x64_i8(__builtin_shufflevector(Bt[n], Bt[n], 0, 1, 2, 3), __builtin_shufflevector(At[m], At[m], 0, 1, 2, 3), ci, 0, 0, 0); \
               ci = __builtin_amdgcn_mfma_i32_16x16x64_i8(__builtin_shufflevector(Bt[n], Bt[n], 4, 5, 6, 7), __builtin_shufflevector(At[m], At[m], 4, 5, 6, 7), ci, 0, 0, 0); acc[ai][bj][m][n] = __builtin_bit_cast(f32x4, ci); } \
        else { acc[ai][bj][m][n] = __builtin_amdgcn_mfma_f32_16x16x32_bf16(__builtin_bit_cast(bf16x8, __builtin_shufflevector(Bt[n], Bt[n], 0, 1, 2, 3)), __builtin_bit_cast(bf16x8, __builtin_shufflevector(At[m], At[m], 0, 1, 2, 3)), acc[ai][bj][m][n], 0, 0, 0); \
               acc[ai][bj][m][n] = __builtin_amdgcn_mfma_f32_16x16x32_bf16(__builtin_bit_cast(bf16x8, __builtin_shufflevector(Bt[n], Bt[n], 4, 5, 6, 7)), __builtin_bit_cast(bf16x8, __builtin_shufflevector(At[m], At[m], 4, 5, 6, 7)), acc[ai][bj][m][n], 0, 0, 0); } } \
        __builtin_amdgcn_s_setprio(0); } while (0)
#define PG8_WAIT_V(n) asm volatile("s_waitcnt vmcnt(" #n ")" ::: "memory")
#define PG8_WAIT_L(n) asm volatile("s_waitcnt lgkmcnt(" #n ")" ::: "memory")
#define PG8_BAR __builtin_amdgcn_s_barrier()
#define PG8_SCHED __builtin_amdgcn_sched_barrier(0)
    Unit cur, nxt; int ui = 0;
    if (!P.next(0, cur)) return;
    f32x4 acc[2][2][4][2];
#pragma unroll
    for (int a = 0; a < 2; ++a)
#pragma unroll
        for (int b = 0; b < 2; ++b)
#pragma unroll
            for (int m = 0; m < 4; ++m)
#pragma unroll
                for (int n = 0; n < 2; ++n) acc[a][b][m][n] = (f32x4){0.f, 0.f, 0.f, 0.f};
    i32x8 At[4], B0[2], B1[2];
    const int f8sw = F8_SCALE_W, f8sa = F8_SCALE_A;
    const char* cA = P.a_base(cur); const char* cB = P.b_base(cur);
    unsigned vAc[2][2], vAn[2][2];
    P.a_voff(cur, sR, sC, vAc);
    PG8_STAGEB(PG8_SB(0, 0), cB); PG8_STAGEB(PG8_SB(0, 1), cB + hstep); PG8_STAGE2(PG8_SA(0, 0), cA, vAc[0][0], vAc[0][1]); PG8_STAGE2(PG8_SA(0, 1), cA, vAc[1][0], vAc[1][1]);
    if (wr == 1) PG8_BAR;
    PG8_WAIT_V(2); PG8_BAR;
    PG8_STAGEB(PG8_SB(1, 0), cB + kstep); PG8_STAGE2(PG8_SA(1, 0), cA + kstep, vAc[0][0], vAc[0][1]); PG8_STAGEB(PG8_SB(1, 1), cB + hstep + kstep);
    PG8_WAIT_V(6); PG8_BAR;
    for (;;) {
        const bool has_next = P.next(ui + 1, nxt);
        const char* nA = cA; const char* nB = cB;
        if (has_next) { nA = P.a_base(nxt); nB = P.b_base(nxt); P.a_voff(nxt, sR, sC, vAn); }
        else {
#pragma unroll
            for (int h = 0; h < 2; ++h)
#pragma unroll
                for (int i = 0; i < 2; ++i) vAn[h][i] = vAc[h][i];
        }
        for (int t = 0; t < nt; t += 2) {
            const bool last = (t == nt - 2);
            const char* a1 = cA + (size_t)(t + 1) * kstep;
            const char* a2 = last ? nA : cA + (size_t)(t + 2) * kstep; const char* b2 = last ? nB : cB + (size_t)(t + 2) * kstep;
            const char* a3 = a2 + kstep; const char* b3 = b2 + kstep;
            const unsigned w00 = last ? vAn[0][0] : vAc[0][0], w01 = last ? vAn[0][1] : vAc[0][1], w10 = last ? vAn[1][0] : vAc[1][0], w11 = last ? vAn[1][1] : vAc[1][1];
            PG8_LDB(B0, 0, 0); PG8_LDB(B1, 0, 1); PG8_SCHED; PG8_LDA(At, 0, 0); PG8_STAGE2(PG8_SA(1, 1), a1, vAc[1][0], vAc[1][1]);
            PG8_WAIT_V(8); PG8_WAIT_L(0); PG8_BAR; PG8_MMA(0, 0, At, B0); PG8_MMA(0, 1, At, B1); PG8_BAR; PG8_SCHED;
            PG8_LDA(At, 0, 1); PG8_STAGEB(PG8_SB(0, 0), b2); PG8_STAGEB(PG8_SB(0, 1), b2 + hstep); PG8_STAGE2(PG8_SA(0, 0), a2, w00, w01);
            PG8_WAIT_V(8); PG8_WAIT_L(0); PG8_BAR; PG8_MMA(1, 0, At, B0); PG8_MMA(1, 1, At, B1); PG8_BAR; PG8_SCHED;
            PG8_LDB(B0, 1, 0); PG8_LDB(B1, 1, 1); PG8_SCHED; PG8_LDA(At, 1, 0); PG8_STAGE2(PG8_SA(0, 1), a2, w10, w11);
            PG8_WAIT_V(8); PG8_WAIT_L(0); PG8_BAR; PG8_MMA(0, 0, At, B0); PG8_MMA(0, 1, At, B1); PG8_BAR; PG8_SCHED;
            PG8_LDA(At, 1, 1); PG8_STAGEB(PG8_SB(1, 0), b3); PG8_STAGEB(PG8_SB(1, 1), b3 + hstep); PG8_STAGE2(PG8_SA(1, 0), a3, w00, w01);
            PG8_WAIT_V(8); PG8_WAIT_L(0); PG8_BAR; PG8_MMA(1, 0, At, B0); PG8_MMA(1, 1, At, B1); PG8_BAR; PG8_SCHED;
        }
        if (wr == 0) PG8_BAR;
        if constexpr (F8) asm volatile("s_nop 15\n\ts_nop 15" ::: "memory");
        E(acc, cur, wr, wc, fr, fq);
        if (!has_next) break;
#pragma unroll
        for (int a = 0; a < 2; ++a)
#pragma unroll
            for (int b = 0; b < 2; ++b)
#pragma unroll
                for (int m = 0; m < 4; ++m)
#pragma unroll
                    for (int n = 0; n < 2; ++n) acc[a][b][m][n] = (f32x4){0.f, 0.f, 0.f, 0.f};
        cur = nxt; cA = nA; cB = nB; ++ui;
#pragma unroll
        for (int h = 0; h < 2; ++h)
#pragma unroll
            for (int i = 0; i < 2; ++i) vAc[h][i] = vAn[h][i];
        if (wr == 1) PG8_BAR;
    }
    PG8_WAIT_V(0);
    PG8_BAR;
#undef PG8_SA
#undef PG8_SB
#undef PG8_STAGE2
#undef PG8_STAGEB
#undef PG8_LDA
#undef PG8_LDB
#undef PG8_MMA
#undef PG8_WAIT_V
#undef PG8_WAIT_L
#undef PG8_BAR
#undef PG8_SCHED
}
}
namespace pg8 {
template <bool I8> struct EpiBf16Plain {
    static constexpr bool PERM = true;
    bf16_t* O; int ldc; const float* sa; const float* cm;
    DI void operator()(const f32x4 (&acc)[2][2][4][2], const Unit& u, int wr, int wc, int fr, int fq) const {
        const int row0 = u.pm * BM + wr * 64 + fr, col0 = u.pn * BM + wc * 32 + 8 * fq;
        f32x4 sb[2][2];
        if constexpr (I8) {
#pragma unroll
            for (int bj = 0; bj < 2; ++bj)
#pragma unroll
                for (int n = 0; n < 2; ++n) sb[bj][n] = *(const f32x4*)(cm + col0 + bj * HALF + 4 * n) * (1.0f / 127.0f); }
#pragma unroll
        for (int ai = 0; ai < 2; ++ai)
#pragma unroll
            for (int m = 0; m < 4; ++m) { const int row = row0 + ai * HALF + m * 16; bf16_t* rowp = O + (size_t)row * ldc + col0; float sr = 1.f; if constexpr (I8) sr = sa[row];
#pragma unroll
                for (int bj = 0; bj < 2; ++bj) { f32x4 v0 = acc[ai][bj][m][0], v1 = acc[ai][bj][m][1];
                    if constexpr (I8) { const i32x4 i0 = __builtin_bit_cast(i32x4, v0), i1 = __builtin_bit_cast(i32x4, v1);
                        v0 = (f32x4){(float)i0[0], (float)i0[1], (float)i0[2], (float)i0[3]} * sb[bj][0] * sr; v1 = (f32x4){(float)i1[0], (float)i1[1], (float)i1[2], (float)i1[3]} * sb[bj][1] * sr; }
                    u32x4 w; w.x = pk_bf16(v0[0], v0[1]); w.y = pk_bf16(v0[2], v0[3]); w.z = pk_bf16(v1[0], v1[1]); w.w = pk_bf16(v1[2], v1[3]);
                    *(u32x4*)(rowp + bj * HALF) = w; } }
    }
};
template <bool I8> struct EpiResF32 {
    static constexpr bool PERM = true;
    const float* base; float* C; int ldc; const float* sa; const float* cm;
    DI void operator()(const f32x4 (&acc)[2][2][4][2], const Unit& u, int wr, int wc, int fr, int fq) const {
        const int row0 = u.pm * BM + wr * 64 + fr, col0 = u.pn * BM + wc * 32 + 8 * fq;
        f32x4 sb[2][2];
        if constexpr (I8) {
#pragma unroll
            for (int bj = 0; bj < 2; ++bj)
#pragma unroll
                for (int n = 0; n < 2; ++n) sb[bj][n] = *(const f32x4*)(cm + col0 + bj * HALF + 4 * n) * (1.0f / 127.0f); }
#pragma unroll
        for (int ai = 0; ai < 2; ++ai)
#pragma unroll
            for (int m = 0; m < 4; ++m) { const int row = row0 + ai * HALF + m * 16; const size_t off = (size_t)row * ldc + col0; float sr = 1.f; if constexpr (I8) sr = sa[row];
#pragma unroll
                for (int bj = 0; bj < 2; ++bj)
#pragma unroll
                    for (int n = 0; n < 2; ++n) { f32x4 v = acc[ai][bj][m][n];
                        if constexpr (I8) { const i32x4 iv = __builtin_bit_cast(i32x4, v); v = (f32x4){(float)iv[0], (float)iv[1], (float)iv[2], (float)iv[3]} * sb[bj][n] * sr; }
                        const f32x4 bs = *(const f32x4*)(base + off + bj * HALF + 4 * n); *(f32x4*)(C + off + bj * HALF + 4 * n) = bs + v; } }
    }
};
struct EpiGlu {
    static constexpr bool PERM = true;
    unsigned char* O; int ldc; const float* bias;
    DI void operator()(const f32x4 (&acc)[2][2][4][2], const Unit& u, int wr, int wc, int fr, int fq) const {
        const int row0 = u.pm * BM + wr * 64 + fr, colg = u.pn * HALF + wc * 32 + 8 * fq;
        const float* bg = bias + (size_t)u.e * 4096 + colg;
        f32x4 bgl[2], bln[2];
#pragma unroll
        for (int n = 0; n < 2; ++n) { bgl[n] = *(const f32x4*)(bg + 4 * n); bln[n] = *(const f32x4*)(bg + 2048 + 4 * n); }
#pragma unroll
        for (int ai = 0; ai < 2; ++ai)
#pragma unroll
            for (int m = 0; m < 4; ++m) { unsigned char* rowp = O + (size_t)(row0 + ai * HALF + m * 16) * ldc + colg;
                float r[8];
#pragma unroll
                for (int n = 0; n < 2; ++n)
#pragma unroll
                    for (int j = 0; j < 4; ++j) { float g = acc[ai][0][m][n][j] + bgl[n][j], l = acc[ai][1][m][n][j] + bln[n][j];
                        g = fminf(g, 7.0f); l = fminf(fmaxf(l, -7.0f), 7.0f);
                        r[4 * n + j] = clamp_fp8(8.0f * (g * fast_sigmoid(1.702f * g) * (l + 1.0f))); }
                u32x2 w; w.x = pk4_fp8(r[0], r[1], r[2], r[3]); w.y = pk4_fp8(r[4], r[5], r[6], r[7]);
                *(u32x2*)rowp = w; }
    }
};
struct EpiBf16BiasE {
    static constexpr bool PERM = true;
    bf16_t* O; int ldc; const float* bias;
    DI void operator()(const f32x4 (&acc)[2][2][4][2], const Unit& u, int wr, int wc, int fr, int fq) const {
        const int row0 = u.pm * BM + wr * 64 + fr, col0 = u.pn * BM + wc * 32 + 8 * fq;
        const float* bp = bias + (size_t)u.e * 2048 + col0;
        f32x4 bv[2][2];
#pragma unroll
        for (int bj = 0; bj < 2; ++bj)
#pragma unroll
            for (int n = 0; n < 2; ++n) bv[bj][n] = *(const f32x4*)(bp + bj * HALF + 4 * n);
#pragma unroll
        for (int ai = 0; ai < 2; ++ai)
#pragma unroll
            for (int m = 0; m < 4; ++m) { bf16_t* rowp = O + (size_t)(row0 + ai * HALF + m * 16) * ldc + col0;
#pragma unroll
                for (int bj = 0; bj < 2; ++bj) { const f32x4 v0 = acc[ai][bj][m][0] + bv[bj][0], v1 = acc[ai][bj][m][1] + bv[bj][1];
                    u32x4 w; w.x = pk_bf16(v0[0], v0[1]); w.y = pk_bf16(v0[2], v0[3]); w.z = pk_bf16(v1[0], v1[1]); w.w = pk_bf16(v1[2], v1[3]);
                    *(u32x4*)(rowp + bj * HALF) = w; } }
    }
};
}
constexpr int NWAVES = 8;
constexpr int NTOK = 16384, DM = 2048, SEQ = 2048, NBATCH = 8;
constexpr int DIN = 12816, LDP = 13056;
constexpr int C_QA = 0, C_KA = 2048, C_VA = 2304, C_QB = 2560, C_KB = 3584, C_VB = 4608, C_RB = 6656, C_GA = 8704, C_GB = 10752, C_ALR = 12800;
constexpr int NEXP = 32, TOPK = 4, DFF = 2048;
constexpr int PMAX = 73728;
constexpr float EPS = 1e-5f;
constexpr float LOG2E = 1.4426950408889634f;
#ifndef MK_I8_P1
#define MK_I8_P1 1
#endif
#ifndef MK_I8_P5
#define MK_I8_P5 0
#endif
constexpr bool I8_P1 = MK_I8_P1 != 0, I8_P5 = MK_I8_P5 != 0;
constexpr bool I8_DENSE = I8_P1 || I8_P5;
#ifndef MK_MIX_CLIP
#define MK_MIX_CLIP 1e30f
#endif
constexpr float MIX_CLIP = MK_MIX_CLIP;

constexpr size_t MiB = 1u << 20;
constexpr size_t WS_CTL = 0, CTL_ZERO_BYTES = 1 * MiB;
constexpr size_t WS_TOPE = 1 * MiB;
constexpr size_t WS_TOPS = WS_TOPE + (size_t)NTOK * 4 * 4;
constexpr size_t WS_GATE = WS_TOPS + (size_t)NTOK * 4 * 4;
constexpr size_t WS_TOKL = WS_GATE + (size_t)NTOK * 4 * 4;
constexpr size_t WS_WIN  = 4 * MiB;
constexpr size_t WS_WOUT = WS_WIN + (size_t)LDP * DM * 2;
constexpr size_t WS_WGU  = WS_WOUT + (size_t)DM * DM * 2;
constexpr size_t WS_WDN  = WS_WGU + (size_t)NEXP * 4096 * DM * 2;
constexpr size_t WS_H    = WS_WDN + (size_t)NEXP * DM * DM * 2;
constexpr size_t WS_PROJ = WS_H + (size_t)NTOK * DM * 2;
constexpr size_t WS_OA   = WS_PROJ + (size_t)NTOK * LDP * 2;
constexpr size_t WS_OB   = WS_OA + (size_t)NTOK * DM * 2;
constexpr size_t WS_MIX  = WS_OB + (size_t)NTOK * DM * 2;
constexpr size_t WS_X1   = WS_MIX + (size_t)NTOK * DM * 2;
constexpr size_t WS_GQT  = WS_X1 + (size_t)NTOK * DM * 4;
constexpr size_t WS_GKT  = WS_GQT + (size_t)1024 * 16384 * 2;
constexpr size_t WS_GATT = WS_GKT + (size_t)1024 * 16384 * 2;
constexpr size_t WS_GDEC = WS_GATT + (size_t)1024 * 4096 * 2;
constexpr size_t WS_GVT  = WS_GDEC + (size_t)1024 * 256 * 4;
constexpr size_t WS_ACT  = WS_GVT + (size_t)1024 * 32768 * 2;
constexpr size_t WS_Y    = WS_ACT + (size_t)PMAX * DFF * 2;
constexpr size_t WS_END  = WS_Y + (size_t)PMAX * DM * 2;
constexpr size_t WS_SAH  = WS_TOKL + (size_t)NEXP * NTOK * 4;
constexpr size_t WS_SAMIX = WS_SAH + (size_t)NTOK * 4;
static_assert(WS_SAMIX + (size_t)NTOK * 4 <= WS_WIN, "row scales below the weight copies");
static_assert(WS_WIN % 256 == 0 && WS_WOUT % 256 == 0 && WS_WGU % 256 == 0 && WS_WDN % 256 == 0 && WS_H % 256 == 0 && WS_PROJ % 256 == 0 && WS_OA % 256 == 0 && WS_X1 % 256 == 0 &&
              WS_GQT % 256 == 0 && WS_GKT % 256 == 0 && WS_GATT % 256 == 0 && WS_GDEC % 256 == 0 && WS_GVT % 256 == 0 && WS_ACT % 256 == 0 && WS_Y % 256 == 0, "alignment");
constexpr int CW_TMO = 0, CW_CODE = 1;
constexpr int CW_BAR = 4096;
constexpr int CW_CNT = 8192;
constexpr int CW_SWAQ = CW_CNT + 64 * 40;
constexpr int CW_CVQ = CW_CNT + 64 * 41;
constexpr int P0_NITEMS = 16 * 408 + 16 * 64 + 32 * 16 * 128 + 32 * 16 * 64;
constexpr int P0_EARLY = 16 * 408 + 16 * 64;
constexpr int P0_LATE = 24576;
constexpr int P0_EMBED = P0_NITEMS - P0_EARLY - P0_LATE;
constexpr int EMB_CHUNKS = 4, EMB_PER_WAVE = P0_EMBED / 2048 / EMB_CHUNKS;
static_assert(P0_EMBED == 2048 * EMB_CHUNKS * EMB_PER_WAVE, "embedded copy items divide evenly over 2048 waves and the chunks");
constexpr int CV_GROUP = 8, CV_NGROUPS = P0_LATE / CV_GROUP;
constexpr int CW_CMAX_IN = 16384, CW_CMAX_OUT = CW_CMAX_IN + LDP;
static_assert((CW_CMAX_OUT + DM) * 4 <= (int)CTL_ZERO_BYTES, "CTL words inside the memset region");
constexpr int RING_OFF = 0, RING_BYTES = 131072;
constexpr int LDSCTL_OFF = RING_BYTES, MISC_OFF = LDSCTL_OFF + 320;
constexpr int TBL_OFF = LDSCTL_OFF + 1024;
constexpr int LDS_BYTES = 147456;
static_assert(MISC_OFF + 128 <= TBL_OFF && TBL_OFF + 4096 <= LDS_BYTES, "LDS map");

typedef GAS unsigned gu32;
#define RLX_AGENT __ATOMIC_RELAXED, __HIP_MEMORY_SCOPE_AGENT
#define LDS_WAIT() asm volatile("s_waitcnt lgkmcnt(0)" ::: "memory")
#define VM_WAIT() asm volatile("s_waitcnt vmcnt(0)" ::: "memory")

#define XB_TMO      128
#define XB_XCNT(j)  (256  + 64 * (j))
#define XB_XSUB(j)  (1280 + 64 * (j))
#define XB_XGEN(j)  (2304 + 64 * (j))
#define XB_TOP      3328
#define XB_TOPGEN   3392
#define XCD_BAR_WORDS 3456
#define XB_SPIN_CAP (1u << 18)

__device__ __forceinline__ unsigned xb_ld(unsigned* p)              { return __hip_atomic_load(p, __ATOMIC_RELAXED, __HIP_MEMORY_SCOPE_AGENT); }
__device__ __forceinline__ unsigned xb_add(unsigned* p, unsigned v) { return __hip_atomic_fetch_add(p, v, __ATOMIC_RELAXED, __HIP_MEMORY_SCOPE_AGENT); }
__device__ __forceinline__ unsigned xb_xcc_id() { return (unsigned)__builtin_amdgcn_s_getreg((3 << 11) | 20) & 0xFu; }
#define XB_SPIN(cond, bar) do { unsigned _sp = 0; while (cond) { __builtin_amdgcn_s_sleep(1); \
    if ((++_sp & 255u) == 0u) { if (xb_ld(&(bar)[XB_TMO])) break; if (_sp > XB_SPIN_CAP) { atomicAdd(&(bar)[XB_TMO], 1u); break; } } } } while (0)

struct XcdBarrier {
    unsigned* bar; unsigned x;
    volatile LAS unsigned* st;
};

__device__ __forceinline__ XcdBarrier xcd_barrier_post(unsigned* bar, volatile LAS unsigned* st) {
    XcdBarrier b; b.bar = bar; b.x = xb_xcc_id(); b.st = st;
    if (threadIdx.x == 0) (void)xb_add(&bar[XB_XCNT(b.x)], 1u);
    return b;
}
__device__ __forceinline__ void xcd_barrier_complete(unsigned* bar, unsigned x, unsigned& nloc, unsigned& nx) {
    const unsigned G = gridDim.x * gridDim.y * gridDim.z;
    unsigned sum, cnt, mine, sp = 0u;
    for (;;) {
        sum = 0u; cnt = 0u; mine = 0u;
#pragma unroll
        for (unsigned j = 0; j < 16; ++j) { const unsigned c = xb_ld(&bar[XB_XCNT(j)]); sum += c; cnt += (c > 0u) ? 1u : 0u; mine = (j == x) ? c : mine; }
        if (sum == G) break;
        __builtin_amdgcn_s_sleep(1);
        if ((++sp & 255u) == 0u) { if (xb_ld(&bar[XB_TMO])) break; if (sp > XB_SPIN_CAP) { atomicAdd(&bar[XB_TMO], 1u); break; } }
    }
    nloc = mine > 0u ? mine : 1u; nx = cnt > 0u ? cnt : 1u;
}

__device__ __forceinline__ void xcd_barrier(const XcdBarrier& b) {
    asm volatile("s_waitcnt vmcnt(0)" ::: "memory");
    __syncthreads();
    if (threadIdx.x == 0) {
        unsigned* bar = b.bar;
        __builtin_amdgcn_s_waitcnt(0);
        unsigned nloc = b.st[0], nx = b.st[1];
        if (nloc == 0u) { xcd_barrier_complete(bar, b.x, nloc, nx); b.st[0] = nloc; b.st[1] = nx; }
        const unsigned old = xb_add(&bar[XB_XSUB(b.x)], 1u);
        const unsigned gen = old / nloc;
        if (old + 1u == (gen + 1u) * nloc) {
            __builtin_amdgcn_fence(__ATOMIC_RELEASE, "agent");
            asm volatile("s_waitcnt vmcnt(0)" ::: "memory");
            const unsigned og = xb_add(&bar[XB_TOP], 1u);
            const unsigned tg = og / nx;
            if (og + 1u == (tg + 1u) * nx) xb_add(&bar[XB_TOPGEN], 1u);
            else XB_SPIN(xb_ld(&bar[XB_TOPGEN]) == tg, bar);
            __builtin_amdgcn_fence(__ATOMIC_ACQUIRE, "agent");
            xb_add(&bar[XB_XGEN(b.x)], 1u);
            asm volatile("s_waitcnt vmcnt(0)" ::: "memory");
        } else {
            XB_SPIN(xb_ld(&bar[XB_XGEN(b.x)]) == gen, bar);
            __builtin_amdgcn_fence(__ATOMIC_ACQUIRE, "agent");
            asm volatile("s_waitcnt vmcnt(0)" ::: "memory");
        }
    }
    __syncthreads();
}

struct Frame {
    LAS unsigned char* lds;
    gu32* ctl;
    int tid, lane, wave, vcu, G;
    const float *x, *attn_g, *w_in, *sinks, *w_alpha2, *b_alpha, *gla_g, *w_out, *ffn_g, *w_router, *b_router, *w_gu, *b_gu, *w_dn, *b_dn, *final_g;
    float* out;
    int *tope, *tops, *tokl; float* gate;
    float *sa_h, *sa_mix;
    bf16_t *Win, *Wout, *Wgu, *Wdn, *H, *PROJ, *OA, *OB, *MIX, *GQT, *GKT, *GATT, *GVT, *ACT, *Y;
    float *X1, *GDEC;
};
DI void p0_transpose_item(const float* Wsrc, int ldw, int srccol0, int nvalid, int k0, bf16_t* dst, int K, LAS float* scr, int lane) {
    const int krow = lane >> 3, n4 = lane & 7;
    const bool ok = 4 * n4 < nvalid;
#pragma unroll
    for (int i = 0; i < 8; ++i) { const int kk = 8 * i + krow; f32x4 v = (f32x4){0.f, 0.f, 0.f, 0.f};
        if (ok) v = *(const f32x4*)(Wsrc + (size_t)(k0 + kk) * ldw + srccol0 + 4 * n4);
        LAS float* d = scr + kk * 33 + 4 * n4; d[0] = v[0]; d[1] = v[1]; d[2] = v[2]; d[3] = v[3]; }
    LDS_WAIT(); asm volatile("" ::: "memory");
    const int c = lane & 7;
#pragma unroll
    for (int j = 0; j < 4; ++j) { const int n = (lane >> 3) + 8 * j; const LAS float* s = scr + (8 * c) * 33 + n;
        u32x4 o; o.x = pk_bf16(s[0 * 33], s[1 * 33]); o.y = pk_bf16(s[2 * 33], s[3 * 33]); o.z = pk_bf16(s[4 * 33], s[5 * 33]); o.w = pk_bf16(s[6 * 33], s[7 * 33]);
        *(u32x4*)(dst + (size_t)n * K + k0 + 8 * c) = o; }
    LDS_WAIT(); asm volatile("" ::: "memory");
}
DI void rms_row_to_bf16(const float* xrow, const float* g, bf16_t* orow, int lane) {
    const f32x4* xr = (const f32x4*)xrow + lane; const f32x4* gr = (const f32x4*)g + lane;
    f32x4 v[8]; float s = 0.f;
#pragma unroll
    for (int j = 0; j < 8; ++j) { v[j] = xr[64 * j]; s += (v[j].x * v[j].x + v[j].y * v[j].y) + (v[j].z * v[j].z + v[j].w * v[j].w); }
    const float r = 1.0f / sqrtf(wave_sum(s) * (1.f / DM) + EPS);
    u32x2* o8 = (u32x2*)orow + lane;
#pragma unroll
    for (int j = 0; j < 8; ++j) { const f32x4 gg = gr[64 * j]; u32x2 w; w.x = pk_bf16(v[j].x * r * gg.x, v[j].y * r * gg.y); w.y = pk_bf16(v[j].z * r * gg.z, v[j].w * r * gg.w); o8[64 * j] = w; }
}
DI void p0_transpose_item_f8(const float* Wsrc, int ldw, int srccol0, int nvalid, int k0, unsigned char* dst, int K, LAS float* scr, int lane) {
    const int krow = lane >> 3, n4 = lane & 7;
    const bool ok = 4 * n4 < nvalid;
#pragma unroll
    for (int i = 0; i < 8; ++i) { const int kk = 8 * i + krow; f32x4 v = (f32x4){0.f, 0.f, 0.f, 0.f};
        if (ok) v = *(const f32x4*)(Wsrc + (size_t)(k0 + kk) * ldw + srccol0 + 4 * n4);
        LAS float* d = scr + kk * 33 + 4 * n4; d[0] = v[0]; d[1] = v[1]; d[2] = v[2]; d[3] = v[3]; }
    LDS_WAIT(); asm volatile("" ::: "memory");
    const int c = lane & 7;
#pragma unroll
    for (int j = 0; j < 4; ++j) { const int n = (lane >> 3) + 8 * j; const LAS float* s = scr + (8 * c) * 33 + n;
        u32x2 o; o.x = pk4_fp8(64.f * s[0 * 33], 64.f * s[1 * 33], 64.f * s[2 * 33], 64.f * s[3 * 33]); o.y = pk4_fp8(64.f * s[4 * 33], 64.f * s[5 * 33], 64.f * s[6 * 33], 64.f * s[7 * 33]);
        *(u32x2*)(dst + (size_t)n * K + k0 + 8 * c) = o; }
    LDS_WAIT(); asm volatile("" ::: "memory");
}
DI void rms_row_to_f8(const float* xrow, const float* g, unsigned char* orow, int lane) {
    const f32x4* xr = (const f32x4*)xrow + lane; const f32x4* gr = (const f32x4*)g + lane;
    f32x4 v[8]; float s = 0.f;
#pragma unroll
    for (int j = 0; j < 8; ++j) { v[j] = xr[64 * j]; s += (v[j].x * v[j].x + v[j].y * v[j].y) + (v[j].z * v[j].z + v[j].w * v[j].w); }
    const float r = 8.0f / sqrtf(wave_sum(s) * (1.f / DM) + EPS);
    unsigned* o4 = (unsigned*)orow + lane;
#pragma unroll
    for (int j = 0; j < 8; ++j) { const f32x4 gg = gr[64 * j]; o4[64 * j] = pk4_fp8(clamp_fp8(v[j].x * r * gg.x), clamp_fp8(v[j].y * r * gg.y), clamp_fp8(v[j].z * r * gg.z), clamp_fp8(v[j].w * r * gg.w)); }
}
struct P0Item { const float* src; unsigned char* dst; int ldw, pitch, mode; bool ok, live; f32x4 inv; };
DI f32x4 p0_inv(const float* cmax) { const f32x4 c = *(const f32x4*)cmax; return (f32x4){127.f / fmaxf(c.x, 1e-30f), 127.f / fmaxf(c.y, 1e-30f), 127.f / fmaxf(c.z, 1e-30f), 127.f / fmaxf(c.w, 1e-30f)}; }
DI P0Item p0_decode(Frame& F, int it, int nitems, int lane) {
    constexpr int I_IN = 16 * 408, I_OUT = 16 * 64, I_GU = 32 * 16 * 128;
    const int kc = lane >> 3, n4 = lane & 7;
    P0Item d; d.live = it < nitems; d.ok = true; d.mode = GM_FP8; d.ldw = DM; d.pitch = DM; d.src = F.w_in; d.dst = (unsigned char*)F.Win; d.inv = (f32x4){0.f, 0.f, 0.f, 0.f};
    if (!d.live) { d.ok = false; return d; }
    int r = it;
    int dmode = I8_P1 ? GM_I8 : GM_BF16, esz = I8_P1 ? 1 : 2;
    if (r < I_IN) { const int kb = r / 408, nb = r % 408, n0 = 32 * nb; int sc = n0, nv = 32;
        if (n0 >= 8704 && n0 < 12800) sc = n0 + 16; else if (n0 == 12800) { sc = 8704; nv = 16; } else if (n0 > 12800) { sc = 0; nv = 0; }
        d.mode = dmode; d.ok = 4 * n4 < nv; d.ldw = DIN; d.src = F.w_in + (size_t)(128 * kb + 16 * kc) * DIN + sc + 4 * n4;
        if (I8_P1) d.inv = p0_inv((const float*)(F.ctl + CW_CMAX_IN) + n0 + 4 * n4);
        d.pitch = DM * esz; d.dst = (unsigned char*)F.Win + (size_t)(n0 + 4 * n4) * d.pitch + (128 * kb + 16 * kc) * esz; return d; }
    r -= I_IN; dmode = I8_P5 ? GM_I8 : GM_BF16; esz = I8_P5 ? 1 : 2;
    if (r < I_OUT) { const int kb = r / 64, nb = r % 64; d.mode = dmode; d.ldw = DM; d.src = F.w_out + (size_t)(128 * kb + 16 * kc) * DM + 32 * nb + 4 * n4;
        if (I8_P5) d.inv = p0_inv((const float*)(F.ctl + CW_CMAX_OUT) + 32 * nb + 4 * n4);
        d.pitch = DM * esz; d.dst = (unsigned char*)F.Wout + (size_t)(32 * nb + 4 * n4) * d.pitch + (128 * kb + 16 * kc) * esz; return d; }
    r -= I_OUT;
    if (r < I_GU) { const int e = r / 2048, rr = r % 2048, kb = rr / 128, nb = rr % 128, n0 = 32 * nb, pn = n0 >> 8, i0 = n0 & 255;
        const int sc = (i0 < 128) ? (128 * pn + i0) : (2048 + 128 * pn + i0 - 128);
        d.ldw = 4096; d.src = F.w_gu + (size_t)e * DM * 4096 + (size_t)(128 * kb + 16 * kc) * 4096 + sc + 4 * n4; d.pitch = DM;
        d.dst = (unsigned char*)F.Wgu + ((size_t)e * 4096 + n0 + 4 * n4) * DM + 128 * kb + 16 * kc; return d; }
    r -= I_GU;
    { const int e = r / 1024, rr = r % 1024, kb = rr / 64, nb = rr % 64;
        d.ldw = DM; d.src = F.w_dn + (size_t)e * DFF * DM + (size_t)(128 * kb + 16 * kc) * DM + 32 * nb + 4 * n4; d.pitch = DFF;
        d.dst = (unsigned char*)F.Wdn + ((size_t)e * DM + 32 * nb + 4 * n4) * DFF + 128 * kb + 16 * kc; return d; }
}
DI void p0_load(const P0Item& d, f32x4 (&v)[16]) {
#pragma unroll
    for (int j = 0; j < 16; ++j) { v[j] = (f32x4){0.f, 0.f, 0.f, 0.f}; if (d.ok) v[j] = __builtin_nontemporal_load((const f32x4*)(d.src + (size_t)j * d.ldw)); }
}
DI void p0_store(const P0Item& d, const f32x4 (&v)[16]) {
    if (!d.live) return;
    if (d.mode == GM_FP8) {
#pragma unroll
        for (int q = 0; q < 4; ++q) { u32x4 o; o.x = pk4_fp8(64.f * v[0][q], 64.f * v[1][q], 64.f * v[2][q], 64.f * v[3][q]); o.y = pk4_fp8(64.f * v[4][q], 64.f * v[5][q], 64.f * v[6][q], 64.f * v[7][q]);
            o.z = pk4_fp8(64.f * v[8][q], 64.f * v[9][q], 64.f * v[10][q], 64.f * v[11][q]); o.w = pk4_fp8(64.f * v[12][q], 64.f * v[13][q], 64.f * v[14][q], 64.f * v[15][q]);
            __builtin_nontemporal_store(o, (u32x4*)(d.dst + (size_t)q * d.pitch)); }
    } else if (d.mode == GM_I8) {
#pragma unroll
        for (int q = 0; q < 4; ++q) { const float s = d.inv[q]; u32x4 o; o.x = pk4_i8(s * v[0][q], s * v[1][q], s * v[2][q], s * v[3][q]); o.y = pk4_i8(s * v[4][q], s * v[5][q], s * v[6][q], s * v[7][q]);
            o.z = pk4_i8(s * v[8][q], s * v[9][q], s * v[10][q], s * v[11][q]); o.w = pk4_i8(s * v[12][q], s * v[13][q], s * v[14][q], s * v[15][q]);
            *(u32x4*)(d.dst + (size_t)q * d.pitch) = o; }
    } else {
#pragma unroll
        for (int q = 0; q < 4; ++q) { u32x4 o; o.x = pk_bf16(v[0][q], v[1][q]); o.y = pk_bf16(v[2][q], v[3][q]); o.z = pk_bf16(v[4][q], v[5][q]); o.w = pk_bf16(v[6][q], v[7][q]);
            *(u32x4*)(d.dst + (size_t)q * d.pitch) = o;
            o.x = pk_bf16(v[8][q], v[9][q]); o.y = pk_bf16(v[10][q], v[11][q]); o.z = pk_bf16(v[12][q], v[13][q]); o.w = pk_bf16(v[14][q], v[15][q]);
            *(u32x4*)(d.dst + (size_t)q * d.pitch + 16) = o; }
    }
}
DI void rms_row_to_i8(const float* xrow, const float* g, unsigned char* orow, float* sa, int lane) {
    const f32x4* xr = (const f32x4*)xrow + lane; const f32x4* gr = (const f32x4*)g + lane;
    f32x4 v[8]; float s = 0.f;
#pragma unroll
    for (int j = 0; j < 8; ++j) { v[j] = xr[64 * j]; s += (v[j].x * v[j].x + v[j].y * v[j].y) + (v[j].z * v[j].z + v[j].w * v[j].w); }
    const float r = 1.0f / sqrtf(wave_sum(s) * (1.f / DM) + EPS);
    float am = 0.f;
#pragma unroll
    for (int j = 0; j < 8; ++j) { const f32x4 gg = gr[64 * j]; v[j] = v[j] * gg * r; am = fmaxf(am, fmaxf(fmaxf(fabsf(v[j].x), fabsf(v[j].y)), fmaxf(fabsf(v[j].z), fabsf(v[j].w)))); }
    am = fmaxf(wave_max(am), 1e-30f);
    const float inv = 127.f / am;
    if (lane == 0) *sa = am * (1.f / 127.f);
    unsigned* o4 = (unsigned*)orow + lane;
#pragma unroll
    for (int j = 0; j < 8; ++j) o4[64 * j] = pk4_i8(v[j].x * inv, v[j].y * inv, v[j].z * inv, v[j].w * inv);
}
DI void colmax_phase(Frame& F) {
    if (!I8_DENSE) return;
    const int gw = F.vcu * NWAVES + F.wave, NGW = F.G * NWAVES, lane = F.lane, kc = lane >> 4, n4 = lane & 15;
    constexpr int NB_IN = (DIN + 63) / 64, I_IN = 32 * NB_IN, I_OUT = 32 * 32;
    for (int it = gw; it < I_IN + I_OUT; it += NGW) {
        const bool in = it < I_IN; const int r = in ? it : it - I_IN, nbs = in ? NB_IN : 32, kb = r / nbs, nb = r % nbs, ldw = in ? DIN : DM, c0 = 64 * nb + 4 * n4;
        const bool ok = c0 < ldw;
        const float* src = (in ? F.w_in : F.w_out) + (size_t)(64 * kb + kc) * ldw + c0;
        f32x4 m = (f32x4){0.f, 0.f, 0.f, 0.f};
        if (ok) {
#pragma unroll
            for (int j = 0; j < 16; ++j) { const f32x4 v = *(const f32x4*)(src + (size_t)(4 * j) * ldw); m.x = fmaxf(m.x, fabsf(v.x)); m.y = fmaxf(m.y, fabsf(v.y)); m.z = fmaxf(m.z, fabsf(v.z)); m.w = fmaxf(m.w, fabsf(v.w)); } }
#pragma unroll
        for (int q = 0; q < 4; ++q) { m[q] = fmaxf(m[q], __shfl_xor(m[q], 16)); m[q] = fmaxf(m[q], __shfl_xor(m[q], 32)); }
        if (ok && kc == 0) { int n = c0; if (in) { if (c0 >= 8720) n = c0 - 16; else if (c0 >= 8704) n = 12800 + c0 - 8704; }
            unsigned* dst = (unsigned*)(F.ctl + (in ? CW_CMAX_IN : CW_CMAX_OUT)) + n;
#pragma unroll
            for (int q = 0; q < 4; ++q) __hip_atomic_fetch_max(dst + q, __float_as_uint(m[q]), __ATOMIC_RELAXED, __HIP_MEMORY_SCOPE_AGENT); }
    }
}
DI void p0_prologue(Frame& F) {
    const int gw = F.vcu * NWAVES + F.wave, NGW = F.G * NWAVES;
    constexpr int NITEMS = P0_EARLY;
    f32x4 va[16], vb[16];
    P0Item da = p0_decode(F, gw, NITEMS, F.lane), db;
    p0_load(da, va);
    for (int it = gw; it < NITEMS; it += 2 * NGW) {
        db = p0_decode(F, it + NGW, NITEMS, F.lane); p0_load(db, vb);
        p0_store(da, va);
        da = p0_decode(F, it + 2 * NGW, NITEMS, F.lane); p0_load(da, va);
        p0_store(db, vb);
    }
    for (int m = gw; m < NTOK; m += NGW) { if (I8_P1) rms_row_to_i8(F.x + (size_t)m * DM, F.attn_g, (unsigned char*)F.H + (size_t)m * DM, F.sa_h + m, F.lane); else rms_row_to_bf16(F.x + (size_t)m * DM, F.attn_g, F.H + (size_t)m * DM, F.lane); }
}

DI void embed_copy_chunk(Frame& F, int q) {
    if (F.G != 256) { if (q != 0) return;
        const int gw = F.vcu * NWAVES + F.wave, NGW = F.G * NWAVES; f32x4 va[16];
        for (int it = P0_EARLY + gw; it < P0_EARLY + P0_EMBED; it += NGW) { const P0Item da = p0_decode(F, it, P0_NITEMS, F.lane); p0_load(da, va); p0_store(da, va); }
        return; }
    const int gw = F.vcu * NWAVES + F.wave, base = P0_EARLY + q * EMB_PER_WAVE * 2048 + gw;
    f32x4 va[16], vb[16];
    P0Item da = p0_decode(F, base, P0_NITEMS, F.lane), db;
    p0_load(da, va);
#pragma unroll 1
    for (int i = 0; i < EMB_PER_WAVE; i += 2) {
        db = p0_decode(F, (i + 1 < EMB_PER_WAVE) ? base + (i + 1) * 2048 : P0_NITEMS, P0_NITEMS, F.lane); p0_load(db, vb);
        p0_store(da, va);
        da = p0_decode(F, (i + 2 < EMB_PER_WAVE) ? base + (i + 2) * 2048 : P0_NITEMS, P0_NITEMS, F.lane); p0_load(da, va);
        p0_store(db, vb);
    }
}
DI void late_copy_phase(Frame& F) {
    volatile LAS unsigned* qslot = (volatile LAS unsigned*)(F.lds + MISC_OFF) + 16;
    for (;;) {
        if (F.tid == 0) qslot[0] = __hip_atomic_fetch_add((unsigned*)(F.ctl + CW_CVQ), 1u, __ATOMIC_RELAXED, __HIP_MEMORY_SCOPE_AGENT);
        __syncthreads();
        const int g = (int)qslot[0];
        __syncthreads();
        if (g >= CV_NGROUPS) break;
        const int base = P0_NITEMS - P0_LATE + g * CV_GROUP + F.wave;
        f32x4 va[16];
        const P0Item da = p0_decode(F, base, P0_NITEMS, F.lane);
        p0_load(da, va); p0_store(da, va);
    }
}
DI s16x4 tr_read(const LAS unsigned char* p) { return __builtin_bit_cast(s16x4, __builtin_amdgcn_ds_read_tr16_b64_v4i16((LAS s16x4*)p)); }
DI bf16x8 pack8(const f32x16& x, int s) {
    u32x4 p; p.x = pk_bf16(x[8 * s + 0], x[8 * s + 1]); p.y = pk_bf16(x[8 * s + 2], x[8 * s + 3]); p.z = pk_bf16(x[8 * s + 4], x[8 * s + 5]); p.w = pk_bf16(x[8 * s + 6], x[8 * s + 7]);
    return __builtin_bit_cast(bf16x8, p);
}
DI bf16x8 pack8_pinned(const f32x16& x, int s) {
    u32x4 p;
    asm volatile("v_cvt_pk_bf16_f32 %0, %4, %5\n\tv_cvt_pk_bf16_f32 %1, %6, %7\n\tv_cvt_pk_bf16_f32 %2, %8, %9\n\tv_cvt_pk_bf16_f32 %3, %10, %11\n\ts_nop 1"
                 : "=&v"(p[0]), "=&v"(p[1]), "=&v"(p[2]), "=&v"(p[3])
                 : "v"(x[8 * s]), "v"(x[8 * s + 1]), "v"(x[8 * s + 2]), "v"(x[8 * s + 3]), "v"(x[8 * s + 4]), "v"(x[8 * s + 5]), "v"(x[8 * s + 6]), "v"(x[8 * s + 7]));
    return __builtin_bit_cast(bf16x8, p);
}
DI void swa_phase(Frame& F) {
    LAS unsigned char* Ks = F.lds;
    LAS unsigned char* Vs = F.lds + 36864;
    const int lane = F.lane, w = F.wave, c31 = lane & 31, h = lane >> 5;
    const int i16 = lane & 15, q4 = i16 >> 2, p4 = i16 & 3, blk = (lane >> 4) & 1;
    volatile LAS unsigned* qslot = (volatile LAS unsigned*)(F.lds + MISC_OFF) + 16;
    for (;;) {
        if (F.tid == 0) qslot[0] = __hip_atomic_fetch_add((unsigned*)(F.ctl + CW_SWAQ), 1u, __ATOMIC_RELAXED, __HIP_MEMORY_SCOPE_AGENT);
        __syncthreads();
        const int u = (int)qslot[0];
        if (u >= 512) break;
        const int kh = u & 3, qb = (u >> 2) & 15, b = u >> 6;
        const size_t tokbase = (size_t)b * SEQ;
        const int pos0 = qb * 128 - 128;
#pragma unroll
        for (int i = 0; i < 4; ++i) { const int id = F.tid + 512 * i, row = id >> 3, ch = id & 7, pos = pos0 + row;
            u32x4 kv = (u32x4){0u, 0u, 0u, 0u}, vv = (u32x4){0u, 0u, 0u, 0u};
            if (pos >= 0) { const bf16_t* src = F.PROJ + (tokbase + pos) * LDP + C_KA + kh * 64 + ch * 8; kv = *(const u32x4*)src; vv = *(const u32x4*)(src + (C_VA - C_KA)); }
            *(LAS u32x4*)(Ks + row * 144 + ch * 16) = kv; *(LAS u32x4*)(Vs + row * 144 + ch * 16) = vv; }
        __syncthreads();
        const int head = kh * 8 + w;
        const float slope2 = __builtin_amdgcn_exp2f(-0.25f * (float)(head + 1)) * LOG2E;
        const float sink2 = F.sinks[head] * LOG2E;
        for (int qt = 0; qt < 4; ++qt) {
            const size_t qrow = tokbase + qb * 128 + qt * 32 + c31;
            bf16x8 bq[4];
#pragma unroll
            for (int ks = 0; ks < 4; ++ks) bq[ks] = *(const bf16x8*)(F.PROJ + qrow * LDP + C_QA + head * 64 + ks * 16 + h * 8);
            f32x16 S[5];
#pragma unroll
            for (int kt = 0; kt < 5; ++kt) { f32x16 acc;
#pragma unroll
                for (int i = 0; i < 16; ++i) acc[i] = 0.f;
#pragma unroll
                for (int ks = 0; ks < 4; ++ks) { const bf16x8 a = *(const LAS bf16x8*)(Ks + (32 * (qt + kt) + c31) * 144 + (ks * 16 + h * 8) * 2); acc = MFMA32(a, bq[ks], acc); }
                S[kt] = acc; }
            float mx = sink2;
#pragma unroll
            for (int kt = 0; kt < 5; ++kt)
#pragma unroll
                for (int i = 0; i < 16; ++i) { const int key = 32 * (qt + kt) + crow(i, h); const int dist = 32 * qt + c31 + 128 - key;
                    const bool valid = (dist >= 0) && (dist < 128) && (pos0 + key >= 0);
                    const float s = valid ? (S[kt][i] * (0.125f * LOG2E) - slope2 * (float)dist) : -INFINITY;
                    S[kt][i] = s; mx = fmaxf(mx, s); }
            mx = fmaxf(mx, __shfl_xor(mx, 32));
            float sum = 0.f;
#pragma unroll
            for (int kt = 0; kt < 5; ++kt)
#pragma unroll
                for (int i = 0; i < 16; ++i) { const float p = __builtin_amdgcn_exp2f(S[kt][i] - mx); S[kt][i] = p; sum += p; }
            sum += __shfl_xor(sum, 32); sum += __builtin_amdgcn_exp2f(sink2 - mx);
            const float inv = 1.0f / sum;
            f32x16 O[2];
#pragma unroll
            for (int dt = 0; dt < 2; ++dt)
#pragma unroll
                for (int i = 0; i < 16; ++i) O[dt][i] = 0.f;
#pragma unroll
            for (int kt = 0; kt < 5; ++kt)
#pragma unroll
                for (int s = 0; s < 2; ++s) { const bf16x8 bp = pack8(S[kt], s);
                    const int kb = 32 * (qt + kt) + 16 * s + 4 * h + q4;
#pragma unroll
                    for (int dt = 0; dt < 2; ++dt) { const LAS unsigned char* vp = Vs + kb * 144 + (32 * dt + 16 * blk + 4 * p4) * 2;
                        const s16x4 lo = tr_read(vp), hi = tr_read(vp + 8 * 144);
                        const bf16x8 a = __builtin_shufflevector(lo, hi, 0, 1, 2, 3, 4, 5, 6, 7);
                        O[dt] = MFMA32(a, bp, O[dt]); } }
            bf16_t* orow = F.OA + qrow * DM + head * 64 + 4 * h;
#pragma unroll
            for (int dt = 0; dt < 2; ++dt)
#pragma unroll
                for (int g4 = 0; g4 < 4; ++g4) { u32x2 wv; wv.x = pk_bf16(O[dt][4 * g4] * inv, O[dt][4 * g4 + 1] * inv); wv.y = pk_bf16(O[dt][4 * g4 + 2] * inv, O[dt][4 * g4 + 3] * inv);
                    *(u32x2*)(orow + 32 * dt + 8 * g4) = wv; }
        }
        __syncthreads();
    }
}

DI void gla_prep_phase(Frame& F) {
    LAS unsigned char* Qs = F.lds;
    LAS unsigned char* Kss = F.lds + 33792;
    LAS float* alr = (LAS float*)(F.lds + 67584);
    LAS float* tot = (LAS float*)(F.lds + 71680);
    LAS unsigned char* Vr = F.lds;
    const int tid = F.tid, lane = F.lane, w = F.wave, c31 = lane & 31, h = lane >> 5;
    for (int u = F.vcu; u < 1024; u += F.G) {
        const int hh = (u >> 5) & 3, b = u >> 7, c = u & 31;
        const size_t T0 = (size_t)b * SEQ + c * 64;
#pragma unroll
        for (int j = 0; j < 4; ++j) { const int id = tid + 512 * j, row = id >> 5, ch = id & 31; const bf16_t* src = F.PROJ + (T0 + row) * LDP + C_QB + hh * 256 + ch * 8;
            *(LAS u32x4*)(Qs + row * 528 + ch * 16) = *(const u32x4*)src; *(LAS u32x4*)(Kss + row * 528 + ch * 16) = *(const u32x4*)(src + (C_KB - C_QB)); }
        u32x4 vreg[8];
#pragma unroll
        for (int j = 0; j < 8; ++j) { const int id = tid + 512 * j, row = id >> 6, ch = id & 63; vreg[j] = *(const u32x4*)(F.PROJ + (T0 + row) * LDP + C_VB + hh * 512 + ch * 8); }
        if (tid < 128) { const int t = tid >> 1, hf = tid & 1; const u32x4 raw = *(const u32x4*)(F.PROJ + (T0 + t) * LDP + C_ALR + 8 * hf);
            LAS float* d = alr + t * 16 + 8 * hf;
            d[0] = bf_lo(raw.x); d[1] = bf_hi(raw.x); d[2] = bf_lo(raw.y); d[3] = bf_hi(raw.y); d[4] = bf_lo(raw.z); d[5] = bf_hi(raw.z); d[6] = bf_lo(raw.w); d[7] = bf_hi(raw.w); }
        __syncthreads();
        const int d = tid & 255, hf = tid >> 8;
        float w2[16];
#pragma unroll
        for (int r = 0; r < 16; ++r) w2[r] = F.w_alpha2[r * 1024 + hh * 256 + d];
        const float ba = F.b_alpha[hh * 256 + d];
        float bc[32]; float run = 0.f;
#pragma unroll
        for (int i = 0; i < 32; ++i) { const LAS f32x4* ar = (const LAS f32x4*)(alr + (32 * hf + i) * 16); float z = ba;
#pragma unroll
            for (int r4 = 0; r4 < 4; ++r4) { const f32x4 a = ar[r4]; z += a.x * w2[4 * r4] + a.y * w2[4 * r4 + 1] + a.z * w2[4 * r4 + 2] + a.w * w2[4 * r4 + 3]; }
            const float la = (fminf(z, 0.f) - __logf(1.0f + fast_exp(-fabsf(z)))) * (1.0f / 16.0f);
            run += la; bc[i] = run; }
        tot[hf * 256 + d] = run;
        __syncthreads();
        const float t0 = tot[d], t1 = tot[256 + d], blast = t0 + t1;
        if (hf) {
#pragma unroll
            for (int i = 0; i < 32; ++i) bc[i] += t0;
        } else F.GDEC[(size_t)u * 256 + d] = fast_exp(blast);
        unsigned kpk[16];
#pragma unroll
        for (int i2 = 0; i2 < 16; ++i2) { float kh2[2];
#pragma unroll
            for (int j = 0; j < 2; ++j) { const int i = 2 * i2 + j; LAS bf16_t* qp = (LAS bf16_t*)(Qs + (32 * hf + i) * 528 + d * 2); LAS bf16_t* kp = (LAS bf16_t*)(Kss + (32 * hf + i) * 528 + d * 2);
                const float q = bf2f(*qp), k = bf2f(*kp);
                const float e = fast_exp(bc[i]);
                *qp = f2bf(q * e * 0.0625f);
                *kp = f2bf(k * fast_exp(-bc[i]));
                kh2[j] = k * fast_exp(blast - bc[i]); }
            kpk[i2] = pk_bf16(kh2[0], kh2[1]); }
        { u32x4* dst = (u32x4*)(F.GKT + (size_t)u * 16384 + d * 64 + 32 * hf);
#pragma unroll
            for (int j = 0; j < 4; ++j) dst[j] = (u32x4){kpk[4 * j], kpk[4 * j + 1], kpk[4 * j + 2], kpk[4 * j + 3]}; }
        __syncthreads();
        if (w < 4) { const int m = w >> 1, n = w & 1; f32x16 acc;
#pragma unroll
            for (int i = 0; i < 16; ++i) acc[i] = 0.f;
#pragma unroll
            for (int ks = 0; ks < 16; ++ks) { const bf16x8 a = *(const LAS bf16x8*)(Qs + (32 * m + c31) * 528 + (16 * ks + 8 * h) * 2), bb = *(const LAS bf16x8*)(Kss + (32 * n + c31) * 528 + (16 * ks + 8 * h) * 2);
                acc = MFMA32(a, bb, acc); }
            bf16_t* ao = F.GATT + (size_t)u * 4096;
#pragma unroll
            for (int i = 0; i < 16; ++i) { const int t = 32 * m + crow(i, h), s = 32 * n + c31; ao[t * 64 + s] = f2bf(s <= t ? acc[i] : 0.f); }
        } else { const int t2 = tid - 256;
#pragma unroll
            for (int j = 0; j < 8; ++j) { const int id = t2 + 256 * j, row = id >> 5, ch = id & 31; *(u32x4*)(F.GQT + (size_t)u * 16384 + row * 256 + ch * 8) = *(const LAS u32x4*)(Qs + row * 528 + ch * 16); } }
        __syncthreads();
#pragma unroll
        for (int j = 0; j < 8; ++j) { const int id = tid + 512 * j, row = id >> 6, ch = id & 63; *(LAS u32x4*)(Vr + row * 1040 + ch * 16) = vreg[j]; }
        __syncthreads();
        { u32x4* dst = (u32x4*)(F.GVT + (size_t)u * 32768 + tid * 64);
#pragma unroll
            for (int t8 = 0; t8 < 8; ++t8) { unsigned short v[8];
#pragma unroll
                for (int j = 0; j < 8; ++j) v[j] = *(const LAS bf16_t*)(Vr + (8 * t8 + j) * 1040 + tid * 2);
                dst[t8] = (u32x4){(unsigned)v[0] | ((unsigned)v[1] << 16), (unsigned)v[2] | ((unsigned)v[3] << 16), (unsigned)v[4] | ((unsigned)v[5] << 16), (unsigned)v[6] | ((unsigned)v[7] << 16)}; } }
        __syncthreads();
    }
}

DI void gla_scan_phase(Frame& F) {
    LAS unsigned char* L = F.lds;
    const int lane = F.lane, w = F.wave, c31 = lane & 31, h = lane >> 5;
    const int u = F.vcu, hf = u & 1, hh = (u >> 1) & 3, b = u >> 3;
    f32x16 S[8];
#pragma unroll
    for (int i = 0; i < 8; ++i)
#pragma unroll
        for (int j = 0; j < 16; ++j) S[i][j] = 0.f;
    const size_t item0 = (size_t)(b * 4 + hh) * 32;
    const int vr0 = hf * 256 + 32 * w;
    unsigned tidv = (unsigned)F.tid;
    unsigned qrb = (unsigned)(c31 * 528 + 8 * h), krb = (unsigned)(c31 * 144 + 16 * h);
    u32x4 rq[4], rk[4], ra; f32x4 rd; u32x4 bvn[4];
#define BV(ks) (*(const LAS bf16x8*)(L + 80896 + w * 4608 + krb + 32 * (ks)))
#define SCAN_LOAD_A(item) do { const char* q0 = (const char*)(F.GQT + (item) * 16384); const char* k0 = (const char*)(F.GKT + (item) * 16384); asm volatile("" : "+v"(tidv)); const unsigned tb = tidv * 16u; \
        _Pragma("unroll") for (int j = 0; j < 4; ++j) { rq[j] = *(const u32x4*)(q0 + j * 8192 + tb); rk[j] = *(const u32x4*)(k0 + j * 8192 + tb); } } while (0)
#define SCAN_LOAD_B(item) do { const char* v0 = (const char*)(F.GVT + (item) * 32768 + (size_t)vr0 * 64); asm volatile("" : "+v"(tidv)); const unsigned tb = tidv * 16u, db = (tidv & 63u) * 16u, vb = (tidv & 31u) * 128u + ((tidv >> 5) & 1u) * 16u; \
        ra = *(const u32x4*)((const char*)(F.GATT + (item) * 4096) + tb); \
        rd = *(const f32x4*)((const char*)(F.GDEC + (item) * 256) + db); \
        _Pragma("unroll") for (int ks = 0; ks < 4; ++ks) bvn[ks] = *(const u32x4*)(v0 + 32 * ks + vb); } while (0)
#define SCAN_WRITE() do { asm volatile("" : "+v"(tidv)); const unsigned qwo = (tidv >> 5) * 528u + (tidv & 31u) * 16u, kwo = (tidv >> 3) * 144u + (tidv & 7u) * 16u; \
        _Pragma("unroll") for (int j = 0; j < 4; ++j) { *(LAS u32x4*)(L + qwo + j * 16 * 528) = rq[j]; *(LAS u32x4*)(L + 33792 + kwo + j * 64 * 144) = rk[j]; } \
        *(LAS u32x4*)(L + 70656 + kwo) = ra; \
        if (tidv < 64u) *(LAS f32x4*)(L + 79872 + tidv * 16u) = rd; \
        _Pragma("unroll") for (int ks = 0; ks < 4; ++ks) *(LAS u32x4*)(L + 80896 + w * 4608 + krb + 32 * ks) = bvn[ks]; } while (0)
    SCAN_LOAD_A(item0); SCAN_LOAD_B(item0);
    SCAN_WRITE();
    __syncthreads();
    for (int c = 0; c < 32; ++c) {
        const size_t nitem = item0 + (c < 31 ? c + 1 : c);
        SCAN_LOAD_A(nitem);
        asm volatile("" : "+v"(qrb), "+v"(krb));
#pragma unroll 1
        for (int m = 0; m < 2; ++m) { f32x16 o;
#pragma unroll
            for (int j = 0; j < 16; ++j) o[j] = 0.f;
#pragma unroll
            for (int i = 0; i < 8; ++i)
#pragma unroll
                for (int s = 0; s < 2; ++s) { const bf16x8 bs = pack8_pinned(S[i], s);
                    const LAS unsigned char* ap = L + qrb + (32 * m) * 528 + (32 * i + 16 * s) * 2;
                    const s16x4 lo = *(const LAS s16x4*)ap, hi = *(const LAS s16x4*)(ap + 16);
                    const bf16x8 a = __builtin_shufflevector(lo, hi, 0, 1, 2, 3, 4, 5, 6, 7);
                    o = MFMA32(a, bs, o); }
#pragma unroll
            for (int ks = 0; ks < 4; ++ks) { const bf16x8 a = *(const LAS bf16x8*)(L + 70656 + krb + (32 * m) * 144 + 32 * ks); o = MFMA32(a, BV(ks), o); }
            { asm volatile("" : "+v"(tidv)); const unsigned ovb = ((tidv >> 5) & 1u) * (4u * DM * 2u) + (tidv & 31u) * 2u;
                char* ob = (char*)(F.OB + ((size_t)b * SEQ + c * 64 + 32 * m) * DM + hh * 512 + vr0);
#pragma unroll
                for (int j = 0; j < 16; ++j) *(bf16_t*)(ob + ((j & 3) + 8 * (j >> 2)) * (DM * 2) + ovb) = f2bf(o[j]); } }
        asm volatile("" ::: "memory");
        SCAN_LOAD_B(nitem);
#pragma unroll
        for (int i = 0; i < 8; ++i) {
#pragma unroll
            for (int g4 = 0; g4 < 4; ++g4) { const f32x4 dc = *(const LAS f32x4*)(L + 79872 + (32 * i + 8 * g4) * 4 + (((tidv >> 5) & 1u) * 16u));
                S[i][4 * g4] *= dc.x; S[i][4 * g4 + 1] *= dc.y; S[i][4 * g4 + 2] *= dc.z; S[i][4 * g4 + 3] *= dc.w; }
        }
#pragma unroll
        for (int ks = 0; ks < 4; ++ks) { const bf16x8 bvk = BV(ks);
#pragma unroll
            for (int i = 0; i < 8; ++i) { const bf16x8 a = *(const LAS bf16x8*)(L + 33792 + krb + (32 * i) * 144 + 32 * ks); S[i] = MFMA32(a, bvk, S[i]); } }
        __syncthreads();
        SCAN_WRITE();
        __syncthreads();
    }
#undef SCAN_LOAD_A
#undef SCAN_LOAD_B
#undef SCAN_WRITE
#undef BV
}

DI void merge_phase(Frame& F) {
    const int gw = F.vcu * NWAVES + F.wave, NGW = F.G * NWAVES, lane = F.lane;
    for (int m = gw; m < NTOK; m += NGW) {
        const bf16_t* pr = F.PROJ + (size_t)m * LDP;
        float rr[4][8]; float am = 0.f;
#pragma unroll
        for (int j = 0; j < 4; ++j) { const int c0 = j * 512 + lane * 8;
            const u32x4 ob = *(const u32x4*)(F.OB + (size_t)m * DM + c0), oa = *(const u32x4*)(F.OA + (size_t)m * DM + c0);
            const u32x4 rb = *(const u32x4*)(pr + C_RB + c0), ga = *(const u32x4*)(pr + C_GA + c0), gb = *(const u32x4*)(pr + C_GB + c0);
            const f32x4 g0 = *(const f32x4*)(F.gla_g + lane * 8), g1 = *(const f32x4*)(F.gla_g + lane * 8 + 4);
            float vb[8] = {bf_lo(ob.x), bf_hi(ob.x), bf_lo(ob.y), bf_hi(ob.y), bf_lo(ob.z), bf_hi(ob.z), bf_lo(ob.w), bf_hi(ob.w)};
            const float va[8] = {bf_lo(oa.x), bf_hi(oa.x), bf_lo(oa.y), bf_hi(oa.y), bf_lo(oa.z), bf_hi(oa.z), bf_lo(oa.w), bf_hi(oa.w)};
            const float vr[8] = {bf_lo(rb.x), bf_hi(rb.x), bf_lo(rb.y), bf_hi(rb.y), bf_lo(rb.z), bf_hi(rb.z), bf_lo(rb.w), bf_hi(rb.w)};
            const float vga[8] = {bf_lo(ga.x), bf_hi(ga.x), bf_lo(ga.y), bf_hi(ga.y), bf_lo(ga.z), bf_hi(ga.z), bf_lo(ga.w), bf_hi(ga.w)};
            const float vgb[8] = {bf_lo(gb.x), bf_hi(gb.x), bf_lo(gb.y), bf_hi(gb.y), bf_lo(gb.z), bf_hi(gb.z), bf_lo(gb.w), bf_hi(gb.w)};
            const float gn[8] = {g0.x, g0.y, g0.z, g0.w, g1.x, g1.y, g1.z, g1.w};
            float ss = 0.f;
#pragma unroll
            for (int k = 0; k < 8; ++k) ss += vb[k] * vb[k];
            const float rn = 1.0f / sqrtf(wave_sum(ss) * (1.f / 512.f) + EPS);
#pragma unroll
            for (int k = 0; k < 8; ++k) { const float obn = vb[k] * rn * gn[k]; const float sl = vr[k] * fast_sigmoid(vr[k]);
                rr[j][k] = fast_sigmoid(vga[k]) * va[k] + fast_sigmoid(vgb[k]) * obn * sl; am = fmaxf(am, fabsf(rr[j][k])); }
            if (!I8_P5) *(u32x4*)(F.MIX + (size_t)m * DM + c0) = (u32x4){pk_bf16(rr[j][0], rr[j][1]), pk_bf16(rr[j][2], rr[j][3]), pk_bf16(rr[j][4], rr[j][5]), pk_bf16(rr[j][6], rr[j][7])}; }
        if (I8_P5) { float sq = 0.f;
#pragma unroll
            for (int j = 0; j < 4; ++j)
#pragma unroll
                for (int k = 0; k < 8; ++k) sq += rr[j][k] * rr[j][k];
            am = fminf(wave_max(am), MIX_CLIP * sqrtf(wave_sum(sq) * (1.f / DM))); am = fmaxf(am, 1e-30f);
            const float inv = 127.f / am; if (lane == 0) F.sa_mix[m] = am * (1.f / 127.f);
#pragma unroll
            for (int j = 0; j < 4; ++j) { u32x2 wv; wv.x = pk4_i8(rr[j][0] * inv, rr[j][1] * inv, rr[j][2] * inv, rr[j][3] * inv); wv.y = pk4_i8(rr[j][4] * inv, rr[j][5] * inv, rr[j][6] * inv, rr[j][7] * inv);
                *(u32x2*)((unsigned char*)F.MIX + (size_t)m * DM + j * 512 + lane * 8) = wv; }
        }
    }
}

DI void router_phase(Frame& F) {
    LAS float* part = (LAS float*)F.lds;
    LAS float* ssp = (LAS float*)(F.lds + 34816);
    LAS float* rt = (LAS float*)(F.lds + 36864);
    LAS float* lg = (LAS float*)(F.lds + 37888);
    const int tid = F.tid, lane = F.lane, w = F.wave, c31 = lane & 31, h = lane >> 5;
    for (int tile = F.vcu; tile < NTOK / 32; tile += F.G) {
        const int t0 = tile * 32, kw = 256 * w;
        { const float* xr = F.X1 + (size_t)(t0 + c31) * DM + kw + 4 * h; const float* gp = F.ffn_g + kw + 4 * h; const float* wp = F.w_router + (size_t)(kw + 4 * h) * 32 + c31;
            f32x16 acc;
#pragma unroll
            for (int i = 0; i < 16; ++i) acc[i] = 0.f;
            float ss = 0.f;
#pragma unroll 4
            for (int m = 0; m < 32; ++m) { const f32x4 a = *(const f32x4*)(xr + 8 * m); const f32x4 g4 = *(const f32x4*)(gp + 8 * m); const float* wr_ = wp + (size_t)m * 256;
                const float b0 = g4.x * wr_[0], b1 = g4.y * wr_[32], b2 = g4.z * wr_[64], b3 = g4.w * wr_[96];
                ss += (a.x * a.x + a.y * a.y) + (a.z * a.z + a.w * a.w);
                acc = __builtin_amdgcn_mfma_f32_32x32x2f32(a.x, b0, acc, 0, 0, 0); acc = __builtin_amdgcn_mfma_f32_32x32x2f32(a.y, b1, acc, 0, 0, 0);
                acc = __builtin_amdgcn_mfma_f32_32x32x2f32(a.z, b2, acc, 0, 0, 0); acc = __builtin_amdgcn_mfma_f32_32x32x2f32(a.w, b3, acc, 0, 0, 0); }
            ss += __shfl_xor(ss, 32);
#pragma unroll
            for (int i = 0; i < 16; ++i) part[(w * 32 + crow(i, h)) * 33 + c31] = acc[i];
            if (h == 0) ssp[w * 32 + c31] = ss; }
        __syncthreads();
        { const int tok = tid >> 4, e0 = tid & 15; float s0 = 0.f, s1 = 0.f, sst = 0.f;
#pragma unroll
            for (int w2 = 0; w2 < 8; ++w2) { s0 += part[(w2 * 32 + tok) * 33 + e0]; s1 += part[(w2 * 32 + tok) * 33 + e0 + 16]; sst += ssp[w2 * 32 + tok]; }
            const float r = 1.0f / sqrtf(sst * (1.f / DM) + EPS);
            lg[tok * 33 + e0] = s0 * r + F.b_router[e0]; lg[tok * 33 + e0 + 16] = s1 * r + F.b_router[e0 + 16]; if (e0 == 0) rt[tok] = r; }
        __syncthreads();
#pragma unroll
        for (int it = 0; it < 2; ++it) { const int tok = 4 * w + 2 * it + h; const int m = t0 + tok;
            float v = lg[tok * 33 + c31]; float tv[4]; int ti[4];
#pragma unroll
            for (int k = 0; k < 4; ++k) { float bv = v; int bi = c31;
#pragma unroll
                for (int o = 1; o < 32; o <<= 1) { const float ov = __shfl_xor(bv, o); const int oi = __shfl_xor(bi, o); const bool take = (ov > bv) || (ov == bv && oi < bi); bv = take ? ov : bv; bi = take ? oi : bi; }
                tv[k] = bv; ti[k] = bi; v = (c31 == bi) ? -INFINITY : v; }
            const float e1 = fast_exp(tv[1] - tv[0]), e2 = fast_exp(tv[2] - tv[0]), e3 = fast_exp(tv[3] - tv[0]); const float inv = 1.0f / (1.0f + e1 + e2 + e3);
            if (c31 < 4) { const int ex = c31 == 0 ? ti[0] : c31 == 1 ? ti[1] : c31 == 2 ? ti[2] : ti[3]; const float gt = (c31 == 0 ? 1.0f : c31 == 1 ? e1 : c31 == 2 ? e2 : e3) * inv;
                const unsigned slot = __hip_atomic_fetch_add((unsigned*)(F.ctl + CW_CNT + 64 * ex), 1u, __ATOMIC_RELAXED, __HIP_MEMORY_SCOPE_AGENT);
                F.tokl[(size_t)ex * NTOK + slot] = m; F.tope[m * 4 + c31] = ex; F.tops[m * 4 + c31] = (int)slot; F.gate[m * 4 + c31] = gt; } }
#pragma unroll
        for (int q = 0; q < 4; ++q) { const int tok = 4 * w + q; const size_t m = (size_t)(t0 + tok); const float r = rt[tok];
            const f32x4* xr = (const f32x4*)(F.X1 + m * DM) + lane; const f32x4* gr = (const f32x4*)F.ffn_g + lane; unsigned* o4 = (unsigned*)((unsigned char*)F.H + m * DM) + lane;
            const float r8 = 8.0f * r;
#pragma unroll
            for (int j = 0; j < 8; ++j) { const f32x4 xv = xr[64 * j], gg = gr[64 * j];
                o4[64 * j] = pk4_fp8(clamp_fp8(xv.x * r8 * gg.x), clamp_fp8(xv.y * r8 * gg.y), clamp_fp8(xv.z * r8 * gg.z), clamp_fp8(xv.w * r8 * gg.w)); } }
        __syncthreads();
    }
}

DI void moe_tables(Frame& F) {
    LAS int* tb = (LAS int*)(F.lds + TBL_OFF);
    if (F.tid == 0) { int acc = 0;
        for (int e = 0; e < NEXP; ++e) { const int c = (int)__hip_atomic_load((unsigned*)(F.ctl + CW_CNT + 64 * e), __ATOMIC_RELAXED, __HIP_MEMORY_SCOPE_AGENT); tb[e] = acc; tb[40 + e] = c; acc += (c + 255) >> 8; }
        tb[32] = acc; }
    __syncthreads();
}
struct MoeProb {
    const bf16_t* A; const bf16_t* Bt; const int* tokl; const LAS int* tb; int K, NT  , brows  , G, c; bool gather;
    DI bool next_linear(int L, pg8::Unit& u) const {
        const int blk = L / NT, pn = L % NT; int e = 0;
        for (int j = 1; j < NEXP; ++j) e += (tb[j] <= blk) ? 1 : 0;
        const int rb = blk - tb[e]; int nr = tb[40 + e] - rb * 256; nr = nr > 256 ? 256 : nr;
        u.pm = blk; u.pn = pn; u.e = e; u.rb = rb; u.nrow = nr; return true;
    }
    DI bool next(int i, pg8::Unit& u) const {
        const int nb = tb[32]; const int x = c & 7, j = c >> 3, T = i * 8 + x, nsp = NT >> 3;
        const int blk = 4 * (T / nsp) + (j & 3), pn = 8 * (T % nsp) + (j >> 2);
        if (G != 256 || blk >= nb) { if (G == 256) return false; const int L = i * G + c; if (L >= nb * NT) return false; return next_linear(L, u); }
        int e = 0;
        for (int j = 1; j < NEXP; ++j) e += (tb[j] <= blk) ? 1 : 0;
        const int rb = blk - tb[e]; int nr = tb[40 + e] - rb * 256; nr = nr > 256 ? 256 : nr;
        u.pm = blk; u.pn = pn; u.e = e; u.rb = rb; u.nrow = nr; return true;
    }
    DI const char* a_base(const pg8::Unit& u) const { return gather ? (const char*)A : (const char*)A + (size_t)u.pm * 256 * K * 2; }
    DI const char* b_base(const pg8::Unit& u) const { return (const char*)Bt + ((size_t)u.e * brows + (size_t)u.pn * 256) * K * 2; }
    DI void a_voff(const pg8::Unit& u, const int (&R)[2], const int (&C)[2], unsigned (&v)[2][2]) const {
#pragma unroll
        for (int h = 0; h < 2; ++h)
#pragma unroll
            for (int i = 0; i < 2; ++i) { const int r = h * 128 + R[i];
                if (gather) { int tok = 0; if (r < u.nrow) tok = tokl[(size_t)u.e * NTOK + u.rb * 256 + r]; v[h][i] = (unsigned)(tok * K + C[i]) * 2u; }
                else v[h][i] = (unsigned)(r * K + C[i]) * 2u; }
    }
};

DI void final_phase(Frame& F) {
    const LAS int* tb = (const LAS int*)(F.lds + TBL_OFF);
    const int gw = F.vcu * NWAVES + F.wave, NGW = F.G * NWAVES, lane = F.lane;
    for (int m = gw; m < NTOK; m += NGW) {
        const bf16_t* yr[4]; float gt[4];
#pragma unroll
        for (int k = 0; k < 4; ++k) { const int e = F.tope[m * 4 + k], sl = F.tops[m * 4 + k]; gt[k] = F.gate[m * 4 + k]; yr[k] = F.Y + ((size_t)tb[e] * 256 + sl) * DM; }
        float v[4][8]; float ss = 0.f;
#pragma unroll
        for (int j = 0; j < 4; ++j) { const int c0 = 8 * (lane + 64 * j);
            const f32x4 x0 = *(const f32x4*)(F.X1 + (size_t)m * DM + c0), x1 = *(const f32x4*)(F.X1 + (size_t)m * DM + c0 + 4);
            float a[8] = {x0.x, x0.y, x0.z, x0.w, x1.x, x1.y, x1.z, x1.w};
#pragma unroll
            for (int k = 0; k < 4; ++k) { const u32x4 y = *(const u32x4*)(yr[k] + c0);
                a[0] += gt[k] * bf_lo(y.x); a[1] += gt[k] * bf_hi(y.x); a[2] += gt[k] * bf_lo(y.y); a[3] += gt[k] * bf_hi(y.y);
                a[4] += gt[k] * bf_lo(y.z); a[5] += gt[k] * bf_hi(y.z); a[6] += gt[k] * bf_lo(y.w); a[7] += gt[k] * bf_hi(y.w); }
#pragma unroll
            for (int q = 0; q < 8; ++q) { v[j][q] = a[q]; ss += a[q] * a[q]; } }
        const float r = 1.0f / sqrtf(wave_sum(ss) * (1.f / DM) + EPS);
#pragma unroll
        for (int j = 0; j < 4; ++j) { const int c0 = 8 * (lane + 64 * j);
            const f32x4 g0 = *(const f32x4*)(F.final_g + c0), g1 = *(const f32x4*)(F.final_g + c0 + 4);
            *(f32x4*)(F.out + (size_t)m * DM + c0) = (f32x4){v[j][0] * r * g0.x, v[j][1] * r * g0.y, v[j][2] * r * g0.z, v[j][3] * r * g0.w};
            *(f32x4*)(F.out + (size_t)m * DM + c0 + 4) = (f32x4){v[j][4] * r * g1.x, v[j][5] * r * g1.y, v[j][6] * r * g1.z, v[j][7] * r * g1.w}; }
    }
}
#ifndef MK_N_LAUNCHES
#define MK_N_LAUNCHES 1
#endif
constexpr int N_PHASES = 11;
struct Args { const float* in[16]; float* out; unsigned char* ws; int ph_lo, ph_hi; };
static_assert(sizeof(Args) == 16 * 8 + 8 + 8 + 8, "Args has no padding");

__global__ void __launch_bounds__(NWAVES * 64, 2) fwd_kernel(Args args) {
    extern __shared__ __attribute__((aligned(16))) unsigned char lds_raw[];
    Frame F;
    F.lds = (LAS unsigned char*)lds_raw;
    F.tid = threadIdx.x; F.lane = F.tid & 63; F.wave = __builtin_amdgcn_readfirstlane(F.tid >> 6);
    F.G = gridDim.x; { const int bx = blockIdx.x; F.vcu = (F.G % 8 == 0) ? (bx % 8) * (F.G / 8) + bx / 8 : bx; }
    unsigned char* ws = args.ws;
    F.ctl = (gu32*)(ws + WS_CTL);
    F.x = args.in[0]; F.attn_g = args.in[1]; F.w_in = args.in[2]; F.sinks = args.in[3]; F.w_alpha2 = args.in[4]; F.b_alpha = args.in[5]; F.gla_g = args.in[6]; F.w_out = args.in[7];
    F.ffn_g = args.in[8]; F.w_router = args.in[9]; F.b_router = args.in[10]; F.w_gu = args.in[11]; F.b_gu = args.in[12]; F.w_dn = args.in[13]; F.b_dn = args.in[14]; F.final_g = args.in[15];
    F.out = args.out;
    F.tope = (int*)(ws + WS_TOPE); F.tops = (int*)(ws + WS_TOPS); F.gate = (float*)(ws + WS_GATE); F.tokl = (int*)(ws + WS_TOKL);
    F.Win = (bf16_t*)(ws + WS_WIN); F.Wout = (bf16_t*)(ws + WS_WOUT); F.Wgu = (bf16_t*)(ws + WS_WGU); F.Wdn = (bf16_t*)(ws + WS_WDN);
    F.sa_h = (float*)(ws + WS_SAH); F.sa_mix = (float*)(ws + WS_SAMIX);
    F.H = (bf16_t*)(ws + WS_H); F.PROJ = (bf16_t*)(ws + WS_PROJ); F.OA = (bf16_t*)(ws + WS_OA); F.OB = (bf16_t*)(ws + WS_OB); F.MIX = (bf16_t*)(ws + WS_MIX);
    F.X1 = (float*)(ws + WS_X1); F.GQT = (bf16_t*)(ws + WS_GQT); F.GKT = (bf16_t*)(ws + WS_GKT); F.GATT = (bf16_t*)(ws + WS_GATT); F.GDEC = (float*)(ws + WS_GDEC); F.GVT = (bf16_t*)(ws + WS_GVT);
    F.ACT = (bf16_t*)(ws + WS_ACT); F.Y = (bf16_t*)(ws + WS_Y);
    for (int u = F.tid; u < (LDS_BYTES - LDSCTL_OFF) / 4; u += NWAVES * 64) ((LAS unsigned*)(F.lds + LDSCTL_OFF))[u] = 0u;
    __syncthreads();
    const int lo = args.ph_lo, hi = args.ph_hi;
    const bool use_bar = (hi - lo) > 1;
    XcdBarrier bar; bar.bar = (unsigned*)(F.ctl + CW_BAR); bar.x = 0; bar.st = nullptr;
    if (use_bar) bar = xcd_barrier_post((unsigned*)(F.ctl + CW_BAR), (volatile LAS unsigned*)(F.lds + MISC_OFF) + 8);
#define IN(k) (lo <= (k) && (k) < hi)
#define SEAM(k) do { if (IN(k) && IN((k) + 1)) xcd_barrier(bar); } while (0)

    if (IN(0)) { colmax_phase(F); }
    SEAM(0);
    if (IN(1)) { p0_prologue(F); }
    SEAM(1);
    if (IN(2)) {
        pg8::DenseProb P; P.A = F.H; P.Bt = F.Win; P.K = I8_P1 ? DM / 2 : DM; P.S.init(NTOK, LDP, F.G, (int)blockIdx.x);
        pg8::EpiBf16Plain<I8_P1> E{F.PROJ, LDP, F.sa_h, (const float*)(F.ctl + CW_CMAX_IN)};
        const bool grpB = ((F.vcu >> 2) & 1) != 0;
        if (grpB) embed_copy_chunk(F, 0);
        P.i0 = 0; P.i1 = 3; pg8::gemm_phase<I8_P1 ? GM_I8 : GM_BF16>(F.lds + RING_OFF, P, E);
        embed_copy_chunk(F, grpB ? 1 : 0);
        P.i0 = 3; P.i1 = 6; pg8::gemm_phase<I8_P1 ? GM_I8 : GM_BF16>(F.lds + RING_OFF, P, E);
        embed_copy_chunk(F, grpB ? 2 : 1);
        P.i0 = 6; P.i1 = 9; pg8::gemm_phase<I8_P1 ? GM_I8 : GM_BF16>(F.lds + RING_OFF, P, E);
        embed_copy_chunk(F, grpB ? 3 : 2);
        P.i0 = 9; P.i1 = 1 << 30; pg8::gemm_phase<I8_P1 ? GM_I8 : GM_BF16>(F.lds + RING_OFF, P, E);
        if (!grpB) embed_copy_chunk(F, 3);
    }
    SEAM(2);
    if (IN(3)) { gla_prep_phase(F); }
    SEAM(3);
    if (IN(4)) { if (F.vcu < 64) gla_scan_phase(F); swa_phase(F); late_copy_phase(F); }
    SEAM(4);
    if (IN(5)) { merge_phase(F); }
    SEAM(5);
    if (IN(6)) {
        pg8::DenseProb P; P.A = F.MIX; P.Bt = F.Wout; P.K = I8_P5 ? DM / 2 : DM; P.S.init(NTOK, DM, F.G, (int)blockIdx.x);
        pg8::EpiResF32<I8_P5> E{F.x, F.X1, DM, F.sa_mix, (const float*)(F.ctl + CW_CMAX_OUT)};
        pg8::gemm_phase<I8_P5 ? GM_I8 : GM_BF16>(F.lds + RING_OFF, P, E);
    }
    SEAM(6);
    if (IN(7)) { router_phase(F); }
    SEAM(7);
    if (IN(8)) {
        moe_tables(F);
        MoeProb P; P.A = F.H; P.Bt = F.Wgu; P.tokl = F.tokl; P.tb = (const LAS int*)(F.lds + TBL_OFF); P.K = DM / 2; P.NT = 16; P.brows = 4096; P.G = F.G; P.c = (int)blockIdx.x; P.gather = true;
        pg8::EpiGlu E{(unsigned char*)F.ACT, DFF, F.b_gu};
        pg8::gemm_phase<GM_FP8>(F.lds + RING_OFF, P, E);
    }
    SEAM(8);
    if (IN(9)) {
        moe_tables(F);
        MoeProb P; P.A = F.ACT; P.Bt = F.Wdn; P.tokl = F.tokl; P.tb = (const LAS int*)(F.lds + TBL_OFF); P.K = DFF / 2; P.NT = 8; P.brows = 2048; P.G = F.G; P.c = (int)blockIdx.x; P.gather = false;
        pg8::EpiBf16BiasE E{F.Y, DM, F.b_dn};
        pg8::gemm_phase<GM_FP8>(F.lds + RING_OFF, P, E);
    }
    SEAM(9);
    if (IN(10)) { moe_tables(F); final_phase(F); }
#undef IN
#undef SEAM
}

extern "C" void kernel_launch(void* const* d_in, const int* in_sizes, int n_in, void* d_out, int out_size, void* d_ws, size_t ws_size, hipStream_t stream) {
    static int grid = 0;
    if (grid == 0) {
        if (n_in != 16 || out_size != NTOK * DM || ws_size < WS_END) { fprintf(stderr, "kernel_launch: unexpected shapes (n_in %d, out %d, ws %zu, need %zu); nothing launched\n", n_in, out_size, ws_size, (size_t)WS_END); grid = -1; return; }
        int dev = 0, cus = 0, per_cu = 0;
        if (hipGetDevice(&dev) != hipSuccess || hipDeviceGetAttribute(&cus, hipDeviceAttributeMultiprocessorCount, dev) != hipSuccess) { fprintf(stderr, "kernel_launch: device query failed\n"); grid = -1; return; }
        if (hipFuncSetAttribute((const void*)fwd_kernel, hipFuncAttributeMaxDynamicSharedMemorySize, LDS_BYTES) != hipSuccess) { fprintf(stderr, "kernel_launch: hipFuncSetAttribute failed\n"); grid = -1; return; }
        if (hipOccupancyMaxActiveBlocksPerMultiprocessor(&per_cu, (const void*)fwd_kernel, NWAVES * 64, LDS_BYTES) != hipSuccess || per_cu < 1)
            fprintf(stderr, "kernel_launch: note: occupancy query reports %d workgroups per CU\n", per_cu);
        (void)hipGetLastError();
        grid = cus;
    }
    if (grid < 0) return;
    if (hipMemsetAsync((char*)d_ws + WS_CTL, 0, CTL_ZERO_BYTES, stream) != hipSuccess) { fprintf(stderr, "kernel_launch: hipMemsetAsync failed\n"); return; }
    Args a{};
    for (int i = 0; i < 16; ++i) a.in[i] = (const float*)d_in[i];
    a.out = (float*)d_out; a.ws = (unsigned char*)d_ws;
    if (MK_N_LAUNCHES == 1) { a.ph_lo = 0; a.ph_hi = N_PHASES; hipLaunchKernelGGL(fwd_kernel, dim3(grid), dim3(NWAVES * 64), LDS_BYTES, stream, a); }
    else for (int p = 0; p < N_PHASES; ++p) { a.ph_lo = p; a.ph_hi = p + 1; hipLaunchKernelGGL(fwd_kernel, dim3(grid), dim3(NWAVES * 64), LDS_BYTES, stream, a);
#ifdef MK_REPEAT_MASK
        if ((MK_REPEAT_MASK >> p) & 1) hipLaunchKernelGGL(fwd_kernel, dim3(grid), dim3(NWAVES * 64), LDS_BYTES, stream, a);
#endif
    }
    const hipError_t le = hipPeekAtLastError();
    if (le != hipSuccess) fprintf(stderr, "kernel_launch: launch failed: %s\n", hipGetErrorName(le));
}
```

```cpp
#include <hip/hip_runtime.h>
#include <cstdio>
#include <cstdint>

#define DI __device__ __forceinline__
#define LAS __attribute__((address_space(3)))
#define GAS __attribute__((address_space(1)))
typedef unsigned short bf16_t;
typedef short bf16x8 __attribute__((ext_vector_type(8)));
typedef short s16x4 __attribute__((ext_vector_type(4)));
typedef float f32x4 __attribute__((ext_vector_type(4)));
typedef float f32x16 __attribute__((ext_vector_type(16)));
typedef unsigned u32x4 __attribute__((ext_vector_type(4)));
typedef unsigned u32x2 __attribute__((ext_vector_type(2)));
typedef float f32x2_t __attribute__((ext_vector_type(2)));
typedef __bf16 bf16x2_t __attribute__((ext_vector_type(2)));
typedef int i32x4 __attribute__((ext_vector_type(4)));
typedef int i32x8 __attribute__((ext_vector_type(8)));
DI unsigned pk4_fp8(float a, float b, float c, float d) { int p = __builtin_amdgcn_cvt_pk_fp8_f32(a, b, 0, false); p = __builtin_amdgcn_cvt_pk_fp8_f32(c, d, p, true); return (unsigned)p; }
DI float clamp_fp8(float x) { return fminf(fmaxf(x, -448.0f), 448.0f); }
constexpr int F8_SCALE_W = 0x79797979;
constexpr int F8_SCALE_A = 0x7c7c7c7c;
DI unsigned pk4_i8(float a, float b, float c, float d) {
    const int ia = (int)__builtin_rintf(fminf(fmaxf(a, -127.f), 127.f)), ib = (int)__builtin_rintf(fminf(fmaxf(b, -127.f), 127.f));
    const int ic = (int)__builtin_rintf(fminf(fmaxf(c, -127.f), 127.f)), id = (int)__builtin_rintf(fminf(fmaxf(d, -127.f), 127.f));
    return ((unsigned)ia & 0xffu) | (((unsigned)ib & 0xffu) << 8) | (((unsigned)ic & 0xffu) << 16) | ((unsigned)id << 24);
}
DI float wave_max(float v) {
#pragma unroll
    for (int o = 1; o < 64; o <<= 1) v = fmaxf(v, __shfl_xor(v, o));
    return v;
}
constexpr int GM_BF16 = 0, GM_FP8 = 1, GM_I8 = 2;

DI unsigned pk_bf16(float lo, float hi) { f32x2_t v = {lo, hi}; bf16x2_t b = __builtin_convertvector(v, bf16x2_t); return __builtin_bit_cast(unsigned, b); }
DI float bf_lo(unsigned w) { return __uint_as_float(w << 16); }
DI float bf_hi(unsigned w) { return __uint_as_float(w & 0xffff0000u); }
DI float bf2f(bf16_t v) { return __uint_as_float(((unsigned)v) << 16); }
DI bf16_t f2bf(float f) { return (bf16_t)(pk_bf16(f, 0.f) & 0xffffu); }
DI float fast_exp(float x) { return __builtin_amdgcn_exp2f(x * 1.4426950408889634f); }
DI float fast_rcp(float x) { return __builtin_amdgcn_rcpf(x); }
DI float fast_sigmoid(float x) { return fast_rcp(1.0f + fast_exp(-x)); }
DI float wave_sum(float v) {
#pragma unroll
    for (int o = 1; o < 64; o <<= 1) v += __shfl_xor(v, o);
    return v;
}
DI int crow(int reg, int h) { return (reg & 3) + 8 * (reg >> 2) + 4 * h; }
#define MFMA32(a, b, c) __builtin_amdgcn_mfma_f32_32x32x16_bf16((a), (b), (c), 0, 0, 0)

namespace pg8 {
constexpr int BM = 256, BK = 64, HALF = 128, HTB = HALF * BK * 2  , STAGE_BYTES = 8 * HTB, NXCD = 8, WGM = 8;
constexpr int EPI_LDS_OFF = 131072 + 1024 + 2048, EPI_SLOT_BYTES = 2048;
DI void dma16(const void* gsrc, LAS unsigned char* lds_uniform) { __builtin_amdgcn_global_load_lds((const unsigned*)gsrc, (LAS unsigned*)lds_uniform, 16, 0, 0); }

DI int lds_byte(int r, int c) { const int st = (r >> 4) * 2 + (c >> 5), rr = r & 15, cc = c & 31, ob = rr * 64 + cc * 2; return st * 1024 + (ob ^ (((ob >> 9) & 1) << 5)); }
DI void stage_rc(int b, int& R, int& C) { const int st = b / 1024, sb = b % 1024, swz = sb ^ (((sb >> 9) & 1) << 5); R = (st >> 1) * 16 + swz / 64; C = (st & 1) * 32 + (swz % 64) / 2; }
DI int perm32(int rho) { const int n = rho >> 4, i = rho & 15; return 8 * (i >> 2) + 4 * n + (i & 3); }

struct Unit { int pm, pn, e, rb, nrow; };

struct StaticOrder {
    int nM, nN, nwg, G, c;
    DI void init(int M, int N, int G_, int c_) { nM = M / BM; nN = N / BM; nwg = nM * nN; G = G_; c = c_; }
    DI bool next(int i, int& pm, int& pn) const {
        const long L = (long)i * G + c; if (L >= nwg) return false;
        int wgid = (int)L; { const int q = nwg / NXCD, r = nwg % NXCD, xcd = wgid % NXCD, off = wgid / NXCD; wgid = (xcd < r ? xcd * (q + 1) : r * (q + 1) + (xcd - r) * q) + off; }
        const int nig = WGM * nN, gid = wgid / nig, fm = gid * WGM, gsz = (nM - fm) < WGM ? (nM - fm) : WGM;
        pm = fm + ((wgid % nig) % gsz); pn = (wgid % nig) / gsz; return true;
    }
};

struct DenseProb {
    const bf16_t* A; const bf16_t* Bt; int K; StaticOrder S; int i0 = 0, i1 = 1 << 30;
    DI bool next(int i, Unit& u) const { int pm, pn; if (i + i0 >= i1 || !S.next(i + i0, pm, pn)) return false; u.pm = pm; u.pn = pn; u.e = 0; u.rb = 0; u.nrow = 256; return true; }
    DI const char* a_base(const Unit& u) const { return (const char*)A + (size_t)u.pm * 256 * K * 2; }
    DI const char* b_base(const Unit& u) const { return (const char*)Bt + (size_t)u.pn * 256 * K * 2; }
    DI void a_rows(const Unit&, const int (&R)[2], unsigned (&v)[2][2]) const {
#pragma unroll
        for (int h = 0; h < 2; ++h)
#pragma unroll
            for (int i = 0; i < 2; ++i) v[h][i] = (unsigned)(h * HALF + R[i]);
    }
};

template <int MODE, class Prob, class Epi>
DI void gemm_phase(LAS unsigned char* lds, const Prob& P, const Epi& E) {
    constexpr bool F8 = (MODE == GM_FP8);
    const int tid = threadIdx.x, wid = __builtin_amdgcn_readfirstlane(tid >> 6), lane = tid & 63, wr = wid >> 2, wc = wid & 3, fr = lane & 15, fq = lane >> 4;
    const int K = P.K, nt = K / BK;
    int sR[2], sC[2]; unsigned voffB[2];
#pragma unroll
    for (int i = 0; i < 2; ++i) { int R, C; stage_rc(tid * 16 + i * 8192, R, C); const int Rb = Epi::PERM ? ((R & ~31) + perm32(R & 31)) : R; sR[i] = R; sC[i] = C; voffB[i] = (unsigned)(Rb * K + C) * 2u; }
    const size_t kstep = (size_t)(BK * 2);
    const size_t hstep = (size_t)HALF * K * 2;
    const unsigned ldsw = (unsigned)wid * 1024u;
    const int aoff = lds_byte(wr * 64 + fr, fq * 8), boff = lds_byte(wc * 32 + fr, fq * 8);
#define PG8_SA(b, h) (((b) * 2 + (h)) * HTB)
#define PG8_SB(b, h) ((4 + (b) * 2 + (h)) * HTB)
#define PG8_STAGE2(bufoff, gbase, v0, v1) do { \
        __builtin_amdgcn_global_load_lds((const unsigned*)((const char*)(gbase) + (v0)), (LAS unsigned*)(lds + (bufoff) + ldsw), 16, 0, 0); \
        __builtin_amdgcn_global_load_lds((const unsigned*)((const char*)(gbase) + (v1)), (LAS unsigned*)(lds + (bufoff) + ldsw + 8192), 16, 0, 0); } while (0)
#define PG8_STAGEB(bufoff, gbase) PG8_STAGE2(bufoff, gbase, voffB[0], voffB[1])
#define PG8_LDA(dst, b, h) do { _Pragma("unroll") for (int m = 0; m < 4; ++m) { const i32x4 lo_ = *(const LAS i32x4*)(lds + PG8_SA(b, h) + aoff + m * 2048), hi_ = *(const LAS i32x4*)(lds + PG8_SA(b, h) + aoff + m * 2048 + 1024); \
        dst[m] = __builtin_shufflevector(lo_, hi_, 0, 1, 2, 3, 4, 5, 6, 7); } } while (0)
#define PG8_LDB(dst, b, h) do { _Pragma("unroll") for (int n = 0; n < 2; ++n) { const i32x4 lo_ = *(const LAS i32x4*)(lds + PG8_SB(b, h) + boff + n * 2048), hi_ = *(const LAS i32x4*)(lds + PG8_SB(b, h) + boff + n * 2048 + 1024); \
        dst[n] = __builtin_shufflevector(lo_, hi_, 0, 1, 2, 3, 4, 5, 6, 7); } } while (0)
#define PG8_MMA(ai, bj, At, Bt) do { __builtin_amdgcn_s_setprio(1); _Pragma("unroll") for (int m = 0; m < 4; ++m) _Pragma("unroll") for (int n = 0; n < 2; ++n) { \
        if constexpr (F8) asm volatile("v_mfma_scale_f32_16x16x128_f8f6f4 %0, %1, %2, %0, %3, %4 op_sel_hi:[0,0,0]" : "+v"(acc[ai][bj][m][n]) : "v"(Bt[n]), "v"(At[m]), "v"(f8sw), "v"(f8sa)); \
        else if constexpr (MODE == GM_I8) { i32x4 ci = __builtin_bit_cast(i32x4, acc[ai][bj][m][n]); \
               ci = __builtin_amdgcn_mfma_i32_16x16x64_i8(__builtin_shufflevector(Bt[n], Bt[n], 0, 1, 2, 3), __builtin_shufflevector(At[m], At[m], 0, 1, 2, 3), ci, 0, 0, 0); \
               ci = __builtin_amdgcn_mfma_i32_16x16x64_i8(__builtin_shufflevector(Bt[n], Bt[n], 4, 5, 6, 7), __builtin_shufflevector(At[m], At[m], 4, 5, 6, 7), ci, 0, 0, 0); acc[ai][bj][m][n] = __builtin_bit_cast(f32x4, ci); } \
        else { acc[ai][bj][m][n] = __builtin_amdgcn_mfma_f32_16x16x32_bf16(__builtin_bit_cast(bf16x8, __builtin_shufflevector(Bt[n], Bt[n], 0, 1, 2, 3)), __builtin_bit_cast(bf16x8, __builtin_shufflevector(At[m], At[m], 0, 1, 2, 3)), acc[ai][bj][m][n], 0, 0, 0); \
               acc[ai][bj][m][n] = __builtin_amdgcn_mfma_f32_16x16x32_bf16(__builtin_bit_cast(bf16x8, __builtin_shufflevector(Bt[n], Bt[n], 4, 5, 6, 7)), __builtin_bit_cast(bf16x8, __builtin_shufflevector(At[m], At[m], 4, 5, 6, 7)), acc[ai][bj][m][n], 0, 0, 0); } } \
        __builtin_amdgcn_s_setprio(0); } while (0)
#define PG8_WAIT_V(n) asm volatile("s_waitcnt vmcnt(" #n ")" ::: "memory")
#define PG8_WAIT_L(n) asm volatile("s_waitcnt lgkmcnt(" #n ")" ::: "memory")
#define PG8_BAR __builtin_amdgcn_s_barrier()
#define PG8_SCHED __builtin_amdgcn_sched_barrier(0)
    Unit cur, nxt; int ui = 0;
    if (!P.next(0, cur)) return;
    f32x4 acc[2][2][4][2];
#pragma unroll
    for (int a = 0; a < 2; ++a)
#pragma unroll
        for (int b = 0; b < 2; ++b)
#pragma unroll
            for (int m = 0; m < 4; ++m)
#pragma unroll
                for (int n = 0; n < 2; ++n) acc[a][b][m][n] = (f32x4){0.f, 0.f, 0.f, 0.f};
    i32x8 At[4], B0[2], B1[2];
    const int f8sw = F8_SCALE_W, f8sa = F8_SCALE_A;
    const char* cA = P.a_base(cur); const char* cB = P.b_base(cur);
    LAS unsigned char* const epi_lds = lds + EPI_LDS_OFF;
    if (wid == 0) E.prefetch(cur, epi_lds, lane);
    unsigned vAc[2][2], vAn[2][2];
#define PG8_OFF(row, i) (((row) * (unsigned)K + (unsigned)sC[i]) * 2u)
    P.a_rows(cur, sR, vAc);
#pragma unroll
    for (int h = 0; h < 2; ++h)
#pragma unroll
        for (int i = 0; i < 2; ++i) vAc[h][i] = PG8_OFF(vAc[h][i], i);
    PG8_STAGEB(PG8_SB(0, 0), cB); PG8_STAGEB(PG8_SB(0, 1), cB + hstep); PG8_STAGE2(PG8_SA(0, 0), cA, vAc[0][0], vAc[0][1]); PG8_STAGE2(PG8_SA(0, 1), cA, vAc[1][0], vAc[1][1]);
    if (wr == 1) PG8_BAR;
    PG8_WAIT_V(2); PG8_BAR;
    PG8_STAGEB(PG8_SB(1, 0), cB + kstep); PG8_STAGE2(PG8_SA(1, 0), cA + kstep, vAc[0][0], vAc[0][1]); PG8_STAGEB(PG8_SB(1, 1), cB + hstep + kstep);
    PG8_WAIT_V(6); PG8_BAR;
    for (;;) {
        const bool has_next = P.next(ui + 1, nxt);
        const char* nA = cA; const char* nB = cB;
        if (has_next) { nA = P.a_base(nxt); nB = P.b_base(nxt); P.a_rows(nxt, sR, vAn); }
        else {
#pragma unroll
            for (int h = 0; h < 2; ++h)
#pragma unroll
                for (int i = 0; i < 2; ++i) vAn[h][i] = vAc[h][i];
        }
        for (int t = 0; t < nt; t += 2) {
            const bool last = (t == nt - 2);
            const char* a1 = cA + (size_t)(t + 1) * kstep;
            const char* a2 = last ? nA : cA + (size_t)(t + 2) * kstep; const char* b2 = last ? nB : cB + (size_t)(t + 2) * kstep;
            const char* a3 = a2 + kstep; const char* b3 = b2 + kstep;
            unsigned w00 = vAc[0][0], w01 = vAc[0][1], w10 = vAc[1][0], w11 = vAc[1][1];
            if (last) { asm volatile("" : "+v"(vAn[0][0]), "+v"(vAn[0][1]), "+v"(vAn[1][0]), "+v"(vAn[1][1]));
                if (has_next) { vAn[0][0] = PG8_OFF(vAn[0][0], 0); vAn[0][1] = PG8_OFF(vAn[0][1], 1); vAn[1][0] = PG8_OFF(vAn[1][0], 0); vAn[1][1] = PG8_OFF(vAn[1][1], 1); }
                w00 = vAn[0][0]; w01 = vAn[0][1]; w10 = vAn[1][0]; w11 = vAn[1][1]; }
            PG8_LDB(B0, 0, 0); PG8_LDB(B1, 0, 1); PG8_SCHED; PG8_LDA(At, 0, 0); PG8_STAGE2(PG8_SA(1, 1), a1, vAc[1][0], vAc[1][1]);
            PG8_WAIT_V(8); PG8_WAIT_L(0); PG8_BAR; PG8_MMA(0, 0, At, B0); PG8_MMA(0, 1, At, B1); PG8_BAR; PG8_SCHED;
            PG8_LDA(At, 0, 1); PG8_STAGEB(PG8_SB(0, 0), b2); PG8_STAGEB(PG8_SB(0, 1), b2 + hstep); PG8_STAGE2(PG8_SA(0, 0), a2, w00, w01);
            PG8_WAIT_V(8); PG8_WAIT_L(0); PG8_BAR; PG8_MMA(1, 0, At, B0); PG8_MMA(1, 1, At, B1); PG8_BAR; PG8_SCHED;
            PG8_LDB(B0, 1, 0); PG8_LDB(B1, 1, 1); PG8_SCHED; PG8_LDA(At, 1, 0); PG8_STAGE2(PG8_SA(0, 1), a2, w10, w11);
            PG8_WAIT_V(8); PG8_WAIT_L(0); PG8_BAR; PG8_MMA(0, 0, At, B0); PG8_MMA(0, 1, At, B1); PG8_BAR; PG8_SCHED;
            PG8_LDA(At, 1, 1); PG8_STAGEB(PG8_SB(1, 0), b3); PG8_STAGEB(PG8_SB(1, 1), b3 + hstep); PG8_STAGE2(PG8_SA(1, 0), a3, w00, w01);
            PG8_WAIT_V(8); PG8_WAIT_L(0); PG8_BAR; PG8_MMA(1, 0, At, B0); PG8_MMA(1, 1, At, B1); PG8_BAR; PG8_SCHED;
        }
        if (wr == 0) PG8_BAR;
        if constexpr (F8) asm volatile("s_nop 15\n\ts_nop 15" ::: "memory");
        E(acc, cur, wr, wc, fr, fq, epi_lds + (ui & 1) * EPI_SLOT_BYTES);
        if (!has_next) break;
#pragma unroll
        for (int a = 0; a < 2; ++a)
#pragma unroll
            for (int b = 0; b < 2; ++b)
#pragma unroll
                for (int m = 0; m < 4; ++m)
#pragma unroll
                    for (int n = 0; n < 2; ++n) acc[a][b][m][n] = (f32x4){0.f, 0.f, 0.f, 0.f};
        cur = nxt; cA = nA; cB = nB; ++ui;
        if (wid == 0) E.prefetch(cur, epi_lds + (ui & 1) * EPI_SLOT_BYTES, lane);
#pragma unroll
        for (int h = 0; h < 2; ++h)
#pragma unroll
            for (int i = 0; i < 2; ++i) vAc[h][i] = vAn[h][i];
        if (wr == 1) PG8_BAR;
    }
    PG8_WAIT_V(0);
    PG8_BAR;
#undef PG8_OFF
#undef PG8_SA
#undef PG8_SB
#undef PG8_STAGE2
#undef PG8_STAGEB
#undef PG8_LDA
#undef PG8_LDB
#undef PG8_MMA
#undef PG8_WAIT_V
#undef PG8_WAIT_L
#undef PG8_BAR
#undef PG8_SCHED
}
}
namespace pg8 {
constexpr float LOG2E_ = 1.4426950408889634f;
constexpr float Y_SCALE = 32.0f;
template <bool I8> struct EpiBf16Plain {
    static constexpr bool PERM = true;
    bf16_t* O; int ldc; const float* sa; const float* cm;
    DI void prefetch(const Unit& u, LAS unsigned char* slot, int lane) const { if constexpr (I8) { dma16(sa + u.pm * BM + 4 * lane, slot); dma16(cm + u.pn * BM + 4 * lane, slot + 1024); } }
    DI void operator()(const f32x4 (&acc)[2][2][4][2], const Unit& u, int wr, int wc, int fr, int fq, const LAS unsigned char* slot) const {
        const int row0 = u.pm * BM + wr * 64 + fr, col0 = u.pn * BM + wc * 32 + 8 * fq;
        f32x4 sb[2][2];
        if constexpr (I8) {
#pragma unroll
            for (int bj = 0; bj < 2; ++bj)
#pragma unroll
                for (int n = 0; n < 2; ++n) sb[bj][n] = *(const LAS f32x4*)(slot + 1024 + (wc * 32 + 8 * fq + bj * HALF + 4 * n) * 4) * (1.0f / 127.0f); }
#pragma unroll
        for (int ai = 0; ai < 2; ++ai)
#pragma unroll
            for (int m = 0; m < 4; ++m) { const int row = row0 + ai * HALF + m * 16; bf16_t* rowp = O + (size_t)row * ldc + col0; float sr = 1.f; if constexpr (I8) sr = *(const LAS float*)(slot + (wr * 64 + fr + ai * HALF + m * 16) * 4);
#pragma unroll
                for (int bj = 0; bj < 2; ++bj) { f32x4 v0 = acc[ai][bj][m][0], v1 = acc[ai][bj][m][1];
                    if constexpr (I8) { const i32x4 i0 = __builtin_bit_cast(i32x4, v0), i1 = __builtin_bit_cast(i32x4, v1);
                        v0 = (f32x4){(float)i0[0], (float)i0[1], (float)i0[2], (float)i0[3]} * sb[bj][0] * sr; v1 = (f32x4){(float)i1[0], (float)i1[1], (float)i1[2], (float)i1[3]} * sb[bj][1] * sr; }
                    u32x4 w; w.x = pk_bf16(v0[0], v0[1]); w.y = pk_bf16(v0[2], v0[3]); w.z = pk_bf16(v1[0], v1[1]); w.w = pk_bf16(v1[2], v1[3]);
                    *(u32x4*)(rowp + bj * HALF) = w; } }
    }
};
template <bool I8> struct EpiResF32 {
    static constexpr bool PERM = true;
    const float* base; bf16_t* C; int ldc; const float* sa; const float* cm;
    DI void prefetch(const Unit& u, LAS unsigned char* slot, int lane) const { if constexpr (I8) { dma16(sa + u.pm * BM + 4 * lane, slot); dma16(cm + u.pn * BM + 4 * lane, slot + 1024); } }
    DI void operator()(const f32x4 (&acc)[2][2][4][2], const Unit& u, int wr, int wc, int fr, int fq, const LAS unsigned char* slot) const {
        const int row0 = u.pm * BM + wr * 64 + fr, col0 = u.pn * BM + wc * 32 + 8 * fq;
        f32x4 sb[2][2];
        if constexpr (I8) {
#pragma unroll
            for (int bj = 0; bj < 2; ++bj)
#pragma unroll
                for (int n = 0; n < 2; ++n) sb[bj][n] = *(const LAS f32x4*)(slot + 1024 + (wc * 32 + 8 * fq + bj * HALF + 4 * n) * 4) * (1.0f / 127.0f); }
#pragma unroll
        for (int ai = 0; ai < 2; ++ai)
#pragma unroll
            for (int m = 0; m < 4; ++m) { const int row = row0 + ai * HALF + m * 16; const size_t off = (size_t)row * ldc + col0; float sr = 1.f; if constexpr (I8) sr = *(const LAS float*)(slot + (wr * 64 + fr + ai * HALF + m * 16) * 4);
#pragma unroll
                for (int bj = 0; bj < 2; ++bj)
                { f32x4 v[2];
#pragma unroll
                    for (int n = 0; n < 2; ++n) { v[n] = acc[ai][bj][m][n];
                        if constexpr (I8) { const i32x4 iv = __builtin_bit_cast(i32x4, v[n]); v[n] = (f32x4){(float)iv[0], (float)iv[1], (float)iv[2], (float)iv[3]} * sb[bj][n] * sr; }
                        v[n] = v[n] + *(const f32x4*)(base + off + bj * HALF + 4 * n); }
                    u32x4 w; w.x = pk_bf16(v[0][0], v[0][1]); w.y = pk_bf16(v[0][2], v[0][3]); w.z = pk_bf16(v[1][0], v[1][1]); w.w = pk_bf16(v[1][2], v[1][3]);
                    *(u32x4*)(C + off + bj * HALF) = w; } }
    }
};
struct EpiGlu {
    static constexpr bool PERM = true;
    unsigned char* O; int ldc; const float* bias;
    DI void prefetch(const Unit& u, LAS unsigned char* slot, int lane) const { dma16(bias + (size_t)u.e * 4096 + (lane >> 5) * 2048 + u.pn * HALF + 4 * (lane & 31), slot); }
    DI void operator()(const f32x4 (&acc)[2][2][4][2], const Unit& u, int wr, int wc, int fr, int fq, const LAS unsigned char* slot) const {
        typedef float f2 __attribute__((ext_vector_type(2)));
        const int row0 = u.pm * BM + wr * 64 + fr, colg = u.pn * HALF + wc * 32 + 8 * fq;
        f32x4 bgl[2], bln[2];
#pragma unroll
        for (int n = 0; n < 2; ++n) { bgl[n] = *(const LAS f32x4*)(slot + (wc * 32 + 8 * fq + 4 * n) * 4); bln[n] = *(const LAS f32x4*)(slot + 512 + (wc * 32 + 8 * fq + 4 * n) * 4); }
#pragma unroll
        for (int ai = 0; ai < 2; ++ai)
#pragma unroll
            for (int m = 0; m < 4; ++m) { unsigned char* rowp = O + (size_t)(row0 + ai * HALF + m * 16) * ldc + colg;
                f2 r[4];
#pragma unroll
                for (int n = 0; n < 2; ++n)
#pragma unroll
                    for (int jj = 0; jj < 2; ++jj) { const int j = 2 * jj;
                        f2 g = (f2){acc[ai][0][m][n][j], acc[ai][0][m][n][j + 1]} + (f2){bgl[n][j], bgl[n][j + 1]};
                        f2 l = (f2){acc[ai][1][m][n][j], acc[ai][1][m][n][j + 1]} + (f2){bln[n][j], bln[n][j + 1]};
                        g.x = fminf(g.x, 7.0f); g.y = fminf(g.y, 7.0f); l.x = __builtin_amdgcn_fmed3f(l.x, -7.0f, 7.0f); l.y = __builtin_amdgcn_fmed3f(l.y, -7.0f, 7.0f);
                        const f2 t = g * (-1.702f * LOG2E_);
                        f2 e; e.x = __builtin_amdgcn_exp2f(t.x); e.y = __builtin_amdgcn_exp2f(t.y);
                        const f2 d = e + 1.0f;
                        f2 q; q.x = __builtin_amdgcn_rcpf(d.x); q.y = __builtin_amdgcn_rcpf(d.y);
                        r[2 * n + jj] = (g * q) * (l * 8.0f + 8.0f); }
                u32x2 w; w.x = pk4_fp8(r[0].x, r[0].y, r[1].x, r[1].y); w.y = pk4_fp8(r[2].x, r[2].y, r[3].x, r[3].y);
                *(u32x2*)rowp = w; }
    }
};
struct EpiF8BiasE {
    static constexpr bool PERM = true;
    unsigned char* O; int ldc; const float* bias;
    DI void prefetch(const Unit& u, LAS unsigned char* slot, int lane) const { dma16(bias + (size_t)u.e * 2048 + u.pn * BM + 4 * lane, slot); }
    DI void operator()(const f32x4 (&acc)[2][2][4][2], const Unit& u, int wr, int wc, int fr, int fq, const LAS unsigned char* slot) const {
        const int row0 = u.pm * BM + wr * 64 + fr, col0 = u.pn * BM + wc * 32 + 8 * fq;
        f32x4 bv[2][2];
#pragma unroll
        for (int bj = 0; bj < 2; ++bj)
#pragma unroll
            for (int n = 0; n < 2; ++n) bv[bj][n] = *(const LAS f32x4*)(slot + (wc * 32 + 8 * fq + bj * HALF + 4 * n) * 4);
#pragma unroll
        for (int ai = 0; ai < 2; ++ai)
#pragma unroll
            for (int m = 0; m < 4; ++m) { unsigned char* rowp = O + (size_t)(row0 + ai * HALF + m * 16) * ldc + col0;
#pragma unroll
                for (int bj = 0; bj < 2; ++bj) { const f32x4 v0 = (acc[ai][bj][m][0] + bv[bj][0]) * Y_SCALE, v1 = (acc[ai][bj][m][1] + bv[bj][1]) * Y_SCALE;
                    u32x2 w; w.x = pk4_fp8(clamp_fp8(v0[0]), clamp_fp8(v0[1]), clamp_fp8(v0[2]), clamp_fp8(v0[3])); w.y = pk4_fp8(clamp_fp8(v1[0]), clamp_fp8(v1[1]), clamp_fp8(v1[2]), clamp_fp8(v1[3]));
                    *(u32x2*)(rowp + bj * HALF) = w; } }
    }
};
}
constexpr int NWAVES = 8;
constexpr int NTOK = 16384, DM = 2048, SEQ = 2048, NBATCH = 8;
constexpr int DIN = 12816, LDP = 13056;
constexpr int C_QA = 0, C_KA = 2048, C_VA = 2304, C_QB = 2560, C_KB = 3584, C_VB = 4608, C_RB = 6656, C_GA = 8704, C_GB = 10752, C_ALR = 12800;
constexpr int NEXP = 32, TOPK = 4, DFF = 2048;
constexpr int PMAX = 73728;
constexpr float EPS = 1e-5f;
constexpr float LOG2E = 1.4426950408889634f;
#ifndef MK_I8_P1
#define MK_I8_P1 1
#endif
#ifndef MK_I8_P5
#define MK_I8_P5 0
#endif
constexpr bool I8_P1 = MK_I8_P1 != 0, I8_P5 = MK_I8_P5 != 0;
constexpr bool I8_DENSE = I8_P1 || I8_P5;
#ifndef MK_MIX_CLIP
#define MK_MIX_CLIP 1e30f
#endif
constexpr float MIX_CLIP = MK_MIX_CLIP;
#ifndef MK_STAGGER_US
#define MK_STAGGER_US 0
#endif
constexpr int STAGGER_US = MK_STAGGER_US;

constexpr size_t MiB = 1u << 20;
constexpr size_t WS_CTL = 0, CTL_ZERO_BYTES = 1 * MiB;
constexpr size_t WS_TOPE = 1 * MiB;
constexpr size_t WS_TOPS = WS_TOPE + (size_t)NTOK * 4 * 4;
constexpr size_t WS_GATE = WS_TOPS + (size_t)NTOK * 4 * 4;
constexpr size_t WS_TOKL = WS_GATE + (size_t)NTOK * 4 * 4;
constexpr size_t WS_WIN  = 4 * MiB;
constexpr size_t WS_WOUT = WS_WIN + (size_t)LDP * DM * 2;
constexpr size_t WS_WGU  = WS_WOUT + (size_t)DM * DM * 2;
constexpr size_t WS_WDN  = WS_WGU + (size_t)NEXP * 4096 * DM * 2;
constexpr size_t WS_H    = WS_WDN + (size_t)NEXP * DM * DM * 2;
constexpr size_t WS_PROJ = WS_H + (size_t)NTOK * DM * 2;
constexpr size_t WS_OA   = WS_PROJ + (size_t)NTOK * LDP * 2;
constexpr size_t WS_OB   = WS_OA + (size_t)NTOK * DM * 2;
constexpr size_t WS_MIX  = WS_OB + (size_t)NTOK * DM * 2;
constexpr size_t WS_X1   = WS_MIX + (size_t)NTOK * DM * 2;
constexpr size_t WS_GQT  = WS_X1 + (size_t)NTOK * DM * 4;
constexpr size_t WS_GKT  = WS_GQT + (size_t)1024 * 16384 * 2;
constexpr size_t WS_GATT = WS_GKT + (size_t)1024 * 16384 * 2;
constexpr size_t WS_GDEC = WS_GATT + (size_t)1024 * 4096 * 2;
constexpr size_t WS_GVT  = WS_GDEC + (size_t)1024 * 256 * 4;
constexpr size_t WS_ACT  = WS_GVT + (size_t)1024 * 32768 * 2;
constexpr size_t WS_Y    = WS_ACT + (size_t)PMAX * DFF * 2;
constexpr size_t WS_END  = WS_Y + (size_t)PMAX * DM * 2;
constexpr size_t WS_SAH  = WS_TOKL + (size_t)NEXP * NTOK * 4;
constexpr size_t WS_SAMIX = WS_SAH + (size_t)NTOK * 4;
static_assert(WS_SAMIX + (size_t)NTOK * 4 <= WS_WIN, "row scales below the weight copies");
static_assert(WS_WIN % 256 == 0 && WS_WOUT % 256 == 0 && WS_WGU % 256 == 0 && WS_WDN % 256 == 0 && WS_H % 256 == 0 && WS_PROJ % 256 == 0 && WS_OA % 256 == 0 && WS_X1 % 256 == 0 &&
              WS_GQT % 256 == 0 && WS_GKT % 256 == 0 && WS_GATT % 256 == 0 && WS_GDEC % 256 == 0 && WS_GVT % 256 == 0 && WS_ACT % 256 == 0 && WS_Y % 256 == 0, "alignment");
constexpr int CW_TMO = 0, CW_CODE = 1;
constexpr int CW_BAR = 4096;
constexpr int CW_CNT = 8192;
constexpr int CW_SWAQ = CW_CNT + 64 * 40;
constexpr int CW_CVQ = CW_CNT + 64 * 41;
constexpr int P0_NITEMS = 16 * 408 + 16 * 64 + 32 * 16 * 128 + 32 * 16 * 64;
constexpr int P0_EARLY = 16 * 408 + 16 * 64;
constexpr int P0_LATE = 32768;
constexpr int P0_EMBED = P0_NITEMS - P0_EARLY - P0_LATE;
constexpr int EMB_PER_WAVE = P0_EMBED / 2048;
#ifndef MK_EMB_P5
#define MK_EMB_P5 4
#endif
constexpr int EMB_P5 = MK_EMB_P5;
#ifndef MK_SUPER_RB16
#define MK_SUPER_RB16 4
#endif
constexpr int SUPER_RB16 = MK_SUPER_RB16;
static_assert(P0_EMBED == 2048 * EMB_PER_WAVE && EMB_P5 <= EMB_PER_WAVE, "embedded copy items divide evenly over 2048 waves");
constexpr int CV_GROUP = 8, CV_NGROUPS = P0_LATE / CV_GROUP;
constexpr int CW_CMAX_IN = 16384, CW_CMAX_OUT = CW_CMAX_IN + LDP;
static_assert((CW_CMAX_OUT + DM) * 4 <= (int)CTL_ZERO_BYTES, "CTL words inside the memset region");
constexpr int RING_OFF = 0, RING_BYTES = 131072;
constexpr int LDSCTL_OFF = RING_BYTES, MISC_OFF = LDSCTL_OFF + 320;
constexpr int TBL_OFF = LDSCTL_OFF + 1024;
constexpr int LDS_BYTES = 147456;
static_assert(MISC_OFF + 128 <= TBL_OFF && TBL_OFF + 4096 <= LDS_BYTES, "LDS map");

typedef GAS unsigned gu32;
#define RLX_AGENT __ATOMIC_RELAXED, __HIP_MEMORY_SCOPE_AGENT
#define LDS_WAIT() asm volatile("s_waitcnt lgkmcnt(0)" ::: "memory")
#define VM_WAIT() asm volatile("s_waitcnt vmcnt(0)" ::: "memory")

#define XB_TMO      128
#define XB_XCNT(j)  (256  + 64 * (j))
#define XB_XSUB(j)  (1280 + 64 * (j))
#define XB_XGEN(j)  (2304 + 64 * (j))
#define XB_TOP      3328
#define XB_TOPGEN   3392
#define XCD_BAR_WORDS 3456
#define XB_SPIN_CAP (1u << 18)

__device__ __forceinline__ unsigned xb_ld(unsigned* p)              { return __hip_atomic_load(p, __ATOMIC_RELAXED, __HIP_MEMORY_SCOPE_AGENT); }
__device__ __forceinline__ unsigned xb_add(unsigned* p, unsigned v) { return __hip_atomic_fetch_add(p, v, __ATOMIC_RELAXED, __HIP_MEMORY_SCOPE_AGENT); }
__device__ __forceinline__ unsigned xb_xcc_id() { return (unsigned)__builtin_amdgcn_s_getreg((3 << 11) | 20) & 0xFu; }
#define XB_SPIN(cond, bar) do { unsigned _sp = 0; while (cond) { __builtin_amdgcn_s_sleep(1); \
    if ((++_sp & 255u) == 0u) { if (xb_ld(&(bar)[XB_TMO])) break; if (_sp > XB_SPIN_CAP) { atomicAdd(&(bar)[XB_TMO], 1u); break; } } } } while (0)

struct XcdBarrier {
    unsigned* bar; unsigned x;
    volatile LAS unsigned* st;
};

__device__ __forceinline__ XcdBarrier xcd_barrier_post(unsigned* bar, volatile LAS unsigned* st) {
    XcdBarrier b; b.bar = bar; b.x = xb_xcc_id(); b.st = st;
    if (threadIdx.x == 0) (void)xb_add(&bar[XB_XCNT(b.x)], 1u);
    return b;
}
__device__ __forceinline__ void xcd_barrier_complete(unsigned* bar, unsigned x, unsigned& nloc, unsigned& nx) {
    const unsigned G = gridDim.x * gridDim.y * gridDim.z;
    unsigned sum, cnt, mine, sp = 0u;
    for (;;) {
        sum = 0u; cnt = 0u; mine = 0u;
#pragma unroll
        for (unsigned j = 0; j < 16; ++j) { const unsigned c = xb_ld(&bar[XB_XCNT(j)]); sum += c; cnt += (c > 0u) ? 1u : 0u; mine = (j == x) ? c : mine; }
        if (sum == G) break;
        __builtin_amdgcn_s_sleep(1);
        if ((++sp & 255u) == 0u) { if (xb_ld(&bar[XB_TMO])) break; if (sp > XB_SPIN_CAP) { atomicAdd(&bar[XB_TMO], 1u); break; } }
    }
    nloc = mine > 0u ? mine : 1u; nx = cnt > 0u ? cnt : 1u;
}

__device__ __forceinline__ void xcd_barrier(const XcdBarrier& b) {
    asm volatile("s_waitcnt vmcnt(0)" ::: "memory");
    __syncthreads();
    if (threadIdx.x == 0) {
        unsigned* bar = b.bar;
        __builtin_amdgcn_s_waitcnt(0);
        unsigned nloc = b.st[0], nx = b.st[1];
        if (nloc == 0u) { xcd_barrier_complete(bar, b.x, nloc, nx); b.st[0] = nloc; b.st[1] = nx; }
        const unsigned old = xb_add(&bar[XB_XSUB(b.x)], 1u);
        const unsigned gen = old / nloc;
        if (old + 1u == (gen + 1u) * nloc) {
            __builtin_amdgcn_fence(__ATOMIC_RELEASE, "agent");
            asm volatile("s_waitcnt vmcnt(0)" ::: "memory");
            const unsigned og = xb_add(&bar[XB_TOP], 1u);
            const unsigned tg = og / nx;
            if (og + 1u == (tg + 1u) * nx) xb_add(&bar[XB_TOPGEN], 1u);
            else XB_SPIN(xb_ld(&bar[XB_TOPGEN]) == tg, bar);
            __builtin_amdgcn_fence(__ATOMIC_ACQUIRE, "agent");
            xb_add(&bar[XB_XGEN(b.x)], 1u);
            asm volatile("s_waitcnt vmcnt(0)" ::: "memory");
        } else {
            XB_SPIN(xb_ld(&bar[XB_XGEN(b.x)]) == gen, bar);
            __builtin_amdgcn_fence(__ATOMIC_ACQUIRE, "agent");
            asm volatile("s_waitcnt vmcnt(0)" ::: "memory");
        }
    }
    __syncthreads();
}

struct Frame {
    LAS unsigned char* lds;
    gu32* ctl;
    int tid, lane, wave, vcu, G;
    const float *x, *attn_g, *w_in, *sinks, *w_alpha2, *b_alpha, *gla_g, *w_out, *ffn_g, *w_router, *b_router, *w_gu, *b_gu, *w_dn, *b_dn, *final_g;
    float* out;
    int *tope, *tops, *tokl; float* gate;
    float *sa_h, *sa_mix;
    bf16_t *Win, *Wout, *Wgu, *Wdn, *H, *PROJ, *OA, *OB, *MIX, *GQT, *GKT, *GATT, *GVT, *ACT, *Y;
    bf16_t* X1; float* GDEC;
};
DI void p0_transpose_item(const float* Wsrc, int ldw, int srccol0, int nvalid, int k0, bf16_t* dst, int K, LAS float* scr, int lane) {
    const int krow = lane >> 3, n4 = lane & 7;
    const bool ok = 4 * n4 < nvalid;
#pragma unroll
    for (int i = 0; i < 8; ++i) { const int kk = 8 * i + krow; f32x4 v = (f32x4){0.f, 0.f, 0.f, 0.f};
        if (ok) v = *(const f32x4*)(Wsrc + (size_t)(k0 + kk) * ldw + srccol0 + 4 * n4);
        LAS float* d = scr + kk * 33 + 4 * n4; d[0] = v[0]; d[1] = v[1]; d[2] = v[2]; d[3] = v[3]; }
    LDS_WAIT(); asm volatile("" ::: "memory");
    const int c = lane & 7;
#pragma unroll
    for (int j = 0; j < 4; ++j) { const int n = (lane >> 3) + 8 * j; const LAS float* s = scr + (8 * c) * 33 + n;
        u32x4 o; o.x = pk_bf16(s[0 * 33], s[1 * 33]); o.y = pk_bf16(s[2 * 33], s[3 * 33]); o.z = pk_bf16(s[4 * 33], s[5 * 33]); o.w = pk_bf16(s[6 * 33], s[7 * 33]);
        *(u32x4*)(dst + (size_t)n * K + k0 + 8 * c) = o; }
    LDS_WAIT(); asm volatile("" ::: "memory");
}
DI void rms_row_to_bf16(const float* xrow, const float* g, bf16_t* orow, int lane) {
    const f32x4* xr = (const f32x4*)xrow + lane; const f32x4* gr = (const f32x4*)g + lane;
    f32x4 v[8]; float s = 0.f;
#pragma unroll
    for (int j = 0; j < 8; ++j) { v[j] = xr[64 * j]; s += (v[j].x * v[j].x + v[j].y * v[j].y) + (v[j].z * v[j].z + v[j].w * v[j].w); }
    const float r = 1.0f / sqrtf(wave_sum(s) * (1.f / DM) + EPS);
    u32x2* o8 = (u32x2*)orow + lane;
#pragma unroll
    for (int j = 0; j < 8; ++j) { const f32x4 gg = gr[64 * j]; u32x2 w; w.x = pk_bf16(v[j].x * r * gg.x, v[j].y * r * gg.y); w.y = pk_bf16(v[j].z * r * gg.z, v[j].w * r * gg.w); o8[64 * j] = w; }
}
DI void p0_transpose_item_f8(const float* Wsrc, int ldw, int srccol0, int nvalid, int k0, unsigned char* dst, int K, LAS float* scr, int lane) {
    const int krow = lane >> 3, n4 = lane & 7;
    const bool ok = 4 * n4 < nvalid;
#pragma unroll
    for (int i = 0; i < 8; ++i) { const int kk = 8 * i + krow; f32x4 v = (f32x4){0.f, 0.f, 0.f, 0.f};
        if (ok) v = *(const f32x4*)(Wsrc + (size_t)(k0 + kk) * ldw + srccol0 + 4 * n4);
        LAS float* d = scr + kk * 33 + 4 * n4; d[0] = v[0]; d[1] = v[1]; d[2] = v[2]; d[3] = v[3]; }
    LDS_WAIT(); asm volatile("" ::: "memory");
    const int c = lane & 7;
#pragma unroll
    for (int j = 0; j < 4; ++j) { const int n = (lane >> 3) + 8 * j; const LAS float* s = scr + (8 * c) * 33 + n;
        u32x2 o; o.x = pk4_fp8(64.f * s[0 * 33], 64.f * s[1 * 33], 64.f * s[2 * 33], 64.f * s[3 * 33]); o.y = pk4_fp8(64.f * s[4 * 33], 64.f * s[5 * 33], 64.f * s[6 * 33], 64.f * s[7 * 33]);
        *(u32x2*)(dst + (size_t)n * K + k0 + 8 * c) = o; }
    LDS_WAIT(); asm volatile("" ::: "memory");
}
DI void rms_row_to_f8(const float* xrow, const float* g, unsigned char* orow, int lane) {
    const f32x4* xr = (const f32x4*)xrow + lane; const f32x4* gr = (const f32x4*)g + lane;
    f32x4 v[8]; float s = 0.f;
#pragma unroll
    for (int j = 0; j < 8; ++j) { v[j] = xr[64 * j]; s += (v[j].x * v[j].x + v[j].y * v[j].y) + (v[j].z * v[j].z + v[j].w * v[j].w); }
    const float r = 8.0f / sqrtf(wave_sum(s) * (1.f / DM) + EPS);
    unsigned* o4 = (unsigned*)orow + lane;
#pragma unroll
    for (int j = 0; j < 8; ++j) { const f32x4 gg = gr[64 * j]; o4[64 * j] = pk4_fp8(clamp_fp8(v[j].x * r * gg.x), clamp_fp8(v[j].y * r * gg.y), clamp_fp8(v[j].z * r * gg.z), clamp_fp8(v[j].w * r * gg.w)); }
}
struct P0Item { const float* src; unsigned char* dst; int ldw, pitch, mode; bool ok, live; f32x4 inv; };
DI f32x4 p0_inv(const float* cmax) { const f32x4 c = *(const f32x4*)cmax; return (f32x4){127.f / fmaxf(c.x, 1e-30f), 127.f / fmaxf(c.y, 1e-30f), 127.f / fmaxf(c.z, 1e-30f), 127.f / fmaxf(c.w, 1e-30f)}; }
DI P0Item p0_decode(Frame& F, int it, int nitems, int lane) {
    constexpr int I_IN = 16 * 408, I_OUT = 16 * 64, I_GU = 32 * 16 * 128;
    const int kc = lane >> 3, n4 = lane & 7;
    P0Item d; d.live = it < nitems; d.ok = true; d.mode = GM_FP8; d.ldw = DM; d.pitch = DM; d.src = F.w_in; d.dst = (unsigned char*)F.Win; d.inv = (f32x4){0.f, 0.f, 0.f, 0.f};
    if (!d.live) { d.ok = false; return d; }
    int r = it;
    int dmode = I8_P1 ? GM_I8 : GM_BF16, esz = I8_P1 ? 1 : 2;
    if (r < I_IN) { const int kb = r / 408, nb = r % 408, n0 = 32 * nb; int sc = n0, nv = 32;
        if (n0 >= 8704 && n0 < 12800) sc = n0 + 16; else if (n0 == 12800) { sc = 8704; nv = 16; } else if (n0 > 12800) { sc = 0; nv = 0; }
        d.mode = dmode; d.ok = 4 * n4 < nv; d.ldw = DIN; d.src = F.w_in + (size_t)(128 * kb + 16 * kc) * DIN + sc + 4 * n4;
        if (I8_P1) d.inv = p0_inv((const float*)(F.ctl + CW_CMAX_IN) + n0 + 4 * n4);
        d.pitch = DM * esz; d.dst = (unsigned char*)F.Win + (size_t)(n0 + 4 * n4) * d.pitch + (128 * kb + 16 * kc) * esz; return d; }
    r -= I_IN; dmode = I8_P5 ? GM_I8 : GM_BF16; esz = I8_P5 ? 1 : 2;
    if (r < I_OUT) { const int kb = r / 64, nb = r % 64; d.mode = dmode; d.ldw = DM; d.src = F.w_out + (size_t)(128 * kb + 16 * kc) * DM + 32 * nb + 4 * n4;
        if (I8_P5) d.inv = p0_inv((const float*)(F.ctl + CW_CMAX_OUT) + 32 * nb + 4 * n4);
        d.pitch = DM * esz; d.dst = (unsigned char*)F.Wout + (size_t)(32 * nb + 4 * n4) * d.pitch + (128 * kb + 16 * kc) * esz; return d; }
    r -= I_OUT;
    if (r < I_GU) { const int e = r / 2048, rr = r % 2048, kb = rr / 128, nb = rr % 128, n0 = 32 * nb, pn = n0 >> 8, i0 = n0 & 255;
        const int sc = (i0 < 128) ? (128 * pn + i0) : (2048 + 128 * pn + i0 - 128);
        d.ldw = 4096; d.src = F.w_gu + (size_t)e * DM * 4096 + (size_t)(128 * kb + 16 * kc) * 4096 + sc + 4 * n4; d.pitch = DM;
        d.dst = (unsigned char*)F.Wgu + ((size_t)e * 4096 + n0 + 4 * n4) * DM + 128 * kb + 16 * kc; return d; }
    r -= I_GU;
    { const int e = r / 1024, rr = r % 1024, kb = rr / 64, nb = rr % 64;
        d.ldw = DM; d.src = F.w_dn + (size_t)e * DFF * DM + (size_t)(128 * kb + 16 * kc) * DM + 32 * nb + 4 * n4; d.pitch = DFF;
        d.dst = (unsigned char*)F.Wdn + ((size_t)e * DM + 32 * nb + 4 * n4) * DFF + 128 * kb + 16 * kc; return d; }
}
DI void p0_load(const P0Item& d, f32x4 (&v)[16]) {
#pragma unroll
    for (int j = 0; j < 16; ++j) { v[j] = (f32x4){0.f, 0.f, 0.f, 0.f}; if (d.ok) v[j] = __builtin_nontemporal_load((const f32x4*)(d.src + (size_t)j * d.ldw)); }
}
DI void p0_store(const P0Item& d, const f32x4 (&v)[16]) {
    if (!d.live) return;
    if (d.mode == GM_FP8) {
#pragma unroll
        for (int q = 0; q < 4; ++q) { u32x4 o;
#define W8(j) __builtin_amdgcn_fmed3f(64.f * v[j][q], -448.f, 448.f)
            o.x = pk4_fp8(W8(0), W8(1), W8(2), W8(3)); o.y = pk4_fp8(W8(4), W8(5), W8(6), W8(7)); o.z = pk4_fp8(W8(8), W8(9), W8(10), W8(11)); o.w = pk4_fp8(W8(12), W8(13), W8(14), W8(15));
#undef W8
            __builtin_nontemporal_store(o, (u32x4*)(d.dst + (size_t)q * d.pitch)); }
    } else if (d.mode == GM_I8) {
#pragma unroll
        for (int q = 0; q < 4; ++q) { const float s = d.inv[q]; u32x4 o; o.x = pk4_i8(s * v[0][q], s * v[1][q], s * v[2][q], s * v[3][q]); o.y = pk4_i8(s * v[4][q], s * v[5][q], s * v[6][q], s * v[7][q]);
            o.z = pk4_i8(s * v[8][q], s * v[9][q], s * v[10][q], s * v[11][q]); o.w = pk4_i8(s * v[12][q], s * v[13][q], s * v[14][q], s * v[15][q]);
            *(u32x4*)(d.dst + (size_t)q * d.pitch) = o; }
    } else {
#pragma unroll
        for (int q = 0; q < 4; ++q) { u32x4 o; o.x = pk_bf16(v[0][q], v[1][q]); o.y = pk_bf16(v[2][q], v[3][q]); o.z = pk_bf16(v[4][q], v[5][q]); o.w = pk_bf16(v[6][q], v[7][q]);
            *(u32x4*)(d.dst + (size_t)q * d.pitch) = o;
            o.x = pk_bf16(v[8][q], v[9][q]); o.y = pk_bf16(v[10][q], v[11][q]); o.z = pk_bf16(v[12][q], v[13][q]); o.w = pk_bf16(v[14][q], v[15][q]);
            *(u32x4*)(d.dst + (size_t)q * d.pitch + 16) = o; }
    }
}
DI void rms_row_to_i8(const float* xrow, const float* g, unsigned char* orow, float* sa, int lane) {
    const f32x4* xr = (const f32x4*)xrow + lane; const f32x4* gr = (const f32x4*)g + lane;
    f32x4 v[8]; float s = 0.f;
#pragma unroll
    for (int j = 0; j < 8; ++j) { v[j] = xr[64 * j]; s += (v[j].x * v[j].x + v[j].y * v[j].y) + (v[j].z * v[j].z + v[j].w * v[j].w); }
    const float r = 1.0f / sqrtf(wave_sum(s) * (1.f / DM) + EPS);
    float am = 0.f;
#pragma unroll
    for (int j = 0; j < 8; ++j) { const f32x4 gg = gr[64 * j]; v[j] = v[j] * gg * r; am = fmaxf(am, fmaxf(fmaxf(fabsf(v[j].x), fabsf(v[j].y)), fmaxf(fabsf(v[j].z), fabsf(v[j].w)))); }
    am = fmaxf(wave_max(am), 1e-30f);
    const float inv = 127.f / am;
    if (lane == 0) *sa = am * (1.f / 127.f);
    unsigned* o4 = (unsigned*)orow + lane;
#pragma unroll
    for (int j = 0; j < 8; ++j) o4[64 * j] = pk4_i8(v[j].x * inv, v[j].y * inv, v[j].z * inv, v[j].w * inv);
}
DI void colmax_phase(Frame& F) {
    if (!I8_DENSE) return;
    const int gw = F.vcu * NWAVES + F.wave, NGW = F.G * NWAVES, lane = F.lane, kc = lane >> 4, n4 = lane & 15;
    constexpr int NB_IN = (DIN + 63) / 64, I_IN = 32 * NB_IN, I_OUT = 32 * 32;
    for (int it = gw; it < I_IN + I_OUT; it += NGW) {
        const bool in = it < I_IN; const int r = in ? it : it - I_IN, nbs = in ? NB_IN : 32, kb = r / nbs, nb = r % nbs, ldw = in ? DIN : DM, c0 = 64 * nb + 4 * n4;
        const bool ok = c0 < ldw;
        const float* src = (in ? F.w_in : F.w_out) + (size_t)(64 * kb + kc) * ldw + c0;
        f32x4 m = (f32x4){0.f, 0.f, 0.f, 0.f};
        if (ok) {
#pragma unroll
            for (int j = 0; j < 16; ++j) { const f32x4 v = *(const f32x4*)(src + (size_t)(4 * j) * ldw); m.x = fmaxf(m.x, fabsf(v.x)); m.y = fmaxf(m.y, fabsf(v.y)); m.z = fmaxf(m.z, fabsf(v.z)); m.w = fmaxf(m.w, fabsf(v.w)); } }
#pragma unroll
        for (int q = 0; q < 4; ++q) { m[q] = fmaxf(m[q], __shfl_xor(m[q], 16)); m[q] = fmaxf(m[q], __shfl_xor(m[q], 32)); }
        if (ok && kc == 0) { int n = c0; if (in) { if (c0 >= 8720) n = c0 - 16; else if (c0 >= 8704) n = 12800 + c0 - 8704; }
            unsigned* dst = (unsigned*)(F.ctl + (in ? CW_CMAX_IN : CW_CMAX_OUT)) + n;
#pragma unroll
            for (int q = 0; q < 4; ++q) __hip_atomic_fetch_max(dst + q, __float_as_uint(m[q]), __ATOMIC_RELAXED, __HIP_MEMORY_SCOPE_AGENT); }
    }
}
DI void p0_prologue(Frame& F) {
    const int gw = F.vcu * NWAVES + F.wave, NGW = F.G * NWAVES;
    constexpr int NITEMS = P0_EARLY;
    f32x4 va[16], vb[16];
    P0Item da = p0_decode(F, gw, NITEMS, F.lane), db;
    p0_load(da, va);
    for (int it = gw; it < NITEMS; it += 2 * NGW) {
        db = p0_decode(F, it + NGW, NITEMS, F.lane); p0_load(db, vb);
        p0_store(da, va);
        da = p0_decode(F, it + 2 * NGW, NITEMS, F.lane); p0_load(da, va);
        p0_store(db, vb);
    }
    for (int m = gw; m < NTOK; m += NGW) { if (I8_P1) rms_row_to_i8(F.x + (size_t)m * DM, F.attn_g, (unsigned char*)F.H + (size_t)m * DM, F.sa_h + m, F.lane); else rms_row_to_bf16(F.x + (size_t)m * DM, F.attn_g, F.H + (size_t)m * DM, F.lane); }
}

DI void embed_copy_range(Frame& F, int i0, int i1) {
    if (F.G != 256) { if (i0 != 0) return;
        const int gw = F.vcu * NWAVES + F.wave, NGW = F.G * NWAVES; f32x4 va[16];
        for (int it = P0_EARLY + gw; it < P0_EARLY + P0_EMBED; it += NGW) { const P0Item da = p0_decode(F, it, P0_NITEMS, F.lane); p0_load(da, va); p0_store(da, va); }
        return; }
    const int gw = F.vcu * NWAVES + F.wave, base = P0_EARLY + gw;
    f32x4 va[16], vb[16];
    P0Item da = p0_decode(F, base + i0 * 2048, P0_NITEMS, F.lane), db;
    p0_load(da, va);
#pragma unroll 1
    for (int i = i0; i < i1; i += 2) {
        db = p0_decode(F, (i + 1 < i1) ? base + (i + 1) * 2048 : P0_NITEMS, P0_NITEMS, F.lane); p0_load(db, vb);
        p0_store(da, va);
        da = p0_decode(F, (i + 2 < i1) ? base + (i + 2) * 2048 : P0_NITEMS, P0_NITEMS, F.lane); p0_load(da, va);
        p0_store(db, vb);
    }
}
DI void late_copy_phase(Frame& F) {
    volatile LAS unsigned* qslot = (volatile LAS unsigned*)(F.lds + MISC_OFF) + 16;
    for (;;) {
        if (F.tid == 0) qslot[0] = __hip_atomic_fetch_add((unsigned*)(F.ctl + CW_CVQ), 1u, __ATOMIC_RELAXED, __HIP_MEMORY_SCOPE_AGENT);
        __syncthreads();
        const int g = (int)qslot[0];
        __syncthreads();
        if (g >= CV_NGROUPS) break;
        const int base = P0_NITEMS - P0_LATE + g * CV_GROUP + F.wave;
        f32x4 va[16];
        const P0Item da = p0_decode(F, base, P0_NITEMS, F.lane);
        p0_load(da, va); p0_store(da, va);
    }
}
DI s16x4 tr_read(const LAS unsigned char* p) { return __builtin_bit_cast(s16x4, __builtin_amdgcn_ds_read_tr16_b64_v4i16((LAS s16x4*)p)); }
DI bf16x8 pack8(const f32x16& x, int s) {
    u32x4 p; p.x = pk_bf16(x[8 * s + 0], x[8 * s + 1]); p.y = pk_bf16(x[8 * s + 2], x[8 * s + 3]); p.z = pk_bf16(x[8 * s + 4], x[8 * s + 5]); p.w = pk_bf16(x[8 * s + 6], x[8 * s + 7]);
    return __builtin_bit_cast(bf16x8, p);
}
DI bf16x8 pack8_pinned(const f32x16& x, int s) {
    u32x4 p;
    asm volatile("v_cvt_pk_bf16_f32 %0, %4, %5\n\tv_cvt_pk_bf16_f32 %1, %6, %7\n\tv_cvt_pk_bf16_f32 %2, %8, %9\n\tv_cvt_pk_bf16_f32 %3, %10, %11\n\ts_nop 1"
                 : "=&v"(p[0]), "=&v"(p[1]), "=&v"(p[2]), "=&v"(p[3])
                 : "v"(x[8 * s]), "v"(x[8 * s + 1]), "v"(x[8 * s + 2]), "v"(x[8 * s + 3]), "v"(x[8 * s + 4]), "v"(x[8 * s + 5]), "v"(x[8 * s + 6]), "v"(x[8 * s + 7]));
    return __builtin_bit_cast(bf16x8, p);
}
DI void swa_phase(Frame& F) {
    LAS unsigned char* Ks = F.lds;
    LAS unsigned char* Vs = F.lds + 36864;
    const int lane = F.lane, w = F.wave, c31 = lane & 31, h = lane >> 5;
    const int i16 = lane & 15, q4 = i16 >> 2, p4 = i16 & 3, blk = (lane >> 4) & 1;
    volatile LAS unsigned* qslot = (volatile LAS unsigned*)(F.lds + MISC_OFF) + 16;
    for (;;) {
        if (F.tid == 0) qslot[0] = __hip_atomic_fetch_add((unsigned*)(F.ctl + CW_SWAQ), 1u, __ATOMIC_RELAXED, __HIP_MEMORY_SCOPE_AGENT);
        __syncthreads();
        const int u = (int)qslot[0];
        __syncthreads();
        if (u >= 512) break;
        const int kh = u & 3, qb = (u >> 2) & 15, b = u >> 6;
        const size_t tokbase = (size_t)b * SEQ;
        const int pos0 = qb * 128 - 128;
#pragma unroll
        for (int i = 0; i < 4; ++i) { const int id = F.tid + 512 * i, row = id >> 3, ch = id & 7, pos = pos0 + row;
            u32x4 kv = (u32x4){0u, 0u, 0u, 0u}, vv = (u32x4){0u, 0u, 0u, 0u};
            if (pos >= 0) { const bf16_t* src = F.PROJ + (tokbase + pos) * LDP + C_KA + kh * 64 + ch * 8; kv = *(const u32x4*)src; vv = *(const u32x4*)(src + (C_VA - C_KA)); }
            *(LAS u32x4*)(Ks + row * 144 + ch * 16) = kv; *(LAS u32x4*)(Vs + row * 144 + ch * 16) = vv; }
        __syncthreads();
        const int head = kh * 8 + w;
        const float slope2 = __builtin_amdgcn_exp2f(-0.25f * (float)(head + 1)) * LOG2E;
        const float sink2 = F.sinks[head] * LOG2E;
        for (int qt = 0; qt < 4; ++qt) {
            const size_t qrow = tokbase + qb * 128 + qt * 32 + c31;
            bf16x8 bq[4];
#pragma unroll
            for (int ks = 0; ks < 4; ++ks) bq[ks] = *(const bf16x8*)(F.PROJ + qrow * LDP + C_QA + head * 64 + ks * 16 + h * 8);
            f32x16 S[5];
#pragma unroll
            for (int kt = 0; kt < 5; ++kt) { f32x16 acc;
#pragma unroll
                for (int i = 0; i < 16; ++i) acc[i] = 0.f;
#pragma unroll
                for (int ks = 0; ks < 4; ++ks) { const bf16x8 a = *(const LAS bf16x8*)(Ks + (32 * (qt + kt) + c31) * 144 + (ks * 16 + h * 8) * 2); acc = MFMA32(a, bq[ks], acc); }
                S[kt] = acc; }
            float mx = sink2;
            const float lbase = -slope2 * (float)(c31 - 4 * h);
#pragma unroll
            for (int kt = 0; kt < 5; ++kt) { const bool tile_ok = (qb > 0) || (qt + kt >= 4);
#pragma unroll
                for (int i = 0; i < 16; ++i) { const int ci = 128 - 32 * kt - (i & 3) - 8 * (i >> 2), cr = (i & 3) + 8 * (i >> 2) + 4 * h;
                    float sc_ = __builtin_fmaf(S[kt][i], 0.125f * LOG2E, __builtin_fmaf(-slope2, (float)ci, lbase));
                    bool valid = tile_ok;
                    if (kt == 0) valid = valid && (cr > c31);
                    if (kt == 4) valid = valid && (cr <= c31);
                    sc_ = valid ? sc_ : -INFINITY;
                    S[kt][i] = sc_; mx = fmaxf(mx, sc_); } }
            mx = fmaxf(mx, __shfl_xor(mx, 32));
            float sum = 0.f;
#pragma unroll
            for (int kt = 0; kt < 5; ++kt)
#pragma unroll
                for (int i = 0; i < 16; ++i) { const float p = __builtin_amdgcn_exp2f(S[kt][i] - mx); S[kt][i] = p; sum += p; }
            sum += __shfl_xor(sum, 32); sum += __builtin_amdgcn_exp2f(sink2 - mx);
            const float inv = 1.0f / sum;
            f32x16 O[2];
#pragma unroll
            for (int dt = 0; dt < 2; ++dt)
#pragma unroll
                for (int i = 0; i < 16; ++i) O[dt][i] = 0.f;
#pragma unroll
            for (int kt = 0; kt < 5; ++kt)
#pragma unroll
                for (int s = 0; s < 2; ++s) { const bf16x8 bp = pack8(S[kt], s);
                    const int kb = 32 * (qt + kt) + 16 * s + 4 * h + q4;
#pragma unroll
                    for (int dt = 0; dt < 2; ++dt) { const LAS unsigned char* vp = Vs + kb * 144 + (32 * dt + 16 * blk + 4 * p4) * 2;
                        const s16x4 lo = tr_read(vp), hi = tr_read(vp + 8 * 144);
                        const bf16x8 a = __builtin_shufflevector(lo, hi, 0, 1, 2, 3, 4, 5, 6, 7);
                        O[dt] = MFMA32(a, bp, O[dt]); } }
            bf16_t* orow = F.OA + qrow * DM + head * 64 + 4 * h;
#pragma unroll
            for (int dt = 0; dt < 2; ++dt)
#pragma unroll
                for (int g4 = 0; g4 < 4; ++g4) { u32x2 wv; wv.x = pk_bf16(O[dt][4 * g4] * inv, O[dt][4 * g4 + 1] * inv); wv.y = pk_bf16(O[dt][4 * g4 + 2] * inv, O[dt][4 * g4 + 3] * inv);
                    *(u32x2*)(orow + 32 * dt + 8 * g4) = wv; }
        }
        __syncthreads();
    }
}

DI void gla_prep_phase(Frame& F) {
    LAS unsigned char* Qs = F.lds;
    LAS unsigned char* Kss = F.lds + 33792;
    LAS float* alr = (LAS float*)(F.lds + 67584);
    LAS float* tot = (LAS float*)(F.lds + 71680);
    LAS unsigned char* Vr = F.lds;
    const int tid = F.tid, lane = F.lane, w = F.wave, c31 = lane & 31, h = lane >> 5;
    const int d = tid & 255, hf = tid >> 8;
    u32x4 rq[4], rk[4], ralr, vreg[8];
#define PREP_LOAD_QK(uu) do { const int hh_ = ((uu) >> 5) & 3, b_ = (uu) >> 7, c_ = (uu) & 31; const size_t T_ = (size_t)b_ * SEQ + c_ * 64; \
        _Pragma("unroll") for (int j = 0; j < 4; ++j) { const int id = tid + 512 * j, row = id >> 5, ch = id & 31; const bf16_t* src = F.PROJ + (T_ + row) * LDP + C_QB + hh_ * 256 + ch * 8; rq[j] = *(const u32x4*)src; rk[j] = *(const u32x4*)(src + (C_KB - C_QB)); } \
        ralr = *(const u32x4*)(F.PROJ + (T_ + ((tid & 127) >> 1)) * LDP + C_ALR + 8 * (tid & 1)); } while (0)
#define PREP_LOAD_V(uu) do { const int hh_ = ((uu) >> 5) & 3, b_ = (uu) >> 7, c_ = (uu) & 31; const size_t T_ = (size_t)b_ * SEQ + c_ * 64; \
        _Pragma("unroll") for (int j = 0; j < 8; ++j) { const int id = tid + 512 * j, row = id >> 6, ch = id & 63; vreg[j] = *(const u32x4*)(F.PROJ + (T_ + row) * LDP + C_VB + hh_ * 512 + ch * 8); } } while (0)
    int hh_w = -1; float w2[16]; float ba = 0.f;
    if (F.vcu < 1024) { PREP_LOAD_QK(F.vcu); PREP_LOAD_V(F.vcu); }
    for (int u = F.vcu; u < 1024; u += F.G) {
        const int hh = (u >> 5) & 3;
        const int un = (u + F.G < 1024) ? u + F.G : u;
#pragma unroll
        for (int j = 0; j < 4; ++j) { const int id = tid + 512 * j, row = id >> 5, ch = id & 31; *(LAS u32x4*)(Qs + row * 528 + ch * 16) = rq[j]; *(LAS u32x4*)(Kss + row * 528 + ch * 16) = rk[j]; }
        if (tid < 128) { const int t = tid >> 1, hq = tid & 1; LAS float* dd = alr + t * 16 + 8 * hq;
            dd[0] = bf_lo(ralr.x); dd[1] = bf_hi(ralr.x); dd[2] = bf_lo(ralr.y); dd[3] = bf_hi(ralr.y); dd[4] = bf_lo(ralr.z); dd[5] = bf_hi(ralr.z); dd[6] = bf_lo(ralr.w); dd[7] = bf_hi(ralr.w); }
        if (hh != hh_w) { hh_w = hh;
#pragma unroll
            for (int r = 0; r < 16; ++r) w2[r] = F.w_alpha2[r * 1024 + hh * 256 + d];
            ba = F.b_alpha[hh * 256 + d]; }
        __syncthreads();
        PREP_LOAD_QK(un);
        float bc[32]; float run = 0.f;
#pragma unroll
        for (int i = 0; i < 32; ++i) { const LAS f32x4* ar = (const LAS f32x4*)(alr + (32 * hf + i) * 16); float z = ba;
#pragma unroll
            for (int r4 = 0; r4 < 4; ++r4) { const f32x4 a = ar[r4]; z += a.x * w2[4 * r4] + a.y * w2[4 * r4 + 1] + a.z * w2[4 * r4 + 2] + a.w * w2[4 * r4 + 3]; }
            const float la = (fminf(z, 0.f) - __logf(1.0f + fast_exp(-fabsf(z)))) * (1.0f / 16.0f);
            run += la; bc[i] = run; }
        tot[hf * 256 + d] = run;
        __syncthreads();
        const float t0 = tot[d], t1 = tot[256 + d], blast = t0 + t1;
        if (hf) {
#pragma unroll
            for (int i = 0; i < 32; ++i) bc[i] += t0;
        } else F.GDEC[(size_t)u * 256 + d] = fast_exp(blast);
        unsigned kpk[16];
#pragma unroll
        for (int i2 = 0; i2 < 16; ++i2) { float kh2[2];
#pragma unroll
            for (int j = 0; j < 2; ++j) { const int i = 2 * i2 + j; LAS bf16_t* qp = (LAS bf16_t*)(Qs + (32 * hf + i) * 528 + d * 2); LAS bf16_t* kp = (LAS bf16_t*)(Kss + (32 * hf + i) * 528 + d * 2);
                const float q = bf2f(*qp), k = bf2f(*kp);
                const float e = fast_exp(bc[i]);
                *qp = f2bf(q * e * 0.0625f);
                *kp = f2bf(k * fast_exp(-bc[i]));
                kh2[j] = k * fast_exp(blast - bc[i]); }
            kpk[i2] = pk_bf16(kh2[0], kh2[1]); }
        { u32x4* dst = (u32x4*)(F.GKT + (size_t)u * 16384 + d * 64 + 32 * hf);
#pragma unroll
            for (int j = 0; j < 4; ++j) dst[j] = (u32x4){kpk[4 * j], kpk[4 * j + 1], kpk[4 * j + 2], kpk[4 * j + 3]}; }
        __syncthreads();
        if (w < 4) { const int m = w >> 1, n = w & 1; f32x16 acc;
#pragma unroll
            for (int i = 0; i < 16; ++i) acc[i] = 0.f;
#pragma unroll
            for (int ks = 0; ks < 16; ++ks) { const bf16x8 a = *(const LAS bf16x8*)(Qs + (32 * m + c31) * 528 + (16 * ks + 8 * h) * 2), bb = *(const LAS bf16x8*)(Kss + (32 * n + c31) * 528 + (16 * ks + 8 * h) * 2);
                acc = MFMA32(a, bb, acc); }
            bf16_t* ao = F.GATT + (size_t)u * 4096;
#pragma unroll
            for (int i = 0; i < 16; ++i) { const int t = 32 * m + crow(i, h), s = 32 * n + c31; ao[t * 64 + s] = f2bf(s <= t ? acc[i] : 0.f); }
        } else { const int t2 = tid - 256;
#pragma unroll
            for (int j = 0; j < 8; ++j) { const int id = t2 + 256 * j, row = id >> 5, ch = id & 31; *(u32x4*)(F.GQT + (size_t)u * 16384 + row * 256 + ch * 8) = *(const LAS u32x4*)(Qs + row * 528 + ch * 16); } }
        __syncthreads();
#pragma unroll
        for (int j = 0; j < 8; ++j) { const int id = tid + 512 * j, row = id >> 6, ch = id & 63; *(LAS u32x4*)(Vr + row * 1040 + ch * 16) = vreg[j]; }
        __syncthreads();
        PREP_LOAD_V(un);
        { u32x4* dst = (u32x4*)(F.GVT + (size_t)u * 32768 + tid * 64);
#pragma unroll
            for (int t8 = 0; t8 < 8; ++t8) { unsigned short v[8];
#pragma unroll
                for (int j = 0; j < 8; ++j) v[j] = *(const LAS bf16_t*)(Vr + (8 * t8 + j) * 1040 + tid * 2);
                dst[t8] = (u32x4){(unsigned)v[0] | ((unsigned)v[1] << 16), (unsigned)v[2] | ((unsigned)v[3] << 16), (unsigned)v[4] | ((unsigned)v[5] << 16), (unsigned)v[6] | ((unsigned)v[7] << 16)}; } }
        __syncthreads();
    }
#undef PREP_LOAD_QK
#undef PREP_LOAD_V
}

DI void gla_scan_phase(Frame& F) {
    LAS unsigned char* L = F.lds;
    const int lane = F.lane, w = F.wave, c31 = lane & 31, h = lane >> 5;
    const int u = F.vcu >> 2, hf = u & 1, hh = (u >> 1) & 3, b = u >> 3;
    f32x16 S[8];
#pragma unroll
    for (int i = 0; i < 8; ++i)
#pragma unroll
        for (int j = 0; j < 16; ++j) S[i][j] = 0.f;
    const size_t item0 = (size_t)(b * 4 + hh) * 32;
    const int vr0 = hf * 256 + 32 * w;
    unsigned tidv = (unsigned)F.tid;
    unsigned qrb = (unsigned)(c31 * 528 + 8 * h), krb = (unsigned)(c31 * 144 + 16 * h);
    u32x4 rq[4], rk[4], ra; f32x4 rd; u32x4 bvn[4];
#define BV(ks) (*(const LAS bf16x8*)(L + 80896 + w * 4608 + krb + 32 * (ks)))
#define SCAN_LOAD_A(item) do { const char* q0 = (const char*)(F.GQT + (item) * 16384); const char* k0 = (const char*)(F.GKT + (item) * 16384); asm volatile("" : "+v"(tidv)); const unsigned tb = tidv * 16u; \
        _Pragma("unroll") for (int j = 0; j < 4; ++j) { rq[j] = *(const u32x4*)(q0 + j * 8192 + tb); rk[j] = *(const u32x4*)(k0 + j * 8192 + tb); } } while (0)
#define SCAN_LOAD_B(item) do { const char* v0 = (const char*)(F.GVT + (item) * 32768 + (size_t)vr0 * 64); asm volatile("" : "+v"(tidv)); const unsigned tb = tidv * 16u, db = (tidv & 63u) * 16u, vb = (tidv & 31u) * 128u + ((tidv >> 5) & 1u) * 16u; \
        ra = *(const u32x4*)((const char*)(F.GATT + (item) * 4096) + tb); \
        rd = *(const f32x4*)((const char*)(F.GDEC + (item) * 256) + db); \
        _Pragma("unroll") for (int ks = 0; ks < 4; ++ks) bvn[ks] = *(const u32x4*)(v0 + 32 * ks + vb); } while (0)
#define SCAN_WRITE() do { asm volatile("" : "+v"(tidv)); const unsigned qwo = (tidv >> 5) * 528u + (tidv & 31u) * 16u, kwo = (tidv >> 3) * 144u + (tidv & 7u) * 16u; \
        _Pragma("unroll") for (int j = 0; j < 4; ++j) { *(LAS u32x4*)(L + qwo + j * 16 * 528) = rq[j]; *(LAS u32x4*)(L + 33792 + kwo + j * 64 * 144) = rk[j]; } \
        *(LAS u32x4*)(L + 70656 + kwo) = ra; \
        if (tidv < 64u) *(LAS f32x4*)(L + 79872 + tidv * 16u) = rd; \
        _Pragma("unroll") for (int ks = 0; ks < 4; ++ks) *(LAS u32x4*)(L + 80896 + w * 4608 + krb + 32 * ks) = bvn[ks]; } while (0)
    SCAN_LOAD_A(item0); SCAN_LOAD_B(item0);
    SCAN_WRITE();
    __syncthreads();
    for (int c = 0; c < 32; ++c) {
        const size_t nitem = item0 + (c < 31 ? c + 1 : c);
        SCAN_LOAD_A(nitem);
        asm volatile("" : "+v"(qrb), "+v"(krb));
#pragma unroll 1
        for (int m = 0; m < 2; ++m) { f32x16 o;
#pragma unroll
            for (int j = 0; j < 16; ++j) o[j] = 0.f;
#pragma unroll
            for (int i = 0; i < 8; ++i)
#pragma unroll
                for (int s = 0; s < 2; ++s) { const bf16x8 bs = pack8_pinned(S[i], s);
                    const LAS unsigned char* ap = L + qrb + (32 * m) * 528 + (32 * i + 16 * s) * 2;
                    const s16x4 lo = *(const LAS s16x4*)ap, hi = *(const LAS s16x4*)(ap + 16);
                    const bf16x8 a = __builtin_shufflevector(lo, hi, 0, 1, 2, 3, 4, 5, 6, 7);
                    o = MFMA32(a, bs, o); }
#pragma unroll
            for (int ks = 0; ks < 4; ++ks) { const bf16x8 a = *(const LAS bf16x8*)(L + 70656 + krb + (32 * m) * 144 + 32 * ks); o = MFMA32(a, BV(ks), o); }
            { asm volatile("" : "+v"(tidv)); const unsigned ovb = ((tidv >> 5) & 1u) * (4u * DM * 2u) + (tidv & 31u) * 2u;
                char* ob = (char*)(F.OB + ((size_t)b * SEQ + c * 64 + 32 * m) * DM + hh * 512 + vr0);
#pragma unroll
                for (int j = 0; j < 16; ++j) *(bf16_t*)(ob + ((j & 3) + 8 * (j >> 2)) * (DM * 2) + ovb) = f2bf(o[j]); } }
        asm volatile("" ::: "memory");
        SCAN_LOAD_B(nitem);
#pragma unroll
        for (int i = 0; i < 8; ++i) {
#pragma unroll
            for (int g4 = 0; g4 < 4; ++g4) { const f32x4 dc = *(const LAS f32x4*)(L + 79872 + (32 * i + 8 * g4) * 4 + (((tidv >> 5) & 1u) * 16u));
                S[i][4 * g4] *= dc.x; S[i][4 * g4 + 1] *= dc.y; S[i][4 * g4 + 2] *= dc.z; S[i][4 * g4 + 3] *= dc.w; }
        }
#pragma unroll
        for (int ks = 0; ks < 4; ++ks) { const bf16x8 bvk = BV(ks);
#pragma unroll
            for (int i = 0; i < 8; ++i) { const bf16x8 a = *(const LAS bf16x8*)(L + 33792 + krb + (32 * i) * 144 + 32 * ks); S[i] = MFMA32(a, bvk, S[i]); } }
        __syncthreads();
        SCAN_WRITE();
        __syncthreads();
    }
#undef SCAN_LOAD_A
#undef SCAN_LOAD_B
#undef SCAN_WRITE
#undef BV
}

DI void merge_phase(Frame& F) {
    const int gw = F.vcu * NWAVES + F.wave, NGW = F.G * NWAVES, lane = F.lane;
    for (int m = gw; m < NTOK; m += NGW) {
        const bf16_t* pr = F.PROJ + (size_t)m * LDP;
        float rr[4][8]; float am = 0.f;
#pragma unroll
        for (int j = 0; j < 4; ++j) { const int c0 = j * 512 + lane * 8;
            const u32x4 ob = *(const u32x4*)(F.OB + (size_t)m * DM + c0), oa = *(const u32x4*)(F.OA + (size_t)m * DM + c0);
            const u32x4 rb = *(const u32x4*)(pr + C_RB + c0), ga = *(const u32x4*)(pr + C_GA + c0), gb = *(const u32x4*)(pr + C_GB + c0);
            const f32x4 g0 = *(const f32x4*)(F.gla_g + lane * 8), g1 = *(const f32x4*)(F.gla_g + lane * 8 + 4);
            float vb[8] = {bf_lo(ob.x), bf_hi(ob.x), bf_lo(ob.y), bf_hi(ob.y), bf_lo(ob.z), bf_hi(ob.z), bf_lo(ob.w), bf_hi(ob.w)};
            const float va[8] = {bf_lo(oa.x), bf_hi(oa.x), bf_lo(oa.y), bf_hi(oa.y), bf_lo(oa.z), bf_hi(oa.z), bf_lo(oa.w), bf_hi(oa.w)};
            const float vr[8] = {bf_lo(rb.x), bf_hi(rb.x), bf_lo(rb.y), bf_hi(rb.y), bf_lo(rb.z), bf_hi(rb.z), bf_lo(rb.w), bf_hi(rb.w)};
            const float vga[8] = {bf_lo(ga.x), bf_hi(ga.x), bf_lo(ga.y), bf_hi(ga.y), bf_lo(ga.z), bf_hi(ga.z), bf_lo(ga.w), bf_hi(ga.w)};
            const float vgb[8] = {bf_lo(gb.x), bf_hi(gb.x), bf_lo(gb.y), bf_hi(gb.y), bf_lo(gb.z), bf_hi(gb.z), bf_lo(gb.w), bf_hi(gb.w)};
            const float gn[8] = {g0.x, g0.y, g0.z, g0.w, g1.x, g1.y, g1.z, g1.w};
            float ss = 0.f;
#pragma unroll
            for (int k = 0; k < 8; ++k) ss += vb[k] * vb[k];
            const float rn = 1.0f / sqrtf(wave_sum(ss) * (1.f / 512.f) + EPS);
#pragma unroll
            for (int k = 0; k < 8; ++k) { const float obn = vb[k] * rn * gn[k]; const float sl = vr[k] * fast_sigmoid(vr[k]);
                rr[j][k] = fast_sigmoid(vga[k]) * va[k] + fast_sigmoid(vgb[k]) * obn * sl; am = fmaxf(am, fabsf(rr[j][k])); }
            if (!I8_P5) *(u32x4*)(F.MIX + (size_t)m * DM + c0) = (u32x4){pk_bf16(rr[j][0], rr[j][1]), pk_bf16(rr[j][2], rr[j][3]), pk_bf16(rr[j][4], rr[j][5]), pk_bf16(rr[j][6], rr[j][7])}; }
        if (I8_P5) { float sq = 0.f;
#pragma unroll
            for (int j = 0; j < 4; ++j)
#pragma unroll
                for (int k = 0; k < 8; ++k) sq += rr[j][k] * rr[j][k];
            am = fminf(wave_max(am), MIX_CLIP * sqrtf(wave_sum(sq) * (1.f / DM))); am = fmaxf(am, 1e-30f);
            const float inv = 127.f / am; if (lane == 0) F.sa_mix[m] = am * (1.f / 127.f);
#pragma unroll
            for (int j = 0; j < 4; ++j) { u32x2 wv; wv.x = pk4_i8(rr[j][0] * inv, rr[j][1] * inv, rr[j][2] * inv, rr[j][3] * inv); wv.y = pk4_i8(rr[j][4] * inv, rr[j][5] * inv, rr[j][6] * inv, rr[j][7] * inv);
                *(u32x2*)((unsigned char*)F.MIX + (size_t)m * DM + j * 512 + lane * 8) = wv; }
        }
    }
}

DI void router_phase(Frame& F) {
    LAS float* part = (LAS float*)F.lds;
    LAS float* ssp = (LAS float*)(F.lds + 34816);
    LAS float* rt = (LAS float*)(F.lds + 36864);
    LAS float* lg = (LAS float*)(F.lds + 37888);
    const int tid = F.tid, lane = F.lane, w = F.wave, c31 = lane & 31, h = lane >> 5;
    for (int tile = F.vcu; tile < NTOK / 32; tile += F.G) {
        const int t0 = tile * 32, kw = 256 * w;
        { const bf16_t* xr = F.X1 + (size_t)(t0 + c31) * DM + kw + 4 * h; const float* gp = F.ffn_g + kw + 4 * h; const float* wp = F.w_router + (size_t)(kw + 4 * h) * 32 + c31;
            f32x16 acc;
#pragma unroll
            for (int i = 0; i < 16; ++i) acc[i] = 0.f;
            float ss = 0.f;
#pragma unroll 4
            for (int m = 0; m < 32; ++m) { const u32x2 ab = *(const u32x2*)(xr + 8 * m); const f32x4 a = (f32x4){bf_lo(ab.x), bf_hi(ab.x), bf_lo(ab.y), bf_hi(ab.y)}; const f32x4 g4 = *(const f32x4*)(gp + 8 * m); const float* wr_ = wp + (size_t)m * 256;
                const float b0 = g4.x * wr_[0], b1 = g4.y * wr_[32], b2 = g4.z * wr_[64], b3 = g4.w * wr_[96];
                ss += (a.x * a.x + a.y * a.y) + (a.z * a.z + a.w * a.w);
                acc = __builtin_amdgcn_mfma_f32_32x32x2f32(a.x, b0, acc, 0, 0, 0); acc = __builtin_amdgcn_mfma_f32_32x32x2f32(a.y, b1, acc, 0, 0, 0);
                acc = __builtin_amdgcn_mfma_f32_32x32x2f32(a.z, b2, acc, 0, 0, 0); acc = __builtin_amdgcn_mfma_f32_32x32x2f32(a.w, b3, acc, 0, 0, 0); }
            ss += __shfl_xor(ss, 32);
#pragma unroll
            for (int i = 0; i < 16; ++i) part[(w * 32 + crow(i, h)) * 33 + c31] = acc[i];
            if (h == 0) ssp[w * 32 + c31] = ss; }
        __syncthreads();
        { const int tok = tid >> 4, e0 = tid & 15; float s0 = 0.f, s1 = 0.f, sst = 0.f;
#pragma unroll
            for (int w2 = 0; w2 < 8; ++w2) { s0 += part[(w2 * 32 + tok) * 33 + e0]; s1 += part[(w2 * 32 + tok) * 33 + e0 + 16]; sst += ssp[w2 * 32 + tok]; }
            const float r = 1.0f / sqrtf(sst * (1.f / DM) + EPS);
            lg[tok * 33 + e0] = s0 * r + F.b_router[e0]; lg[tok * 33 + e0 + 16] = s1 * r + F.b_router[e0 + 16]; if (e0 == 0) rt[tok] = r; }
        __syncthreads();
#pragma unroll
        for (int it = 0; it < 2; ++it) { const int tok = 4 * w + 2 * it + h; const int m = t0 + tok;
            float v = lg[tok * 33 + c31]; float tv[4]; int ti[4];
#pragma unroll
            for (int k = 0; k < 4; ++k) { float bv = v; int bi = c31;
#pragma unroll
                for (int o = 1; o < 32; o <<= 1) { const float ov = __shfl_xor(bv, o); const int oi = __shfl_xor(bi, o); const bool take = (ov > bv) || (ov == bv && oi < bi); bv = take ? ov : bv; bi = take ? oi : bi; }
                tv[k] = bv; ti[k] = bi; v = (c31 == bi) ? -INFINITY : v; }
            const float e1 = fast_exp(tv[1] - tv[0]), e2 = fast_exp(tv[2] - tv[0]), e3 = fast_exp(tv[3] - tv[0]); const float inv = 1.0f / (1.0f + e1 + e2 + e3);
            if (c31 < 4) { const int ex = c31 == 0 ? ti[0] : c31 == 1 ? ti[1] : c31 == 2 ? ti[2] : ti[3]; const float gt = (c31 == 0 ? 1.0f : c31 == 1 ? e1 : c31 == 2 ? e2 : e3) * inv;
                const unsigned slot = __hip_atomic_fetch_add((unsigned*)(F.ctl + CW_CNT + 64 * ex), 1u, __ATOMIC_RELAXED, __HIP_MEMORY_SCOPE_AGENT);
                F.tokl[(size_t)ex * NTOK + slot] = m; F.tope[m * 4 + c31] = ex; F.tops[m * 4 + c31] = (int)slot; F.gate[m * 4 + c31] = gt; } }
#pragma unroll
        for (int q = 0; q < 4; ++q) { const int tok = 4 * w + q; const size_t m = (size_t)(t0 + tok); const float r = rt[tok];
            const float r8 = 8.0f * r;
#pragma unroll
            for (int j = 0; j < 4; ++j) { const int c0 = 8 * (lane + 64 * j); const u32x4 xb = *(const u32x4*)(F.X1 + m * DM + c0); const f32x4 g0 = *(const f32x4*)(F.ffn_g + c0), g1 = *(const f32x4*)(F.ffn_g + c0 + 4);
                u32x2 wv; wv.x = pk4_fp8(clamp_fp8(bf_lo(xb.x) * r8 * g0.x), clamp_fp8(bf_hi(xb.x) * r8 * g0.y), clamp_fp8(bf_lo(xb.y) * r8 * g0.z), clamp_fp8(bf_hi(xb.y) * r8 * g0.w));
                wv.y = pk4_fp8(clamp_fp8(bf_lo(xb.z) * r8 * g1.x), clamp_fp8(bf_hi(xb.z) * r8 * g1.y), clamp_fp8(bf_lo(xb.w) * r8 * g1.z), clamp_fp8(bf_hi(xb.w) * r8 * g1.w));
                *(u32x2*)((unsigned char*)F.H + m * DM + c0) = wv; } }
        __syncthreads();
    }
}

DI void moe_tables(Frame& F) {
    LAS int* tb = (LAS int*)(F.lds + TBL_OFF);
    if (F.tid == 0) { int acc = 0;
        for (int e = 0; e < NEXP; ++e) { const int c = (int)__hip_atomic_load((unsigned*)(F.ctl + CW_CNT + 64 * e), __ATOMIC_RELAXED, __HIP_MEMORY_SCOPE_AGENT); tb[e] = acc; tb[40 + e] = c; acc += (c + 255) >> 8; }
        tb[32] = acc; }
    __syncthreads();
    for (int blk = F.tid; blk < tb[32]; blk += NWAVES * 64) { int e = 0; for (int j = 1; j < NEXP; ++j) e += (tb[j] <= blk) ? 1 : 0; tb[80 + blk] = e; }
    __syncthreads();
}
struct MoeProb {
    const bf16_t* A; const bf16_t* Bt; const int* tokl; const LAS int* tb; int K, NT  , brows  , G, c; bool gather;
    DI bool next_linear(int L, pg8::Unit& u) const {
        const int blk = L / NT, pn = L % NT; const int e = tb[80 + blk];
        const int rb = blk - tb[e]; int nr = tb[40 + e] - rb * 256; nr = nr > 256 ? 256 : nr;
        u.pm = blk; u.pn = pn; u.e = e; u.rb = rb; u.nrow = nr; return true;
    }
    DI bool next(int i, pg8::Unit& u) const {
        const int nb = tb[32]; const int x = c & 7, j = c >> 3, T = i * 8 + x;
        const int srb = (NT == 16) ? SUPER_RB16 : 4, spn = 32 / srb, nsp = NT / spn;
        const int blk = srb * (T / nsp) + (j % srb), pn = spn * (T % nsp) + (j / srb);
        if (G != 256 || blk >= nb) { if (G == 256) return false; const int L = i * G + c; if (L >= nb * NT) return false; return next_linear(L, u); }
        const int e = tb[80 + blk];
        const int rb = blk - tb[e]; int nr = tb[40 + e] - rb * 256; nr = nr > 256 ? 256 : nr;
        u.pm = blk; u.pn = pn; u.e = e; u.rb = rb; u.nrow = nr; return true;
    }
    DI const char* a_base(const pg8::Unit& u) const { return gather ? (const char*)A : (const char*)A + (size_t)u.pm * 256 * K * 2; }
    DI const char* b_base(const pg8::Unit& u) const { return (const char*)Bt + ((size_t)u.e * brows + (size_t)u.pn * 256) * K * 2; }
    DI void a_rows(const pg8::Unit& u, const int (&R)[2], unsigned (&v)[2][2]) const {
#pragma unroll
        for (int h = 0; h < 2; ++h)
#pragma unroll
            for (int i = 0; i < 2; ++i) { const int r = h * 128 + R[i];
                if (gather) { const int rc = r < u.nrow ? r : u.nrow - 1; v[h][i] = (unsigned)tokl[(size_t)u.e * NTOK + u.rb * 256 + rc]; }
                else v[h][i] = (unsigned)r; }
    }
};

DI void final_phase(Frame& F) {
    const LAS int* tb = (const LAS int*)(F.lds + TBL_OFF);
    const int gw = F.vcu * NWAVES + F.wave, NGW = F.G * NWAVES, lane = F.lane;
    for (int m = gw; m < NTOK; m += NGW) {
        const unsigned char* yr[4]; float gt[4];
#pragma unroll
        for (int k = 0; k < 4; ++k) { const int e = F.tope[m * 4 + k], sl = F.tops[m * 4 + k]; gt[k] = F.gate[m * 4 + k] * (1.0f / pg8::Y_SCALE); yr[k] = (const unsigned char*)F.Y + ((size_t)tb[e] * 256 + sl) * DM; }
        float v[4][8]; float ss = 0.f;
#pragma unroll
        for (int j = 0; j < 4; ++j) { const int c0 = 8 * (lane + 64 * j);
            const u32x4 xb = *(const u32x4*)(F.X1 + (size_t)m * DM + c0);
            float a[8] = {bf_lo(xb.x), bf_hi(xb.x), bf_lo(xb.y), bf_hi(xb.y), bf_lo(xb.z), bf_hi(xb.z), bf_lo(xb.w), bf_hi(xb.w)};
#pragma unroll
            for (int k = 0; k < 4; ++k) { const u32x2 y = *(const u32x2*)(yr[k] + c0);
                const f32x2_t y0 = __builtin_amdgcn_cvt_pk_f32_fp8((int)y.x, false), y1 = __builtin_amdgcn_cvt_pk_f32_fp8((int)y.x, true), y2 = __builtin_amdgcn_cvt_pk_f32_fp8((int)y.y, false), y3 = __builtin_amdgcn_cvt_pk_f32_fp8((int)y.y, true);
                a[0] += gt[k] * y0.x; a[1] += gt[k] * y0.y; a[2] += gt[k] * y1.x; a[3] += gt[k] * y1.y; a[4] += gt[k] * y2.x; a[5] += gt[k] * y2.y; a[6] += gt[k] * y3.x; a[7] += gt[k] * y3.y; }
#pragma unroll
            for (int q = 0; q < 8; ++q) { v[j][q] = a[q]; ss += a[q] * a[q]; } }
        const float r = 1.0f / sqrtf(wave_sum(ss) * (1.f / DM) + EPS);
#pragma unroll
        for (int j = 0; j < 4; ++j) { const int c0 = 8 * (lane + 64 * j);
            const f32x4 g0 = *(const f32x4*)(F.final_g + c0), g1 = *(const f32x4*)(F.final_g + c0 + 4);
            *(f32x4*)(F.out + (size_t)m * DM + c0) = (f32x4){v[j][0] * r * g0.x, v[j][1] * r * g0.y, v[j][2] * r * g0.z, v[j][3] * r * g0.w};
            *(f32x4*)(F.out + (size_t)m * DM + c0 + 4) = (f32x4){v[j][4] * r * g1.x, v[j][5] * r * g1.y, v[j][6] * r * g1.z, v[j][7] * r * g1.w}; }
    }
}
#ifndef MK_N_LAUNCHES
#define MK_N_LAUNCHES 1
#endif
constexpr int N_PHASES = 11;
struct Args { const float* in[16]; float* out; unsigned char* ws; int ph_lo, ph_hi; };
static_assert(sizeof(Args) == 16 * 8 + 8 + 8 + 8, "Args has no padding");

__global__ void __launch_bounds__(NWAVES * 64, 2) fwd_kernel(Args args) {
    extern __shared__ __attribute__((aligned(16))) unsigned char lds_raw[];
    Frame F;
    F.lds = (LAS unsigned char*)lds_raw;
    F.tid = threadIdx.x; F.lane = F.tid & 63; F.wave = __builtin_amdgcn_readfirstlane(F.tid >> 6);
    F.G = gridDim.x; { const int bx = blockIdx.x; F.vcu = (F.G % 8 == 0) ? (bx % 8) * (F.G / 8) + bx / 8 : bx; }
    unsigned char* ws = args.ws;
    F.ctl = (gu32*)(ws + WS_CTL);
    F.x = args.in[0]; F.attn_g = args.in[1]; F.w_in = args.in[2]; F.sinks = args.in[3]; F.w_alpha2 = args.in[4]; F.b_alpha = args.in[5]; F.gla_g = args.in[6]; F.w_out = args.in[7];
    F.ffn_g = args.in[8]; F.w_router = args.in[9]; F.b_router = args.in[10]; F.w_gu = args.in[11]; F.b_gu = args.in[12]; F.w_dn = args.in[13]; F.b_dn = args.in[14]; F.final_g = args.in[15];
    F.out = args.out;
    F.tope = (int*)(ws + WS_TOPE); F.tops = (int*)(ws + WS_TOPS); F.gate = (float*)(ws + WS_GATE); F.tokl = (int*)(ws + WS_TOKL);
    F.Win = (bf16_t*)(ws + WS_WIN); F.Wout = (bf16_t*)(ws + WS_WOUT); F.Wgu = (bf16_t*)(ws + WS_WGU); F.Wdn = (bf16_t*)(ws + WS_WDN);
    F.sa_h = (float*)(ws + WS_SAH); F.sa_mix = (float*)(ws + WS_SAMIX);
    F.H = (bf16_t*)(ws + WS_H); F.PROJ = (bf16_t*)(ws + WS_PROJ); F.OA = (bf16_t*)(ws + WS_OA); F.OB = (bf16_t*)(ws + WS_OB); F.MIX = (bf16_t*)(ws + WS_MIX);
    F.X1 = (bf16_t*)(ws + WS_X1); F.GQT = (bf16_t*)(ws + WS_GQT); F.GKT = (bf16_t*)(ws + WS_GKT); F.GATT = (bf16_t*)(ws + WS_GATT); F.GDEC = (float*)(ws + WS_GDEC); F.GVT = (bf16_t*)(ws + WS_GVT);
    F.ACT = (bf16_t*)(ws + WS_ACT); F.Y = (bf16_t*)(ws + WS_Y);
    for (int u = F.tid; u < (LDS_BYTES - LDSCTL_OFF) / 4; u += NWAVES * 64) ((LAS unsigned*)(F.lds + LDSCTL_OFF))[u] = 0u;
    __syncthreads();
    const int lo = args.ph_lo, hi = args.ph_hi;
    const bool use_bar = (hi - lo) > 1;
    XcdBarrier bar; bar.bar = (unsigned*)(F.ctl + CW_BAR); bar.x = 0; bar.st = nullptr;
    if (use_bar) bar = xcd_barrier_post((unsigned*)(F.ctl + CW_BAR), (volatile LAS unsigned*)(F.lds + MISC_OFF) + 8);
#define IN(k) (lo <= (k) && (k) < hi)
#define SEAM(k) do { if (IN(k) && IN((k) + 1)) xcd_barrier(bar); } while (0)

    if (IN(0)) { colmax_phase(F); }
    SEAM(0);
    if (IN(1)) { p0_prologue(F); }
    SEAM(1);
    if (IN(2)) {
        pg8::DenseProb P; P.A = F.H; P.Bt = F.Win; P.K = I8_P1 ? DM / 2 : DM; P.S.init(NTOK, LDP, F.G, (int)blockIdx.x);
        pg8::EpiBf16Plain<I8_P1> E{F.PROJ, LDP, F.sa_h, (const float*)(F.ctl + CW_CMAX_IN)};
        const int grp = (int)(blockIdx.x & 3), split = grp == 0 ? 0 : grp == 1 ? 4 : grp == 2 ? 9 : 13;
        P.i0 = 0; P.i1 = split; pg8::gemm_phase<I8_P1 ? GM_I8 : GM_BF16>(F.lds + RING_OFF, P, E);
        embed_copy_range(F, 0, EMB_PER_WAVE - EMB_P5);
        P.i0 = split; P.i1 = 1 << 30; pg8::gemm_phase<I8_P1 ? GM_I8 : GM_BF16>(F.lds + RING_OFF, P, E);
    }
    SEAM(2);
    if (IN(3)) { gla_prep_phase(F); }
    SEAM(3);
    if (IN(4)) { if ((F.vcu & 3) == 0 && F.vcu < 256) gla_scan_phase(F); swa_phase(F); late_copy_phase(F); }
    SEAM(4);
    if (IN(5)) { merge_phase(F); }
    SEAM(5);
    if (IN(6)) {
        pg8::DenseProb P; P.A = F.MIX; P.Bt = F.Wout; P.K = I8_P5 ? DM / 2 : DM; P.S.init(NTOK, DM, F.G, (int)blockIdx.x);
        pg8::EpiResF32<I8_P5> E{F.x, F.X1, DM, F.sa_mix, (const float*)(F.ctl + CW_CMAX_OUT)};
        const bool late = (blockIdx.x & 1) != 0;
        if (EMB_P5 > 0 && !late) embed_copy_range(F, EMB_PER_WAVE - EMB_P5, EMB_PER_WAVE);
        pg8::gemm_phase<I8_P5 ? GM_I8 : GM_BF16>(F.lds + RING_OFF, P, E);
        if (EMB_P5 > 0 && late) embed_copy_range(F, EMB_PER_WAVE - EMB_P5, EMB_PER_WAVE);
    }
    SEAM(6);
    if (IN(7)) { router_phase(F); }
    SEAM(7);
    if (IN(8)) {
        moe_tables(F);
        MoeProb P; P.A = F.H; P.Bt = F.Wgu; P.tokl = F.tokl; P.tb = (const LAS int*)(F.lds + TBL_OFF); P.K = DM / 2; P.NT = 16; P.brows = 4096; P.G = F.G; P.c = (int)blockIdx.x; P.gather = true;
        pg8::EpiGlu E{(unsigned char*)F.ACT, DFF, F.b_gu};
        pg8::gemm_phase<GM_FP8>(F.lds + RING_OFF, P, E);
    }
    SEAM(8);
    if (IN(9)) {
        moe_tables(F);
        if (STAGGER_US > 0 && (F.vcu & 1)) { const unsigned long long t0 = __builtin_amdgcn_s_memrealtime(); while (__builtin_amdgcn_s_memrealtime() - t0 < (unsigned long long)(STAGGER_US * 100)) __builtin_amdgcn_s_sleep(8); }
        MoeProb P; P.A = F.ACT; P.Bt = F.Wdn; P.tokl = F.tokl; P.tb = (const LAS int*)(F.lds + TBL_OFF); P.K = DFF / 2; P.NT = 8; P.brows = 2048; P.G = F.G; P.c = (int)blockIdx.x; P.gather = false;
        pg8::EpiF8BiasE E{(unsigned char*)F.Y, DM, F.b_dn};
        pg8::gemm_phase<GM_FP8>(F.lds + RING_OFF, P, E);
    }
    SEAM(9);
    if (IN(10)) { moe_tables(F); final_phase(F);
    }
#undef IN
#undef SEAM
}

extern "C" void kernel_launch(void* const* d_in, const int* in_sizes, int n_in, void* d_out, int out_size, void* d_ws, size_t ws_size, hipStream_t stream) {
    static int grid = 0;
    if (grid == 0) {
        if (n_in != 16 || out_size != NTOK * DM || ws_size < WS_END) { fprintf(stderr, "kernel_launch: unexpected shapes (n_in %d, out %d, ws %zu, need %zu); nothing launched\n", n_in, out_size, ws_size, (size_t)WS_END); grid = -1; return; }
        int dev = 0, cus = 0, per_cu = 0;
        if (hipGetDevice(&dev) != hipSuccess || hipDeviceGetAttribute(&cus, hipDeviceAttributeMultiprocessorCount, dev) != hipSuccess) { fprintf(stderr, "kernel_launch: device query failed\n"); grid = -1; return; }
        if (hipFuncSetAttribute((const void*)fwd_kernel, hipFuncAttributeMaxDynamicSharedMemorySize, LDS_BYTES) != hipSuccess) { fprintf(stderr, "kernel_launch: hipFuncSetAttribute failed\n"); grid = -1; return; }
        if (hipOccupancyMaxActiveBlocksPerMultiprocessor(&per_cu, (const void*)fwd_kernel, NWAVES * 64, LDS_BYTES) != hipSuccess || per_cu < 1)
            fprintf(stderr, "kernel_launch: note: occupancy query reports %d workgroups per CU\n", per_cu);
        (void)hipGetLastError();
        grid = cus;
    }
    if (grid < 0) return;
    if (hipMemsetAsync((char*)d_ws + WS_CTL, 0, CTL_ZERO_BYTES, stream) != hipSuccess) { fprintf(stderr, "kernel_launch: hipMemsetAsync failed\n"); return; }
    Args a{};
    for (int i = 0; i < 16; ++i) a.in[i] = (const float*)d_in[i];
    a.out = (float*)d_out; a.ws = (unsigned char*)d_ws;
    if (MK_N_LAUNCHES == 1) { a.ph_lo = 0; a.ph_hi = N_PHASES; hipLaunchKernelGGL(fwd_kernel, dim3(grid), dim3(NWAVES * 64), LDS_BYTES, stream, a); }
    else for (int p = 0; p < N_PHASES; ++p) { a.ph_lo = p; a.ph_hi = p + 1; hipLaunchKernelGGL(fwd_kernel, dim3(grid), dim3(NWAVES * 64), LDS_BYTES, stream, a);
    }
    const hipError_t le = hipPeekAtLastError();
    if (le != hipSuccess) fprintf(stderr, "kernel_launch: launch failed: %s\n", hipGetErrorName(le));
}
```

```cpp
#include <hip/hip_runtime.h>
#include <cstdio>
#include <cstdint>

#define DI __device__ __forceinline__
#define LAS __attribute__((address_space(3)))
#define GAS __attribute__((address_space(1)))
typedef unsigned short bf16_t;
typedef short bf16x8 __attribute__((ext_vector_type(8)));
typedef short s16x4 __attribute__((ext_vector_type(4)));
typedef float f32x4 __attribute__((ext_vector_type(4)));
typedef float f32x16 __attribute__((ext_vector_type(16)));
typedef unsigned u32x4 __attribute__((ext_vector_type(4)));
typedef unsigned u32x2 __attribute__((ext_vector_type(2)));
typedef float f32x2_t __attribute__((ext_vector_type(2)));
typedef __bf16 bf16x2_t __attribute__((ext_vector_type(2)));
typedef int i32x4 __attribute__((ext_vector_type(4)));
typedef int i32x8 __attribute__((ext_vector_type(8)));
DI unsigned pk4_fp8(float a, float b, float c, float d) { int p = __builtin_amdgcn_cvt_pk_fp8_f32(a, b, 0, false); p = __builtin_amdgcn_cvt_pk_fp8_f32(c, d, p, true); return (unsigned)p; }
DI float clamp_fp8(float x) { return fminf(fmaxf(x, -448.0f), 448.0f); }
constexpr int F8_SCALE_W = 0x79797979;
constexpr int F8_SCALE_A = 0x7c7c7c7c;
DI unsigned pk4_i8(float a, float b, float c, float d) {
    constexpr float MAGIC = 12582912.0f;
    const unsigned fa = __float_as_uint(__builtin_amdgcn_fmed3f(a, -127.f, 127.f) + MAGIC), fb = __float_as_uint(__builtin_amdgcn_fmed3f(b, -127.f, 127.f) + MAGIC);
    const unsigned fc = __float_as_uint(__builtin_amdgcn_fmed3f(c, -127.f, 127.f) + MAGIC), fd = __float_as_uint(__builtin_amdgcn_fmed3f(d, -127.f, 127.f) + MAGIC);
    unsigned r = __builtin_amdgcn_perm(fb, fa, 0x0c0c0400u);
    r = __builtin_amdgcn_perm(fc, r, 0x0c040100u);
    return __builtin_amdgcn_perm(fd, r, 0x04020100u);
}
DI float wave_max(float v) {
#pragma unroll
    for (int o = 1; o < 64; o <<= 1) v = fmaxf(v, __shfl_xor(v, o));
    return v;
}
constexpr int GM_BF16 = 0, GM_FP8 = 1, GM_I8 = 2;

DI unsigned pk_bf16(float lo, float hi) { f32x2_t v = {lo, hi}; bf16x2_t b = __builtin_convertvector(v, bf16x2_t); return __builtin_bit_cast(unsigned, b); }
DI float bf_lo(unsigned w) { return __uint_as_float(w << 16); }
DI float bf_hi(unsigned w) { return __uint_as_float(w & 0xffff0000u); }
DI float bf2f(bf16_t v) { return __uint_as_float(((unsigned)v) << 16); }
DI bf16_t f2bf(float f) { return (bf16_t)(pk_bf16(f, 0.f) & 0xffffu); }
DI float fast_exp(float x) { return __builtin_amdgcn_exp2f(x * 1.4426950408889634f); }
DI float fast_rcp(float x) { return __builtin_amdgcn_rcpf(x); }
DI float fast_sigmoid(float x) { return fast_rcp(1.0f + fast_exp(-x)); }
DI float wave_sum(float v) {
#pragma unroll
    for (int o = 1; o < 64; o <<= 1) v += __shfl_xor(v, o);
    return v;
}
DI int crow(int reg, int h) { return (reg & 3) + 8 * (reg >> 2) + 4 * h; }
#define MFMA32(a, b, c) __builtin_amdgcn_mfma_f32_32x32x16_bf16((a), (b), (c), 0, 0, 0)

namespace pg8 {
constexpr int BM = 256, BK = 64, HALF = 128, HTB = HALF * BK * 2  , STAGE_BYTES = 8 * HTB, NXCD = 8, WGM = 8;
constexpr int EPI_LDS_OFF = 131072 + 1024 + 2048, EPI_SLOT_BYTES = 2048;
DI void dma16(const void* gsrc, LAS unsigned char* lds_uniform) { __builtin_amdgcn_global_load_lds((const unsigned*)gsrc, (LAS unsigned*)lds_uniform, 16, 0, 0); }

DI int lds_byte(int r, int c) { const int st = (r >> 4) * 2 + (c >> 5), rr = r & 15, cc = c & 31, ob = rr * 64 + cc * 2; return st * 1024 + (ob ^ (((ob >> 9) & 1) << 5)); }
DI void stage_rc(int b, int& R, int& C) { const int st = b / 1024, sb = b % 1024, swz = sb ^ (((sb >> 9) & 1) << 5); R = (st >> 1) * 16 + swz / 64; C = (st & 1) * 32 + (swz % 64) / 2; }
DI int perm32(int rho) { const int n = rho >> 4, i = rho & 15; return 8 * (i >> 2) + 4 * n + (i & 3); }

struct Unit { int pm, pn, e, rb, nrow; };

struct StaticOrder {
    int nM, nN, nwg, G, c;
    DI void init(int M, int N, int G_, int c_) { nM = M / BM; nN = N / BM; nwg = nM * nN; G = G_; c = c_; }
    DI bool next(int i, int& pm, int& pn) const {
        const long L = (long)i * G + c; if (L >= nwg) return false;
        int wgid = (int)L; { const int q = nwg / NXCD, r = nwg % NXCD, xcd = wgid % NXCD, off = wgid / NXCD; wgid = (xcd < r ? xcd * (q + 1) : r * (q + 1) + (xcd - r) * q) + off; }
        const int nig = WGM * nN, gid = wgid / nig, fm = gid * WGM, gsz = (nM - fm) < WGM ? (nM - fm) : WGM;
        pm = fm + ((wgid % nig) % gsz); pn = (wgid % nig) / gsz; return true;
    }
};

struct DenseProb {
    const bf16_t* A; const bf16_t* Bt; int K; StaticOrder S; int i0 = 0, i1 = 1 << 30;
    DI bool next(int i, Unit& u) const { int pm, pn; if (i + i0 >= i1 || !S.next(i + i0, pm, pn)) return false; u.pm = pm; u.pn = pn; u.e = 0; u.rb = 0; u.nrow = 256; return true; }
    DI const char* a_base(const Unit& u) const { return (const char*)A + (size_t)u.pm * 256 * K * 2; }
    DI const char* b_base(const Unit& u) const { return (const char*)Bt + (size_t)u.pn * 256 * K * 2; }
    DI void a_rows(const Unit&, const int (&R)[2], unsigned (&v)[2][2]) const {
#pragma unroll
        for (int h = 0; h < 2; ++h)
#pragma unroll
            for (int i = 0; i < 2; ++i) v[h][i] = (unsigned)(h * HALF + R[i]);
    }
};

template <int MODE, class Prob, class Epi>
DI void gemm_phase(LAS unsigned char* lds, const Prob& P, const Epi& E) {
    constexpr bool F8 = (MODE == GM_FP8);
    const int tid = threadIdx.x, wid = __builtin_amdgcn_readfirstlane(tid >> 6), lane = tid & 63, wr = wid >> 2, wc = wid & 3, fr = lane & 15, fq = lane >> 4;
    const int K = P.K, nt = K / BK;
    int sR[2], sC[2]; unsigned voffB[2];
#pragma unroll
    for (int i = 0; i < 2; ++i) { int R, C; stage_rc(tid * 16 + i * 8192, R, C); const int Rb = Epi::PERM ? ((R & ~31) + perm32(R & 31)) : R; sR[i] = R; sC[i] = C; voffB[i] = (unsigned)(Rb * K + C) * 2u; }
    const size_t kstep = (size_t)(BK * 2);
    const size_t hstep = (size_t)HALF * K * 2;
    const unsigned ldsw = (unsigned)wid * 1024u;
    const int aoff = lds_byte(wr * 64 + fr, fq * 8), boff = lds_byte(wc * 32 + fr, fq * 8);
#define PG8_SA(b, h) (((b) * 2 + (h)) * HTB)
#define PG8_SB(b, h) ((4 + (b) * 2 + (h)) * HTB)
#define PG8_STAGE2(bufoff, gbase, v0, v1) do { \
        __builtin_amdgcn_global_load_lds((const unsigned*)((const char*)(gbase) + (v0)), (LAS unsigned*)(lds + (bufoff) + ldsw), 16, 0, 0); \
        __builtin_amdgcn_global_load_lds((const unsigned*)((const char*)(gbase) + (v1)), (LAS unsigned*)(lds + (bufoff) + ldsw + 8192), 16, 0, 0); } while (0)
#define PG8_STAGEB(bufoff, gbase) PG8_STAGE2(bufoff, gbase, voffB[0], voffB[1])
#define PG8_LDA(dst, b, h) do { _Pragma("unroll") for (int m = 0; m < 4; ++m) { const i32x4 lo_ = *(const LAS i32x4*)(lds + PG8_SA(b, h) + aoff + m * 2048), hi_ = *(const LAS i32x4*)(lds + PG8_SA(b, h) + aoff + m * 2048 + 1024); \
        dst[m] = __builtin_shufflevector(lo_, hi_, 0, 1, 2, 3, 4, 5, 6, 7); } } while (0)
#define PG8_LDB(dst, b, h) do { _Pragma("unroll") for (int n = 0; n < 2; ++n) { const i32x4 lo_ = *(const LAS i32x4*)(lds + PG8_SB(b, h) + boff + n * 2048), hi_ = *(const LAS i32x4*)(lds + PG8_SB(b, h) + boff + n * 2048 + 1024); \
        dst[n] = __builtin_shufflevector(lo_, hi_, 0, 1, 2, 3, 4, 5, 6, 7); } } while (0)
#define PG8_MMA(ai, bj, At, Bt) do { __builtin_amdgcn_s_setprio(1); _Pragma("unroll") for (int m = 0; m < 4; ++m) _Pragma("unroll") for (int n = 0; n < 2; ++n) { \
        if constexpr (F8) asm volatile("v_mfma_scale_f32_16x16x128_f8f6f4 %0, %1, %2, %0, %3, %4 op_sel_hi:[0,0,0]" : "+v"(acc[ai][bj][m][n]) : "v"(Bt[n]), "v"(At[m]), "v"(f8sw), "v"(f8sa)); \
        else if constexpr (MODE == GM_I8) { i32x4 ci = __builtin_bit_cast(i32x4, acc[ai][bj][m][n]); \
               ci = __builtin_amdgcn_mfma_i32_16x16x64_i8(__builtin_shufflevector(Bt[n], Bt[n], 0, 1, 2, 3), __builtin_shufflevector(At[m], At[m], 0, 1, 2, 3), ci, 0, 0, 0); \
               ci = __builtin_amdgcn_mfma_i32_16x16x64_i8(__builtin_shufflevector(Bt[n], Bt[n], 4, 5, 6, 7), __builtin_shufflevector(At[m], At[m], 4, 5, 6, 7), ci, 0, 0, 0); acc[ai][bj][m][n] = __builtin_bit_cast(f32x4, ci); } \
        else { acc[ai][bj][m][n] = __builtin_amdgcn_mfma_f32_16x16x32_bf16(__builtin_bit_cast(bf16x8, __builtin_shufflevector(Bt[n], Bt[n], 0, 1, 2, 3)), __builtin_bit_cast(bf16x8, __builtin_shufflevector(At[m], At[m], 0, 1, 2, 3)), acc[ai][bj][m][n], 0, 0, 0); \
               acc[ai][bj][m][n] = __builtin_amdgcn_mfma_f32_16x16x32_bf16(__builtin_bit_cast(bf16x8, __builtin_shufflevector(Bt[n], Bt[n], 4, 5, 6, 7)), __builtin_bit_cast(bf16x8, __builtin_shufflevector(At[m], At[m], 4, 5, 6, 7)), acc[ai][bj][m][n], 0, 0, 0); } } \
        __builtin_amdgcn_s_setprio(0); } while (0)
#define PG8_WAIT_V(n) asm volatile("s_waitcnt vmcnt(" #n ")" ::: "memory")
#define PG8_WAIT_L(n) asm volatile("s_waitcnt lgkmcnt(" #n ")" ::: "memory")
#define PG8_BAR __builtin_amdgcn_s_barrier()
#define PG8_SCHED __builtin_amdgcn_sched_barrier(0)
    Unit cur, nxt; int ui = 0;
    if (!P.next(0, cur)) return;
    f32x4 acc[2][2][4][2];
#pragma unroll
    for (int a = 0; a < 2; ++a)
#pragma unroll
        for (int b = 0; b < 2; ++b)
#pragma unroll
            for (int m = 0; m < 4; ++m)
#pragma unroll
                for (int n = 0; n < 2; ++n) acc[a][b][m][n] = (f32x4){0.f, 0.f, 0.f, 0.f};
    i32x8 At[4], B0[2], B1[2];
    const int f8sw = F8_SCALE_W, f8sa = F8_SCALE_A;
    const char* cA = P.a_base(cur); const char* cB = P.b_base(cur);
    LAS unsigned char* const epi_lds = lds + EPI_LDS_OFF;
    if (wid == 0) E.prefetch(cur, epi_lds, lane);
    unsigned vAc[2][2], vAn[2][2];
#define PG8_OFF(row, i) (((row) * (unsigned)K + (unsigned)sC[i]) * 2u)
    P.a_rows(cur, sR, vAc);
#pragma unroll
    for (int h = 0; h < 2; ++h)
#pragma unroll
        for (int i = 0; i < 2; ++i) vAc[h][i] = PG8_OFF(vAc[h][i], i);
    PG8_STAGEB(PG8_SB(0, 0), cB); PG8_STAGEB(PG8_SB(0, 1), cB + hstep); PG8_STAGE2(PG8_SA(0, 0), cA, vAc[0][0], vAc[0][1]); PG8_STAGE2(PG8_SA(0, 1), cA, vAc[1][0], vAc[1][1]);
    if (wr == 1) PG8_BAR;
    PG8_WAIT_V(2); PG8_BAR;
    PG8_STAGEB(PG8_SB(1, 0), cB + kstep); PG8_STAGE2(PG8_SA(1, 0), cA + kstep, vAc[0][0], vAc[0][1]); PG8_STAGEB(PG8_SB(1, 1), cB + hstep + kstep);
    PG8_WAIT_V(6); PG8_BAR;
    for (;;) {
        const bool has_next = P.next(ui + 1, nxt);
        const char* nA = cA; const char* nB = cB;
        if (has_next) { nA = P.a_base(nxt); nB = P.b_base(nxt); P.a_rows(nxt, sR, vAn); }
        else {
#pragma unroll
            for (int h = 0; h < 2; ++h)
#pragma unroll
                for (int i = 0; i < 2; ++i) vAn[h][i] = vAc[h][i];
        }
        for (int t = 0; t < nt; t += 2) {
            const bool last = (t == nt - 2);
            const char* a1 = cA + (size_t)(t + 1) * kstep;
            const char* a2 = last ? nA : cA + (size_t)(t + 2) * kstep; const char* b2 = last ? nB : cB + (size_t)(t + 2) * kstep;
            const char* a3 = a2 + kstep; const char* b3 = b2 + kstep;
            unsigned w00 = vAc[0][0], w01 = vAc[0][1], w10 = vAc[1][0], w11 = vAc[1][1];
            if (last) { asm volatile("" : "+v"(vAn[0][0]), "+v"(vAn[0][1]), "+v"(vAn[1][0]), "+v"(vAn[1][1]));
                if (has_next) { vAn[0][0] = PG8_OFF(vAn[0][0], 0); vAn[0][1] = PG8_OFF(vAn[0][1], 1); vAn[1][0] = PG8_OFF(vAn[1][0], 0); vAn[1][1] = PG8_OFF(vAn[1][1], 1); }
                w00 = vAn[0][0]; w01 = vAn[0][1]; w10 = vAn[1][0]; w11 = vAn[1][1]; }
            PG8_LDB(B0, 0, 0); PG8_LDB(B1, 0, 1); PG8_SCHED; PG8_LDA(At, 0, 0); PG8_STAGE2(PG8_SA(1, 1), a1, vAc[1][0], vAc[1][1]);
            PG8_WAIT_V(8); PG8_WAIT_L(0); PG8_BAR; PG8_MMA(0, 0, At, B0); PG8_MMA(0, 1, At, B1); PG8_BAR; PG8_SCHED;
            PG8_LDA(At, 0, 1); PG8_STAGEB(PG8_SB(0, 0), b2); PG8_STAGEB(PG8_SB(0, 1), b2 + hstep); PG8_STAGE2(PG8_SA(0, 0), a2, w00, w01);
            PG8_WAIT_V(8); PG8_WAIT_L(0); PG8_BAR; PG8_MMA(1, 0, At, B0); PG8_MMA(1, 1, At, B1); PG8_BAR; PG8_SCHED;
            PG8_LDB(B0, 1, 0); PG8_LDB(B1, 1, 1); PG8_SCHED; PG8_LDA(At, 1, 0); PG8_STAGE2(PG8_SA(0, 1), a2, w10, w11);
            PG8_WAIT_V(8); PG8_WAIT_L(0); PG8_BAR; PG8_MMA(0, 0, At, B0); PG8_MMA(0, 1, At, B1); PG8_BAR; PG8_SCHED;
            PG8_LDA(At, 1, 1); PG8_STAGEB(PG8_SB(1, 0), b3); PG8_STAGEB(PG8_SB(1, 1), b3 + hstep); PG8_STAGE2(PG8_SA(1, 0), a3, w00, w01);
            PG8_WAIT_V(8); PG8_WAIT_L(0); PG8_BAR; PG8_MMA(1, 0, At, B0); PG8_MMA(1, 1, At, B1); PG8_BAR; PG8_SCHED;
        }
        if (wr == 0) PG8_BAR;
        if constexpr (F8) asm volatile("s_nop 15\n\ts_nop 15" ::: "memory");
        E(acc, cur, wr, wc, fr, fq, epi_lds + (ui & 1) * EPI_SLOT_BYTES);
        if (!has_next) break;
#pragma unroll
        for (int a = 0; a < 2; ++a)
#pragma unroll
            for (int b = 0; b < 2; ++b)
#pragma unroll
                for (int m = 0; m < 4; ++m)
#pragma unroll
                    for (int n = 0; n < 2; ++n) acc[a][b][m][n] = (f32x4){0.f, 0.f, 0.f, 0.f};
        cur = nxt; cA = nA; cB = nB; ++ui;
        if (wid == 0) E.prefetch(cur, epi_lds + (ui & 1) * EPI_SLOT_BYTES, lane);
#pragma unroll
        for (int h = 0; h < 2; ++h)
#pragma unroll
            for (int i = 0; i < 2; ++i) vAc[h][i] = vAn[h][i];
        if (wr == 1) PG8_BAR;
    }
    PG8_WAIT_V(0);
    PG8_BAR;
#undef PG8_OFF
#undef PG8_SA
#undef PG8_SB
#undef PG8_STAGE2
#undef PG8_STAGEB
#undef PG8_LDA
#undef PG8_LDB
#undef PG8_MMA
#undef PG8_WAIT_V
#undef PG8_WAIT_L
#undef PG8_BAR
#undef PG8_SCHED
}
}
namespace pg8 {
constexpr float LOG2E_ = 1.4426950408889634f;
constexpr float Y_SCALE = 32.0f;
template <bool I8> struct EpiBf16Plain {
    static constexpr bool PERM = true;
    bf16_t* O; int ldc; const float* sa; const float* cm;
    DI void prefetch(const Unit& u, LAS unsigned char* slot, int lane) const { if constexpr (I8) { dma16(sa + u.pm * BM + 4 * lane, slot); dma16(cm + u.pn * BM + 4 * lane, slot + 1024); } }
    DI void operator()(const f32x4 (&acc)[2][2][4][2], const Unit& u, int wr, int wc, int fr, int fq, const LAS unsigned char* slot) const {
        const int row0 = u.pm * BM + wr * 64 + fr, col0 = u.pn * BM + wc * 32 + 8 * fq;
        f32x4 sb[2][2];
        if constexpr (I8) {
#pragma unroll
            for (int bj = 0; bj < 2; ++bj)
#pragma unroll
                for (int n = 0; n < 2; ++n) sb[bj][n] = *(const LAS f32x4*)(slot + 1024 + (wc * 32 + 8 * fq + bj * HALF + 4 * n) * 4) * (1.0f / 127.0f); }
#pragma unroll
        for (int ai = 0; ai < 2; ++ai)
#pragma unroll
            for (int m = 0; m < 4; ++m) { const int row = row0 + ai * HALF + m * 16; bf16_t* rowp = O + (size_t)row * ldc + col0; float sr = 1.f; if constexpr (I8) sr = *(const LAS float*)(slot + (wr * 64 + fr + ai * HALF + m * 16) * 4);
#pragma unroll
                for (int bj = 0; bj < 2; ++bj) { f32x4 v0 = acc[ai][bj][m][0], v1 = acc[ai][bj][m][1];
                    if constexpr (I8) { const i32x4 i0 = __builtin_bit_cast(i32x4, v0), i1 = __builtin_bit_cast(i32x4, v1);
                        v0 = (f32x4){(float)i0[0], (float)i0[1], (float)i0[2], (float)i0[3]} * sb[bj][0] * sr; v1 = (f32x4){(float)i1[0], (float)i1[1], (float)i1[2], (float)i1[3]} * sb[bj][1] * sr; }
                    u32x4 w; w.x = pk_bf16(v0[0], v0[1]); w.y = pk_bf16(v0[2], v0[3]); w.z = pk_bf16(v1[0], v1[1]); w.w = pk_bf16(v1[2], v1[3]);
                    *(u32x4*)(rowp + bj * HALF) = w; } }
    }
};
template <bool I8> struct EpiResF32 {
    static constexpr bool PERM = true;
    const float* base; bf16_t* C; int ldc; const float* sa; const float* cm;
    DI void prefetch(const Unit& u, LAS unsigned char* slot, int lane) const { if constexpr (I8) { dma16(sa + u.pm * BM + 4 * lane, slot); dma16(cm + u.pn * BM + 4 * lane, slot + 1024); } }
    DI void operator()(const f32x4 (&acc)[2][2][4][2], const Unit& u, int wr, int wc, int fr, int fq, const LAS unsigned char* slot) const {
        const int row0 = u.pm * BM + wr * 64 + fr, col0 = u.pn * BM + wc * 32 + 8 * fq;
        f32x4 sb[2][2];
        if constexpr (I8) {
#pragma unroll
            for (int bj = 0; bj < 2; ++bj)
#pragma unroll
                for (int n = 0; n < 2; ++n) sb[bj][n] = *(const LAS f32x4*)(slot + 1024 + (wc * 32 + 8 * fq + bj * HALF + 4 * n) * 4) * (1.0f / 127.0f); }
#pragma unroll
        for (int ai = 0; ai < 2; ++ai)
#pragma unroll
            for (int m = 0; m < 4; ++m) { const int row = row0 + ai * HALF + m * 16; const size_t off = (size_t)row * ldc + col0; float sr = 1.f; if constexpr (I8) sr = *(const LAS float*)(slot + (wr * 64 + fr + ai * HALF + m * 16) * 4);
#pragma unroll
                for (int bj = 0; bj < 2; ++bj)
                { f32x4 v[2];
#pragma unroll
                    for (int n = 0; n < 2; ++n) { v[n] = acc[ai][bj][m][n];
                        if constexpr (I8) { const i32x4 iv = __builtin_bit_cast(i32x4, v[n]); v[n] = (f32x4){(float)iv[0], (float)iv[1], (float)iv[2], (float)iv[3]} * sb[bj][n] * sr; }
                        v[n] = v[n] + *(const f32x4*)(base + off + bj * HALF + 4 * n); }
                    u32x4 w; w.x = pk_bf16(v[0][0], v[0][1]); w.y = pk_bf16(v[0][2], v[0][3]); w.z = pk_bf16(v[1][0], v[1][1]); w.w = pk_bf16(v[1][2], v[1][3]);
                    *(u32x4*)(C + off + bj * HALF) = w; } }
    }
};
struct EpiGlu {
    static constexpr bool PERM = true;
    unsigned char* O; int ldc; const float* bias;
    DI void prefetch(const Unit& u, LAS unsigned char* slot, int lane) const { dma16(bias + (size_t)u.e * 4096 + (lane >> 5) * 2048 + u.pn * HALF + 4 * (lane & 31), slot); }
    DI void operator()(const f32x4 (&acc)[2][2][4][2], const Unit& u, int wr, int wc, int fr, int fq, const LAS unsigned char* slot) const {
        typedef float f2 __attribute__((ext_vector_type(2)));
        const int row0 = u.pm * BM + wr * 64 + fr, colg = u.pn * HALF + wc * 32 + 8 * fq;
        f32x4 bgl[2], bln[2];
#pragma unroll
        for (int n = 0; n < 2; ++n) { bgl[n] = *(const LAS f32x4*)(slot + (wc * 32 + 8 * fq + 4 * n) * 4); bln[n] = *(const LAS f32x4*)(slot + 512 + (wc * 32 + 8 * fq + 4 * n) * 4); }
#pragma unroll
        for (int ai = 0; ai < 2; ++ai)
#pragma unroll
            for (int m = 0; m < 4; ++m) { unsigned char* rowp = O + (size_t)(row0 + ai * HALF + m * 16) * ldc + colg;
                f2 r[4];
#pragma unroll
                for (int n = 0; n < 2; ++n)
#pragma unroll
                    for (int jj = 0; jj < 2; ++jj) { const int j = 2 * jj;
                        f2 g = (f2){acc[ai][0][m][n][j], acc[ai][0][m][n][j + 1]} + (f2){bgl[n][j], bgl[n][j + 1]};
                        f2 l = (f2){acc[ai][1][m][n][j], acc[ai][1][m][n][j + 1]} + (f2){bln[n][j], bln[n][j + 1]};
                        g.x = fminf(g.x, 7.0f); g.y = fminf(g.y, 7.0f); l.x = __builtin_amdgcn_fmed3f(l.x, -7.0f, 7.0f); l.y = __builtin_amdgcn_fmed3f(l.y, -7.0f, 7.0f);
                        const f2 t = g * (-1.702f * LOG2E_);
                        f2 e; e.x = __builtin_amdgcn_exp2f(t.x); e.y = __builtin_amdgcn_exp2f(t.y);
                        const f2 d = e + 1.0f;
                        f2 q; q.x = __builtin_amdgcn_rcpf(d.x); q.y = __builtin_amdgcn_rcpf(d.y);
                        r[2 * n + jj] = (g * q) * (l * 8.0f + 8.0f); }
                u32x2 w; w.x = pk4_fp8(r[0].x, r[0].y, r[1].x, r[1].y); w.y = pk4_fp8(r[2].x, r[2].y, r[3].x, r[3].y);
                *(u32x2*)rowp = w; }
    }
};
struct EpiF8BiasE {
    static constexpr bool PERM = true;
    unsigned char* O; int ldc; const float* bias;
    DI void prefetch(const Unit& u, LAS unsigned char* slot, int lane) const { dma16(bias + (size_t)u.e * 2048 + u.pn * BM + 4 * lane, slot); }
    DI void operator()(const f32x4 (&acc)[2][2][4][2], const Unit& u, int wr, int wc, int fr, int fq, const LAS unsigned char* slot) const {
        const int row0 = u.pm * BM + wr * 64 + fr, col0 = u.pn * BM + wc * 32 + 8 * fq;
        f32x4 bv[2][2];
#pragma unroll
        for (int bj = 0; bj < 2; ++bj)
#pragma unroll
            for (int n = 0; n < 2; ++n) bv[bj][n] = *(const LAS f32x4*)(slot + (wc * 32 + 8 * fq + bj * HALF + 4 * n) * 4);
#pragma unroll
        for (int ai = 0; ai < 2; ++ai)
#pragma unroll
            for (int m = 0; m < 4; ++m) { unsigned char* rowp = O + (size_t)(row0 + ai * HALF + m * 16) * ldc + col0;
#pragma unroll
                for (int bj = 0; bj < 2; ++bj) { const f32x4 v0 = (acc[ai][bj][m][0] + bv[bj][0]) * Y_SCALE, v1 = (acc[ai][bj][m][1] + bv[bj][1]) * Y_SCALE;
                    u32x2 w; w.x = pk4_fp8(clamp_fp8(v0[0]), clamp_fp8(v0[1]), clamp_fp8(v0[2]), clamp_fp8(v0[3])); w.y = pk4_fp8(clamp_fp8(v1[0]), clamp_fp8(v1[1]), clamp_fp8(v1[2]), clamp_fp8(v1[3]));
                    *(u32x2*)(rowp + bj * HALF) = w; } }
    }
};
}
constexpr int NWAVES = 8;
constexpr int NTOK = 16384, DM = 2048, SEQ = 2048, NBATCH = 8;
constexpr int DIN = 12816, LDP = 13056;
constexpr int C_QA = 0, C_KA = 2048, C_VA = 2304, C_QB = 2560, C_KB = 3584, C_VB = 4608, C_RB = 6656, C_GA = 8704, C_GB = 10752, C_ALR = 12800;
constexpr int NEXP = 32, TOPK = 4, DFF = 2048;
constexpr int PMAX = 73728;
constexpr float EPS = 1e-5f;
constexpr float LOG2E = 1.4426950408889634f;
#ifndef MK_I8_P1
#define MK_I8_P1 1
#endif
#ifndef MK_I8_P5
#define MK_I8_P5 1
#endif
constexpr bool I8_P1 = MK_I8_P1 != 0, I8_P5 = MK_I8_P5 != 0;
constexpr bool I8_DENSE = I8_P1 || I8_P5;
#ifndef MK_MIX_CLIP
#define MK_MIX_CLIP 1e30f
#endif
constexpr float MIX_CLIP = MK_MIX_CLIP;
#ifndef MK_STAGGER_US
#define MK_STAGGER_US 0
#endif
constexpr int STAGGER_US = MK_STAGGER_US;

constexpr size_t MiB = 1u << 20;
constexpr size_t WS_CTL = 0, CTL_ZERO_BYTES = 1 * MiB;
constexpr size_t WS_TOPE = 1 * MiB;
constexpr size_t WS_TOPS = WS_TOPE + (size_t)NTOK * 4 * 4;
constexpr size_t WS_GATE = WS_TOPS + (size_t)NTOK * 4 * 4;
constexpr size_t WS_TOKL = WS_GATE + (size_t)NTOK * 4 * 4;
constexpr size_t WS_WIN  = 4 * MiB;
constexpr size_t WS_WOUT = WS_WIN + (size_t)LDP * DM * 2;
constexpr size_t WS_WGU  = WS_WOUT + (size_t)DM * DM * 2;
constexpr size_t WS_WDN  = WS_WGU + (size_t)NEXP * 4096 * DM * 2;
constexpr size_t WS_H    = WS_WDN + (size_t)NEXP * DM * DM * 2;
constexpr size_t WS_PROJ = WS_H + (size_t)NTOK * DM * 2;
constexpr size_t WS_OA   = WS_PROJ + (size_t)NTOK * LDP * 2;
constexpr size_t WS_OB   = WS_OA + (size_t)NTOK * DM * 2;
constexpr size_t WS_MIX  = WS_OB + (size_t)NTOK * DM * 2;
constexpr size_t WS_X1   = WS_MIX + (size_t)NTOK * DM * 2;
constexpr size_t WS_GQT  = WS_X1 + (size_t)NTOK * DM * 4;
constexpr size_t WS_GKT  = WS_GQT + (size_t)1024 * 16384 * 2;
constexpr size_t WS_GATT = WS_GKT + (size_t)1024 * 16384 * 2;
constexpr size_t WS_GDEC = WS_GATT + (size_t)1024 * 4096 * 2;
constexpr size_t WS_GVT  = WS_GDEC + (size_t)1024 * 256 * 4;
constexpr size_t WS_ACT  = WS_GVT + (size_t)1024 * 32768 * 2;
constexpr size_t WS_Y    = WS_ACT + (size_t)PMAX * DFF * 2;
constexpr size_t WS_RTB  = WS_Y + (size_t)PMAX * DM * 2;
constexpr size_t WS_END  = WS_RTB + (size_t)2 * 32 * 2048 * 2;
constexpr size_t WS_SAH  = WS_TOKL + (size_t)NEXP * NTOK * 4;
constexpr size_t WS_SAMIX = WS_SAH + (size_t)NTOK * 4;
static_assert(WS_SAMIX + (size_t)NTOK * 4 <= WS_WIN, "row scales below the weight copies");
static_assert(WS_WIN % 256 == 0 && WS_WOUT % 256 == 0 && WS_WGU % 256 == 0 && WS_WDN % 256 == 0 && WS_H % 256 == 0 && WS_PROJ % 256 == 0 && WS_OA % 256 == 0 && WS_X1 % 256 == 0 &&
              WS_GQT % 256 == 0 && WS_GKT % 256 == 0 && WS_GATT % 256 == 0 && WS_GDEC % 256 == 0 && WS_GVT % 256 == 0 && WS_ACT % 256 == 0 && WS_Y % 256 == 0, "alignment");
constexpr int CW_TMO = 0, CW_CODE = 1;
constexpr int CW_BAR = 4096;
constexpr int CW_CNT = 8192;
constexpr int CW_SWAQ = CW_CNT + 64 * 40;
constexpr int CW_CVQ = CW_CNT + 64 * 41;
constexpr int P0_NITEMS = 16 * 408 + 16 * 64 + 32 * 16 * 128 + 32 * 16 * 64;
constexpr int P0_EARLY = 16 * 408 + 16 * 64;
constexpr int P0_LATE = 32768;
constexpr int P0_EMBED = P0_NITEMS - P0_EARLY - P0_LATE;
constexpr int EMB_PER_WAVE = P0_EMBED / 2048;
#ifndef MK_EMB_P5
#define MK_EMB_P5 4
#endif
constexpr int EMB_P5 = MK_EMB_P5;
#ifndef MK_EMB_MV
#define MK_EMB_MV 2
#endif
constexpr int EMB_MV = MK_EMB_MV;
#ifndef MK_SUPER_RB16
#define MK_SUPER_RB16 4
#endif
constexpr int SUPER_RB16 = MK_SUPER_RB16;
static_assert(P0_EMBED == 2048 * EMB_PER_WAVE && EMB_P5 <= EMB_PER_WAVE, "embedded copy items divide evenly over 2048 waves");
constexpr int CV_GROUP = 8, CV_NGROUPS = P0_LATE / CV_GROUP;
constexpr int CW_CMAX_IN = 16384, CW_CMAX_OUT = CW_CMAX_IN + LDP;
static_assert((CW_CMAX_OUT + DM) * 4 <= (int)CTL_ZERO_BYTES, "CTL words inside the memset region");
constexpr int RING_OFF = 0, RING_BYTES = 131072;
constexpr int LDSCTL_OFF = RING_BYTES, MISC_OFF = LDSCTL_OFF + 320;
constexpr int TBL_OFF = LDSCTL_OFF + 1024;
constexpr int LDS_BYTES = 147456;
static_assert(MISC_OFF + 128 <= TBL_OFF && TBL_OFF + 4096 <= LDS_BYTES, "LDS map");

typedef GAS unsigned gu32;
#define RLX_AGENT __ATOMIC_RELAXED, __HIP_MEMORY_SCOPE_AGENT
#define LDS_WAIT() asm volatile("s_waitcnt lgkmcnt(0)" ::: "memory")
#define VM_WAIT() asm volatile("s_waitcnt vmcnt(0)" ::: "memory")

#define XB_TMO      128
#define XB_XCNT(j)  (256  + 64 * (j))
#define XB_XSUB(j)  (1280 + 64 * (j))
#define XB_XGEN(j)  (2304 + 64 * (j))
#define XB_TOP      3328
#define XB_TOPGEN   3392
#define XCD_BAR_WORDS 3456
#define XB_SPIN_CAP (1u << 18)

__device__ __forceinline__ unsigned xb_ld(unsigned* p)              { return __hip_atomic_load(p, __ATOMIC_RELAXED, __HIP_MEMORY_SCOPE_AGENT); }
__device__ __forceinline__ unsigned xb_add(unsigned* p, unsigned v) { return __hip_atomic_fetch_add(p, v, __ATOMIC_RELAXED, __HIP_MEMORY_SCOPE_AGENT); }
__device__ __forceinline__ unsigned xb_xcc_id() { return (unsigned)__builtin_amdgcn_s_getreg((3 << 11) | 20) & 0xFu; }
#define XB_SPIN(cond, bar) do { unsigned _sp = 0; while (cond) { __builtin_amdgcn_s_sleep(1); \
    if ((++_sp & 255u) == 0u) { if (xb_ld(&(bar)[XB_TMO])) break; if (_sp > XB_SPIN_CAP) { atomicAdd(&(bar)[XB_TMO], 1u); break; } } } } while (0)

struct XcdBarrier {
    unsigned* bar; unsigned x;
    volatile LAS unsigned* st;
};

__device__ __forceinline__ XcdBarrier xcd_barrier_post(unsigned* bar, volatile LAS unsigned* st) {
    XcdBarrier b; b.bar = bar; b.x = xb_xcc_id(); b.st = st;
    if (threadIdx.x == 0) (void)xb_add(&bar[XB_XCNT(b.x)], 1u);
    return b;
}
__device__ __forceinline__ void xcd_barrier_complete(unsigned* bar, unsigned x, unsigned& nloc, unsigned& nx) {
    const unsigned G = gridDim.x * gridDim.y * gridDim.z;
    unsigned sum, cnt, mine, sp = 0u;
    for (;;) {
        sum = 0u; cnt = 0u; mine = 0u;
#pragma unroll
        for (unsigned j = 0; j < 16; ++j) { const unsigned c = xb_ld(&bar[XB_XCNT(j)]); sum += c; cnt += (c > 0u) ? 1u : 0u; mine = (j == x) ? c : mine; }
        if (sum == G) break;
        __builtin_amdgcn_s_sleep(1);
        if ((++sp & 255u) == 0u) { if (xb_ld(&bar[XB_TMO])) break; if (sp > XB_SPIN_CAP) { atomicAdd(&bar[XB_TMO], 1u); break; } }
    }
    nloc = mine > 0u ? mine : 1u; nx = cnt > 0u ? cnt : 1u;
}

__device__ __forceinline__ void xcd_barrier(const XcdBarrier& b) {
    asm volatile("s_waitcnt vmcnt(0)" ::: "memory");
    __syncthreads();
    if (threadIdx.x == 0) {
        unsigned* bar = b.bar;
        __builtin_amdgcn_s_waitcnt(0);
        unsigned nloc = b.st[0], nx = b.st[1];
        if (nloc == 0u) { xcd_barrier_complete(bar, b.x, nloc, nx); b.st[0] = nloc; b.st[1] = nx; }
        const unsigned old = xb_add(&bar[XB_XSUB(b.x)], 1u);
        const unsigned gen = old / nloc;
        if (old + 1u == (gen + 1u) * nloc) {
            __builtin_amdgcn_fence(__ATOMIC_RELEASE, "agent");
            asm volatile("s_waitcnt vmcnt(0)" ::: "memory");
            const unsigned og = xb_add(&bar[XB_TOP], 1u);
            const unsigned tg = og / nx;
            if (og + 1u == (tg + 1u) * nx) xb_add(&bar[XB_TOPGEN], 1u);
            else XB_SPIN(xb_ld(&bar[XB_TOPGEN]) == tg, bar);
            __builtin_amdgcn_fence(__ATOMIC_ACQUIRE, "agent");
            xb_add(&bar[XB_XGEN(b.x)], 1u);
            asm volatile("s_waitcnt vmcnt(0)" ::: "memory");
        } else {
            XB_SPIN(xb_ld(&bar[XB_XGEN(b.x)]) == gen, bar);
            __builtin_amdgcn_fence(__ATOMIC_ACQUIRE, "agent");
            asm volatile("s_waitcnt vmcnt(0)" ::: "memory");
        }
    }
    __syncthreads();
}

struct Frame {
    LAS unsigned char* lds;
    gu32* ctl;
    int tid, lane, wave, vcu, G;
    const float *x, *attn_g, *w_in, *sinks, *w_alpha2, *b_alpha, *gla_g, *w_out, *ffn_g, *w_router, *b_router, *w_gu, *b_gu, *w_dn, *b_dn, *final_g;
    float* out;
    int *tope, *tops, *tokl; float* gate;
    float *sa_h, *sa_mix;
    bf16_t *Win, *Wout, *Wgu, *Wdn, *H, *PROJ, *OA, *OB, *MIX, *GQT, *GKT, *GATT, *GVT, *ACT, *Y;
    bf16_t* X1; float* GDEC; bf16_t* RTB;
};
DI void p0_transpose_item(const float* Wsrc, int ldw, int srccol0, int nvalid, int k0, bf16_t* dst, int K, LAS float* scr, int lane) {
    const int krow = lane >> 3, n4 = lane & 7;
    const bool ok = 4 * n4 < nvalid;
#pragma unroll
    for (int i = 0; i < 8; ++i) { const int kk = 8 * i + krow; f32x4 v = (f32x4){0.f, 0.f, 0.f, 0.f};
        if (ok) v = *(const f32x4*)(Wsrc + (size_t)(k0 + kk) * ldw + srccol0 + 4 * n4);
        LAS float* d = scr + kk * 33 + 4 * n4; d[0] = v[0]; d[1] = v[1]; d[2] = v[2]; d[3] = v[3]; }
    LDS_WAIT(); asm volatile("" ::: "memory");
    const int c = lane & 7;
#pragma unroll
    for (int j = 0; j < 4; ++j) { const int n = (lane >> 3) + 8 * j; const LAS float* s = scr + (8 * c) * 33 + n;
        u32x4 o; o.x = pk_bf16(s[0 * 33], s[1 * 33]); o.y = pk_bf16(s[2 * 33], s[3 * 33]); o.z = pk_bf16(s[4 * 33], s[5 * 33]); o.w = pk_bf16(s[6 * 33], s[7 * 33]);
        *(u32x4*)(dst + (size_t)n * K + k0 + 8 * c) = o; }
    LDS_WAIT(); asm volatile("" ::: "memory");
}
DI void rms_row_to_bf16(const float* xrow, const float* g, bf16_t* orow, int lane) {
    const f32x4* xr = (const f32x4*)xrow + lane; const f32x4* gr = (const f32x4*)g + lane;
    f32x4 v[8]; float s = 0.f;
#pragma unroll
    for (int j = 0; j < 8; ++j) { v[j] = xr[64 * j]; s += (v[j].x * v[j].x + v[j].y * v[j].y) + (v[j].z * v[j].z + v[j].w * v[j].w); }
    const float r = 1.0f / sqrtf(wave_sum(s) * (1.f / DM) + EPS);
    u32x2* o8 = (u32x2*)orow + lane;
#pragma unroll
    for (int j = 0; j < 8; ++j) { const f32x4 gg = gr[64 * j]; u32x2 w; w.x = pk_bf16(v[j].x * r * gg.x, v[j].y * r * gg.y); w.y = pk_bf16(v[j].z * r * gg.z, v[j].w * r * gg.w); o8[64 * j] = w; }
}
DI void p0_transpose_item_f8(const float* Wsrc, int ldw, int srccol0, int nvalid, int k0, unsigned char* dst, int K, LAS float* scr, int lane) {
    const int krow = lane >> 3, n4 = lane & 7;
    const bool ok = 4 * n4 < nvalid;
#pragma unroll
    for (int i = 0; i < 8; ++i) { const int kk = 8 * i + krow; f32x4 v = (f32x4){0.f, 0.f, 0.f, 0.f};
        if (ok) v = *(const f32x4*)(Wsrc + (size_t)(k0 + kk) * ldw + srccol0 + 4 * n4);
        LAS float* d = scr + kk * 33 + 4 * n4; d[0] = v[0]; d[1] = v[1]; d[2] = v[2]; d[3] = v[3]; }
    LDS_WAIT(); asm volatile("" ::: "memory");
    const int c = lane & 7;
#pragma unroll
    for (int j = 0; j < 4; ++j) { const int n = (lane >> 3) + 8 * j; const LAS float* s = scr + (8 * c) * 33 + n;
        u32x2 o; o.x = pk4_fp8(64.f * s[0 * 33], 64.f * s[1 * 33], 64.f * s[2 * 33], 64.f * s[3 * 33]); o.y = pk4_fp8(64.f * s[4 * 33], 64.f * s[5 * 33], 64.f * s[6 * 33], 64.f * s[7 * 33]);
        *(u32x2*)(dst + (size_t)n * K + k0 + 8 * c) = o; }
    LDS_WAIT(); asm volatile("" ::: "memory");
}
DI void rms_row_to_f8(const float* xrow, const float* g, unsigned char* orow, int lane) {
    const f32x4* xr = (const f32x4*)xrow + lane; const f32x4* gr = (const f32x4*)g + lane;
    f32x4 v[8]; float s = 0.f;
#pragma unroll
    for (int j = 0; j < 8; ++j) { v[j] = xr[64 * j]; s += (v[j].x * v[j].x + v[j].y * v[j].y) + (v[j].z * v[j].z + v[j].w * v[j].w); }
    const float r = 8.0f / sqrtf(wave_sum(s) * (1.f / DM) + EPS);
    unsigned* o4 = (unsigned*)orow + lane;
#pragma unroll
    for (int j = 0; j < 8; ++j) { const f32x4 gg = gr[64 * j]; o4[64 * j] = pk4_fp8(clamp_fp8(v[j].x * r * gg.x), clamp_fp8(v[j].y * r * gg.y), clamp_fp8(v[j].z * r * gg.z), clamp_fp8(v[j].w * r * gg.w)); }
}
struct P0Item { const float* src; unsigned char* dst; int ldw, pitch, mode; bool ok, live; f32x4 inv; };
DI f32x4 p0_inv(const float* cmax) { const f32x4 c = *(const f32x4*)cmax; return (f32x4){127.f / fmaxf(c.x, 1e-30f), 127.f / fmaxf(c.y, 1e-30f), 127.f / fmaxf(c.z, 1e-30f), 127.f / fmaxf(c.w, 1e-30f)}; }
DI P0Item p0_decode(Frame& F, int it, int nitems, int lane) {
    constexpr int I_IN = 16 * 408, I_OUT = 16 * 64, I_GU = 32 * 16 * 128;
    const int kc = lane >> 3, n4 = lane & 7;
    P0Item d; d.live = it < nitems; d.ok = true; d.mode = GM_FP8; d.ldw = DM; d.pitch = DM; d.src = F.w_in; d.dst = (unsigned char*)F.Win; d.inv = (f32x4){0.f, 0.f, 0.f, 0.f};
    if (!d.live) { d.ok = false; return d; }
    int r = it;
    int dmode = I8_P1 ? GM_I8 : GM_BF16, esz = I8_P1 ? 1 : 2;
    if (r < I_IN) { const int kb = r / 408, nb = r % 408, n0 = 32 * nb; int sc = n0, nv = 32;
        if (n0 >= 8704 && n0 < 12800) sc = n0 + 16; else if (n0 == 12800) { sc = 8704; nv = 16; } else if (n0 > 12800) { sc = 0; nv = 0; }
        d.mode = dmode; d.ok = 4 * n4 < nv; d.ldw = DIN; d.src = F.w_in + (size_t)(128 * kb + 16 * kc) * DIN + sc + 4 * n4;
        if (I8_P1) d.inv = p0_inv((const float*)(F.ctl + CW_CMAX_IN) + n0 + 4 * n4);
        d.pitch = DM * esz; d.dst = (unsigned char*)F.Win + (size_t)(n0 + 4 * n4) * d.pitch + (128 * kb + 16 * kc) * esz; return d; }
    r -= I_IN; dmode = I8_P5 ? GM_I8 : GM_BF16; esz = I8_P5 ? 1 : 2;
    if (r < I_OUT) { const int kb = r / 64, nb = r % 64; d.mode = dmode; d.ldw = DM; d.src = F.w_out + (size_t)(128 * kb + 16 * kc) * DM + 32 * nb + 4 * n4;
        if (I8_P5) d.inv = p0_inv((const float*)(F.ctl + CW_CMAX_OUT) + 32 * nb + 4 * n4);
        d.pitch = DM * esz; d.dst = (unsigned char*)F.Wout + (size_t)(32 * nb + 4 * n4) * d.pitch + (128 * kb + 16 * kc) * esz; return d; }
    r -= I_OUT;
    if (r < I_GU) { const int e = r / 2048, rr = r % 2048, kb = rr / 128, nb = rr % 128, n0 = 32 * nb, pn = n0 >> 8, i0 = n0 & 255;
        const int sc = (i0 < 128) ? (128 * pn + i0) : (2048 + 128 * pn + i0 - 128);
        d.ldw = 4096; d.src = F.w_gu + (size_t)e * DM * 4096 + (size_t)(128 * kb + 16 * kc) * 4096 + sc + 4 * n4; d.pitch = DM;
        d.dst = (unsigned char*)F.Wgu + ((size_t)e * 4096 + n0 + 4 * n4) * DM + 128 * kb + 16 * kc; return d; }
    r -= I_GU;
    { const int e = r / 1024, rr = r % 1024, kb = rr / 64, nb = rr % 64;
        d.ldw = DM; d.src = F.w_dn + (size_t)e * DFF * DM + (size_t)(128 * kb + 16 * kc) * DM + 32 * nb + 4 * n4; d.pitch = DFF;
        d.dst = (unsigned char*)F.Wdn + ((size_t)e * DM + 32 * nb + 4 * n4) * DFF + 128 * kb + 16 * kc; return d; }
}
DI void p0_load(const P0Item& d, f32x4 (&v)[16]) {
#pragma unroll
    for (int j = 0; j < 16; ++j) { v[j] = (f32x4){0.f, 0.f, 0.f, 0.f}; if (d.ok) v[j] = __builtin_nontemporal_load((const f32x4*)(d.src + (size_t)j * d.ldw)); }
}
DI void p0_store(const P0Item& d, const f32x4 (&v)[16]) {
    if (!d.live) return;
    if (d.mode == GM_FP8) {
#pragma unroll
        for (int q = 0; q < 4; ++q) { u32x4 o;
#define W8(j) __builtin_amdgcn_fmed3f(64.f * v[j][q], -448.f, 448.f)
            o.x = pk4_fp8(W8(0), W8(1), W8(2), W8(3)); o.y = pk4_fp8(W8(4), W8(5), W8(6), W8(7)); o.z = pk4_fp8(W8(8), W8(9), W8(10), W8(11)); o.w = pk4_fp8(W8(12), W8(13), W8(14), W8(15));
#undef W8
            __builtin_nontemporal_store(o, (u32x4*)(d.dst + (size_t)q * d.pitch)); }
    } else if (d.mode == GM_I8) {
#pragma unroll
        for (int q = 0; q < 4; ++q) { const float s = d.inv[q]; u32x4 o; o.x = pk4_i8(s * v[0][q], s * v[1][q], s * v[2][q], s * v[3][q]); o.y = pk4_i8(s * v[4][q], s * v[5][q], s * v[6][q], s * v[7][q]);
            o.z = pk4_i8(s * v[8][q], s * v[9][q], s * v[10][q], s * v[11][q]); o.w = pk4_i8(s * v[12][q], s * v[13][q], s * v[14][q], s * v[15][q]);
            *(u32x4*)(d.dst + (size_t)q * d.pitch) = o; }
    } else {
#pragma unroll
        for (int q = 0; q < 4; ++q) { u32x4 o; o.x = pk_bf16(v[0][q], v[1][q]); o.y = pk_bf16(v[2][q], v[3][q]); o.z = pk_bf16(v[4][q], v[5][q]); o.w = pk_bf16(v[6][q], v[7][q]);
            *(u32x4*)(d.dst + (size_t)q * d.pitch) = o;
            o.x = pk_bf16(v[8][q], v[9][q]); o.y = pk_bf16(v[10][q], v[11][q]); o.z = pk_bf16(v[12][q], v[13][q]); o.w = pk_bf16(v[14][q], v[15][q]);
            *(u32x4*)(d.dst + (size_t)q * d.pitch + 16) = o; }
    }
}
DI void rms_row_to_i8(const float* xrow, const float* g, unsigned char* orow, float* sa, int lane) {
    const f32x4* xr = (const f32x4*)xrow + lane; const f32x4* gr = (const f32x4*)g + lane;
    f32x4 v[8]; float s = 0.f;
#pragma unroll
    for (int j = 0; j < 8; ++j) { v[j] = xr[64 * j]; s += (v[j].x * v[j].x + v[j].y * v[j].y) + (v[j].z * v[j].z + v[j].w * v[j].w); }
    const float r = 1.0f / sqrtf(wave_sum(s) * (1.f / DM) + EPS);
    float am = 0.f;
#pragma unroll
    for (int j = 0; j < 8; ++j) { const f32x4 gg = gr[64 * j]; v[j] = v[j] * gg * r; am = fmaxf(am, fmaxf(fmaxf(fabsf(v[j].x), fabsf(v[j].y)), fmaxf(fabsf(v[j].z), fabsf(v[j].w)))); }
    am = fmaxf(wave_max(am), 1e-30f);
    const float inv = 127.f / am;
    if (lane == 0) *sa = am * (1.f / 127.f);
    unsigned* o4 = (unsigned*)orow + lane;
#pragma unroll
    for (int j = 0; j < 8; ++j) o4[64 * j] = pk4_i8(v[j].x * inv, v[j].y * inv, v[j].z * inv, v[j].w * inv);
}
DI void colmax_phase(Frame& F) {
    if (!I8_DENSE) return;
    const int gw = F.vcu * NWAVES + F.wave, NGW = F.G * NWAVES, lane = F.lane, kc = lane >> 4, n4 = lane & 15;
    constexpr int NB_IN = (DIN + 63) / 64, I_IN = 32 * NB_IN, I_OUT = 32 * 32;
    for (int it = gw; it < I_IN + I_OUT; it += NGW) {
        const bool in = it < I_IN; const int r = in ? it : it - I_IN, nbs = in ? NB_IN : 32, kb = r / nbs, nb = r % nbs, ldw = in ? DIN : DM, c0 = 64 * nb + 4 * n4;
        const bool ok = c0 < ldw;
        const float* src = (in ? F.w_in : F.w_out) + (size_t)(64 * kb + kc) * ldw + c0;
        f32x4 m = (f32x4){0.f, 0.f, 0.f, 0.f};
        if (ok) {
#pragma unroll
            for (int j = 0; j < 16; ++j) { const f32x4 v = *(const f32x4*)(src + (size_t)(4 * j) * ldw); m.x = fmaxf(m.x, fabsf(v.x)); m.y = fmaxf(m.y, fabsf(v.y)); m.z = fmaxf(m.z, fabsf(v.z)); m.w = fmaxf(m.w, fabsf(v.w)); } }
#pragma unroll
        for (int q = 0; q < 4; ++q) { m[q] = fmaxf(m[q], __shfl_xor(m[q], 16)); m[q] = fmaxf(m[q], __shfl_xor(m[q], 32)); }
        if (ok && kc == 0) { int n = c0; if (in) { if (c0 >= 8720) n = c0 - 16; else if (c0 >= 8704) n = 12800 + c0 - 8704; }
            unsigned* dst = (unsigned*)(F.ctl + (in ? CW_CMAX_IN : CW_CMAX_OUT)) + n;
#pragma unroll
            for (int q = 0; q < 4; ++q) __hip_atomic_fetch_max(dst + q, __float_as_uint(m[q]), __ATOMIC_RELAXED, __HIP_MEMORY_SCOPE_AGENT); }
    }
}
DI void p0_prologue(Frame& F) {
    const int gw = F.vcu * NWAVES + F.wave, NGW = F.G * NWAVES;
    constexpr int NITEMS = P0_EARLY;
    f32x4 va[16], vb[16];
    P0Item da = p0_decode(F, gw, NITEMS, F.lane), db;
    p0_load(da, va);
    for (int it = gw; it < NITEMS; it += 2 * NGW) {
        db = p0_decode(F, it + NGW, NITEMS, F.lane); p0_load(db, vb);
        p0_store(da, va);
        da = p0_decode(F, it + 2 * NGW, NITEMS, F.lane); p0_load(da, va);
        p0_store(db, vb);
    }
    for (int idx = gw * 64 + F.lane; idx < 32 * 2048; idx += NGW * 64) {
        { const int e = idx >> 11, k = idx & 2047; const float v = F.ffn_g[k] * F.w_router[k * 32 + e]; const bf16_t hi = f2bf(v);
            const int o = (((k >> 3) * 32 + e) << 3) + (k & 7);
            F.RTB[o] = hi; F.RTB[32 * 2048 + o] = f2bf(v - bf2f(hi)); } }
    for (int m = gw; m < NTOK; m += NGW) { if (I8_P1) rms_row_to_i8(F.x + (size_t)m * DM, F.attn_g, (unsigned char*)F.H + (size_t)m * DM, F.sa_h + m, F.lane); else rms_row_to_bf16(F.x + (size_t)m * DM, F.attn_g, F.H + (size_t)m * DM, F.lane); }
}

DI void embed_copy_range(Frame& F, int i0, int i1, int coloff = 0) {
    if (F.G != 256) { if (i0 != 0) return;
        const int gw = F.vcu * NWAVES + F.wave, NGW = F.G * NWAVES; f32x4 va[16];
        for (int it = P0_EARLY + gw; it < P0_EARLY + P0_EMBED; it += NGW) { const P0Item da = p0_decode(F, it, P0_NITEMS, F.lane); p0_load(da, va); p0_store(da, va); }
        return; }
    if (i0 >= i1) return;
    const int gw = F.vcu * NWAVES + F.wave, base = P0_EARLY + gw + coloff;
    f32x4 va[16], vb[16];
    P0Item da = p0_decode(F, base + i0 * 2048, P0_NITEMS, F.lane), db;
    p0_load(da, va);
#pragma unroll 1
    for (int i = i0; i < i1; i += 2) {
        db = p0_decode(F, (i + 1 < i1) ? base + (i + 1) * 2048 : P0_NITEMS, P0_NITEMS, F.lane); p0_load(db, vb);
        p0_store(da, va);
        da = p0_decode(F, (i + 2 < i1) ? base + (i + 2) * 2048 : P0_NITEMS, P0_NITEMS, F.lane); p0_load(da, va);
        p0_store(db, vb);
    }
}
DI void late_copy_phase(Frame& F, int maxn = 1 << 30) {
    volatile LAS unsigned* qslot = (volatile LAS unsigned*)(F.lds + MISC_OFF) + 16;
    if (F.tid == 0) qslot[0] = __hip_atomic_fetch_add((unsigned*)(F.ctl + CW_CVQ), 1u, __ATOMIC_RELAXED, __HIP_MEMORY_SCOPE_AGENT);
    __syncthreads();
    for (int n = 0;; ++n) {
        const int g = (int)qslot[0];
        __syncthreads();
        if (g >= CV_NGROUPS) break;
        const bool more = n + 1 < maxn;
        unsigned nt = 0xffffffffu;
        if (F.tid == 0 && more) nt = __hip_atomic_fetch_add((unsigned*)(F.ctl + CW_CVQ), 1u, __ATOMIC_RELAXED, __HIP_MEMORY_SCOPE_AGENT);
        const int base = P0_NITEMS - P0_LATE + g * CV_GROUP + F.wave;
        f32x4 va[16];
        const P0Item da = p0_decode(F, base, P0_NITEMS, F.lane);
        p0_load(da, va);
        if (F.tid == 0) qslot[0] = nt;
        p0_store(da, va);
        __syncthreads();
        if (!more) break;
    }
}
DI s16x4 tr_read(const LAS unsigned char* p) { return __builtin_bit_cast(s16x4, __builtin_amdgcn_ds_read_tr16_b64_v4i16((LAS s16x4*)p)); }
DI bf16x8 pack8(const f32x16& x, int s) {
    u32x4 p; p.x = pk_bf16(x[8 * s + 0], x[8 * s + 1]); p.y = pk_bf16(x[8 * s + 2], x[8 * s + 3]); p.z = pk_bf16(x[8 * s + 4], x[8 * s + 5]); p.w = pk_bf16(x[8 * s + 6], x[8 * s + 7]);
    return __builtin_bit_cast(bf16x8, p);
}
DI bf16x8 pack8_pinned(const f32x16& x, int s) {
    u32x4 p;
    asm volatile("v_cvt_pk_bf16_f32 %0, %4, %5\n\tv_cvt_pk_bf16_f32 %1, %6, %7\n\tv_cvt_pk_bf16_f32 %2, %8, %9\n\tv_cvt_pk_bf16_f32 %3, %10, %11\n\ts_nop 1"
                 : "=&v"(p[0]), "=&v"(p[1]), "=&v"(p[2]), "=&v"(p[3])
                 : "v"(x[8 * s]), "v"(x[8 * s + 1]), "v"(x[8 * s + 2]), "v"(x[8 * s + 3]), "v"(x[8 * s + 4]), "v"(x[8 * s + 5]), "v"(x[8 * s + 6]), "v"(x[8 * s + 7]));
    return __builtin_bit_cast(bf16x8, p);
}
DI void swa_phase(Frame& F) {
    LAS unsigned char* Ks = F.lds;
    LAS unsigned char* Vs = F.lds + 36864;
    const int lane = F.lane, w = F.wave, c31 = lane & 31, h = lane >> 5;
    const int i16 = lane & 15, q4 = i16 >> 2, p4 = i16 & 3, blk = (lane >> 4) & 1;
    volatile LAS unsigned* qslot = (volatile LAS unsigned*)(F.lds + MISC_OFF) + 16;
    if (F.tid == 0) qslot[0] = __hip_atomic_fetch_add((unsigned*)(F.ctl + CW_SWAQ), 1u, __ATOMIC_RELAXED, __HIP_MEMORY_SCOPE_AGENT);
    __syncthreads();
    for (;;) {
        const int u = (int)qslot[0];
        __syncthreads();
        if (u >= 512) break;
        unsigned nt = 0u;
        if (F.tid == 0) nt = __hip_atomic_fetch_add((unsigned*)(F.ctl + CW_SWAQ), 1u, __ATOMIC_RELAXED, __HIP_MEMORY_SCOPE_AGENT);
        const int kh = u & 3, qb = (u >> 2) & 15, b = u >> 6;
        const size_t tokbase = (size_t)b * SEQ;
        const int pos0 = qb * 128 - 128;
#pragma unroll
        for (int i = 0; i < 4; ++i) { const int id = F.tid + 512 * i, row = id >> 3, ch = id & 7, pos = pos0 + row;
            u32x4 kv = (u32x4){0u, 0u, 0u, 0u}, vv = (u32x4){0u, 0u, 0u, 0u};
            if (pos >= 0) { const bf16_t* src = F.PROJ + (tokbase + pos) * LDP + C_KA + kh * 64 + ch * 8; kv = *(const u32x4*)src; vv = *(const u32x4*)(src + (C_VA - C_KA)); }
            *(LAS u32x4*)(Ks + row * 144 + ch * 16) = kv; *(LAS u32x4*)(Vs + row * 144 + ch * 16) = vv; }
        if (F.tid == 0) qslot[0] = nt;
        __syncthreads();
        const int head = kh * 8 + w;
        const float slope2 = __builtin_amdgcn_exp2f(-0.25f * (float)(head + 1)) * LOG2E;
        const float sink2 = F.sinks[head] * LOG2E;
        for (int qt = 0; qt < 4; ++qt) {
            const size_t qrow = tokbase + qb * 128 + qt * 32 + c31;
            bf16x8 bq[4];
#pragma unroll
            for (int ks = 0; ks < 4; ++ks) bq[ks] = *(const bf16x8*)(F.PROJ + qrow * LDP + C_QA + head * 64 + ks * 16 + h * 8);
            f32x16 S[5];
#pragma unroll
            for (int kt = 0; kt < 5; ++kt) { f32x16 acc;
#pragma unroll
                for (int i = 0; i < 16; ++i) acc[i] = 0.f;
#pragma unroll
                for (int ks = 0; ks < 4; ++ks) { const bf16x8 a = *(const LAS bf16x8*)(Ks + (32 * (qt + kt) + c31) * 144 + (ks * 16 + h * 8) * 2); acc = MFMA32(a, bq[ks], acc); }
                S[kt] = acc; }
            float mx = sink2;
            const float lbase = -slope2 * (float)(c31 - 4 * h);
#pragma unroll
            for (int kt = 0; kt < 5; ++kt) { const bool tile_ok = (qb > 0) || (qt + kt >= 4);
#pragma unroll
                for (int i = 0; i < 16; ++i) { const int ci = 128 - 32 * kt - (i & 3) - 8 * (i >> 2), cr = (i & 3) + 8 * (i >> 2) + 4 * h;
                    float sc_ = __builtin_fmaf(S[kt][i], 0.125f * LOG2E, __builtin_fmaf(-slope2, (float)ci, lbase));
                    bool valid = tile_ok;
                    if (kt == 0) valid = valid && (cr > c31);
                    if (kt == 4) valid = valid && (cr <= c31);
                    sc_ = valid ? sc_ : -INFINITY;
                    S[kt][i] = sc_; mx = fmaxf(mx, sc_); } }
            mx = fmaxf(mx, __shfl_xor(mx, 32));
            float sum = 0.f;
#pragma unroll
            for (int kt = 0; kt < 5; ++kt)
#pragma unroll
                for (int i = 0; i < 16; ++i) { const float p = __builtin_amdgcn_exp2f(S[kt][i] - mx); S[kt][i] = p; sum += p; }
            sum += __shfl_xor(sum, 32); sum += __builtin_amdgcn_exp2f(sink2 - mx);
            const float inv = 1.0f / sum;
            f32x16 O[2];
#pragma unroll
            for (int dt = 0; dt < 2; ++dt)
#pragma unroll
                for (int i = 0; i < 16; ++i) O[dt][i] = 0.f;
#pragma unroll
            for (int kt = 0; kt < 5; ++kt)
#pragma unroll
                for (int s = 0; s < 2; ++s) { const bf16x8 bp = pack8(S[kt], s);
                    const int kb = 32 * (qt + kt) + 16 * s + 4 * h + q4;
#pragma unroll
                    for (int dt = 0; dt < 2; ++dt) { const LAS unsigned char* vp = Vs + kb * 144 + (32 * dt + 16 * blk + 4 * p4) * 2;
                        const s16x4 lo = tr_read(vp), hi = tr_read(vp + 8 * 144);
                        const bf16x8 a = __builtin_shufflevector(lo, hi, 0, 1, 2, 3, 4, 5, 6, 7);
                        O[dt] = MFMA32(a, bp, O[dt]); } }
            bf16_t* orow = F.OA + qrow * DM + head * 64 + 4 * h;
#pragma unroll
            for (int dt = 0; dt < 2; ++dt)
#pragma unroll
                for (int g4 = 0; g4 < 4; ++g4) { u32x2 wv; wv.x = pk_bf16(O[dt][4 * g4] * inv, O[dt][4 * g4 + 1] * inv); wv.y = pk_bf16(O[dt][4 * g4 + 2] * inv, O[dt][4 * g4 + 3] * inv);
                    *(u32x2*)(orow + 32 * dt + 8 * g4) = wv; }
        }
        __syncthreads();
    }
}

DI void gla_prep_phase(Frame& F) {
    LAS unsigned char* Qs = F.lds;
    LAS unsigned char* Kss = F.lds + 33792;
    LAS float* alr = (LAS float*)(F.lds + 67584);
    LAS float* tot = (LAS float*)(F.lds + 71680);
    LAS unsigned char* Vr = F.lds;
    const int tid = F.tid, lane = F.lane, w = F.wave, c31 = lane & 31, h = lane >> 5;
    const int d = tid & 255, hf = tid >> 8;
    u32x4 rq[4], rk[4], ralr, vreg[8];
#define PREP_LOAD_QK(uu) do { const int hh_ = ((uu) >> 5) & 3, b_ = (uu) >> 7, c_ = (uu) & 31; const size_t T_ = (size_t)b_ * SEQ + c_ * 64; \
        _Pragma("unroll") for (int j = 0; j < 4; ++j) { const int id = tid + 512 * j, row = id >> 5, ch = id & 31; const bf16_t* src = F.PROJ + (T_ + row) * LDP + C_QB + hh_ * 256 + ch * 8; rq[j] = *(const u32x4*)src; rk[j] = *(const u32x4*)(src + (C_KB - C_QB)); } \
        ralr = *(const u32x4*)(F.PROJ + (T_ + ((tid & 127) >> 1)) * LDP + C_ALR + 8 * (tid & 1)); } while (0)
#define PREP_LOAD_V(uu) do { const int hh_ = ((uu) >> 5) & 3, b_ = (uu) >> 7, c_ = (uu) & 31; const size_t T_ = (size_t)b_ * SEQ + c_ * 64; \
        _Pragma("unroll") for (int j = 0; j < 8; ++j) { const int id = tid + 512 * j, row = id >> 6, ch = id & 63; vreg[j] = *(const u32x4*)(F.PROJ + (T_ + row) * LDP + C_VB + hh_ * 512 + ch * 8); } } while (0)
    int hh_w = -1; float w2[16]; float ba = 0.f;
    if (F.vcu < 1024) { PREP_LOAD_QK(F.vcu); PREP_LOAD_V(F.vcu); }
    for (int u = F.vcu; u < 1024; u += F.G) {
        const int hh = (u >> 5) & 3;
        const int un = (u + F.G < 1024) ? u + F.G : u;
#pragma unroll
        for (int j = 0; j < 4; ++j) { const int id = tid + 512 * j, row = id >> 5, ch = id & 31; *(LAS u32x4*)(Qs + row * 528 + ch * 16) = rq[j]; *(LAS u32x4*)(Kss + row * 528 + ch * 16) = rk[j]; }
        if (tid < 128) { const int t = tid >> 1, hq = tid & 1; LAS float* dd = alr + t * 16 + 8 * hq;
            dd[0] = bf_lo(ralr.x); dd[1] = bf_hi(ralr.x); dd[2] = bf_lo(ralr.y); dd[3] = bf_hi(ralr.y); dd[4] = bf_lo(ralr.z); dd[5] = bf_hi(ralr.z); dd[6] = bf_lo(ralr.w); dd[7] = bf_hi(ralr.w); }
        if (hh != hh_w) { hh_w = hh;
#pragma unroll
            for (int r = 0; r < 16; ++r) w2[r] = F.w_alpha2[r * 1024 + hh * 256 + d];
            ba = F.b_alpha[hh * 256 + d]; }
        __syncthreads();
        PREP_LOAD_QK(un);
        float bc[32]; float run = 0.f;
#pragma unroll
        for (int i = 0; i < 32; ++i) { const LAS f32x4* ar = (const LAS f32x4*)(alr + (32 * hf + i) * 16); float z = ba;
#pragma unroll
            for (int r4 = 0; r4 < 4; ++r4) { const f32x4 a = ar[r4]; z += a.x * w2[4 * r4] + a.y * w2[4 * r4 + 1] + a.z * w2[4 * r4 + 2] + a.w * w2[4 * r4 + 3]; }
            const float la = (fminf(z, 0.f) - __logf(1.0f + fast_exp(-fabsf(z)))) * (1.0f / 16.0f);
            run += la; bc[i] = run; }
        tot[hf * 256 + d] = run;
        __syncthreads();
        const float t0 = tot[d], t1 = tot[256 + d], blast = t0 + t1;
        if (hf) {
#pragma unroll
            for (int i = 0; i < 32; ++i) bc[i] += t0;
        } else F.GDEC[(size_t)u * 256 + d] = fast_exp(blast);
        unsigned kpk[16];
#pragma unroll
        for (int i2 = 0; i2 < 16; ++i2) { float kh2[2];
#pragma unroll
            for (int j = 0; j < 2; ++j) { const int i = 2 * i2 + j; LAS bf16_t* qp = (LAS bf16_t*)(Qs + (32 * hf + i) * 528 + d * 2); LAS bf16_t* kp = (LAS bf16_t*)(Kss + (32 * hf + i) * 528 + d * 2);
                const float q = bf2f(*qp), k = bf2f(*kp);
                const float e = fast_exp(bc[i]);
                *qp = f2bf(q * e * 0.0625f);
                *kp = f2bf(k * fast_exp(-bc[i]));
                kh2[j] = k * fast_exp(blast - bc[i]); }
            kpk[i2] = pk_bf16(kh2[0], kh2[1]); }
        { u32x4* dst = (u32x4*)(F.GKT + (size_t)u * 16384 + d * 64 + 32 * hf);
#pragma unroll
            for (int j = 0; j < 4; ++j) dst[j] = (u32x4){kpk[4 * j], kpk[4 * j + 1], kpk[4 * j + 2], kpk[4 * j + 3]}; }
        __syncthreads();
        if (w < 4) { const int m = w >> 1, n = w & 1; f32x16 acc;
#pragma unroll
            for (int i = 0; i < 16; ++i) acc[i] = 0.f;
#pragma unroll
            for (int ks = 0; ks < 16; ++ks) { const bf16x8 a = *(const LAS bf16x8*)(Qs + (32 * m + c31) * 528 + (16 * ks + 8 * h) * 2), bb = *(const LAS bf16x8*)(Kss + (32 * n + c31) * 528 + (16 * ks + 8 * h) * 2);
                acc = MFMA32(a, bb, acc); }
            bf16_t* ao = F.GATT + (size_t)u * 4096;
#pragma unroll
            for (int i = 0; i < 16; ++i) { const int t = 32 * m + crow(i, h), s = 32 * n + c31; ao[t * 64 + s] = f2bf(s <= t ? acc[i] : 0.f); }
        } else { const int t2 = tid - 256;
#pragma unroll
            for (int j = 0; j < 8; ++j) { const int id = t2 + 256 * j, row = id >> 5, ch = id & 31; *(u32x4*)(F.GQT + (size_t)u * 16384 + row * 256 + ch * 8) = *(const LAS u32x4*)(Qs + row * 528 + ch * 16); } }
        __syncthreads();
#pragma unroll
        for (int j = 0; j < 8; ++j) { const int id = tid + 512 * j, row = id >> 6, ch = id & 63; *(LAS u32x4*)(Vr + row * 1040 + ch * 16) = vreg[j]; }
        __syncthreads();
        PREP_LOAD_V(un);
        { u32x4* dst = (u32x4*)(F.GVT + (size_t)u * 32768 + tid * 64);
#pragma unroll
            for (int t8 = 0; t8 < 8; ++t8) { unsigned short v[8];
#pragma unroll
                for (int j = 0; j < 8; ++j) v[j] = *(const LAS bf16_t*)(Vr + (8 * t8 + j) * 1040 + tid * 2);
                dst[t8] = (u32x4){(unsigned)v[0] | ((unsigned)v[1] << 16), (unsigned)v[2] | ((unsigned)v[3] << 16), (unsigned)v[4] | ((unsigned)v[5] << 16), (unsigned)v[6] | ((unsigned)v[7] << 16)}; } }
        __syncthreads();
    }
#undef PREP_LOAD_QK
#undef PREP_LOAD_V
}

DI void gla_scan_phase(Frame& F) {
    LAS unsigned char* L = F.lds;
    const int lane = F.lane, w = F.wave, c31 = lane & 31, h = lane >> 5;
    const int u = F.vcu >> 2, hf = u & 1, hh = (u >> 1) & 3, b = u >> 3;
    f32x16 S[8];
#pragma unroll
    for (int i = 0; i < 8; ++i)
#pragma unroll
        for (int j = 0; j < 16; ++j) S[i][j] = 0.f;
    const size_t item0 = (size_t)(b * 4 + hh) * 32;
    const int vr0 = hf * 256 + 32 * w;
    unsigned tidv = (unsigned)F.tid;
    unsigned qrb = (unsigned)(c31 * 528 + 8 * h), krb = (unsigned)(c31 * 144 + 16 * h);
    u32x4 rq[4], rk[4], ra; f32x4 rd; u32x4 bvn[4];
#define BV(ks) (*(const LAS bf16x8*)(L + 80896 + w * 4608 + krb + 32 * (ks)))
#define SCAN_LOAD_A(item) do { const char* q0 = (const char*)(F.GQT + (item) * 16384); const char* k0 = (const char*)(F.GKT + (item) * 16384); asm volatile("" : "+v"(tidv)); const unsigned tb = tidv * 16u; \
        _Pragma("unroll") for (int j = 0; j < 4; ++j) { rq[j] = *(const u32x4*)(q0 + j * 8192 + tb); rk[j] = *(const u32x4*)(k0 + j * 8192 + tb); } } while (0)
#define SCAN_LOAD_B(item) do { const char* v0 = (const char*)(F.GVT + (item) * 32768 + (size_t)vr0 * 64); asm volatile("" : "+v"(tidv)); const unsigned tb = tidv * 16u, db = (tidv & 63u) * 16u, vb = (tidv & 31u) * 128u + ((tidv >> 5) & 1u) * 16u; \
        ra = *(const u32x4*)((const char*)(F.GATT + (item) * 4096) + tb); \
        rd = *(const f32x4*)((const char*)(F.GDEC + (item) * 256) + db); \
        _Pragma("unroll") for (int ks = 0; ks < 4; ++ks) bvn[ks] = *(const u32x4*)(v0 + 32 * ks + vb); } while (0)
#define SCAN_WRITE() do { asm volatile("" : "+v"(tidv)); const unsigned qwo = (tidv >> 5) * 528u + (tidv & 31u) * 16u, kwo = (tidv >> 3) * 144u + (tidv & 7u) * 16u; \
        _Pragma("unroll") for (int j = 0; j < 4; ++j) { *(LAS u32x4*)(L + qwo + j * 16 * 528) = rq[j]; *(LAS u32x4*)(L + 33792 + kwo + j * 64 * 144) = rk[j]; } \
        *(LAS u32x4*)(L + 70656 + kwo) = ra; \
        if (tidv < 64u) *(LAS f32x4*)(L + 79872 + tidv * 16u) = rd; \
        _Pragma("unroll") for (int ks = 0; ks < 4; ++ks) *(LAS u32x4*)(L + 80896 + w * 4608 + krb + 32 * ks) = bvn[ks]; } while (0)
    SCAN_LOAD_A(item0); SCAN_LOAD_B(item0);
    SCAN_WRITE();
    __syncthreads();
    for (int c = 0; c < 32; ++c) {
        const size_t nitem = item0 + (c < 31 ? c + 1 : c);
        SCAN_LOAD_A(nitem);
        asm volatile("" : "+v"(qrb), "+v"(krb));
#pragma unroll 1
        for (int m = 0; m < 2; ++m) { f32x16 o;
#pragma unroll
            for (int j = 0; j < 16; ++j) o[j] = 0.f;
#pragma unroll
            for (int i = 0; i < 8; ++i)
#pragma unroll
                for (int s = 0; s < 2; ++s) { const bf16x8 bs = pack8_pinned(S[i], s);
                    const LAS unsigned char* ap = L + qrb + (32 * m) * 528 + (32 * i + 16 * s) * 2;
                    const s16x4 lo = *(const LAS s16x4*)ap, hi = *(const LAS s16x4*)(ap + 16);
                    const bf16x8 a = __builtin_shufflevector(lo, hi, 0, 1, 2, 3, 4, 5, 6, 7);
                    o = MFMA32(a, bs, o); }
#pragma unroll
            for (int ks = 0; ks < 4; ++ks) { const bf16x8 a = *(const LAS bf16x8*)(L + 70656 + krb + (32 * m) * 144 + 32 * ks); o = MFMA32(a, BV(ks), o); }
            { asm volatile("" : "+v"(tidv)); const unsigned ovb = ((tidv >> 5) & 1u) * (4u * DM * 2u) + (tidv & 31u) * 2u;
                char* ob = (char*)(F.OB + ((size_t)b * SEQ + c * 64 + 32 * m) * DM + hh * 512 + vr0);
#pragma unroll
                for (int j = 0; j < 16; ++j) *(bf16_t*)(ob + ((j & 3) + 8 * (j >> 2)) * (DM * 2) + ovb) = f2bf(o[j]); } }
        asm volatile("" ::: "memory");
        SCAN_LOAD_B(nitem);
#pragma unroll
        for (int i = 0; i < 8; ++i) {
#pragma unroll
            for (int g4 = 0; g4 < 4; ++g4) { const f32x4 dc = *(const LAS f32x4*)(L + 79872 + (32 * i + 8 * g4) * 4 + (((tidv >> 5) & 1u) * 16u));
                S[i][4 * g4] *= dc.x; S[i][4 * g4 + 1] *= dc.y; S[i][4 * g4 + 2] *= dc.z; S[i][4 * g4 + 3] *= dc.w; }
        }
#pragma unroll
        for (int ks = 0; ks < 4; ++ks) { const bf16x8 bvk = BV(ks);
#pragma unroll
            for (int i = 0; i < 8; ++i) { const bf16x8 a = *(const LAS bf16x8*)(L + 33792 + krb + (32 * i) * 144 + 32 * ks); S[i] = MFMA32(a, bvk, S[i]); } }
        __syncthreads();
        SCAN_WRITE();
        __syncthreads();
    }
#undef SCAN_LOAD_A
#undef SCAN_LOAD_B
#undef SCAN_WRITE
#undef BV
}

DI void merge_phase(Frame& F) {
    const int gw = F.vcu * NWAVES + F.wave, NGW = F.G * NWAVES, lane = F.lane;
    for (int m = gw; m < NTOK; m += NGW) {
        const bf16_t* pr = F.PROJ + (size_t)m * LDP;
        float rr[4][8]; float am = 0.f;
#pragma unroll
        for (int j = 0; j < 4; ++j) { const int c0 = j * 512 + lane * 8;
            const u32x4 ob = *(const u32x4*)(F.OB + (size_t)m * DM + c0), oa = *(const u32x4*)(F.OA + (size_t)m * DM + c0);
            const u32x4 rb = *(const u32x4*)(pr + C_RB + c0), ga = *(const u32x4*)(pr + C_GA + c0), gb = *(const u32x4*)(pr + C_GB + c0);
            const f32x4 g0 = *(const f32x4*)(F.gla_g + lane * 8), g1 = *(const f32x4*)(F.gla_g + lane * 8 + 4);
            float vb[8] = {bf_lo(ob.x), bf_hi(ob.x), bf_lo(ob.y), bf_hi(ob.y), bf_lo(ob.z), bf_hi(ob.z), bf_lo(ob.w), bf_hi(ob.w)};
            const float va[8] = {bf_lo(oa.x), bf_hi(oa.x), bf_lo(oa.y), bf_hi(oa.y), bf_lo(oa.z), bf_hi(oa.z), bf_lo(oa.w), bf_hi(oa.w)};
            const float vr[8] = {bf_lo(rb.x), bf_hi(rb.x), bf_lo(rb.y), bf_hi(rb.y), bf_lo(rb.z), bf_hi(rb.z), bf_lo(rb.w), bf_hi(rb.w)};
            const float vga[8] = {bf_lo(ga.x), bf_hi(ga.x), bf_lo(ga.y), bf_hi(ga.y), bf_lo(ga.z), bf_hi(ga.z), bf_lo(ga.w), bf_hi(ga.w)};
            const float vgb[8] = {bf_lo(gb.x), bf_hi(gb.x), bf_lo(gb.y), bf_hi(gb.y), bf_lo(gb.z), bf_hi(gb.z), bf_lo(gb.w), bf_hi(gb.w)};
            const float gn[8] = {g0.x, g0.y, g0.z, g0.w, g1.x, g1.y, g1.z, g1.w};
            float ss = 0.f;
#pragma unroll
            for (int k = 0; k < 8; ++k) ss += vb[k] * vb[k];
            const float rn = 1.0f / sqrtf(wave_sum(ss) * (1.f / 512.f) + EPS);
#pragma unroll
            for (int k = 0; k < 8; k += 2) {
                typedef float f2 __attribute__((ext_vector_type(2)));
                constexpr float NL = -1.4426950408889634f;
                const f2 obn = ((f2){vb[k], vb[k + 1]} * rn) * (f2){gn[k], gn[k + 1]}, r2 = (f2){vr[k], vr[k + 1]};
                const f2 tb = (f2){vgb[k], vgb[k + 1]} * NL, tr = r2 * NL, ta = (f2){vga[k], vga[k + 1]} * NL;
                const f2 eb = (f2){__builtin_amdgcn_exp2f(tb.x), __builtin_amdgcn_exp2f(tb.y)}, er = (f2){__builtin_amdgcn_exp2f(tr.x), __builtin_amdgcn_exp2f(tr.y)}, ea = (f2){__builtin_amdgcn_exp2f(ta.x), __builtin_amdgcn_exp2f(ta.y)};
                const f2 d2 = (eb + 1.0f) * (er + 1.0f), d1 = ea + 1.0f;
                const f2 s2 = (f2){fast_rcp(d2.x), fast_rcp(d2.y)}, s1 = (f2){fast_rcp(d1.x), fast_rcp(d1.y)};
                const f2 res = s1 * (f2){va[k], va[k + 1]} + s2 * (obn * r2);
                rr[j][k] = res.x; rr[j][k + 1] = res.y; am = fmaxf(am, fmaxf(fabsf(res.x), fabsf(res.y))); }
            if (!I8_P5) *(u32x4*)(F.MIX + (size_t)m * DM + c0) = (u32x4){pk_bf16(rr[j][0], rr[j][1]), pk_bf16(rr[j][2], rr[j][3]), pk_bf16(rr[j][4], rr[j][5]), pk_bf16(rr[j][6], rr[j][7])}; }
        if (I8_P5) { float sq = 0.f;
#pragma unroll
            for (int j = 0; j < 4; ++j)
#pragma unroll
                for (int k = 0; k < 8; ++k) sq += rr[j][k] * rr[j][k];
            am = fminf(wave_max(am), MIX_CLIP * sqrtf(wave_sum(sq) * (1.f / DM))); am = fmaxf(am, 1e-30f);
            const float inv = 127.f / am; if (lane == 0) F.sa_mix[m] = am * (1.f / 127.f);
#pragma unroll
            for (int j = 0; j < 4; ++j) { u32x2 wv; wv.x = pk4_i8(rr[j][0] * inv, rr[j][1] * inv, rr[j][2] * inv, rr[j][3] * inv); wv.y = pk4_i8(rr[j][4] * inv, rr[j][5] * inv, rr[j][6] * inv, rr[j][7] * inv);
                *(u32x2*)((unsigned char*)F.MIX + (size_t)m * DM + j * 512 + lane * 8) = wv; }
        }
    }
}

#ifndef MK_RT_PF
#define MK_RT_PF 8
#endif
constexpr int RT_PF = MK_RT_PF;
DI void router_phase(Frame& F) {
    LAS float* part = (LAS float*)F.lds;
    LAS float* ssp = (LAS float*)(F.lds + 34816);
    LAS float* rt = (LAS float*)(F.lds + 36864);
    LAS float* lg = (LAS float*)(F.lds + 37888);
    LAS unsigned* cntl = (LAS unsigned*)(F.lds + 42112);
    LAS unsigned* basel = (LAS unsigned*)(F.lds + 42240);
    const int tid = F.tid, lane = F.lane, w = F.wave, c31 = lane & 31, h = lane >> 5;
    for (int tile = F.vcu; tile < NTOK / 32; tile += F.G) {
        const int t0 = tile * 32, kw = 256 * w;
        if (tid < 32) cntl[tid] = 0u;
        {
            LAS unsigned char* const sl = F.lds + 43008 + w * 8704;
            const bf16_t* xg = F.X1 + (size_t)(t0 + (lane >> 4)) * DM + kw + 8 * (lane & 15);
            const bf16_t* bp = F.RTB + (((kw >> 3) + h) * 32 + c31) * 8;
            const unsigned swo = (unsigned)(lane >> 4) * 272u + 16u * (unsigned)(lane & 15), sro = (unsigned)c31 * 272u + 16u * (unsigned)h;
            f32x16 acc;
#pragma unroll
            for (int i = 0; i < 16; ++i) acc[i] = 0.f;
            float ss = 0.f;
            u32x4 xv[8];
#pragma unroll
            for (int j = 0; j < 8; ++j) xv[j] = *(const u32x4*)(xg + (size_t)(4 * j) * DM);
#pragma unroll 1
            for (int hf = 0; hf < 2; ++hf) {
#pragma unroll
                for (int j = 0; j < 8; ++j) *(LAS u32x4*)(sl + swo + j * (4 * 272)) = xv[j];
                if (hf == 0) {
#pragma unroll
                    for (int j = 0; j < 8; ++j) xv[j] = *(const u32x4*)(xg + (size_t)(4 * j) * DM + 128);
                }
#pragma unroll
                for (int ks = 0; ks < 8; ++ks) { const u32x4 au = *(const LAS u32x4*)(sl + sro + 32 * ks);
                    const bf16x8 a = __builtin_bit_cast(bf16x8, au), bh = *(const bf16x8*)(bp + (16 * hf + 2 * ks) * 256), bl = *(const bf16x8*)(bp + 32 * 2048 + (16 * hf + 2 * ks) * 256);
                    const float a0 = bf_lo(au.x), a1 = bf_hi(au.x), a2 = bf_lo(au.y), a3 = bf_hi(au.y), a4 = bf_lo(au.z), a5 = bf_hi(au.z), a6 = bf_lo(au.w), a7 = bf_hi(au.w);
                    ss += ((a0 * a0 + a1 * a1) + (a2 * a2 + a3 * a3)) + ((a4 * a4 + a5 * a5) + (a6 * a6 + a7 * a7));
                    acc = MFMA32(a, bh, acc); acc = MFMA32(a, bl, acc); }
            }
            ss += __shfl_xor(ss, 32);
#pragma unroll
            for (int i = 0; i < 16; ++i) part[(w * 32 + crow(i, h)) * 33 + c31] = acc[i];
            if (h == 0) ssp[w * 32 + c31] = ss; }
        __syncthreads();
        { const int tok = tid >> 4, e0 = tid & 15; float s0 = 0.f, s1 = 0.f, sst = 0.f;
#pragma unroll
            for (int w2 = 0; w2 < 8; ++w2) { s0 += part[(w2 * 32 + tok) * 33 + e0]; s1 += part[(w2 * 32 + tok) * 33 + e0 + 16]; sst += ssp[w2 * 32 + tok]; }
            const float r = 1.0f / sqrtf(sst * (1.f / DM) + EPS);
            lg[tok * 33 + e0] = s0 * r + F.b_router[e0]; lg[tok * 33 + e0 + 16] = s1 * r + F.b_router[e0 + 16]; if (e0 == 0) rt[tok] = r; }
        __syncthreads();
        int sel_ex[2], sel_loc[2]; float sel_g[2];
#pragma unroll
        for (int it = 0; it < 2; ++it) { const int tok = 4 * w + 2 * it + h;
            float v = lg[tok * 33 + c31]; float tv[4]; int ti[4];
#pragma unroll
            for (int k = 0; k < 4; ++k) { float bv = v; int bi = c31;
#pragma unroll
                for (int o = 1; o < 32; o <<= 1) { const float ov = __shfl_xor(bv, o); const int oi = __shfl_xor(bi, o); const bool take = (ov > bv) || (ov == bv && oi < bi); bv = take ? ov : bv; bi = take ? oi : bi; }
                tv[k] = bv; ti[k] = bi; v = (c31 == bi) ? -INFINITY : v; }
            const float e1 = fast_exp(tv[1] - tv[0]), e2 = fast_exp(tv[2] - tv[0]), e3 = fast_exp(tv[3] - tv[0]); const float inv = 1.0f / (1.0f + e1 + e2 + e3);
            sel_ex[it] = c31 == 0 ? ti[0] : c31 == 1 ? ti[1] : c31 == 2 ? ti[2] : ti[3]; sel_g[it] = (c31 == 0 ? 1.0f : c31 == 1 ? e1 : c31 == 2 ? e2 : e3) * inv; sel_loc[it] = 0;
            if (c31 < 4) sel_loc[it] = (int)__hip_atomic_fetch_add((LAS unsigned*)&cntl[sel_ex[it]], 1u, __ATOMIC_RELAXED, __HIP_MEMORY_SCOPE_WORKGROUP); }
        __syncthreads();
        if (tid < 32) { const unsigned c = cntl[tid]; basel[tid] = c ? __hip_atomic_fetch_add((unsigned*)(F.ctl + CW_CNT + 64 * tid), c, __ATOMIC_RELAXED, __HIP_MEMORY_SCOPE_AGENT) : 0u; }
#pragma unroll
        for (int q = 0; q < 4; ++q) { const int tok = 4 * w + q; const size_t m = (size_t)(t0 + tok); const float r = rt[tok];
            const float r8 = 8.0f * r;
#pragma unroll
            for (int j = 0; j < 4; ++j) { const int c0 = 8 * (lane + 64 * j); const u32x4 xb = *(const u32x4*)(F.X1 + m * DM + c0); const f32x4 g0 = *(const f32x4*)(F.ffn_g + c0), g1 = *(const f32x4*)(F.ffn_g + c0 + 4);
                u32x2 wv; wv.x = pk4_fp8(clamp_fp8(bf_lo(xb.x) * r8 * g0.x), clamp_fp8(bf_hi(xb.x) * r8 * g0.y), clamp_fp8(bf_lo(xb.y) * r8 * g0.z), clamp_fp8(bf_hi(xb.y) * r8 * g0.w));
                wv.y = pk4_fp8(clamp_fp8(bf_lo(xb.z) * r8 * g1.x), clamp_fp8(bf_hi(xb.z) * r8 * g1.y), clamp_fp8(bf_lo(xb.w) * r8 * g1.z), clamp_fp8(bf_hi(xb.w) * r8 * g1.w));
                *(u32x2*)((unsigned char*)F.H + m * DM + c0) = wv; } }
        __syncthreads();
#pragma unroll
        for (int it = 0; it < 2; ++it) if (c31 < 4) { const int m = t0 + 4 * w + 2 * it + h, ex = sel_ex[it]; const unsigned slot = basel[ex] + (unsigned)sel_loc[it];
            F.tokl[(size_t)ex * NTOK + slot] = m; F.tope[m * 4 + c31] = ex; F.tops[m * 4 + c31] = (int)slot; F.gate[m * 4 + c31] = sel_g[it]; }
        __syncthreads();
    }
}

DI void moe_tables(Frame& F) {
    LAS int* tb = (LAS int*)(F.lds + TBL_OFF);
    if (F.tid < 64) { const int e = F.tid & 31;
        const int c = (int)__hip_atomic_load((unsigned*)(F.ctl + CW_CNT + 64 * e), __ATOMIC_RELAXED, __HIP_MEMORY_SCOPE_AGENT);
        int inc = (c + 255) >> 8;
#pragma unroll
        for (int o = 1; o < 32; o <<= 1) { const int t = __shfl_up(inc, o); if ((int)F.tid >= o) inc += t; }
        if (F.tid < 32) { tb[e] = inc - ((c + 255) >> 8); tb[40 + e] = c; if (e == 31) tb[32] = inc; } }
    __syncthreads();
    for (int blk = F.tid; blk < tb[32]; blk += NWAVES * 64) { int e = 0; for (int j = 1; j < NEXP; ++j) e += (tb[j] <= blk) ? 1 : 0; tb[80 + blk] = e; }
    __syncthreads();
}
struct MoeProb {
    const bf16_t* A; const bf16_t* Bt; const int* tokl; const LAS int* tb; int K, NT  , brows  , G, c; bool gather;
    DI bool next_linear(int L, pg8::Unit& u) const {
        const int blk = L / NT, pn = L % NT; const int e = tb[80 + blk];
        const int rb = blk - tb[e]; int nr = tb[40 + e] - rb * 256; nr = nr > 256 ? 256 : nr;
        u.pm = blk; u.pn = pn; u.e = e; u.rb = rb; u.nrow = nr; return true;
    }
    DI bool next(int i, pg8::Unit& u) const {
        const int nb = tb[32]; const int x = c & 7, j = c >> 3, T = i * 8 + x;
        const int srb = (NT == 16) ? SUPER_RB16 : 4, spn = 32 / srb, nsp = NT / spn;
        const int blk = srb * (T / nsp) + (j % srb), pn = spn * (T % nsp) + (j / srb);
        if (G != 256 || blk >= nb) { if (G == 256) return false; const int L = i * G + c; if (L >= nb * NT) return false; return next_linear(L, u); }
        const int e = tb[80 + blk];
        const int rb = blk - tb[e]; int nr = tb[40 + e] - rb * 256; nr = nr > 256 ? 256 : nr;
        u.pm = blk; u.pn = pn; u.e = e; u.rb = rb; u.nrow = nr; return true;
    }
    DI const char* a_base(const pg8::Unit& u) const { return gather ? (const char*)A : (const char*)A + (size_t)u.pm * 256 * K * 2; }
    DI const char* b_base(const pg8::Unit& u) const { return (const char*)Bt + ((size_t)u.e * brows + (size_t)u.pn * 256) * K * 2; }
    DI void a_rows(const pg8::Unit& u, const int (&R)[2], unsigned (&v)[2][2]) const {
#pragma unroll
        for (int h = 0; h < 2; ++h)
#pragma unroll
            for (int i = 0; i < 2; ++i) { const int r = h * 128 + R[i];
                if (gather) { const int rc = r < u.nrow ? r : u.nrow - 1; v[h][i] = (unsigned)tokl[(size_t)u.e * NTOK + u.rb * 256 + rc]; }
                else v[h][i] = (unsigned)r; }
    }
};

DI void final_phase(Frame& F) {
    const LAS int* tb = (const LAS int*)(F.lds + TBL_OFF);
    const int gw = F.vcu * NWAVES + F.wave, NGW = F.G * NWAVES, lane = F.lane;
    int ne[4], ns[4]; float ng[4];
#pragma unroll
    for (int k = 0; k < 4; ++k) { ne[k] = 0; ns[k] = 0; ng[k] = 0.f; if (gw < NTOK) { ne[k] = F.tope[gw * 4 + k]; ns[k] = F.tops[gw * 4 + k]; ng[k] = F.gate[gw * 4 + k]; } }
    for (int m = gw; m < NTOK; m += NGW) {
        const unsigned char* yr[4]; float gt[4];
#pragma unroll
        for (int k = 0; k < 4; ++k) { gt[k] = ng[k] * (1.0f / pg8::Y_SCALE); yr[k] = (const unsigned char*)F.Y + ((size_t)tb[ne[k]] * 256 + ns[k]) * DM; }
        { const int mn = m + NGW;
            if (mn < NTOK) {
#pragma unroll
                for (int k = 0; k < 4; ++k) { ne[k] = F.tope[mn * 4 + k]; ns[k] = F.tops[mn * 4 + k]; ng[k] = F.gate[mn * 4 + k]; } } }
        float v[4][8]; float ss = 0.f;
#pragma unroll
        for (int j = 0; j < 4; ++j) { const int c0 = 8 * (lane + 64 * j);
            const u32x4 xb = *(const u32x4*)(F.X1 + (size_t)m * DM + c0);
            float a[8] = {bf_lo(xb.x), bf_hi(xb.x), bf_lo(xb.y), bf_hi(xb.y), bf_lo(xb.z), bf_hi(xb.z), bf_lo(xb.w), bf_hi(xb.w)};
#pragma unroll
            for (int k = 0; k < 4; ++k) { const u32x2 y = *(const u32x2*)(yr[k] + c0);
                const f32x2_t y0 = __builtin_amdgcn_cvt_pk_f32_fp8((int)y.x, false), y1 = __builtin_amdgcn_cvt_pk_f32_fp8((int)y.x, true), y2 = __builtin_amdgcn_cvt_pk_f32_fp8((int)y.y, false), y3 = __builtin_amdgcn_cvt_pk_f32_fp8((int)y.y, true);
                a[0] += gt[k] * y0.x; a[1] += gt[k] * y0.y; a[2] += gt[k] * y1.x; a[3] += gt[k] * y1.y; a[4] += gt[k] * y2.x; a[5] += gt[k] * y2.y; a[6] += gt[k] * y3.x; a[7] += gt[k] * y3.y; }
#pragma unroll
            for (int q = 0; q < 8; ++q) { v[j][q] = a[q]; ss += a[q] * a[q]; } }
        const float r = 1.0f / sqrtf(wave_sum(ss) * (1.f / DM) + EPS);
#pragma unroll
        for (int j = 0; j < 4; ++j) { const int c0 = 8 * (lane + 64 * j);
            const f32x4 g0 = *(const f32x4*)(F.final_g + c0), g1 = *(const f32x4*)(F.final_g + c0 + 4);
            *(f32x4*)(F.out + (size_t)m * DM + c0) = (f32x4){v[j][0] * r * g0.x, v[j][1] * r * g0.y, v[j][2] * r * g0.z, v[j][3] * r * g0.w};
            *(f32x4*)(F.out + (size_t)m * DM + c0 + 4) = (f32x4){v[j][4] * r * g1.x, v[j][5] * r * g1.y, v[j][6] * r * g1.z, v[j][7] * r * g1.w}; }
    }
}
#ifndef MK_N_LAUNCHES
#define MK_N_LAUNCHES 1
#endif
constexpr int N_PHASES = 11;
struct Args { const float* in[16]; float* out; unsigned char* ws; int ph_lo, ph_hi; };
static_assert(sizeof(Args) == 16 * 8 + 8 + 8 + 8, "Args has no padding");

__global__ void __launch_bounds__(NWAVES * 64, 2) fwd_kernel(Args args) {
    extern __shared__ __attribute__((aligned(16))) unsigned char lds_raw[];
    Frame F;
    F.lds = (LAS unsigned char*)lds_raw;
    F.tid = threadIdx.x; F.lane = F.tid & 63; F.wave = __builtin_amdgcn_readfirstlane(F.tid >> 6);
    F.G = gridDim.x; { const int bx = blockIdx.x; F.vcu = (F.G % 8 == 0) ? (bx % 8) * (F.G / 8) + bx / 8 : bx; }
    unsigned char* ws = args.ws;
    F.ctl = (gu32*)(ws + WS_CTL);
    F.x = args.in[0]; F.attn_g = args.in[1]; F.w_in = args.in[2]; F.sinks = args.in[3]; F.w_alpha2 = args.in[4]; F.b_alpha = args.in[5]; F.gla_g = args.in[6]; F.w_out = args.in[7];
    F.ffn_g = args.in[8]; F.w_router = args.in[9]; F.b_router = args.in[10]; F.w_gu = args.in[11]; F.b_gu = args.in[12]; F.w_dn = args.in[13]; F.b_dn = args.in[14]; F.final_g = args.in[15];
    F.out = args.out;
    F.tope = (int*)(ws + WS_TOPE); F.tops = (int*)(ws + WS_TOPS); F.gate = (float*)(ws + WS_GATE); F.tokl = (int*)(ws + WS_TOKL);
    F.Win = (bf16_t*)(ws + WS_WIN); F.Wout = (bf16_t*)(ws + WS_WOUT); F.Wgu = (bf16_t*)(ws + WS_WGU); F.Wdn = (bf16_t*)(ws + WS_WDN);
    F.sa_h = (float*)(ws + WS_SAH); F.sa_mix = (float*)(ws + WS_SAMIX);
    F.H = (bf16_t*)(ws + WS_H); F.PROJ = (bf16_t*)(ws + WS_PROJ); F.OA = (bf16_t*)(ws + WS_OA); F.OB = (bf16_t*)(ws + WS_OB); F.MIX = (bf16_t*)(ws + WS_MIX);
    F.X1 = (bf16_t*)(ws + WS_X1); F.GQT = (bf16_t*)(ws + WS_GQT); F.GKT = (bf16_t*)(ws + WS_GKT); F.GATT = (bf16_t*)(ws + WS_GATT); F.GDEC = (float*)(ws + WS_GDEC); F.GVT = (bf16_t*)(ws + WS_GVT);
    F.ACT = (bf16_t*)(ws + WS_ACT); F.Y = (bf16_t*)(ws + WS_Y); F.RTB = (bf16_t*)(ws + WS_RTB);
    for (int u = F.tid; u < (LDS_BYTES - LDSCTL_OFF) / 4; u += NWAVES * 64) ((LAS unsigned*)(F.lds + LDSCTL_OFF))[u] = 0u;
    __syncthreads();
    const int lo = args.ph_lo, hi = args.ph_hi;
    const bool use_bar = (hi - lo) > 1;
    XcdBarrier bar; bar.bar = (unsigned*)(F.ctl + CW_BAR); bar.x = 0; bar.st = nullptr;
    if (use_bar) bar = xcd_barrier_post((unsigned*)(F.ctl + CW_BAR), (volatile LAS unsigned*)(F.lds + MISC_OFF) + 8);
#define IN(k) (lo <= (k) && (k) < hi)
#define SEAM(k) do { if (IN(k) && IN((k) + 1)) xcd_barrier(bar); } while (0)

    if (IN(0)) { colmax_phase(F); }
    SEAM(0);
    if (IN(1)) { p0_prologue(F); }
    SEAM(1);
    if (IN(2)) {
        pg8::DenseProb P; P.A = F.H; P.Bt = F.Win; P.K = I8_P1 ? DM / 2 : DM; P.S.init(NTOK, LDP, F.G, (int)blockIdx.x);
        pg8::EpiBf16Plain<I8_P1> E{F.PROJ, LDP, F.sa_h, (const float*)(F.ctl + CW_CMAX_IN)};
        const int grp = (int)(blockIdx.x & 3), split = grp == 0 ? 0 : grp == 1 ? 4 : grp == 2 ? 9 : 13;
        P.i0 = 0; P.i1 = split; pg8::gemm_phase<I8_P1 ? GM_I8 : GM_BF16>(F.lds + RING_OFF, P, E);
        embed_copy_range(F, 0, EMB_PER_WAVE - EMB_P5 - (grp >= 2 ? EMB_MV : 0));
        if (grp == 0 && F.G == 256) { embed_copy_range(F, EMB_PER_WAVE - EMB_P5 - EMB_MV, EMB_PER_WAVE - EMB_P5, 512); embed_copy_range(F, EMB_PER_WAVE - EMB_P5 - EMB_MV, EMB_PER_WAVE - EMB_P5, 768); }
        if (grp >= 2 && F.G != 256) embed_copy_range(F, EMB_PER_WAVE - EMB_P5 - EMB_MV, EMB_PER_WAVE - EMB_P5);
        P.i0 = split; P.i1 = 1 << 30; pg8::gemm_phase<I8_P1 ? GM_I8 : GM_BF16>(F.lds + RING_OFF, P, E);
    }
    SEAM(2);
    if (IN(3)) { gla_prep_phase(F); }
    SEAM(3);
    if (IN(4)) { if ((F.vcu & 3) == 0 && F.vcu < 256) gla_scan_phase(F); else if ((blockIdx.x >> 3) & 1) late_copy_phase(F, 4); swa_phase(F); late_copy_phase(F); }
    SEAM(4);
    if (IN(5)) { merge_phase(F); }
    SEAM(5);
    if (IN(6)) {
        pg8::DenseProb P; P.A = F.MIX; P.Bt = F.Wout; P.K = I8_P5 ? DM / 2 : DM; P.S.init(NTOK, DM, F.G, (int)blockIdx.x);
        pg8::EpiResF32<I8_P5> E{F.x, F.X1, DM, F.sa_mix, (const float*)(F.ctl + CW_CMAX_OUT)};
        const bool late = (blockIdx.x & 1) != 0;
        if (EMB_P5 > 0 && !late) embed_copy_range(F, EMB_PER_WAVE - EMB_P5, EMB_PER_WAVE);
        pg8::gemm_phase<I8_P5 ? GM_I8 : GM_BF16>(F.lds + RING_OFF, P, E);
        if (EMB_P5 > 0 && late) embed_copy_range(F, EMB_PER_WAVE - EMB_P5, EMB_PER_WAVE);
    }
    SEAM(6);
    if (IN(7)) { router_phase(F); }
    SEAM(7);
    if (IN(8)) {
        moe_tables(F);
        MoeProb P; P.A = F.H; P.Bt = F.Wgu; P.tokl = F.tokl; P.tb = (const LAS int*)(F.lds + TBL_OFF); P.K = DM / 2; P.NT = 16; P.brows = 4096; P.G = F.G; P.c = (int)blockIdx.x; P.gather = true;
        pg8::EpiGlu E{(unsigned char*)F.ACT, DFF, F.b_gu};
        pg8::gemm_phase<GM_FP8>(F.lds + RING_OFF, P, E);
    }
    SEAM(8);
    if (IN(9)) {
        if (!IN(8)) moe_tables(F);
        if (STAGGER_US > 0 && (F.vcu & 1)) { const unsigned long long t0 = __builtin_amdgcn_s_memrealtime(); while (__builtin_amdgcn_s_memrealtime() - t0 < (unsigned long long)(STAGGER_US * 100)) __builtin_amdgcn_s_sleep(8); }
        MoeProb P; P.A = F.ACT; P.Bt = F.Wdn; P.tokl = F.tokl; P.tb = (const LAS int*)(F.lds + TBL_OFF); P.K = DFF / 2; P.NT = 8; P.brows = 2048; P.G = F.G; P.c = (int)blockIdx.x; P.gather = false;
        pg8::EpiF8BiasE E{(unsigned char*)F.Y, DM, F.b_dn};
        pg8::gemm_phase<GM_FP8>(F.lds + RING_OFF, P, E);
    }
    SEAM(9);
    if (IN(10)) { if (!IN(8)) moe_tables(F); final_phase(F);
    }
#undef IN
#undef SEAM
}

extern "C" void kernel_launch(void* const* d_in, const int* in_sizes, int n_in, void* d_out, int out_size, void* d_ws, size_t ws_size, hipStream_t stream) {
    static int grid = 0;
    if (grid == 0) {
        if (n_in != 16 || out_size != NTOK * DM || ws_size < WS_END) { fprintf(stderr, "kernel_launch: unexpected shapes (n_in %d, out %d, ws %zu, need %zu); nothing launched\n", n_in, out_size, ws_size, (size_t)WS_END); grid = -1; return; }
        int dev = 0, cus = 0, per_cu = 0;
        if (hipGetDevice(&dev) != hipSuccess || hipDeviceGetAttribute(&cus, hipDeviceAttributeMultiprocessorCount, dev) != hipSuccess) { fprintf(stderr, "kernel_launch: device query failed\n"); grid = -1; return; }
        if (hipFuncSetAttribute((const void*)fwd_kernel, hipFuncAttributeMaxDynamicSharedMemorySize, LDS_BYTES) != hipSuccess) { fprintf(stderr, "kernel_launch: hipFuncSetAttribute failed\n"); grid = -1; return; }
        if (hipOccupancyMaxActiveBlocksPerMultiprocessor(&per_cu, (const void*)fwd_kernel, NWAVES * 64, LDS_BYTES) != hipSuccess || per_cu < 1)
            fprintf(stderr, "kernel_launch: note: occupancy query reports %d workgroups per CU\n", per_cu);
        (void)hipGetLastError();
        grid = cus;
    }
    if (grid < 0) return;
    if (hipMemsetAsync((char*)d_ws + WS_CTL, 0, CTL_ZERO_BYTES, stream) != hipSuccess) { fprintf(stderr, "kernel_launch: hipMemsetAsync failed\n"); return; }
    Args a{};
    for (int i = 0; i < 16; ++i) a.in[i] = (const float*)d_in[i];
    a.out = (float*)d_out; a.ws = (unsigned char*)d_ws;
    if (MK_N_LAUNCHES == 1) { a.ph_lo = 0; a.ph_hi = N_PHASES; hipLaunchKernelGGL(fwd_kernel, dim3(grid), dim3(NWAVES * 64), LDS_BYTES, stream, a); }
    else for (int p = 0; p < N_PHASES; ++p) { a.ph_lo = p; a.ph_hi = p + 1; hipLaunchKernelGGL(fwd_kernel, dim3(grid), dim3(NWAVES * 64), LDS_BYTES, stream, a);
    }
    const hipError_t le = hipPeekAtLastError();
    if (le != hipSuccess) fprintf(stderr, "kernel_launch: launch failed: %s\n", hipGetErrorName(le));
}
```
